# Optimizing an MI355X kernel written in HIP

```python
import functools
import jax, jax.numpy as jnp
from jax import lax
import numpy as np

D_MODEL = 2048
BATCH = 2
SEQ = 4096
DEPTH = 1
DEC_BATCH = 32
DEC_SEQ = 4
PAST_LEN = 8192
PAGE_SIZE = 128

D_MIX = D_MODEL
D_RNN = D_MIX // 2
LRU_BLOCKS = 8
LRU_BW = D_RNN // LRU_BLOCKS
CONV_W = 4
LRU_C = 8.0
HEAD_DIM = 128
N_Q_HEADS = (D_MIX - D_RNN) // HEAD_DIM
N_KV_HEADS = 4
GQA_GROUP = N_Q_HEADS // N_KV_HEADS
IDX_HEADS = 8
IDX_DIM = 64
TOPK_MAX = 256
Q_BLOCK = 128
D_FF = 5504
LN_EPS = 1e-5
ALPHA = (2.0 * DEPTH) ** 0.25
BETA = (8.0 * DEPTH) ** -0.25
ATTN_SCALE = HEAD_DIM ** -0.5
IDX_SCALE = IDX_DIM ** -0.5
IDX_W_SCALE = IDX_HEADS ** -0.5
SPLIT_SIZES = (D_RNN, D_RNN, N_Q_HEADS * HEAD_DIM, N_KV_HEADS * HEAD_DIM,
               N_KV_HEADS * HEAD_DIM, IDX_HEADS * IDX_DIM, IDX_DIM, IDX_HEADS)
D_IN = sum(SPLIT_SIZES)
SPLIT_POINTS = tuple(int(s) for s in np.cumsum(SPLIT_SIZES)[:-1])

kernel_name = 'hymba_rglru_dsa_macaron_step'


def layer_norm(x, g, b):
    xf = x.astype(jnp.float32)
    mu = jnp.mean(xf, axis=-1, keepdims=True)
    var = jnp.mean(jnp.square(xf - mu), axis=-1, keepdims=True)
    return ((xf - mu) * lax.rsqrt(var + LN_EPS) * g + b).astype(x.dtype)


def swiglu(x, w_gu, w_down):
    gate, up = jnp.split(x @ w_gu, 2, axis=-1)
    return (jax.nn.silu(gate) * up) @ w_down


def causal_conv(x, buf, w, b):
    T = x.shape[1]
    xp = jnp.concatenate([buf.astype(x.dtype), x], axis=1)
    out = b + w[0] * xp[:, 0:T]
    for j in range(1, CONV_W):
        out = out + w[j] * xp[:, j:j + T]
    return out, xp[:, -(CONV_W - 1):]


def rg_lru(xc, h0, w_a, b_a, w_i, b_i, lam):
    B, T, _ = xc.shape
    xb = xc.reshape(B, T, LRU_BLOCKS, LRU_BW)
    r = jax.nn.sigmoid((jnp.einsum('btnc,ncd->btnd', xb, w_a).reshape(B, T, D_RNN) + b_a).astype(jnp.float32))
    i = jax.nn.sigmoid((jnp.einsum('btnc,ncd->btnd', xb, w_i).reshape(B, T, D_RNN) + b_i).astype(jnp.float32))
    log_a = -LRU_C * r * jax.nn.softplus(-lam.astype(jnp.float32))
    a = jnp.exp(log_a)
    u = jnp.sqrt(-jnp.expm1(2.0 * log_a)) * i * xc.astype(jnp.float32)
    u = u.at[:, 0].add(a[:, 0] * h0.astype(jnp.float32))

    def combine(left, right):
        return (left[0] * right[0], right[0] * left[1] + right[1])

    _, h = lax.associative_scan(combine, (a, u), axis=1)
    return h, h[:, -1]


def indexer_scores(qi, wi, ki):
    s = jax.nn.relu(jnp.einsum('bqhd,bld->bqhl', qi, ki).astype(jnp.float32) * IDX_SCALE)
    return jnp.einsum('bqhl,bqh->bql', s, wi.astype(jnp.float32) * IDX_W_SCALE)


def attend_selected(q, kg, vg, valid):
    B, Q = q.shape[:2]
    qg = q.reshape(B, Q, N_KV_HEADS, GQA_GROUP, HEAD_DIM)
    logits = jnp.einsum('bqngd,bqsnd->bqngs', qg, kg).astype(jnp.float32) * ATTN_SCALE
    logits = jnp.where(valid[:, :, None, None, :], logits, -jnp.inf)
    p = jax.nn.softmax(logits, axis=-1).astype(vg.dtype)
    o = jnp.einsum('bqngs,bqsnd->bqngd', p, vg)
    return o.reshape(B, Q, N_Q_HEADS * HEAD_DIM)


def select_and_attend(q, scores, admissible, t_pos, topk, gather):
    scores = jnp.where(admissible[None], scores, -jnp.inf)
    _, idx = lax.top_k(scores, topk)
    valid = idx <= t_pos[None, :, None]
    kg, vg = gather(idx)
    return attend_selected(q, kg, vg, valid)


def prompt_sparse_attention(q, k, v, qi, ki, wi):
    B, S = q.shape[:2]
    topk = min(TOPK_MAX, S // 4)
    n_blk = S // Q_BLOCK
    key_pos = jnp.arange(S)

    def to_blocks(a):
        return jnp.moveaxis(a.reshape((B, n_blk, Q_BLOCK) + a.shape[2:]), 1, 0)

    def gather(idx):
        take = jax.vmap(lambda rows, ii: rows[ii])
        return take(k, idx), take(v, idx)

    def one_block(args):
        qb, qib, wib, blk = args
        t = blk * Q_BLOCK + jnp.arange(Q_BLOCK)
        scores = indexer_scores(qib, wib, ki)
        admissible = key_pos[None, :] <= t[:, None]
        return select_and_attend(qb, scores, admissible, t, topk, gather)

    out = lax.map(one_block, (to_blocks(q), to_blocks(qi), to_blocks(wi), jnp.arange(n_blk)))
    return jnp.moveaxis(out, 0, 1).reshape(B, S, N_Q_HEADS * HEAD_DIM)


def sample_sparse_attention(q, k, v, qi, ki, wi, cache_k, cache_v, cache_k_idx, page_table):
    B, T = q.shape[:2]
    n_past = page_table.shape[1] * PAGE_SIZE
    L = n_past + T
    topk = min(TOPK_MAX, L // 4)
    past_ki = cache_k_idx[page_table].reshape(B, n_past, IDX_DIM)
    keys_idx = jnp.concatenate([past_ki, ki.astype(past_ki.dtype)], axis=1)
    t = n_past + jnp.arange(T)
    scores = indexer_scores(qi, wi, keys_idx)
    admissible = jnp.arange(L)[None, :] <= t[:, None]

    def gather(idx):
        in_past = idx < n_past
        pidx = jnp.minimum(idx, n_past - 1)
        phys = jax.vmap(lambda pt, ii: pt[ii])(page_table, pidx // PAGE_SIZE)
        off = pidx % PAGE_SIZE
        nidx = jnp.clip(idx - n_past, 0, T - 1)
        take = jax.vmap(lambda rows, ii: rows[ii])

        def pick(pool, new):
            past_rows = pool[phys, off]
            new_rows = take(new, nidx).astype(past_rows.dtype)
            return jnp.where(in_past[..., None, None], past_rows, new_rows)

        return pick(cache_k, k), pick(cache_v, v)

    return select_and_attend(q, scores, admissible, t, topk, gather)


def decoder_layer(x, attn_fn, conv_buf, h0, ln1_g, ln1_b, ffn1_w_gu, ffn1_w_down, w_in,
                  conv_w, conv_b, lru_w_a, lru_b_a, lru_w_i, lru_b_i, lru_lambda, w_out,
                  ln2_g, ln2_b, ffn2_w_gu, ffn2_w_down, ln3_g, ln3_b):
    B, T, _ = x.shape
    x = layer_norm(ALPHA * x + 0.5 * swiglu(x, ffn1_w_gu, ffn1_w_down), ln1_g, ln1_b)
    xr, gr, q, k, v, qi, ki, wi = jnp.split(x @ w_in, SPLIT_POINTS, axis=-1)
    xc, conv_state = causal_conv(xr, conv_buf, conv_w, conv_b)
    h, h_last = rg_lru(xc, h0, lru_w_a, lru_b_a, lru_w_i, lru_b_i, lru_lambda)
    rnn_out = h.astype(x.dtype) * jax.nn.gelu(gr)
    q = q.reshape(B, T, N_Q_HEADS, HEAD_DIM)
    k = k.reshape(B, T, N_KV_HEADS, HEAD_DIM)
    v = v.reshape(B, T, N_KV_HEADS, HEAD_DIM)
    qi = qi.reshape(B, T, IDX_HEADS, IDX_DIM)
    attn_out = attn_fn(q, k, v, qi, ki, wi)
    mix = jnp.concatenate([rnn_out, attn_out.astype(x.dtype)], axis=-1) @ w_out
    x = layer_norm(ALPHA * x + mix, ln2_g, ln2_b)
    x = layer_norm(ALPHA * x + 0.5 * swiglu(x, ffn2_w_gu, ffn2_w_down), ln3_g, ln3_b)
    return x, k, v, ki, conv_state, h_last


def setup_inputs(seed: int = 0) -> dict:
    key = jax.random.key(seed)
    ks = jax.random.split(key, 32)
    n_pages = PAST_LEN // PAGE_SIZE
    n_used = DEC_BATCH * n_pages
    n_pool = n_used + n_used // 4

    def nrm(k, shape, scale):
        return jax.random.normal(k, shape, jnp.float32) * scale

    u = jax.random.uniform(ks[19], (DEPTH, D_RNN), jnp.float32, minval=0.9, maxval=0.999)
    s = u ** (1.0 / LRU_C)
    return {
        'x_prompt': nrm(ks[0], (BATCH, SEQ, D_MODEL), 1.0),
        'x_sample': nrm(ks[1], (DEC_BATCH, DEC_SEQ, D_MODEL), 1.0),
        'cache_k': nrm(ks[2], (DEPTH, n_pool, PAGE_SIZE, N_KV_HEADS, HEAD_DIM), 1.0),
        'cache_v': nrm(ks[3], (DEPTH, n_pool, PAGE_SIZE, N_KV_HEADS, HEAD_DIM), 1.0),
        'cache_k_idx': nrm(ks[4], (DEPTH, n_pool, PAGE_SIZE, IDX_DIM), 1.0),
        'state_conv': nrm(ks[5], (DEPTH, DEC_BATCH, CONV_W - 1, D_RNN), 1.0),
        'state_rnn': nrm(ks[6], (DEPTH, DEC_BATCH, D_RNN), 0.5),
        'page_table': jax.random.permutation(ks[7], n_pool)[:n_used].reshape(DEC_BATCH, n_pages).astype(jnp.int32),
        'ln1_g': 1.0 + nrm(ks[8], (DEPTH, D_MODEL), 0.01),
        'ln1_b': nrm(ks[9], (DEPTH, D_MODEL), 0.01),
        'ffn1_w_gu': nrm(ks[10], (DEPTH, D_MODEL, 2 * D_FF), D_MODEL ** -0.5),
        'ffn1_w_down': nrm(ks[11], (DEPTH, D_FF, D_MODEL), BETA * D_FF ** -0.5),
        'w_in': nrm(ks[12], (DEPTH, D_MODEL, D_IN), D_MODEL ** -0.5),
        'conv_w': nrm(ks[13], (DEPTH, CONV_W, D_RNN), CONV_W ** -0.5),
        'conv_b': nrm(ks[14], (DEPTH, D_RNN), 0.01),
        'lru_w_a': nrm(ks[15], (DEPTH, LRU_BLOCKS, LRU_BW, LRU_BW), LRU_BW ** -0.5),
        'lru_b_a': nrm(ks[16], (DEPTH, D_RNN), 0.01),
        'lru_w_i': nrm(ks[17], (DEPTH, LRU_BLOCKS, LRU_BW, LRU_BW), LRU_BW ** -0.5),
        'lru_b_i': nrm(ks[18], (DEPTH, D_RNN), 0.01),
        'lru_lambda': jnp.log(s) - jnp.log1p(-s),
        'w_out': nrm(ks[20], (DEPTH, D_MIX, D_MODEL), BETA * D_MIX ** -0.5),
        'ln2_g': 1.0 + nrm(ks[21], (DEPTH, D_MODEL), 0.01),
        'ln2_b': nrm(ks[22], (DEPTH, D_MODEL), 0.01),
        'ffn2_w_gu': nrm(ks[23], (DEPTH, D_MODEL, 2 * D_FF), D_MODEL ** -0.5),
        'ffn2_w_down': nrm(ks[24], (DEPTH, D_FF, D_MODEL), BETA * D_FF ** -0.5),
        'ln3_g': 1.0 + nrm(ks[25], (DEPTH, D_MODEL), 0.01),
        'ln3_b': nrm(ks[26], (DEPTH, D_MODEL), 0.01),
    }


def reference(x_prompt, x_sample, cache_k, cache_v, cache_k_idx, state_conv, state_rnn, page_table,
              ln1_g, ln1_b, ffn1_w_gu, ffn1_w_down, w_in, conv_w, conv_b, lru_w_a, lru_b_a,
              lru_w_i, lru_b_i, lru_lambda, w_out, ln2_g, ln2_b, ffn2_w_gu, ffn2_w_down, ln3_g, ln3_b):
    B = x_prompt.shape[0]
    y_p, y_s = x_prompt, x_sample
    kp_l, vp_l, kip_l, cp_l, hp_l = [], [], [], [], []
    ks_l, vs_l, kis_l, cs_l, hs_l = [], [], [], [], []
    for l in range(DEPTH):
        lw = dict(ln1_g=ln1_g[l], ln1_b=ln1_b[l], ffn1_w_gu=ffn1_w_gu[l], ffn1_w_down=ffn1_w_down[l],
                  w_in=w_in[l], conv_w=conv_w[l], conv_b=conv_b[l], lru_w_a=lru_w_a[l],
                  lru_b_a=lru_b_a[l], lru_w_i=lru_w_i[l], lru_b_i=lru_b_i[l],
                  lru_lambda=lru_lambda[l], w_out=w_out[l], ln2_g=ln2_g[l], ln2_b=ln2_b[l],
                  ffn2_w_gu=ffn2_w_gu[l], ffn2_w_down=ffn2_w_down[l], ln3_g=ln3_g[l], ln3_b=ln3_b[l])
        y_p, kp, vp, kip, cp, hp = decoder_layer(
            y_p, prompt_sparse_attention,
            jnp.zeros((B, CONV_W - 1, D_RNN), y_p.dtype), jnp.zeros((B, D_RNN), jnp.float32), **lw)
        sample_attn = functools.partial(sample_sparse_attention, cache_k=cache_k[l], cache_v=cache_v[l],
                                        cache_k_idx=cache_k_idx[l], page_table=page_table)
        y_s, ksm, vsm, kism, csm, hsm = decoder_layer(y_s, sample_attn, state_conv[l], state_rnn[l], **lw)
        kp_l.append(kp); vp_l.append(vp); kip_l.append(kip); cp_l.append(cp); hp_l.append(hp)
        ks_l.append(ksm); vs_l.append(vsm); kis_l.append(kism); cs_l.append(csm); hs_l.append(hsm)
    return (y_p, y_s,
            jnp.stack(kp_l), jnp.stack(vp_l), jnp.stack(kip_l), jnp.stack(cp_l), jnp.stack(hp_l),
            jnp.stack(ks_l), jnp.stack(vs_l), jnp.stack(kis_l), jnp.stack(cs_l), jnp.stack(hs_l))
```

```cpp
#include <hip/hip_runtime.h>
#include <stdint.h>

namespace {
constexpr int D = 2048, SEQ = 4096, NB = 2, MP = NB * SEQ, DB = 32, DS = 4, MS = DB * DS, MT = MP + MS;
constexpr int DFF = 5504, DRNN = 1024, HD = 128, NKV = 4, IDH = 8, IDD = 64, DIN = 4680;
constexpr int NPAGES = 64, PAGE = 128, NPAST = NPAGES * PAGE, LS = NPAST + DS, TOPK = 256;
constexpr int C_XR = 0, C_GR = 1024, C_Q = 2048, C_K = 3072, C_V = 3584, C_QI = 4096, C_KI = 4608, C_WI = 4672;
constexpr float ALPHA = 1.189207115002721f, LN_EPS = 1e-5f, ATTN_SCALE = 0.08838834764831845f, IDX_SCALE = 0.125f, IDX_W_SCALE = 0.35355339059327373f;
constexpr size_t O_YP = 0, O_YS = 16777216, O_KP = 17039360, O_VP = 21233664, O_KIP = 25427968, O_CP = 25952256, O_HP = 25958400,
                 O_KS = 25960448, O_VS = 26025984, O_KIS = 26091520, O_CS = 26099712, O_HS = 26198016;
constexpr int SCS_LD = 8256;

__global__ __launch_bounds__(256) void sgemm(const float* __restrict__ A, int lda, const float* __restrict__ B, int ldb, float* __restrict__ C, int ldc,
                                             int M, int N, int K, long sA, long sB, long sC) {
    __shared__ float As[16][132];
    __shared__ float Bs[16][132];
    A += sA * blockIdx.z; B += sB * blockIdx.z; C += sC * blockIdx.z;
    const int tid = threadIdx.x, tx = tid & 15, ty = tid >> 4;
    const int m0 = blockIdx.y * 128, n0 = blockIdx.x * 128;
    float acc[8][8];
#pragma unroll
    for (int i = 0; i < 8; ++i)
#pragma unroll
        for (int j = 0; j < 8; ++j) acc[i][j] = 0.f;
    for (int k0 = 0; k0 < K; k0 += 16) {
#pragma unroll
        for (int i = 0; i < 8; ++i) {
            const int e = tid + 256 * i, m = e >> 4, k = e & 15, gm = m0 + m;
            As[k][m] = (gm < M) ? A[(size_t)gm * lda + k0 + k] : 0.f;
        }
#pragma unroll
        for (int i = 0; i < 8; ++i) {
            const int e = tid + 256 * i, k = e >> 7, n = e & 127, gn = n0 + n;
            Bs[k][n] = (gn < N) ? B[(size_t)(k0 + k) * ldb + gn] : 0.f;
        }
        __syncthreads();
#pragma unroll
        for (int k = 0; k < 16; ++k) {
            float a[8], b[8];
#pragma unroll
            for (int i = 0; i < 8; ++i) a[i] = As[k][ty * 8 + i];
#pragma unroll
            for (int j = 0; j < 8; ++j) b[j] = Bs[k][tx * 8 + j];
#pragma unroll
            for (int i = 0; i < 8; ++i)
#pragma unroll
                for (int j = 0; j < 8; ++j) acc[i][j] = fmaf(a[i], b[j], acc[i][j]);
        }
        __syncthreads();
    }
#pragma unroll
    for (int i = 0; i < 8; ++i) {
        const int gm = m0 + ty * 8 + i;
        if (gm < M) {
#pragma unroll
            for (int j = 0; j < 8; ++j) { const int gn = n0 + tx * 8 + j; if (gn < N) C[(size_t)gm * ldc + gn] = acc[i][j]; }
        }
    }
}

__device__ __forceinline__ float sigmoidf_(float x) { return 1.0f / (1.0f + expf(-x)); }
__device__ __forceinline__ float gelu_tanh(float x) { return 0.5f * x * (1.0f + tanhf(0.7978845608028654f * (x + 0.044715f * x * x * x))); }

__global__ void swiglu_k(const float* __restrict__ GU, float* __restrict__ H) {
    const size_t n = (size_t)MT * DFF;
    for (size_t i = (size_t)blockIdx.x * blockDim.x + threadIdx.x; i < n; i += (size_t)gridDim.x * blockDim.x) {
        const size_t r = i / DFF, j = i % DFF;
        const float g = GU[r * (2 * DFF) + j], u = GU[r * (2 * DFF) + DFF + j];
        H[i] = g * sigmoidf_(g) * u;
    }
}

__device__ __forceinline__ float block_sum_256(float v, float* red) {
#pragma unroll
    for (int o = 32; o >= 1; o >>= 1) v += __shfl_xor(v, o);
    __syncthreads();
    if ((threadIdx.x & 63) == 0) red[threadIdx.x >> 6] = v;
    __syncthreads();
    return red[0] + red[1] + red[2] + red[3];
}

__global__ __launch_bounds__(256) void resid_ln_k(const float* __restrict__ X, const float* __restrict__ Y, float s, const float* __restrict__ g, const float* __restrict__ b,
                                                  float* __restrict__ out, float* __restrict__ out2) {
    __shared__ float red[4];
    const int r = blockIdx.x, t = threadIdx.x;
    float v[8]; float sum = 0.f;
#pragma unroll
    for (int i = 0; i < 8; ++i) { const int c = t + 256 * i; v[i] = ALPHA * X[(size_t)r * D + c] + s * Y[(size_t)r * D + c]; sum += v[i]; }
    const float mean = block_sum_256(sum, red) * (1.0f / D);
    float q = 0.f;
#pragma unroll
    for (int i = 0; i < 8; ++i) { const float d = v[i] - mean; q += d * d; }
    const float var = block_sum_256(q, red) * (1.0f / D);
    const float rstd = rsqrtf(var + LN_EPS);
#pragma unroll
    for (int i = 0; i < 8; ++i) { const int c = t + 256 * i; const float o = (v[i] - mean) * rstd * g[c] + b[c]; out[(size_t)r * D + c] = o; if (out2) out2[(size_t)r * D + c] = o; }
}

__global__ void copy_kv_k(const float* __restrict__ Z, float* __restrict__ out) {
    const int r = blockIdx.x;
    const float* z = Z + (size_t)r * DIN;
    float* ko; float* vo; float* kio;
    if (r < MP) { ko = out + O_KP + (size_t)r * 512; vo = out + O_VP + (size_t)r * 512; kio = out + O_KIP + (size_t)r * 64; }
    else { const int rs = r - MP; ko = out + O_KS + (size_t)rs * 512; vo = out + O_VS + (size_t)rs * 512; kio = out + O_KIS + (size_t)rs * 64; }
    for (int c = threadIdx.x; c < 512; c += blockDim.x) { ko[c] = z[C_K + c]; vo[c] = z[C_V + c]; }
    for (int c = threadIdx.x; c < 64; c += blockDim.x) kio[c] = z[C_KI + c];
}

__global__ void conv_k(const float* __restrict__ Z, const float* __restrict__ state_conv, const float* __restrict__ cw, const float* __restrict__ cb,
                       float* __restrict__ XC, float* __restrict__ out) {
    const int r = blockIdx.x;
    for (int c = threadIdx.x; c < DRNN; c += blockDim.x) {
        float acc = cb[c];
        if (r < MP) {
            const int b = r / SEQ, t = r % SEQ;
#pragma unroll
            for (int j = 0; j < 4; ++j) { const int tt = t + j - 3; if (tt >= 0) acc += cw[j * DRNN + c] * Z[(size_t)(b * SEQ + tt) * DIN + C_XR + c]; }
            if (t >= SEQ - 3) out[O_CP + (size_t)(b * 3 + (t - (SEQ - 3))) * DRNN + c] = Z[(size_t)r * DIN + C_XR + c];
        } else {
            const int rs = r - MP, b = rs / DS, t = rs % DS;
#pragma unroll
            for (int j = 0; j < 4; ++j) { const int p = t + j; const float xv = (p < 3) ? state_conv[(size_t)(b * 3 + p) * DRNN + c] : Z[(size_t)(MP + b * DS + p - 3) * DIN + C_XR + c]; acc += cw[j * DRNN + c] * xv; }
            if (t >= 1) out[O_CS + (size_t)(b * 3 + (t - 1)) * DRNN + c] = Z[(size_t)r * DIN + C_XR + c];
        }
        XC[(size_t)r * DRNN + c] = acc;
    }
}

__global__ void scan_k(const float* __restrict__ XC, const float* __restrict__ GA, const float* __restrict__ GI, const float* __restrict__ Z,
                       const float* __restrict__ ba, const float* __restrict__ bi, const float* __restrict__ lam, const float* __restrict__ state_rnn,
                       float* __restrict__ CAT, float* __restrict__ out) {
    const int idx = blockIdx.x * blockDim.x + threadIdx.x;
    if (idx >= (NB + DB) * DRNN) return;
    const int s = idx / DRNN, c = idx % DRNN;
    int row0, T; float h;
    if (s < NB) { row0 = s * SEQ; T = SEQ; h = 0.f; } else { row0 = MP + (s - NB) * DS; T = DS; h = state_rnn[(size_t)(s - NB) * DRNN + c]; }
    const float l = lam[c];
    const float sp = (-l > 20.f) ? -l : log1pf(expf(-l));
    const float bac = ba[c], bic = bi[c];
    for (int t = 0; t < T; ++t) {
        const size_t r = (size_t)(row0 + t);
        const float xc = XC[r * DRNN + c];
        const float rg = sigmoidf_(GA[r * DRNN + c] + bac), ig = sigmoidf_(GI[r * DRNN + c] + bic);
        const float log_a = -8.0f * rg * sp;
        const float a = expf(log_a);
        const float u = sqrtf(-expm1f(2.0f * log_a)) * ig * xc;
        h = a * h + u;
        CAT[r * D + c] = h * gelu_tanh(Z[r * DIN + C_GR + c]);
    }
    if (s < NB) out[O_HP + (size_t)s * DRNN + c] = h; else out[O_HS + (size_t)(s - NB) * DRNN + c] = h;
}

__global__ __launch_bounds__(256) void idx_score_k(const float* __restrict__ Z, const float* __restrict__ cache_ki, const int* __restrict__ page_table,
                                                   float* __restrict__ SCP, float* __restrict__ SCS) {
    __shared__ float qs[IDH * IDD];
    __shared__ float ws[IDH];
    const int r = blockIdx.x;
    const float* z = Z + (size_t)r * DIN;
    for (int i = threadIdx.x; i < IDH * IDD; i += 256) qs[i] = z[C_QI + i];
    if (threadIdx.x < IDH) ws[threadIdx.x] = z[C_WI + threadIdx.x] * IDX_W_SCALE;
    __syncthreads();
    int nkeys, b; float* sc;
    if (r < MP) { b = r / SEQ; nkeys = (r % SEQ) + 1; sc = SCP + (size_t)r * SEQ; }
    else { const int rs = r - MP; b = rs / DS; nkeys = NPAST + (rs % DS) + 1; sc = SCS + (size_t)rs * SCS_LD; }
    for (int key = threadIdx.x; key < nkeys; key += 256) {
        const float* kp;
        if (r < MP) kp = Z + (size_t)(b * SEQ + key) * DIN + C_KI;
        else if (key < NPAST) kp = cache_ki + ((size_t)page_table[b * NPAGES + key / PAGE] * PAGE + (key % PAGE)) * IDD;
        else kp = Z + (size_t)(MP + b * DS + key - NPAST) * DIN + C_KI;
        float kv[IDD];
#pragma unroll
        for (int d = 0; d < IDD; d += 4) { const float4 t4 = *(const float4*)(kp + d); kv[d] = t4.x; kv[d + 1] = t4.y; kv[d + 2] = t4.z; kv[d + 3] = t4.w; }
        float tot = 0.f;
#pragma unroll
        for (int h = 0; h < IDH; ++h) {
            float dot = 0.f;
#pragma unroll
            for (int d = 0; d < IDD; ++d) dot = fmaf(qs[h * IDD + d], kv[d], dot);
            tot += fmaxf(dot * IDX_SCALE, 0.f) * ws[h];
        }
        sc[key] = tot;
    }
}

__device__ __forceinline__ unsigned fkey(float f) { const unsigned u = __float_as_uint(f); return (u & 0x80000000u) ? ~u : (u | 0x80000000u); }

__global__ __launch_bounds__(256) void topk_k(const float* __restrict__ SCP, const float* __restrict__ SCS, int* __restrict__ SEL, int* __restrict__ NSEL) {
    __shared__ unsigned cnt_s;
    __shared__ unsigned pos_s;
    const int r = blockIdx.x, t = threadIdx.x;
    int n; const float* sc;
    if (r < MP) { n = (r % SEQ) + 1; sc = SCP + (size_t)r * SEQ; } else { const int rs = r - MP; n = NPAST + (rs % DS) + 1; sc = SCS + (size_t)rs * SCS_LD; }
    int* sel = SEL + (size_t)r * TOPK;
    if (n <= TOPK) { if (t < n) sel[t] = t; if (t == 0) NSEL[r] = n; return; }
    unsigned prefix = 0u;
    for (int bit = 31; bit >= 0; --bit) {
        const unsigned cand = prefix | (1u << bit);
        if (t == 0) cnt_s = 0u;
        __syncthreads();
        unsigned c = 0;
        for (int i = t; i < n; i += 256) c += (fkey(sc[i]) >= cand) ? 1u : 0u;
#pragma unroll
        for (int o = 32; o >= 1; o >>= 1) c += __shfl_xor(c, o);
        if ((t & 63) == 0) atomicAdd(&cnt_s, c);
        __syncthreads();
        if (cnt_s >= (unsigned)TOPK) prefix = cand;
        __syncthreads();
    }
    __shared__ unsigned cnts[256];
    unsigned c = 0;
    for (int i = t; i < n; i += 256) c += (fkey(sc[i]) > prefix) ? 1u : 0u;
    cnts[t] = c;
    __syncthreads();
    unsigned p = 0;
    for (int j = 0; j < t; ++j) p += cnts[j];
    for (int i = t; i < n; i += 256) if (fkey(sc[i]) > prefix) sel[p++] = i;
    if (t == 255) pos_s = p;
    __syncthreads();
    if (t == 0) {
        unsigned q = pos_s;
        for (int i = 0; i < n && q < (unsigned)TOPK; ++i) if (fkey(sc[i]) == prefix) sel[q++] = i;
        NSEL[r] = TOPK;
    }
}

__global__ __launch_bounds__(256) void attn_k(const float* __restrict__ Z, const float* __restrict__ cache_k, const float* __restrict__ cache_v, const int* __restrict__ page_table,
                                              const int* __restrict__ SEL, const int* __restrict__ NSEL, float* __restrict__ CAT) {
    __shared__ float qs[1024];
    __shared__ float ps[8][TOPK];
    __shared__ const float* kptr[TOPK];
    __shared__ const float* vptr[TOPK];
    __shared__ float red[8][4];
    const int r = blockIdx.x, t = threadIdx.x;
    const float* z = Z + (size_t)r * DIN;
    for (int i = t; i < 1024; i += 256) qs[i] = z[C_Q + i];
    const int ns = NSEL[r];
    float lg[8];
    if (t < ns) {
        const int idx = SEL[(size_t)r * TOPK + t];
        const float* kp; const float* vp;
        if (r < MP) { const int b = r / SEQ; kp = Z + (size_t)(b * SEQ + idx) * DIN + C_K; vp = Z + (size_t)(b * SEQ + idx) * DIN + C_V; }
        else {
            const int b = (r - MP) / DS;
            if (idx < NPAST) { const size_t row = (size_t)page_table[b * NPAGES + idx / PAGE] * PAGE + (idx % PAGE); kp = cache_k + row * 512; vp = cache_v + row * 512; }
            else { const size_t zr = (size_t)(MP + b * DS + idx - NPAST); kp = Z + zr * DIN + C_K; vp = Z + zr * DIN + C_V; }
        }
        kptr[t] = kp; vptr[t] = vp;
    }
    __syncthreads();
    if (t < ns) {
        const float* kp = kptr[t];
#pragma unroll
        for (int h = 0; h < 8; ++h) lg[h] = 0.f;
#pragma unroll
        for (int n = 0; n < NKV; ++n) {
            float d0 = 0.f, d1 = 0.f;
            for (int d = 0; d < HD; d += 4) {
                const float4 k4 = *(const float4*)(kp + n * HD + d);
                const float* q0 = qs + (2 * n) * HD + d; const float* q1 = qs + (2 * n + 1) * HD + d;
                d0 += q0[0] * k4.x + q0[1] * k4.y + q0[2] * k4.z + q0[3] * k4.w;
                d1 += q1[0] * k4.x + q1[1] * k4.y + q1[2] * k4.z + q1[3] * k4.w;
            }
            lg[2 * n] = d0 * ATTN_SCALE; lg[2 * n + 1] = d1 * ATTN_SCALE;
        }
    } else {
#pragma unroll
        for (int h = 0; h < 8; ++h) lg[h] = -INFINITY;
    }
#pragma unroll
    for (int h = 0; h < 8; ++h) {
        float m = lg[h];
#pragma unroll
        for (int o = 32; o >= 1; o >>= 1) m = fmaxf(m, __shfl_xor(m, o));
        if ((t & 63) == 0) red[h][t >> 6] = m;
    }
    __syncthreads();
    float e[8];
#pragma unroll
    for (int h = 0; h < 8; ++h) {
        const float m = fmaxf(fmaxf(red[h][0], red[h][1]), fmaxf(red[h][2], red[h][3]));
        e[h] = (t < ns) ? expf(lg[h] - m) : 0.f;
    }
    __syncthreads();
#pragma unroll
    for (int h = 0; h < 8; ++h) {
        float s = e[h];
#pragma unroll
        for (int o = 32; o >= 1; o >>= 1) s += __shfl_xor(s, o);
        if ((t & 63) == 0) red[h][t >> 6] = s;
    }
    __syncthreads();
#pragma unroll
    for (int h = 0; h < 8; ++h) { const float s = red[h][0] + red[h][1] + red[h][2] + red[h][3]; ps[h][t] = e[h] / s; }
    __syncthreads();
#pragma unroll
    for (int i = 0; i < 4; ++i) {
        const int o = t + 256 * i, hq = o >> 7, d = o & 127, n = hq >> 1;
        float acc = 0.f;
        for (int j = 0; j < ns; ++j) acc = fmaf(ps[hq][j], vptr[j][n * HD + d], acc);
        CAT[(size_t)r * D + 1024 + o] = acc;
    }
}
}

extern "C" void kernel_launch(void* const* d_in, const int* in_sizes, int n_in, void* d_out, int out_size, void* d_ws, size_t ws_size, hipStream_t stream) {
    const float* x_prompt = (const float*)d_in[0];   const float* x_sample = (const float*)d_in[1];
    const float* cache_k = (const float*)d_in[2];    const float* cache_v = (const float*)d_in[3];
    const float* cache_ki = (const float*)d_in[4];   const float* state_conv = (const float*)d_in[5];
    const float* state_rnn = (const float*)d_in[6];  const int* page_table = (const int*)d_in[7];
    const float* ln1_g = (const float*)d_in[8];      const float* ln1_b = (const float*)d_in[9];
    const float* w_gu1 = (const float*)d_in[10];     const float* w_d1 = (const float*)d_in[11];
    const float* w_in = (const float*)d_in[12];      const float* conv_w = (const float*)d_in[13];
    const float* conv_b = (const float*)d_in[14];    const float* lru_wa = (const float*)d_in[15];
    const float* lru_ba = (const float*)d_in[16];    const float* lru_wi = (const float*)d_in[17];
    const float* lru_bi = (const float*)d_in[18];    const float* lru_lam = (const float*)d_in[19];
    const float* w_out = (const float*)d_in[20];     const float* ln2_g = (const float*)d_in[21];
    const float* ln2_b = (const float*)d_in[22];     const float* w_gu2 = (const float*)d_in[23];
    const float* w_d2 = (const float*)d_in[24];      const float* ln3_g = (const float*)d_in[25];
    const float* ln3_b = (const float*)d_in[26];
    float* out = (float*)d_out;
    float* ws = (float*)d_ws; size_t off = 0;
    auto take = [&](size_t n) { float* p = ws + off; off += (n + 63) & ~(size_t)63; return p; };
    float* X0 = take((size_t)MT * D);
    float* GU = take((size_t)MT * 2 * DFF);
    float* H = take((size_t)MT * DFF);
    float* Y = take((size_t)MT * D);
    float* X1 = take((size_t)MT * D);
    float* Z = take((size_t)MT * DIN);
    float* XC = take((size_t)MT * DRNN);
    float* GA = take((size_t)MT * DRNN);
    float* GI = take((size_t)MT * DRNN);
    float* CAT = take((size_t)MT * D);
    float* SCP = take((size_t)MP * SEQ);
    float* SCS = take((size_t)MS * SCS_LD);
    int* SEL = (int*)take((size_t)MT * TOPK);
    int* NSEL = (int*)take((size_t)MT);
    float* X2 = take((size_t)MT * D);
    float* X3 = take((size_t)MT * D);

    hipMemcpyAsync(X0, x_prompt, (size_t)MP * D * 4, hipMemcpyDeviceToDevice, stream);
    hipMemcpyAsync(X0 + (size_t)MP * D, x_sample, (size_t)MS * D * 4, hipMemcpyDeviceToDevice, stream);
    auto gemm = [&](const float* A, int lda, const float* B, int ldb, float* C, int ldc, int M, int N, int K, int batch, long sA, long sB, long sC) {
        dim3 g((N + 127) / 128, (M + 127) / 128, batch);
        sgemm<<<g, 256, 0, stream>>>(A, lda, B, ldb, C, ldc, M, N, K, sA, sB, sC);
    };
    gemm(X0, D, w_gu1, 2 * DFF, GU, 2 * DFF, MT, 2 * DFF, D, 1, 0, 0, 0);
    swiglu_k<<<4096, 256, 0, stream>>>(GU, H);
    gemm(H, DFF, w_d1, D, Y, D, MT, D, DFF, 1, 0, 0, 0);
    resid_ln_k<<<MT, 256, 0, stream>>>(X0, Y, 0.5f, ln1_g, ln1_b, X1, nullptr);
    gemm(X1, D, w_in, DIN, Z, DIN, MT, DIN, D, 1, 0, 0, 0);
    copy_kv_k<<<MT, 256, 0, stream>>>(Z, out);
    conv_k<<<MT, 256, 0, stream>>>(Z, state_conv, conv_w, conv_b, XC, out);
    gemm(XC, DRNN, lru_wa, 128, GA, DRNN, MT, 128, 128, 8, 128, 128 * 128, 128);
    gemm(XC, DRNN, lru_wi, 128, GI, DRNN, MT, 128, 128, 8, 128, 128 * 128, 128);
    scan_k<<<((NB + DB) * DRNN + 255) / 256, 256, 0, stream>>>(XC, GA, GI, Z, lru_ba, lru_bi, lru_lam, state_rnn, CAT, out);
    idx_score_k<<<MT, 256, 0, stream>>>(Z, cache_ki, page_table, SCP, SCS);
    topk_k<<<MT, 256, 0, stream>>>(SCP, SCS, SEL, NSEL);
    attn_k<<<MT, 256, 0, stream>>>(Z, cache_k, cache_v, page_table, SEL, NSEL, CAT);
    gemm(CAT, D, w_out, D, Y, D, MT, D, D, 1, 0, 0, 0);
    resid_ln_k<<<MT, 256, 0, stream>>>(X1, Y, 1.0f, ln2_g, ln2_b, X2, nullptr);
    gemm(X2, D, w_gu2, 2 * DFF, GU, 2 * DFF, MT, 2 * DFF, D, 1, 0, 0, 0);
    swiglu_k<<<4096, 256, 0, stream>>>(GU, H);
    gemm(H, DFF, w_d2, D, Y, D, MT, D, DFF, 1, 0, 0, 0);
    resid_ln_k<<<MT, 256, 0, stream>>>(X2, Y, 0.5f, ln3_g, ln3_b, X3, out + O_YP);
}
```

```cpp
#include <hip/hip_runtime.h>
#include <stdint.h>

namespace pg8 {
#define PG8_LAS __attribute__((address_space(3)))
typedef unsigned short bf16_t;
typedef short bf16x8 __attribute__((ext_vector_type(8)));
typedef float f32x4 __attribute__((ext_vector_type(4)));
typedef unsigned u32x4 __attribute__((ext_vector_type(4)));
constexpr int BM = 256, BK = 64, HALF = 128, HTB = HALF * BK * 2  , STAGE_BYTES = 8 * HTB, NXCD = 8, WGM = 8;

__host__ __device__ __forceinline__ int lds_byte(int r, int c) { const int st = (r >> 4) * 2 + (c >> 5), rr = r & 15, cc = c & 31, ob = rr * 64 + cc * 2; return st * 1024 + (ob ^ (((ob >> 9) & 1) << 5)); }
__host__ __device__ __forceinline__ void stage_rc(int b, int& R, int& C) { const int st = b / 1024, sb = b % 1024, swz = sb ^ (((sb >> 9) & 1) << 5); R = (st >> 1) * 16 + swz / 64; C = (st & 1) * 32 + (swz % 64) / 2; }
__host__ __device__ __forceinline__ int perm32(int rho) { const int n = rho >> 4, i = rho & 15; return 8 * (i >> 2) + 4 * n + (i & 3); }

struct Unit { int pm, pn; };
struct Gemm { const bf16_t* A; const bf16_t* Bt; int M, N, K; };

struct StaticOrder {
    int nM, nN, nwg, G, c;
    __host__ __device__ void init(int M, int N, int G_, int c_) { nM = M / BM; nN = N / BM; nwg = nM * nN; G = G_; c = c_; }
    __host__ __device__ bool next(int i, Unit& u) const {
        const long L = (long)i * G + c; if (L >= nwg) return false;
        int wgid = (int)L; { const int q = nwg / NXCD, r = nwg % NXCD, xcd = wgid % NXCD, off = wgid / NXCD; wgid = (xcd < r ? xcd * (q + 1) : r * (q + 1) + (xcd - r) * q) + off; }
        const int nig = WGM * nN, gid = wgid / nig, fm = gid * WGM, gsz = (nM - fm) < WGM ? (nM - fm) : WGM;
        u.pm = fm + ((wgid % nig) % gsz); u.pn = (wgid % nig) / gsz; return true;
    }
    __device__ __forceinline__ void a_ready(const Unit&) const {}
    __device__ __forceinline__ void done(const Unit&) const {}
};

__device__ __forceinline__ unsigned cvt_pk_bf16(float lo, float hi) { unsigned r; asm volatile("v_cvt_pk_bf16_f32 %0, %1, %2" : "=v"(r) : "v"(lo), "v"(hi)); return r; }
typedef float f32x2 __attribute__((ext_vector_type(2)));

template <class Epi, class Sched, bool ALIGN_EPI = false, bool SP2 = false>
__device__ __forceinline__ void gemm_phase(PG8_LAS unsigned char* lds, const Gemm g, const Sched& S, const Epi& E) {
    const int tid = threadIdx.x, wid = __builtin_amdgcn_readfirstlane(tid >> 6), lane = tid & 63, wr = wid >> 2, wc = wid & 3, fr = lane & 15, fq = lane >> 4;
    const int K = g.K, nt = K / BK;
    unsigned voffA[2], voffB[2];
#pragma unroll
    for (int i = 0; i < 2; ++i) { int R, C; stage_rc(tid * 16 + i * 8192, R, C); const int Rb = Epi::PERM ? ((R & ~31) + perm32(R & 31)) : R;
        voffA[i] = (unsigned)(R * K + C) * 2u; voffB[i] = (unsigned)(Rb * K + C) * 2u; }
    const size_t kstep = (size_t)(BK * 2);
    const size_t hstep = (size_t)HALF * K * 2;
    const size_t tstep = 2 * hstep;
    const unsigned ldsw = (unsigned)wid * 1024u;
    const int aoff = lds_byte(wr * 64 + fr, fq * 8), boff = lds_byte(wc * 32 + fr, fq * 8);
#define PG8_SA(b, h) (((b) * 2 + (h)) * HTB)
#define PG8_SB(b, h) ((4 + (b) * 2 + (h)) * HTB)
#define PG8_STAGE(bufoff, gbase, voff) do { _Pragma("unroll") for (int _i = 0; _i < 2; ++_i) \
        __builtin_amdgcn_global_load_lds((const unsigned*)((const char*)(gbase) + (voff)[_i]), (PG8_LAS unsigned*)(lds + (bufoff) + ldsw + _i * 8192), 16, 0, 0); } while (0)
#define PG8_LDA(dst, b, h) do { _Pragma("unroll") for (int m = 0; m < 4; ++m) _Pragma("unroll") for (int k = 0; k < 2; ++k) dst[m][k] = *(const PG8_LAS bf16x8*)(lds + PG8_SA(b, h) + aoff + m * 2048 + k * 1024); } while (0)
#define PG8_LDB(dst, b, h) do { _Pragma("unroll") for (int n = 0; n < 2; ++n) _Pragma("unroll") for (int k = 0; k < 2; ++k) dst[n][k] = *(const PG8_LAS bf16x8*)(lds + PG8_SB(b, h) + boff + n * 2048 + k * 1024); } while (0)
#define PG8_MMA(ai, bj, At, Bt) do { __builtin_amdgcn_s_setprio(1); _Pragma("unroll") for (int m = 0; m < 4; ++m) _Pragma("unroll") for (int n = 0; n < 2; ++n) _Pragma("unroll") for (int k = 0; k < 2; ++k) \
        acc[ai][bj][m][n] = __builtin_amdgcn_mfma_f32_16x16x32_bf16(Bt[n][k], At[m][k], acc[ai][bj][m][n], 0, 0, 0); __builtin_amdgcn_s_setprio(0); } while (0)
#define PG8_WAIT_V(n) asm volatile("s_waitcnt vmcnt(" #n ")" ::: "memory")
#define PG8_WAIT_L(n) asm volatile("s_waitcnt lgkmcnt(" #n ")" ::: "memory")
#define PG8_BAR __builtin_amdgcn_s_barrier()
#define PG8_SCHED __builtin_amdgcn_sched_barrier(0)
    Unit cur, nxt; int ui = 0;
    if (!S.next(0, cur)) return;
    f32x4 acc[2][2][4][2];
#pragma unroll
    for (int a = 0; a < 2; ++a)
#pragma unroll
        for (int b = 0; b < 2; ++b)
#pragma unroll
            for (int m = 0; m < 4; ++m)
#pragma unroll
                for (int n = 0; n < 2; ++n) acc[a][b][m][n] = (f32x4){0.f, 0.f, 0.f, 0.f};
    bf16x8 At[4][2], B0[2][2], B1[2][2];
    const char* cA = (const char*)g.A + (size_t)cur.pm * tstep; const char* cB = (const char*)g.Bt + (size_t)cur.pn * tstep;
    S.a_ready(cur);
    if constexpr (SP2) {
        PG8_STAGE(PG8_SB(0, 0), cB, voffB); PG8_STAGE(PG8_SB(0, 1), cB + hstep, voffB); PG8_STAGE(PG8_SA(0, 0), cA, voffA); PG8_STAGE(PG8_SA(0, 1), cA + hstep, voffA);
        if (wr == 1) PG8_BAR;
        PG8_WAIT_V(2); PG8_BAR;
        PG8_STAGE(PG8_SB(1, 0), cB + kstep, voffB); PG8_STAGE(PG8_SA(1, 0), cA + kstep, voffA); PG8_STAGE(PG8_SB(1, 1), cB + hstep + kstep, voffB);
        PG8_WAIT_V(6); PG8_BAR;
    } else {
        PG8_STAGE(PG8_SB(0, 0), cB, voffB); PG8_STAGE(PG8_SA(0, 0), cA, voffA); PG8_STAGE(PG8_SB(0, 1), cB + hstep, voffB); PG8_STAGE(PG8_SA(0, 1), cA + hstep, voffA);
        if (wr == 1) PG8_BAR;
        PG8_WAIT_V(4); PG8_BAR;
        PG8_STAGE(PG8_SB(1, 0), cB + kstep, voffB); PG8_STAGE(PG8_SA(1, 0), cA + kstep, voffA); PG8_STAGE(PG8_SB(1, 1), cB + hstep + kstep, voffB);
        PG8_WAIT_V(6); PG8_BAR;
    }
    for (;;) {
        const bool has_next = S.next(ui + 1, nxt);
        const char* nA = has_next ? (const char*)g.A + (size_t)nxt.pm * tstep : cA; const char* nB = has_next ? (const char*)g.Bt + (size_t)nxt.pn * tstep : cB;
        for (int t = 0; t < nt; t += 2) {
            const bool last = (t == nt - 2);
            const char* a1 = cA + (size_t)(t + 1) * kstep;
            const char* a2 = last ? nA : cA + (size_t)(t + 2) * kstep; const char* b2 = last ? nB : cB + (size_t)(t + 2) * kstep;
            const char* a3 = a2 + kstep; const char* b3 = b2 + kstep;
            if (last && has_next) S.a_ready(nxt);
            if constexpr (SP2) {
            PG8_LDB(B0, 0, 0); PG8_LDB(B1, 0, 1); PG8_SCHED; PG8_LDA(At, 0, 0); PG8_STAGE(PG8_SA(1, 1), a1 + hstep, voffA);
            PG8_WAIT_V(8); PG8_WAIT_L(0); PG8_BAR; PG8_MMA(0, 0, At, B0); PG8_MMA(0, 1, At, B1); PG8_BAR; PG8_SCHED;
            PG8_LDA(At, 0, 1); PG8_STAGE(PG8_SB(0, 0), b2, voffB); PG8_STAGE(PG8_SB(0, 1), b2 + hstep, voffB); PG8_STAGE(PG8_SA(0, 0), a2, voffA);
            PG8_WAIT_V(8); PG8_WAIT_L(0); PG8_BAR; PG8_MMA(1, 0, At, B0); PG8_MMA(1, 1, At, B1); PG8_BAR; PG8_SCHED;
            PG8_LDB(B0, 1, 0); PG8_LDB(B1, 1, 1); PG8_SCHED; PG8_LDA(At, 1, 0); PG8_STAGE(PG8_SA(0, 1), a2 + hstep, voffA);
            PG8_WAIT_V(8); PG8_WAIT_L(0); PG8_BAR; PG8_MMA(0, 0, At, B0); PG8_MMA(0, 1, At, B1); PG8_BAR; PG8_SCHED;
            PG8_LDA(At, 1, 1); PG8_STAGE(PG8_SB(1, 0), b3, voffB); PG8_STAGE(PG8_SB(1, 1), b3 + hstep, voffB); PG8_STAGE(PG8_SA(1, 0), a3, voffA);
            PG8_WAIT_V(8); PG8_WAIT_L(0); PG8_BAR; PG8_MMA(1, 0, At, B0); PG8_MMA(1, 1, At, B1); PG8_BAR; PG8_SCHED;
            } else {
            PG8_LDB(B0, 0, 0); PG8_SCHED; PG8_LDA(At, 0, 0); PG8_STAGE(PG8_SA(1, 1), a1 + hstep, voffA);
            PG8_WAIT_L(8); PG8_BAR; PG8_WAIT_L(0); PG8_MMA(0, 0, At, B0); PG8_BAR; PG8_SCHED;
            PG8_LDB(B1, 0, 1); PG8_STAGE(PG8_SB(0, 0), b2, voffB);
            PG8_BAR; PG8_WAIT_L(0); PG8_MMA(0, 1, At, B1); PG8_BAR;
            PG8_LDA(At, 0, 1); PG8_STAGE(PG8_SA(0, 0), a2, voffA);
            PG8_BAR; PG8_WAIT_L(0); PG8_MMA(1, 0, At, B0); PG8_BAR; PG8_SCHED;
            PG8_STAGE(PG8_SB(0, 1), b2 + hstep, voffB);
            PG8_WAIT_V(6); PG8_BAR; PG8_MMA(1, 1, At, B1); PG8_BAR;
            PG8_LDB(B0, 1, 0); PG8_SCHED; PG8_LDA(At, 1, 0); PG8_STAGE(PG8_SA(0, 1), a2 + hstep, voffA);
            PG8_WAIT_L(8); PG8_BAR; PG8_WAIT_L(0); PG8_MMA(0, 0, At, B0); PG8_BAR; PG8_SCHED;
            PG8_LDB(B1, 1, 1); PG8_STAGE(PG8_SB(1, 0), b3, voffB);
            PG8_BAR; PG8_WAIT_L(0); PG8_MMA(0, 1, At, B1); PG8_BAR;
            PG8_LDA(At, 1, 1); PG8_STAGE(PG8_SA(1, 0), a3, voffA);
            PG8_BAR; PG8_WAIT_L(0); PG8_MMA(1, 0, At, B0); PG8_BAR; PG8_SCHED;
            PG8_STAGE(PG8_SB(1, 1), b3 + hstep, voffB);
            PG8_WAIT_V(6); PG8_BAR; PG8_MMA(1, 1, At, B1); PG8_BAR;
            }
        }
        if constexpr (ALIGN_EPI) { if (wr == 0) PG8_BAR; }
        if constexpr (!Epi::AFTER_DRAIN) { E(acc, cur, wr, wc, fr, fq); S.done(cur); }
        if (!has_next) break;
#pragma unroll
        for (int a = 0; a < 2; ++a)
#pragma unroll
            for (int b = 0; b < 2; ++b)
#pragma unroll
                for (int m = 0; m < 4; ++m)
#pragma unroll
                    for (int n = 0; n < 2; ++n) acc[a][b][m][n] = (f32x4){0.f, 0.f, 0.f, 0.f};
        cur = nxt; cA = nA; cB = nB; ++ui;
        if constexpr (ALIGN_EPI) { if (wr == 1) PG8_BAR; }
    }
    PG8_WAIT_V(0);
    if constexpr (!ALIGN_EPI) { if (wr == 0) PG8_BAR; }
    PG8_BAR;
    if constexpr (Epi::AFTER_DRAIN) { E.fused(acc, cur, wr, wc, fr, fq, lds, wid, lane); S.done(cur); }
#undef PG8_SA
#undef PG8_SB
#undef PG8_STAGE
#undef PG8_LDA
#undef PG8_LDB
#undef PG8_MMA
#undef PG8_WAIT_V
#undef PG8_WAIT_L
#undef PG8_BAR
#undef PG8_SCHED
}

}

#define XB_TMO      128
#define XB_XCNT(j)  (256  + 64 * (j))
#define XB_XSUB(j)  (1280 + 64 * (j))
#define XB_XGEN(j)  (2304 + 64 * (j))
#define XB_TOP      3328
#define XB_TOPGEN   3392
#define XCD_BAR_WORDS 3456
#define XB_SPIN_CAP (1u << 18)
#define LAS __attribute__((address_space(3)))

__device__ __forceinline__ unsigned xb_ld(unsigned* p)              { return __hip_atomic_load(p, __ATOMIC_RELAXED, __HIP_MEMORY_SCOPE_AGENT); }
__device__ __forceinline__ unsigned xb_add(unsigned* p, unsigned v) { return __hip_atomic_fetch_add(p, v, __ATOMIC_RELAXED, __HIP_MEMORY_SCOPE_AGENT); }
__device__ __forceinline__ unsigned xb_xcc_id() { return (unsigned)__builtin_amdgcn_s_getreg((3 << 11) | 20) & 0xFu; }
#define XB_SPIN(cond, bar) do { unsigned _sp = 0; while (cond) { __builtin_amdgcn_s_sleep(1); \
    if ((++_sp & 255u) == 0u) { if (xb_ld(&(bar)[XB_TMO])) break; if (_sp > XB_SPIN_CAP) { atomicAdd(&(bar)[XB_TMO], 1u); break; } } } } while (0)

struct XcdBarrier {
    unsigned* bar; unsigned x;
    volatile LAS unsigned* st;
};

__device__ __forceinline__ XcdBarrier xcd_barrier_post(unsigned* bar, volatile LAS unsigned* st) {
    XcdBarrier b; b.bar = bar; b.x = xb_xcc_id(); b.st = st;
    if (threadIdx.x == 0) (void)xb_add(&bar[XB_XCNT(b.x)], 1u);
    return b;
}
__device__ __forceinline__ void xcd_barrier_complete(unsigned* bar, unsigned x, unsigned& nloc, unsigned& nx) {
    const unsigned G = gridDim.x * gridDim.y * gridDim.z;
    unsigned sum, cnt, mine, sp = 0u;
    for (;;) {
        sum = 0u; cnt = 0u; mine = 0u;
#pragma unroll
        for (unsigned j = 0; j < 16; ++j) { const unsigned c = xb_ld(&bar[XB_XCNT(j)]); sum += c; cnt += (c > 0u) ? 1u : 0u; mine = (j == x) ? c : mine; }
        if (sum == G) break;
        __builtin_amdgcn_s_sleep(1);
        if ((++sp & 255u) == 0u) { if (xb_ld(&bar[XB_TMO])) break; if (sp > XB_SPIN_CAP) { atomicAdd(&bar[XB_TMO], 1u); break; } }
    }
    nloc = mine > 0u ? mine : 1u; nx = cnt > 0u ? cnt : 1u;
}

__device__ __forceinline__ void xcd_barrier(const XcdBarrier& b) {
    asm volatile("s_waitcnt vmcnt(0)" ::: "memory");
    __syncthreads();
    if (threadIdx.x == 0) {
        unsigned* bar = b.bar;
        __builtin_amdgcn_s_waitcnt(0);
        unsigned nloc = b.st[0], nx = b.st[1];
        if (nloc == 0u) { xcd_barrier_complete(bar, b.x, nloc, nx); b.st[0] = nloc; b.st[1] = nx; }
        const unsigned old = xb_add(&bar[XB_XSUB(b.x)], 1u);
        const unsigned gen = old / nloc;
        if (old + 1u == (gen + 1u) * nloc) {
            __builtin_amdgcn_fence(__ATOMIC_RELEASE, "agent");
            asm volatile("s_waitcnt vmcnt(0)" ::: "memory");
            const unsigned og = xb_add(&bar[XB_TOP], 1u);
            const unsigned tg = og / nx;
            if (og + 1u == (tg + 1u) * nx) xb_add(&bar[XB_TOPGEN], 1u);
            else XB_SPIN(xb_ld(&bar[XB_TOPGEN]) == tg, bar);
            __builtin_amdgcn_fence(__ATOMIC_ACQUIRE, "agent");
            xb_add(&bar[XB_XGEN(b.x)], 1u);
            asm volatile("s_waitcnt vmcnt(0)" ::: "memory");
        } else {
            XB_SPIN(xb_ld(&bar[XB_XGEN(b.x)]) == gen, bar);
            __builtin_amdgcn_fence(__ATOMIC_ACQUIRE, "agent");
            asm volatile("s_waitcnt vmcnt(0)" ::: "memory");
        }
    }
    __syncthreads();
}


namespace {
typedef unsigned short bf16_t;
typedef float f32x4 __attribute__((ext_vector_type(4)));
typedef unsigned u32x4 __attribute__((ext_vector_type(4)));
typedef unsigned u32x2 __attribute__((ext_vector_type(2)));

constexpr int D = 2048, SEQ = 4096, NB = 2, MP = NB * SEQ, DB = 32, DS = 4, MS = DB * DS, MT = MP + MS, MPAD = 8448;
constexpr int DFF = 5504, DRNN = 1024, HD = 128, NKV = 4, IDH = 8, IDD = 64, DIN = 4680, DINP = 4864;
constexpr int NPAGES = 64, PAGE = 128, NPAST = NPAGES * PAGE, LS = NPAST + DS, TOPK = 256;
constexpr int C_XR = 0, C_GR = 1024, C_Q = 2048, C_K = 3072, C_V = 3584, C_QI = 4096, C_KI = 4608, C_WI = 4672;
constexpr float ALPHA = 1.189207115002721f, LN_EPS = 1e-5f, ATTN_SCALE = 0.08838834764831845f, IDX_SCALE = 0.125f, IDX_W_SCALE = 0.35355339059327373f;
constexpr size_t O_YP = 0, O_YS = 16777216, O_KP = 17039360, O_VP = 21233664, O_KIP = 25427968, O_CP = 25952256, O_HP = 25958400,
                 O_KS = 25960448, O_VS = 26025984, O_KIS = 26091520, O_CS = 26099712, O_HS = 26198016;
constexpr int SCS_LD = 8256;
constexpr int ZLD = DINP;

constexpr size_t al256(size_t x) { return (x + 255) & ~(size_t)255; }
constexpr size_t WS_CTL = 0;
constexpr size_t CTL_BYTES = 65536;
constexpr size_t WS_WGU1 = WS_CTL + CTL_BYTES;
constexpr size_t WS_WD1 = WS_WGU1 + al256((size_t)2 * DFF * D * 2);
constexpr size_t WS_WIN = WS_WD1 + al256((size_t)D * DFF * 2);
constexpr size_t WS_WOUT = WS_WIN + al256((size_t)DINP * D * 2);
constexpr size_t WS_WGU2 = WS_WOUT + al256((size_t)D * D * 2);
constexpr size_t WS_WD2 = WS_WGU2 + al256((size_t)2 * DFF * D * 2);
constexpr size_t WS_XB = WS_WD2 + al256((size_t)D * DFF * 2);
constexpr size_t WS_H = WS_XB + al256((size_t)MPAD * D * 2);
constexpr size_t WS_T = WS_H + al256((size_t)MPAD * DFF * 2);
constexpr size_t WS_X1 = WS_T + al256((size_t)MPAD * D * 4);
constexpr size_t WS_X2 = WS_X1 + al256((size_t)MPAD * D * 4);
constexpr size_t WS_Z = WS_X2 + al256((size_t)MPAD * D * 4);
constexpr size_t WS_CATB = WS_Z + al256((size_t)MPAD * DINP * 4);
constexpr size_t WS_XC = WS_CATB + al256((size_t)MPAD * D * 2);
constexpr size_t WS_GA = WS_XC + al256((size_t)MT * DRNN * 4);
constexpr size_t WS_GI = WS_GA + al256((size_t)MT * DRNN * 4);
constexpr size_t WS_SCP = WS_GI + al256((size_t)MT * DRNN * 4);
constexpr size_t WS_SCS = WS_SCP + al256((size_t)MP * SEQ * 4);
constexpr size_t WS_SEL = WS_SCS + al256((size_t)MS * SCS_LD * 4);
constexpr size_t WS_NSEL = WS_SEL + al256((size_t)MT * TOPK * 4);
constexpr size_t WS_END = WS_NSEL + al256((size_t)MT * 4);

constexpr int NWAVES = 8, NTHREADS = 512;
constexpr int LDS_STAGE = 131072, LDS_MISC = LDS_STAGE, LDS_BYTES = LDS_STAGE + 1024;

struct Params {
    const float* in[27];
    float* out;
    unsigned char* ws;
    int ph_lo, ph_hi;
};

__device__ __forceinline__ unsigned cvt_pk_bf16(float lo, float hi) { unsigned r; asm volatile("v_cvt_pk_bf16_f32 %0, %1, %2" : "=v"(r) : "v"(lo), "v"(hi)); return r; }
__device__ __forceinline__ float sigmoidf_(float x) { return 1.0f / (1.0f + expf(-x)); }
__device__ __forceinline__ float gelu_tanh(float x) { return 0.5f * x * (1.0f + tanhf(0.7978845608028654f * (x + 0.044715f * x * x * x))); }
__device__ __forceinline__ bf16_t f2bf(float f) { return (bf16_t)(cvt_pk_bf16(f, 0.f) & 0xffffu); }

struct EpiSwiGLU {
    static constexpr bool PERM = true, AFTER_DRAIN = false;
    bf16_t* H;
    __device__ __forceinline__ void operator()(const f32x4 (&acc)[2][2][4][2], const pg8::Unit& u, int wr, int wc, int fr, int fq) const {
        const int row0 = u.pm * 256 + wr * 64 + fr, col0 = u.pn * 128 + wc * 32 + 8 * fq;
#pragma unroll
        for (int ai = 0; ai < 2; ++ai)
#pragma unroll
            for (int m = 0; m < 4; ++m) {
                bf16_t* rowp = H + (size_t)(row0 + ai * 128 + m * 16) * DFF + col0;
                float h[8];
#pragma unroll
                for (int n = 0; n < 2; ++n)
#pragma unroll
                    for (int j = 0; j < 4; ++j) {
                        const float g = acc[ai][0][m][n][j], up = acc[ai][1][m][n][j];
                        const float sg = __builtin_amdgcn_rcpf(1.0f + __builtin_amdgcn_exp2f(-1.4426950408889634f * g));
                        h[n * 4 + j] = g * sg * up;
                    }
                u32x4 w; w.x = cvt_pk_bf16(h[0], h[1]); w.y = cvt_pk_bf16(h[2], h[3]); w.z = cvt_pk_bf16(h[4], h[5]); w.w = cvt_pk_bf16(h[6], h[7]);
                *(u32x4*)rowp = w;
            }
    }
};
struct EpiResid {
    static constexpr bool PERM = false, AFTER_DRAIN = false;
    const float* Xp; const float* Xs; float* T; float s;
    __device__ __forceinline__ void operator()(const f32x4 (&acc)[2][2][4][2], const pg8::Unit& u, int wr, int wc, int fr, int fq) const {
        const int row0 = u.pm * 256 + wr * 64 + fr, col0 = u.pn * 256 + wc * 32 + 4 * fq;
#pragma unroll
        for (int ai = 0; ai < 2; ++ai)
#pragma unroll
            for (int m = 0; m < 4; ++m) {
                const int row = row0 + ai * 128 + m * 16;
                if (row < MT) {
                    const float* xr = (row < MP) ? Xp + (size_t)row * D + col0 : Xs + (size_t)(row - MP) * D + col0;
                    float* tr = T + (size_t)row * D + col0;
#pragma unroll
                    for (int bj = 0; bj < 2; ++bj)
#pragma unroll
                        for (int n = 0; n < 2; ++n) { const f32x4 xv = *(const f32x4*)(xr + bj * 128 + n * 16); *(f32x4*)(tr + bj * 128 + n * 16) = xv * ALPHA + acc[ai][bj][m][n] * s; }
                }
            }
    }
};
struct EpiF32 {
    static constexpr bool PERM = false, AFTER_DRAIN = false;
    float* C; int ldc;
    __device__ __forceinline__ void operator()(const f32x4 (&acc)[2][2][4][2], const pg8::Unit& u, int wr, int wc, int fr, int fq) const {
        const int row0 = u.pm * 256 + wr * 64 + fr, col0 = u.pn * 256 + wc * 32 + 4 * fq;
#pragma unroll
        for (int ai = 0; ai < 2; ++ai)
#pragma unroll
            for (int m = 0; m < 4; ++m) {
                float* rowp = C + (size_t)(row0 + ai * 128 + m * 16) * ldc + col0;
#pragma unroll
                for (int bj = 0; bj < 2; ++bj)
#pragma unroll
                    for (int n = 0; n < 2; ++n) *(f32x4*)(rowp + bj * 128 + n * 16) = acc[ai][bj][m][n];
            }
    }
};

template <int MODE>
__device__ __forceinline__ void transpose_cvt(const float* __restrict__ W, int K, int N, int Npad, bf16_t* __restrict__ Wt, PG8_LAS float* tile) {
    const int tid = threadIdx.x, ntn = Npad / 64, ntk = K / 64, ntiles = ntn * ntk;
    for (int t = blockIdx.x; t < ntiles; t += gridDim.x) {
        const int tn = t % ntn, tk = t / ntn, n0 = tn * 64, k0 = tk * 64;
        int s0;
        if (MODE == 1) { const int tile256 = n0 >> 8, j = n0 & 255; s0 = (j < 128) ? tile256 * 128 + j : DFF + tile256 * 128 + (j - 128); } else s0 = n0;
#pragma unroll
        for (int i = 0; i < 8; ++i) {
            const int e = tid + 512 * i, k = e >> 6, n = e & 63;
            tile[k * 65 + n] = (MODE == 1 || s0 + n < N) ? W[(size_t)(k0 + k) * N + s0 + n] : 0.f;
        }
        __syncthreads();
        {
            const int n = tid >> 3, kq = (tid & 7) * 8;
            float v[8];
#pragma unroll
            for (int j = 0; j < 8; ++j) v[j] = tile[(kq + j) * 65 + n];
            u32x4 w; w.x = cvt_pk_bf16(v[0], v[1]); w.y = cvt_pk_bf16(v[2], v[3]); w.z = cvt_pk_bf16(v[4], v[5]); w.w = cvt_pk_bf16(v[6], v[7]);
            *(u32x4*)(Wt + (size_t)(n0 + n) * K + k0 + kq) = w;
        }
        __syncthreads();
    }
}
__device__ __forceinline__ void cvt_x(const float* __restrict__ xp, const float* __restrict__ xs, bf16_t* __restrict__ XB) {
    const size_t n4 = (size_t)MPAD * D / 4;
    for (size_t i = (size_t)blockIdx.x * NTHREADS + threadIdx.x; i < n4; i += (size_t)gridDim.x * NTHREADS) {
        const size_t e = i * 4, row = e / D;
        f32x4 v = (f32x4){0.f, 0.f, 0.f, 0.f};
        if (row < (size_t)MP) v = *(const f32x4*)(xp + e); else if (row < (size_t)MT) v = *(const f32x4*)(xs + (e - (size_t)MP * D));
        u32x2 w; w.x = cvt_pk_bf16(v[0], v[1]); w.y = cvt_pk_bf16(v[2], v[3]);
        *(u32x2*)(XB + e) = w;
    }
}
__device__ __forceinline__ void ln_phase(const float* __restrict__ T, const float* __restrict__ g, const float* __restrict__ b, float* __restrict__ Xo, bf16_t* __restrict__ Xb) {
    const int lane = threadIdx.x & 63, wave = threadIdx.x >> 6;
    f32x4 gv[8], bv[8];
#pragma unroll
    for (int i = 0; i < 8; ++i) { gv[i] = *(const f32x4*)(g + lane * 4 + 256 * i); bv[i] = *(const f32x4*)(b + lane * 4 + 256 * i); }
    for (int row = blockIdx.x * NWAVES + wave; row < MT; row += gridDim.x * NWAVES) {
        const float* tr = T + (size_t)row * D + lane * 4;
        f32x4 v[8]; float s = 0.f;
#pragma unroll
        for (int i = 0; i < 8; ++i) { v[i] = *(const f32x4*)(tr + 256 * i); s += (v[i][0] + v[i][1]) + (v[i][2] + v[i][3]); }
#pragma unroll
        for (int o = 32; o >= 1; o >>= 1) s += __shfl_xor(s, o);
        const float mean = s * (1.0f / D);
        float q = 0.f;
#pragma unroll
        for (int i = 0; i < 8; ++i) { const f32x4 d = v[i] - mean; q += (d[0] * d[0] + d[1] * d[1]) + (d[2] * d[2] + d[3] * d[3]); }
#pragma unroll
        for (int o = 32; o >= 1; o >>= 1) q += __shfl_xor(q, o);
        const float rstd = rsqrtf(q * (1.0f / D) + LN_EPS);
#pragma unroll
        for (int i = 0; i < 8; ++i) {
            const f32x4 o = (v[i] - mean) * rstd * gv[i] + bv[i];
            if (Xo) *(f32x4*)(Xo + (size_t)row * D + lane * 4 + 256 * i) = o;
            if (Xb) { u32x2 w; w.x = cvt_pk_bf16(o[0], o[1]); w.y = cvt_pk_bf16(o[2], o[3]); *(u32x2*)(Xb + (size_t)row * D + lane * 4 + 256 * i) = w; }
        }
    }
}

__global__ void __launch_bounds__(NTHREADS, 2) mk_fwd(Params p) {
    extern __shared__ __attribute__((aligned(16))) unsigned char lds_raw[];
    PG8_LAS unsigned char* lds = (PG8_LAS unsigned char*)lds_raw;
    unsigned char* ws = p.ws;
    const int lo = p.ph_lo, hi = p.ph_hi;
    const int G = gridDim.x;
    bf16_t* Wgu1 = (bf16_t*)(ws + WS_WGU1); bf16_t* Wd1 = (bf16_t*)(ws + WS_WD1); bf16_t* Win = (bf16_t*)(ws + WS_WIN); bf16_t* Wout = (bf16_t*)(ws + WS_WOUT);
    bf16_t* Wgu2 = (bf16_t*)(ws + WS_WGU2); bf16_t* Wd2 = (bf16_t*)(ws + WS_WD2);
    bf16_t* XB = (bf16_t*)(ws + WS_XB); bf16_t* H = (bf16_t*)(ws + WS_H); float* T = (float*)(ws + WS_T); float* X1 = (float*)(ws + WS_X1); float* X2 = (float*)(ws + WS_X2);
    float* Z = (float*)(ws + WS_Z); bf16_t* CATB = (bf16_t*)(ws + WS_CATB);
#define IN(k) (lo <= (k) && (k) < hi)
    if (IN(0)) {
        PG8_LAS float* tile = (PG8_LAS float*)lds;
        transpose_cvt<1>(p.in[10], D, 2 * DFF, 2 * DFF, Wgu1, tile);
        transpose_cvt<0>(p.in[11], DFF, D, D, Wd1, tile);
        transpose_cvt<0>(p.in[12], D, DIN, DINP, Win, tile);
        transpose_cvt<0>(p.in[20], D, D, D, Wout, tile);
        transpose_cvt<1>(p.in[23], D, 2 * DFF, 2 * DFF, Wgu2, tile);
        transpose_cvt<0>(p.in[24], DFF, D, D, Wd2, tile);
        cvt_x(p.in[0], p.in[1], XB);
    }
    if (IN(1)) {
        pg8::Gemm g{XB, Wgu1, MPAD, 2 * DFF, D}; pg8::StaticOrder S; S.init(MPAD, 2 * DFF, G, (int)blockIdx.x);
        EpiSwiGLU E{H};
        pg8::gemm_phase<EpiSwiGLU, pg8::StaticOrder, true, true>(lds, g, S, E);
    }
    if (IN(2)) {
        pg8::Gemm g{H, Wd1, MPAD, D, DFF}; pg8::StaticOrder S; S.init(MPAD, D, G, (int)blockIdx.x);
        EpiResid E{p.in[0], p.in[1], T, 0.5f};
        pg8::gemm_phase<EpiResid, pg8::StaticOrder, true, true>(lds, g, S, E);
    }
    if (IN(3)) ln_phase(T, p.in[8], p.in[9], X1, XB);
    if (IN(4)) {
        pg8::Gemm g{XB, Win, MPAD, DINP, D}; pg8::StaticOrder S; S.init(MPAD, DINP, G, (int)blockIdx.x);
        EpiF32 E{Z, ZLD};
        pg8::gemm_phase<EpiF32, pg8::StaticOrder, true, true>(lds, g, S, E);
    }
    if (IN(5)) {
        pg8::Gemm g{CATB, Wout, MPAD, D, D}; pg8::StaticOrder S; S.init(MPAD, D, G, (int)blockIdx.x);
        EpiResid E{X1, X1 + (size_t)MP * D, T, 1.0f};
        pg8::gemm_phase<EpiResid, pg8::StaticOrder, true, true>(lds, g, S, E);
    }
    if (IN(6)) ln_phase(T, p.in[21], p.in[22], X2, XB);
    if (IN(7)) {
        pg8::Gemm g{XB, Wgu2, MPAD, 2 * DFF, D}; pg8::StaticOrder S; S.init(MPAD, 2 * DFF, G, (int)blockIdx.x);
        EpiSwiGLU E{H};
        pg8::gemm_phase<EpiSwiGLU, pg8::StaticOrder, true, true>(lds, g, S, E);
    }
    if (IN(8)) {
        pg8::Gemm g{H, Wd2, MPAD, D, DFF}; pg8::StaticOrder S; S.init(MPAD, D, G, (int)blockIdx.x);
        EpiResid E{X2, X2 + (size_t)MP * D, T, 0.5f};
        pg8::gemm_phase<EpiResid, pg8::StaticOrder, true, true>(lds, g, S, E);
    }
    if (IN(9)) ln_phase(T, p.in[25], p.in[26], p.out + O_YP, nullptr);
#undef IN
}

__global__ __launch_bounds__(256) void sgemm(const float* __restrict__ A, int lda, const float* __restrict__ B, int ldb, float* __restrict__ C, int ldc,
                                             int M, int N, int K, long sA, long sB, long sC) {
    __shared__ float As[16][132];
    __shared__ float Bs[16][132];
    A += sA * blockIdx.z; B += sB * blockIdx.z; C += sC * blockIdx.z;
    const int tid = threadIdx.x, tx = tid & 15, ty = tid >> 4;
    const int m0 = blockIdx.y * 128, n0 = blockIdx.x * 128;
    float acc[8][8];
#pragma unroll
    for (int i = 0; i < 8; ++i)
#pragma unroll
        for (int j = 0; j < 8; ++j) acc[i][j] = 0.f;
    for (int k0 = 0; k0 < K; k0 += 16) {
#pragma unroll
        for (int i = 0; i < 8; ++i) {
            const int e = tid + 256 * i, m = e >> 4, k = e & 15, gm = m0 + m;
            As[k][m] = (gm < M) ? A[(size_t)gm * lda + k0 + k] : 0.f;
        }
#pragma unroll
        for (int i = 0; i < 8; ++i) {
            const int e = tid + 256 * i, k = e >> 7, n = e & 127, gn = n0 + n;
            Bs[k][n] = (gn < N) ? B[(size_t)(k0 + k) * ldb + gn] : 0.f;
        }
        __syncthreads();
#pragma unroll
        for (int k = 0; k < 16; ++k) {
            float a[8], b[8];
#pragma unroll
            for (int i = 0; i < 8; ++i) a[i] = As[k][ty * 8 + i];
#pragma unroll
            for (int j = 0; j < 8; ++j) b[j] = Bs[k][tx * 8 + j];
#pragma unroll
            for (int i = 0; i < 8; ++i)
#pragma unroll
                for (int j = 0; j < 8; ++j) acc[i][j] = fmaf(a[i], b[j], acc[i][j]);
        }
        __syncthreads();
    }
#pragma unroll
    for (int i = 0; i < 8; ++i) {
        const int gm = m0 + ty * 8 + i;
        if (gm < M) {
#pragma unroll
            for (int j = 0; j < 8; ++j) { const int gn = n0 + tx * 8 + j; if (gn < N) C[(size_t)gm * ldc + gn] = acc[i][j]; }
        }
    }
}

__global__ void copy_kv_k(const float* __restrict__ Z, float* __restrict__ out) {
    const int r = blockIdx.x;
    const float* z = Z + (size_t)r * ZLD;
    float* ko; float* vo; float* kio;
    if (r < MP) { ko = out + O_KP + (size_t)r * 512; vo = out + O_VP + (size_t)r * 512; kio = out + O_KIP + (size_t)r * 64; }
    else { const int rs = r - MP; ko = out + O_KS + (size_t)rs * 512; vo = out + O_VS + (size_t)rs * 512; kio = out + O_KIS + (size_t)rs * 64; }
    for (int c = threadIdx.x; c < 512; c += blockDim.x) { ko[c] = z[C_K + c]; vo[c] = z[C_V + c]; }
    for (int c = threadIdx.x; c < 64; c += blockDim.x) kio[c] = z[C_KI + c];
}

__global__ void conv_k(const float* __restrict__ Z, const float* __restrict__ state_conv, const float* __restrict__ cw, const float* __restrict__ cb,
                       float* __restrict__ XC, float* __restrict__ out) {
    const int r = blockIdx.x;
    for (int c = threadIdx.x; c < DRNN; c += blockDim.x) {
        float acc = cb[c];
        if (r < MP) {
            const int b = r / SEQ, t = r % SEQ;
#pragma unroll
            for (int j = 0; j < 4; ++j) { const int tt = t + j - 3; if (tt >= 0) acc += cw[j * DRNN + c] * Z[(size_t)(b * SEQ + tt) * ZLD + C_XR + c]; }
            if (t >= SEQ - 3) out[O_CP + (size_t)(b * 3 + (t - (SEQ - 3))) * DRNN + c] = Z[(size_t)r * ZLD + C_XR + c];
        } else {
            const int rs = r - MP, b = rs / DS, t = rs % DS;
#pragma unroll
            for (int j = 0; j < 4; ++j) { const int pp = t + j; const float xv = (pp < 3) ? state_conv[(size_t)(b * 3 + pp) * DRNN + c] : Z[(size_t)(MP + b * DS + pp - 3) * ZLD + C_XR + c]; acc += cw[j * DRNN + c] * xv; }
            if (t >= 1) out[O_CS + (size_t)(b * 3 + (t - 1)) * DRNN + c] = Z[(size_t)r * ZLD + C_XR + c];
        }
        XC[(size_t)r * DRNN + c] = acc;
    }
}

__global__ void scan_k(const float* __restrict__ XC, const float* __restrict__ GA, const float* __restrict__ GI, const float* __restrict__ Z,
                       const float* __restrict__ ba, const float* __restrict__ bi, const float* __restrict__ lam, const float* __restrict__ state_rnn,
                       bf16_t* __restrict__ CATB, float* __restrict__ out) {
    const int idx = blockIdx.x * blockDim.x + threadIdx.x;
    if (idx >= (NB + DB) * DRNN) return;
    const int s = idx / DRNN, c = idx % DRNN;
    int row0, Tn; float h;
    if (s < NB) { row0 = s * SEQ; Tn = SEQ; h = 0.f; } else { row0 = MP + (s - NB) * DS; Tn = DS; h = state_rnn[(size_t)(s - NB) * DRNN + c]; }
    const float l = lam[c];
    const float sp = (-l > 20.f) ? -l : log1pf(expf(-l));
    const float bac = ba[c], bic = bi[c];
    for (int t = 0; t < Tn; ++t) {
        const size_t r = (size_t)(row0 + t);
        const float xc = XC[r * DRNN + c];
        const float rg = sigmoidf_(GA[r * DRNN + c] + bac), ig = sigmoidf_(GI[r * DRNN + c] + bic);
        const float log_a = -8.0f * rg * sp;
        const float a = expf(log_a);
        const float u = sqrtf(-expm1f(2.0f * log_a)) * ig * xc;
        h = a * h + u;
        CATB[r * D + c] = f2bf(h * gelu_tanh(Z[r * ZLD + C_GR + c]));
    }
    if (s < NB) out[O_HP + (size_t)s * DRNN + c] = h; else out[O_HS + (size_t)(s - NB) * DRNN + c] = h;
}

__global__ __launch_bounds__(256) void idx_score_k(const float* __restrict__ Z, const float* __restrict__ cache_ki, const int* __restrict__ page_table,
                                                   float* __restrict__ SCP, float* __restrict__ SCS) {
    __shared__ float qs[IDH * IDD];
    __shared__ float wsh[IDH];
    const int r = blockIdx.x;
    const float* z = Z + (size_t)r * ZLD;
    for (int i = threadIdx.x; i < IDH * IDD; i += 256) qs[i] = z[C_QI + i];
    if (threadIdx.x < IDH) wsh[threadIdx.x] = z[C_WI + threadIdx.x] * IDX_W_SCALE;
    __syncthreads();
    int nkeys, b; float* sc;
    if (r < MP) { b = r / SEQ; nkeys = (r % SEQ) + 1; sc = SCP + (size_t)r * SEQ; }
    else { const int rs = r - MP; b = rs / DS; nkeys = NPAST + (rs % DS) + 1; sc = SCS + (size_t)rs * SCS_LD; }
    for (int key = threadIdx.x; key < nkeys; key += 256) {
        const float* kp;
        if (r < MP) kp = Z + (size_t)(b * SEQ + key) * ZLD + C_KI;
        else if (key < NPAST) kp = cache_ki + ((size_t)page_table[b * NPAGES + key / PAGE] * PAGE + (key % PAGE)) * IDD;
        else kp = Z + (size_t)(MP + b * DS + key - NPAST) * ZLD + C_KI;
        float kv[IDD];
#pragma unroll
        for (int d = 0; d < IDD; d += 4) { const float4 t4 = *(const float4*)(kp + d); kv[d] = t4.x; kv[d + 1] = t4.y; kv[d + 2] = t4.z; kv[d + 3] = t4.w; }
        float tot = 0.f;
#pragma unroll
        for (int h = 0; h < IDH; ++h) {
            float dot = 0.f;
#pragma unroll
            for (int d = 0; d < IDD; ++d) dot = fmaf(qs[h * IDD + d], kv[d], dot);
            tot += fmaxf(dot * IDX_SCALE, 0.f) * wsh[h];
        }
        sc[key] = tot;
    }
}

__device__ __forceinline__ unsigned fkey(float f) { const unsigned u = __float_as_uint(f); return (u & 0x80000000u) ? ~u : (u | 0x80000000u); }

__global__ __launch_bounds__(256) void topk_k(const float* __restrict__ SCP, const float* __restrict__ SCS, int* __restrict__ SEL, int* __restrict__ NSEL) {
    __shared__ unsigned cnt_s;
    __shared__ unsigned pos_s;
    __shared__ unsigned cnts[256];
    const int r = blockIdx.x, t = threadIdx.x;
    int n; const float* sc;
    if (r < MP) { n = (r % SEQ) + 1; sc = SCP + (size_t)r * SEQ; } else { const int rs = r - MP; n = NPAST + (rs % DS) + 1; sc = SCS + (size_t)rs * SCS_LD; }
    int* sel = SEL + (size_t)r * TOPK;
    if (n <= TOPK) { if (t < n) sel[t] = t; if (t == 0) NSEL[r] = n; return; }
    unsigned prefix = 0u;
    for (int bit = 31; bit >= 0; --bit) {
        const unsigned cand = prefix | (1u << bit);
        if (t == 0) cnt_s = 0u;
        __syncthreads();
        unsigned c = 0;
        for (int i = t; i < n; i += 256) c += (fkey(sc[i]) >= cand) ? 1u : 0u;
#pragma unroll
        for (int o = 32; o >= 1; o >>= 1) c += __shfl_xor(c, o);
        if ((t & 63) == 0) atomicAdd(&cnt_s, c);
        __syncthreads();
        if (cnt_s >= (unsigned)TOPK) prefix = cand;
        __syncthreads();
    }
    unsigned c = 0;
    for (int i = t; i < n; i += 256) c += (fkey(sc[i]) > prefix) ? 1u : 0u;
    cnts[t] = c;
    __syncthreads();
    unsigned pp = 0;
    for (int j = 0; j < t; ++j) pp += cnts[j];
    for (int i = t; i < n; i += 256) if (fkey(sc[i]) > prefix) sel[pp++] = i;
    if (t == 255) pos_s = pp;
    __syncthreads();
    if (t == 0) {
        unsigned q = pos_s;
        for (int i = 0; i < n && q < (unsigned)TOPK; ++i) if (fkey(sc[i]) == prefix) sel[q++] = i;
        NSEL[r] = TOPK;
    }
}

__global__ __launch_bounds__(256) void attn_k(const float* __restrict__ Z, const float* __restrict__ cache_k, const float* __restrict__ cache_v, const int* __restrict__ page_table,
                                              const int* __restrict__ SEL, const int* __restrict__ NSEL, bf16_t* __restrict__ CATB) {
    __shared__ float qs[1024];
    __shared__ float ps[8][TOPK];
    __shared__ const float* kptr[TOPK];
    __shared__ const float* vptr[TOPK];
    __shared__ float red[8][4];
    const int r = blockIdx.x, t = threadIdx.x;
    const float* z = Z + (size_t)r * ZLD;
    for (int i = t; i < 1024; i += 256) qs[i] = z[C_Q + i];
    const int ns = NSEL[r];
    float lg[8];
    if (t < ns) {
        const int idx = SEL[(size_t)r * TOPK + t];
        const float* kp; const float* vp;
        if (r < MP) { const int b = r / SEQ; kp = Z + (size_t)(b * SEQ + idx) * ZLD + C_K; vp = Z + (size_t)(b * SEQ + idx) * ZLD + C_V; }
        else {
            const int b = (r - MP) / DS;
            if (idx < NPAST) { const size_t row = (size_t)page_table[b * NPAGES + idx / PAGE] * PAGE + (idx % PAGE); kp = cache_k + row * 512; vp = cache_v + row * 512; }
            else { const size_t zr = (size_t)(MP + b * DS + idx - NPAST); kp = Z + zr * ZLD + C_K; vp = Z + zr * ZLD + C_V; }
        }
        kptr[t] = kp; vptr[t] = vp;
    }
    __syncthreads();
    if (t < ns) {
        const float* kp = kptr[t];
#pragma unroll
        for (int h = 0; h < 8; ++h) lg[h] = 0.f;
#pragma unroll
        for (int n = 0; n < NKV; ++n) {
            float d0 = 0.f, d1 = 0.f;
            for (int d = 0; d < HD; d += 4) {
                const float4 k4 = *(const float4*)(kp + n * HD + d);
                const float* q0 = qs + (2 * n) * HD + d; const float* q1 = qs + (2 * n + 1) * HD + d;
                d0 += q0[0] * k4.x + q0[1] * k4.y + q0[2] * k4.z + q0[3] * k4.w;
                d1 += q1[0] * k4.x + q1[1] * k4.y + q1[2] * k4.z + q1[3] * k4.w;
            }
            lg[2 * n] = d0 * ATTN_SCALE; lg[2 * n + 1] = d1 * ATTN_SCALE;
        }
    } else {
#pragma unroll
        for (int h = 0; h < 8; ++h) lg[h] = -INFINITY;
    }
#pragma unroll
    for (int h = 0; h < 8; ++h) {
        float m = lg[h];
#pragma unroll
        for (int o = 32; o >= 1; o >>= 1) m = fmaxf(m, __shfl_xor(m, o));
        if ((t & 63) == 0) red[h][t >> 6] = m;
    }
    __syncthreads();
    float e[8];
#pragma unroll
    for (int h = 0; h < 8; ++h) {
        const float m = fmaxf(fmaxf(red[h][0], red[h][1]), fmaxf(red[h][2], red[h][3]));
        e[h] = (t < ns) ? expf(lg[h] - m) : 0.f;
    }
    __syncthreads();
#pragma unroll
    for (int h = 0; h < 8; ++h) {
        float s = e[h];
#pragma unroll
        for (int o = 32; o >= 1; o >>= 1) s += __shfl_xor(s, o);
        if ((t & 63) == 0) red[h][t >> 6] = s;
    }
    __syncthreads();
#pragma unroll
    for (int h = 0; h < 8; ++h) { const float s = red[h][0] + red[h][1] + red[h][2] + red[h][3]; ps[h][t] = e[h] / s; }
    __syncthreads();
#pragma unroll
    for (int i = 0; i < 4; ++i) {
        const int o = t + 256 * i, hq = o >> 7, d = o & 127, n = hq >> 1;
        float acc = 0.f;
        for (int j = 0; j < ns; ++j) acc = fmaf(ps[hq][j], vptr[j][n * HD + d], acc);
        CATB[(size_t)r * D + 1024 + o] = f2bf(acc);
    }
}
}

extern "C" void kernel_launch(void* const* d_in, const int* in_sizes, int n_in, void* d_out, int out_size, void* d_ws, size_t ws_size, hipStream_t stream) {
    static int grid = 0;
    if (grid == 0) {
        if (n_in != 27 || ws_size < WS_END) { grid = -1; return; }
        int dev = 0, cus = 0;
        if (hipGetDevice(&dev) != hipSuccess || hipDeviceGetAttribute(&cus, hipDeviceAttributeMultiprocessorCount, dev) != hipSuccess) { grid = -1; return; }
        if (hipFuncSetAttribute((const void*)mk_fwd, hipFuncAttributeMaxDynamicSharedMemorySize, LDS_BYTES) != hipSuccess) { grid = -1; return; }
        (void)hipGetLastError();
        grid = cus;
    }
    if (grid < 0) return;
    const float* cache_k = (const float*)d_in[2];    const float* cache_v = (const float*)d_in[3];
    const float* cache_ki = (const float*)d_in[4];   const float* state_conv = (const float*)d_in[5];
    const float* state_rnn = (const float*)d_in[6];  const int* page_table = (const int*)d_in[7];
    const float* conv_w = (const float*)d_in[13];    const float* conv_b = (const float*)d_in[14];
    const float* lru_wa = (const float*)d_in[15];    const float* lru_ba = (const float*)d_in[16];
    const float* lru_wi = (const float*)d_in[17];    const float* lru_bi = (const float*)d_in[18];
    const float* lru_lam = (const float*)d_in[19];
    float* out = (float*)d_out;
    unsigned char* ws = (unsigned char*)d_ws;
    float* Z = (float*)(ws + WS_Z); bf16_t* CATB = (bf16_t*)(ws + WS_CATB);
    float* XC = (float*)(ws + WS_XC); float* GA = (float*)(ws + WS_GA); float* GI = (float*)(ws + WS_GI);
    float* SCP = (float*)(ws + WS_SCP); float* SCS = (float*)(ws + WS_SCS); int* SEL = (int*)(ws + WS_SEL); int* NSEL = (int*)(ws + WS_NSEL);

    (void)hipMemsetAsync(ws + WS_CTL, 0, CTL_BYTES, stream);
    Params p{};
    for (int i = 0; i < 27; ++i) p.in[i] = (const float*)d_in[i];
    p.out = out; p.ws = ws;
    auto run = [&](int lo, int hi) { p.ph_lo = lo; p.ph_hi = hi; hipLaunchKernelGGL(mk_fwd, dim3(grid), dim3(NTHREADS), LDS_BYTES, stream, p); };
    auto gemm = [&](const float* A, int lda, const float* B, int ldb, float* C, int ldc, int M, int N, int K, int batch, long sA, long sB, long sC) {
        dim3 g((N + 127) / 128, (M + 127) / 128, batch);
        sgemm<<<g, 256, 0, stream>>>(A, lda, B, ldb, C, ldc, M, N, K, sA, sB, sC);
    };
    for (int ph = 0; ph < 5; ++ph) run(ph, ph + 1);
    copy_kv_k<<<MT, 256, 0, stream>>>(Z, out);
    conv_k<<<MT, 256, 0, stream>>>(Z, state_conv, conv_w, conv_b, XC, out);
    gemm(XC, DRNN, lru_wa, 128, GA, DRNN, MT, 128, 128, 8, 128, 128 * 128, 128);
    gemm(XC, DRNN, lru_wi, 128, GI, DRNN, MT, 128, 128, 8, 128, 128 * 128, 128);
    scan_k<<<((NB + DB) * DRNN + 255) / 256, 256, 0, stream>>>(XC, GA, GI, Z, lru_ba, lru_bi, lru_lam, state_rnn, CATB, out);
    idx_score_k<<<MT, 256, 0, stream>>>(Z, cache_ki, page_table, SCP, SCS);
    topk_k<<<MT, 256, 0, stream>>>(SCP, SCS, SEL, NSEL);
    attn_k<<<MT, 256, 0, stream>>>(Z, cache_k, cache_v, page_table, SEL, NSEL, CATB);
    for (int ph = 5; ph < 10; ++ph) run(ph, ph + 1);
}
```

```cpp
#include <hip/hip_runtime.h>
#include <stdint.h>

namespace pg8 {
#define PG8_LAS __attribute__((address_space(3)))
typedef unsigned short bf16_t;
typedef short bf16x8 __attribute__((ext_vector_type(8)));
typedef float f32x4 __attribute__((ext_vector_type(4)));
typedef unsigned u32x4 __attribute__((ext_vector_type(4)));
constexpr int BM = 256, BK = 64, HALF = 128, HTB = HALF * BK * 2  , STAGE_BYTES = 8 * HTB, NXCD = 8, WGM = 8;

__host__ __device__ __forceinline__ int lds_byte(int r, int c) { const int st = (r >> 4) * 2 + (c >> 5), rr = r & 15, cc = c & 31, ob = rr * 64 + cc * 2; return st * 1024 + (ob ^ (((ob >> 9) & 1) << 5)); }
__host__ __device__ __forceinline__ void stage_rc(int b, int& R, int& C) { const int st = b / 1024, sb = b % 1024, swz = sb ^ (((sb >> 9) & 1) << 5); R = (st >> 1) * 16 + swz / 64; C = (st & 1) * 32 + (swz % 64) / 2; }
__host__ __device__ __forceinline__ int perm32(int rho) { const int n = rho >> 4, i = rho & 15; return 8 * (i >> 2) + 4 * n + (i & 3); }

struct Unit { int pm, pn; };
struct Gemm { const bf16_t* A; const bf16_t* Bt; int M, N, K; };

struct StaticOrder {
    int nM, nN, nwg, G, c;
    __host__ __device__ void init(int M, int N, int G_, int c_) { nM = M / BM; nN = N / BM; nwg = nM * nN; G = G_; c = c_; }
    __host__ __device__ bool next(int i, Unit& u) const {
        const long L = (long)i * G + c; if (L >= nwg) return false;
        int wgid = (int)L; { const int q = nwg / NXCD, r = nwg % NXCD, xcd = wgid % NXCD, off = wgid / NXCD; wgid = (xcd < r ? xcd * (q + 1) : r * (q + 1) + (xcd - r) * q) + off; }
        const int nig = WGM * nN, gid = wgid / nig, fm = gid * WGM, gsz = (nM - fm) < WGM ? (nM - fm) : WGM;
        u.pm = fm + ((wgid % nig) % gsz); u.pn = (wgid % nig) / gsz; return true;
    }
    __device__ __forceinline__ void a_ready(const Unit&) const {}
    __device__ __forceinline__ void done(const Unit&) const {}
};

__device__ __forceinline__ unsigned cvt_pk_bf16(float lo, float hi) { unsigned r; asm volatile("v_cvt_pk_bf16_f32 %0, %1, %2" : "=v"(r) : "v"(lo), "v"(hi)); return r; }
typedef float f32x2 __attribute__((ext_vector_type(2)));

template <class Epi, class Sched, bool ALIGN_EPI = false, bool SP2 = false>
__device__ __forceinline__ void gemm_phase(PG8_LAS unsigned char* lds, const Gemm g, const Sched& S, const Epi& E) {
    const int tid = threadIdx.x, wid = __builtin_amdgcn_readfirstlane(tid >> 6), lane = tid & 63, wr = wid >> 2, wc = wid & 3, fr = lane & 15, fq = lane >> 4;
    const int K = g.K, nt = K / BK;
    unsigned voffA[2], voffB[2];
#pragma unroll
    for (int i = 0; i < 2; ++i) { int R, C; stage_rc(tid * 16 + i * 8192, R, C); const int Rb = Epi::PERM ? ((R & ~31) + perm32(R & 31)) : R;
        voffA[i] = (unsigned)(R * K + C) * 2u; voffB[i] = (unsigned)(Rb * K + C) * 2u; }
    const size_t kstep = (size_t)(BK * 2);
    const size_t hstep = (size_t)HALF * K * 2;
    const size_t tstep = 2 * hstep;
    const unsigned ldsw = (unsigned)wid * 1024u;
    const int aoff = lds_byte(wr * 64 + fr, fq * 8), boff = lds_byte(wc * 32 + fr, fq * 8);
#define PG8_SA(b, h) (((b) * 2 + (h)) * HTB)
#define PG8_SB(b, h) ((4 + (b) * 2 + (h)) * HTB)
#define PG8_STAGE(bufoff, gbase, voff) do { _Pragma("unroll") for (int _i = 0; _i < 2; ++_i) \
        __builtin_amdgcn_global_load_lds((const unsigned*)((const char*)(gbase) + (voff)[_i]), (PG8_LAS unsigned*)(lds + (bufoff) + ldsw + _i * 8192), 16, 0, 0); } while (0)
#define PG8_LDA(dst, b, h) do { _Pragma("unroll") for (int m = 0; m < 4; ++m) _Pragma("unroll") for (int k = 0; k < 2; ++k) dst[m][k] = *(const PG8_LAS bf16x8*)(lds + PG8_SA(b, h) + aoff + m * 2048 + k * 1024); } while (0)
#define PG8_LDB(dst, b, h) do { _Pragma("unroll") for (int n = 0; n < 2; ++n) _Pragma("unroll") for (int k = 0; k < 2; ++k) dst[n][k] = *(const PG8_LAS bf16x8*)(lds + PG8_SB(b, h) + boff + n * 2048 + k * 1024); } while (0)
#define PG8_MMA(ai, bj, At, Bt) do { __builtin_amdgcn_s_setprio(1); _Pragma("unroll") for (int m = 0; m < 4; ++m) _Pragma("unroll") for (int n = 0; n < 2; ++n) _Pragma("unroll") for (int k = 0; k < 2; ++k) \
        acc[ai][bj][m][n] = __builtin_amdgcn_mfma_f32_16x16x32_bf16(Bt[n][k], At[m][k], acc[ai][bj][m][n], 0, 0, 0); __builtin_amdgcn_s_setprio(0); } while (0)
#define PG8_WAIT_V(n) asm volatile("s_waitcnt vmcnt(" #n ")" ::: "memory")
#define PG8_WAIT_L(n) asm volatile("s_waitcnt lgkmcnt(" #n ")" ::: "memory")
#define PG8_BAR __builtin_amdgcn_s_barrier()
#define PG8_SCHED __builtin_amdgcn_sched_barrier(0)
    Unit cur, nxt; int ui = 0;
    if (!S.next(0, cur)) return;
    f32x4 acc[2][2][4][2];
#pragma unroll
    for (int a = 0; a < 2; ++a)
#pragma unroll
        for (int b = 0; b < 2; ++b)
#pragma unroll
            for (int m = 0; m < 4; ++m)
#pragma unroll
                for (int n = 0; n < 2; ++n) acc[a][b][m][n] = (f32x4){0.f, 0.f, 0.f, 0.f};
    bf16x8 At[4][2], B0[2][2], B1[2][2];
    const char* cA = (const char*)g.A + (size_t)cur.pm * tstep; const char* cB = (const char*)g.Bt + (size_t)cur.pn * tstep;
    S.a_ready(cur);
    if constexpr (SP2) {
        PG8_STAGE(PG8_SB(0, 0), cB, voffB); PG8_STAGE(PG8_SB(0, 1), cB + hstep, voffB); PG8_STAGE(PG8_SA(0, 0), cA, voffA); PG8_STAGE(PG8_SA(0, 1), cA + hstep, voffA);
        if (wr == 1) PG8_BAR;
        PG8_WAIT_V(2); PG8_BAR;
        PG8_STAGE(PG8_SB(1, 0), cB + kstep, voffB); PG8_STAGE(PG8_SA(1, 0), cA + kstep, voffA); PG8_STAGE(PG8_SB(1, 1), cB + hstep + kstep, voffB);
        PG8_WAIT_V(6); PG8_BAR;
    } else {
        PG8_STAGE(PG8_SB(0, 0), cB, voffB); PG8_STAGE(PG8_SA(0, 0), cA, voffA); PG8_STAGE(PG8_SB(0, 1), cB + hstep, voffB); PG8_STAGE(PG8_SA(0, 1), cA + hstep, voffA);
        if (wr == 1) PG8_BAR;
        PG8_WAIT_V(4); PG8_BAR;
        PG8_STAGE(PG8_SB(1, 0), cB + kstep, voffB); PG8_STAGE(PG8_SA(1, 0), cA + kstep, voffA); PG8_STAGE(PG8_SB(1, 1), cB + hstep + kstep, voffB);
        PG8_WAIT_V(6); PG8_BAR;
    }
    for (;;) {
        const bool has_next = S.next(ui + 1, nxt);
        const char* nA = has_next ? (const char*)g.A + (size_t)nxt.pm * tstep : cA; const char* nB = has_next ? (const char*)g.Bt + (size_t)nxt.pn * tstep : cB;
        for (int t = 0; t < nt; t += 2) {
            const bool last = (t == nt - 2);
            const char* a1 = cA + (size_t)(t + 1) * kstep;
            const char* a2 = last ? nA : cA + (size_t)(t + 2) * kstep; const char* b2 = last ? nB : cB + (size_t)(t + 2) * kstep;
            const char* a3 = a2 + kstep; const char* b3 = b2 + kstep;
            if (last && has_next) S.a_ready(nxt);
            if constexpr (SP2) {
            PG8_LDB(B0, 0, 0); PG8_LDB(B1, 0, 1); PG8_SCHED; PG8_LDA(At, 0, 0); PG8_STAGE(PG8_SA(1, 1), a1 + hstep, voffA);
            PG8_WAIT_V(8); PG8_WAIT_L(0); PG8_BAR; PG8_MMA(0, 0, At, B0); PG8_MMA(0, 1, At, B1); PG8_BAR; PG8_SCHED;
            PG8_LDA(At, 0, 1); PG8_STAGE(PG8_SB(0, 0), b2, voffB); PG8_STAGE(PG8_SB(0, 1), b2 + hstep, voffB); PG8_STAGE(PG8_SA(0, 0), a2, voffA);
            PG8_WAIT_V(8); PG8_WAIT_L(0); PG8_BAR; PG8_MMA(1, 0, At, B0); PG8_MMA(1, 1, At, B1); PG8_BAR; PG8_SCHED;
            PG8_LDB(B0, 1, 0); PG8_LDB(B1, 1, 1); PG8_SCHED; PG8_LDA(At, 1, 0); PG8_STAGE(PG8_SA(0, 1), a2 + hstep, voffA);
            PG8_WAIT_V(8); PG8_WAIT_L(0); PG8_BAR; PG8_MMA(0, 0, At, B0); PG8_MMA(0, 1, At, B1); PG8_BAR; PG8_SCHED;
            PG8_LDA(At, 1, 1); PG8_STAGE(PG8_SB(1, 0), b3, voffB); PG8_STAGE(PG8_SB(1, 1), b3 + hstep, voffB); PG8_STAGE(PG8_SA(1, 0), a3, voffA);
            PG8_WAIT_V(8); PG8_WAIT_L(0); PG8_BAR; PG8_MMA(1, 0, At, B0); PG8_MMA(1, 1, At, B1); PG8_BAR; PG8_SCHED;
            } else {
            PG8_LDB(B0, 0, 0); PG8_SCHED; PG8_LDA(At, 0, 0); PG8_STAGE(PG8_SA(1, 1), a1 + hstep, voffA);
            PG8_WAIT_L(8); PG8_BAR; PG8_WAIT_L(0); PG8_MMA(0, 0, At, B0); PG8_BAR; PG8_SCHED;
            PG8_LDB(B1, 0, 1); PG8_STAGE(PG8_SB(0, 0), b2, voffB);
            PG8_BAR; PG8_WAIT_L(0); PG8_MMA(0, 1, At, B1); PG8_BAR;
            PG8_LDA(At, 0, 1); PG8_STAGE(PG8_SA(0, 0), a2, voffA);
            PG8_BAR; PG8_WAIT_L(0); PG8_MMA(1, 0, At, B0); PG8_BAR; PG8_SCHED;
            PG8_STAGE(PG8_SB(0, 1), b2 + hstep, voffB);
            PG8_WAIT_V(6); PG8_BAR; PG8_MMA(1, 1, At, B1); PG8_BAR;
            PG8_LDB(B0, 1, 0); PG8_SCHED; PG8_LDA(At, 1, 0); PG8_STAGE(PG8_SA(0, 1), a2 + hstep, voffA);
            PG8_WAIT_L(8); PG8_BAR; PG8_WAIT_L(0); PG8_MMA(0, 0, At, B0); PG8_BAR; PG8_SCHED;
            PG8_LDB(B1, 1, 1); PG8_STAGE(PG8_SB(1, 0), b3, voffB);
            PG8_BAR; PG8_WAIT_L(0); PG8_MMA(0, 1, At, B1); PG8_BAR;
            PG8_LDA(At, 1, 1); PG8_STAGE(PG8_SA(1, 0), a3, voffA);
            PG8_BAR; PG8_WAIT_L(0); PG8_MMA(1, 0, At, B0); PG8_BAR; PG8_SCHED;
            PG8_STAGE(PG8_SB(1, 1), b3 + hstep, voffB);
            PG8_WAIT_V(6); PG8_BAR; PG8_MMA(1, 1, At, B1); PG8_BAR;
            }
        }
        if constexpr (ALIGN_EPI) { if (wr == 0) PG8_BAR; }
        if constexpr (!Epi::AFTER_DRAIN) { E(acc, cur, wr, wc, fr, fq); S.done(cur); }
        if (!has_next) break;
#pragma unroll
        for (int a = 0; a < 2; ++a)
#pragma unroll
            for (int b = 0; b < 2; ++b)
#pragma unroll
                for (int m = 0; m < 4; ++m)
#pragma unroll
                    for (int n = 0; n < 2; ++n) acc[a][b][m][n] = (f32x4){0.f, 0.f, 0.f, 0.f};
        cur = nxt; cA = nA; cB = nB; ++ui;
        if constexpr (ALIGN_EPI) { if (wr == 1) PG8_BAR; }
    }
    PG8_WAIT_V(0);
    if constexpr (!ALIGN_EPI) { if (wr == 0) PG8_BAR; }
    PG8_BAR;
    if constexpr (Epi::AFTER_DRAIN) { E.fused(acc, cur, wr, wc, fr, fq, lds, wid, lane); S.done(cur); }
#undef PG8_SA
#undef PG8_SB
#undef PG8_STAGE
#undef PG8_LDA
#undef PG8_LDB
#undef PG8_MMA
#undef PG8_WAIT_V
#undef PG8_WAIT_L
#undef PG8_BAR
#undef PG8_SCHED
}

}

#define XB_TMO      128
#define XB_XCNT(j)  (256  + 64 * (j))
#define XB_XSUB(j)  (1280 + 64 * (j))
#define XB_XGEN(j)  (2304 + 64 * (j))
#define XB_TOP      3328
#define XB_TOPGEN   3392
#define XCD_BAR_WORDS 3456
#define XB_SPIN_CAP (1u << 18)
#define LAS __attribute__((address_space(3)))

__device__ __forceinline__ unsigned xb_ld(unsigned* p)              { return __hip_atomic_load(p, __ATOMIC_RELAXED, __HIP_MEMORY_SCOPE_AGENT); }
__device__ __forceinline__ unsigned xb_add(unsigned* p, unsigned v) { return __hip_atomic_fetch_add(p, v, __ATOMIC_RELAXED, __HIP_MEMORY_SCOPE_AGENT); }
__device__ __forceinline__ unsigned xb_xcc_id() { return (unsigned)__builtin_amdgcn_s_getreg((3 << 11) | 20) & 0xFu; }
#define XB_SPIN(cond, bar) do { unsigned _sp = 0; while (cond) { __builtin_amdgcn_s_sleep(1); \
    if ((++_sp & 255u) == 0u) { if (xb_ld(&(bar)[XB_TMO])) break; if (_sp > XB_SPIN_CAP) { atomicAdd(&(bar)[XB_TMO], 1u); break; } } } } while (0)

struct XcdBarrier {
    unsigned* bar; unsigned x;
    volatile LAS unsigned* st;
};

__device__ __forceinline__ XcdBarrier xcd_barrier_post(unsigned* bar, volatile LAS unsigned* st) {
    XcdBarrier b; b.bar = bar; b.x = xb_xcc_id(); b.st = st;
    if (threadIdx.x == 0) (void)xb_add(&bar[XB_XCNT(b.x)], 1u);
    return b;
}
__device__ __forceinline__ void xcd_barrier_complete(unsigned* bar, unsigned x, unsigned& nloc, unsigned& nx) {
    const unsigned G = gridDim.x * gridDim.y * gridDim.z;
    unsigned sum, cnt, mine, sp = 0u;
    for (;;) {
        sum = 0u; cnt = 0u; mine = 0u;
#pragma unroll
        for (unsigned j = 0; j < 16; ++j) { const unsigned c = xb_ld(&bar[XB_XCNT(j)]); sum += c; cnt += (c > 0u) ? 1u : 0u; mine = (j == x) ? c : mine; }
        if (sum == G) break;
        __builtin_amdgcn_s_sleep(1);
        if ((++sp & 255u) == 0u) { if (xb_ld(&bar[XB_TMO])) break; if (sp > XB_SPIN_CAP) { atomicAdd(&bar[XB_TMO], 1u); break; } }
    }
    nloc = mine > 0u ? mine : 1u; nx = cnt > 0u ? cnt : 1u;
}

__device__ __forceinline__ void xcd_barrier(const XcdBarrier& b) {
    asm volatile("s_waitcnt vmcnt(0)" ::: "memory");
    __syncthreads();
    if (threadIdx.x == 0) {
        unsigned* bar = b.bar;
        __builtin_amdgcn_s_waitcnt(0);
        unsigned nloc = b.st[0], nx = b.st[1];
        if (nloc == 0u) { xcd_barrier_complete(bar, b.x, nloc, nx); b.st[0] = nloc; b.st[1] = nx; }
        const unsigned old = xb_add(&bar[XB_XSUB(b.x)], 1u);
        const unsigned gen = old / nloc;
        if (old + 1u == (gen + 1u) * nloc) {
            __builtin_amdgcn_fence(__ATOMIC_RELEASE, "agent");
            asm volatile("s_waitcnt vmcnt(0)" ::: "memory");
            const unsigned og = xb_add(&bar[XB_TOP], 1u);
            const unsigned tg = og / nx;
            if (og + 1u == (tg + 1u) * nx) xb_add(&bar[XB_TOPGEN], 1u);
            else XB_SPIN(xb_ld(&bar[XB_TOPGEN]) == tg, bar);
            __builtin_amdgcn_fence(__ATOMIC_ACQUIRE, "agent");
            xb_add(&bar[XB_XGEN(b.x)], 1u);
            asm volatile("s_waitcnt vmcnt(0)" ::: "memory");
        } else {
            XB_SPIN(xb_ld(&bar[XB_XGEN(b.x)]) == gen, bar);
            __builtin_amdgcn_fence(__ATOMIC_ACQUIRE, "agent");
            asm volatile("s_waitcnt vmcnt(0)" ::: "memory");
        }
    }
    __syncthreads();
}


namespace {
typedef unsigned short bf16_t;
typedef float f32x4 __attribute__((ext_vector_type(4)));
typedef unsigned u32x4 __attribute__((ext_vector_type(4)));
typedef unsigned u32x2 __attribute__((ext_vector_type(2)));

constexpr int D = 2048, SEQ = 4096, NB = 2, MP = NB * SEQ, DB = 32, DS = 4, MS = DB * DS, MT = MP + MS, MPAD = 8448;
constexpr int DFF = 5504, DRNN = 1024, HD = 128, NKV = 4, IDH = 8, IDD = 64, DIN = 4680, DINP = 4864;
constexpr int NPAGES = 64, PAGE = 128, NPAST = NPAGES * PAGE, LS = NPAST + DS, TOPK = 256;
constexpr int C_XR = 0, C_GR = 1024, C_Q = 2048, C_K = 3072, C_V = 3584, C_QI = 4096, C_KI = 4608, C_WI = 4672;
constexpr float ALPHA = 1.189207115002721f, LN_EPS = 1e-5f, ATTN_SCALE = 0.08838834764831845f, IDX_SCALE = 0.125f, IDX_W_SCALE = 0.35355339059327373f;
constexpr size_t O_YP = 0, O_YS = 16777216, O_KP = 17039360, O_VP = 21233664, O_KIP = 25427968, O_CP = 25952256, O_HP = 25958400,
                 O_KS = 25960448, O_VS = 26025984, O_KIS = 26091520, O_CS = 26099712, O_HS = 26198016;
constexpr int SCS_LD = 8256;
constexpr int ZLD = DINP;

constexpr size_t al256(size_t x) { return (x + 255) & ~(size_t)255; }
constexpr size_t WS_CTL = 0;
constexpr size_t CTL_BYTES = 65536;
constexpr size_t WS_WGU1 = WS_CTL + CTL_BYTES;
constexpr size_t WS_WD1 = WS_WGU1 + al256((size_t)2 * DFF * D * 2);
constexpr size_t WS_WIN = WS_WD1 + al256((size_t)D * DFF * 2);
constexpr size_t WS_WOUT = WS_WIN + al256((size_t)DINP * D * 2);
constexpr size_t WS_WGU2 = WS_WOUT + al256((size_t)D * D * 2);
constexpr size_t WS_WD2 = WS_WGU2 + al256((size_t)2 * DFF * D * 2);
constexpr size_t WS_XB = WS_WD2 + al256((size_t)D * DFF * 2);
constexpr size_t WS_H = WS_XB + al256((size_t)MPAD * D * 2);
constexpr size_t WS_T = WS_H + al256((size_t)MPAD * DFF * 2);
constexpr size_t WS_X1 = WS_T + al256((size_t)MPAD * D * 4);
constexpr size_t WS_X2 = WS_X1 + al256((size_t)MPAD * D * 4);
constexpr size_t WS_Z = WS_X2 + al256((size_t)MPAD * D * 4);
constexpr size_t WS_CATB = WS_Z + al256((size_t)MPAD * DINP * 4);
constexpr size_t WS_HL = WS_CATB + al256((size_t)MPAD * D * 2);
constexpr size_t WS_PP = WS_HL + al256((size_t)MT * DRNN * 4);
constexpr size_t WS_GI = WS_PP + al256((size_t)MT * DRNN * 4);
constexpr size_t WS_SCP = WS_GI + al256((size_t)MT * DRNN * 4);
constexpr size_t WS_SCS = WS_SCP + al256((size_t)MP * SEQ * 4);
constexpr size_t WS_SEL = WS_SCS + al256((size_t)MS * SCS_LD * 4);
constexpr size_t WS_NSEL = WS_SEL + al256((size_t)MT * TOPK * 4);
constexpr size_t WS_SUMA = WS_NSEL + al256((size_t)MT * 4);
constexpr size_t WS_SUMH = WS_SUMA + al256((size_t)130 * DRNN * 4);
constexpr size_t WS_WAT = WS_SUMH + al256((size_t)130 * DRNN * 4);
constexpr size_t WS_WIT = WS_WAT + al256((size_t)8 * 128 * 128 * 2);
constexpr size_t WS_BM = WS_WIT + al256((size_t)8 * 128 * 128 * 2);
constexpr size_t WS_END = WS_BM + al256((size_t)MP * 64 * 8);

constexpr int NWAVES = 8, NTHREADS = 512;
constexpr int LDS_STAGE = 131072, LDS_MISC = 134144, LDS_BYTES = 135168;

struct Params {
    const float* in[27];
    float* out;
    unsigned char* ws;
    int ph_lo, ph_hi, li, pad_;
};

__device__ __forceinline__ unsigned cvt_pk_bf16(float lo, float hi) { unsigned r; asm volatile("v_cvt_pk_bf16_f32 %0, %1, %2" : "=v"(r) : "v"(lo), "v"(hi)); return r; }
__device__ __forceinline__ float sigmoidf_(float x) { return 1.0f / (1.0f + expf(-x)); }
__device__ __forceinline__ float gelu_tanh(float x) { return 0.5f * x * (1.0f + tanhf(0.7978845608028654f * (x + 0.044715f * x * x * x))); }
__device__ __forceinline__ bf16_t f2bf(float f) { return (bf16_t)(cvt_pk_bf16(f, 0.f) & 0xffffu); }

struct EpiSwiGLU {
    static constexpr bool PERM = true, AFTER_DRAIN = false;
    bf16_t* H;
    __device__ __forceinline__ void operator()(const f32x4 (&acc)[2][2][4][2], const pg8::Unit& u, int wr, int wc, int fr, int fq) const {
        const int row0 = u.pm * 256 + wr * 64 + fr, col0 = u.pn * 128 + wc * 32 + 8 * fq;
#pragma unroll
        for (int ai = 0; ai < 2; ++ai)
#pragma unroll
            for (int m = 0; m < 4; ++m) {
                bf16_t* rowp = H + (size_t)(row0 + ai * 128 + m * 16) * DFF + col0;
                float h[8];
#pragma unroll
                for (int n = 0; n < 2; ++n)
#pragma unroll
                    for (int j = 0; j < 4; ++j) {
                        const float g = acc[ai][0][m][n][j], up = acc[ai][1][m][n][j];
                        const float sg = __builtin_amdgcn_rcpf(1.0f + __builtin_amdgcn_exp2f(-1.4426950408889634f * g));
                        h[n * 4 + j] = g * sg * up;
                    }
                u32x4 w; w.x = cvt_pk_bf16(h[0], h[1]); w.y = cvt_pk_bf16(h[2], h[3]); w.z = cvt_pk_bf16(h[4], h[5]); w.w = cvt_pk_bf16(h[6], h[7]);
                *(u32x4*)rowp = w;
            }
    }
};
struct EpiResid {
    static constexpr bool PERM = false, AFTER_DRAIN = false;
    const float* Xp; const float* Xs; float* T; float s;
    __device__ __forceinline__ void operator()(const f32x4 (&acc)[2][2][4][2], const pg8::Unit& u, int wr, int wc, int fr, int fq) const {
        const int row0 = u.pm * 256 + wr * 64 + fr, col0 = u.pn * 256 + wc * 32 + 4 * fq;
#pragma unroll
        for (int ai = 0; ai < 2; ++ai)
#pragma unroll
            for (int m = 0; m < 4; ++m) {
                const int row = row0 + ai * 128 + m * 16;
                if (row < MT) {
                    const float* xr = (row < MP) ? Xp + (size_t)row * D + col0 : Xs + (size_t)(row - MP) * D + col0;
                    float* tr = T + (size_t)row * D + col0;
#pragma unroll
                    for (int bj = 0; bj < 2; ++bj)
#pragma unroll
                        for (int n = 0; n < 2; ++n) { const f32x4 xv = *(const f32x4*)(xr + bj * 128 + n * 16); *(f32x4*)(tr + bj * 128 + n * 16) = xv * ALPHA + acc[ai][bj][m][n] * s; }
                }
            }
    }
};
struct EpiF32 {
    static constexpr bool PERM = false, AFTER_DRAIN = false;
    float* C; int ldc;
    __device__ __forceinline__ void operator()(const f32x4 (&acc)[2][2][4][2], const pg8::Unit& u, int wr, int wc, int fr, int fq) const {
        const int row0 = u.pm * 256 + wr * 64 + fr, col0 = u.pn * 256 + wc * 32 + 4 * fq;
#pragma unroll
        for (int ai = 0; ai < 2; ++ai)
#pragma unroll
            for (int m = 0; m < 4; ++m) {
                float* rowp = C + (size_t)(row0 + ai * 128 + m * 16) * ldc + col0;
#pragma unroll
                for (int bj = 0; bj < 2; ++bj)
#pragma unroll
                    for (int n = 0; n < 2; ++n) *(f32x4*)(rowp + bj * 128 + n * 16) = acc[ai][bj][m][n];
            }
    }
};

template <int MODE>
__device__ __forceinline__ void transpose_cvt(const float* __restrict__ W, int K, int N, int Npad, bf16_t* __restrict__ Wt, PG8_LAS float* tile) {
    const int tid = threadIdx.x, ntn = Npad / 64, ntk = K / 64, ntiles = ntn * ntk;
    for (int t = blockIdx.x; t < ntiles; t += gridDim.x) {
        const int tn = t % ntn, tk = t / ntn, n0 = tn * 64, k0 = tk * 64;
        int s0;
        if (MODE == 1) { const int tile256 = n0 >> 8, j = n0 & 255; s0 = (j < 128) ? tile256 * 128 + j : DFF + tile256 * 128 + (j - 128); } else s0 = n0;
#pragma unroll
        for (int i = 0; i < 8; ++i) {
            const int e = tid + 512 * i, k = e >> 6, n = e & 63;
            tile[k * 65 + n] = (MODE == 1 || s0 + n < N) ? W[(size_t)(k0 + k) * N + s0 + n] : 0.f;
        }
        __syncthreads();
        {
            const int n = tid >> 3, kq = (tid & 7) * 8;
            float v[8];
#pragma unroll
            for (int j = 0; j < 8; ++j) v[j] = tile[(kq + j) * 65 + n];
            u32x4 w; w.x = cvt_pk_bf16(v[0], v[1]); w.y = cvt_pk_bf16(v[2], v[3]); w.z = cvt_pk_bf16(v[4], v[5]); w.w = cvt_pk_bf16(v[6], v[7]);
            *(u32x4*)(Wt + (size_t)(n0 + n) * K + k0 + kq) = w;
        }
        __syncthreads();
    }
}
__device__ __forceinline__ void cvt_x(const float* __restrict__ xp, const float* __restrict__ xs, bf16_t* __restrict__ XB) {
    const size_t n4 = (size_t)MPAD * D / 4;
    for (size_t i = (size_t)blockIdx.x * NTHREADS + threadIdx.x; i < n4; i += (size_t)gridDim.x * NTHREADS) {
        const size_t e = i * 4, row = e / D;
        f32x4 v = (f32x4){0.f, 0.f, 0.f, 0.f};
        if (row < (size_t)MP) v = *(const f32x4*)(xp + e); else if (row < (size_t)MT) v = *(const f32x4*)(xs + (e - (size_t)MP * D));
        u32x2 w; w.x = cvt_pk_bf16(v[0], v[1]); w.y = cvt_pk_bf16(v[2], v[3]);
        *(u32x2*)(XB + e) = w;
    }
}
__device__ __forceinline__ void ln_phase(const float* __restrict__ T, const float* __restrict__ g, const float* __restrict__ b, float* __restrict__ Xo, bf16_t* __restrict__ Xb) {
    const int lane = threadIdx.x & 63, wave = threadIdx.x >> 6;
    f32x4 gv[8], bv[8];
#pragma unroll
    for (int i = 0; i < 8; ++i) { gv[i] = *(const f32x4*)(g + lane * 4 + 256 * i); bv[i] = *(const f32x4*)(b + lane * 4 + 256 * i); }
    for (int row = blockIdx.x * NWAVES + wave; row < MT; row += gridDim.x * NWAVES) {
        const float* tr = T + (size_t)row * D + lane * 4;
        f32x4 v[8]; float s = 0.f;
#pragma unroll
        for (int i = 0; i < 8; ++i) { v[i] = *(const f32x4*)(tr + 256 * i); s += (v[i][0] + v[i][1]) + (v[i][2] + v[i][3]); }
#pragma unroll
        for (int o = 32; o >= 1; o >>= 1) s += __shfl_xor(s, o);
        const float mean = s * (1.0f / D);
        float q = 0.f;
#pragma unroll
        for (int i = 0; i < 8; ++i) { const f32x4 d = v[i] - mean; q += (d[0] * d[0] + d[1] * d[1]) + (d[2] * d[2] + d[3] * d[3]); }
#pragma unroll
        for (int o = 32; o >= 1; o >>= 1) q += __shfl_xor(q, o);
        const float rstd = rsqrtf(q * (1.0f / D) + LN_EPS);
#pragma unroll
        for (int i = 0; i < 8; ++i) {
            const f32x4 o = (v[i] - mean) * rstd * gv[i] + bv[i];
            if (Xo) *(f32x4*)(Xo + (size_t)row * D + lane * 4 + 256 * i) = o;
            if (Xb) { u32x2 w; w.x = cvt_pk_bf16(o[0], o[1]); w.y = cvt_pk_bf16(o[2], o[3]); *(u32x2*)(Xb + (size_t)row * D + lane * 4 + 256 * i) = w; }
        }
    }
}


typedef short bf16x8 __attribute__((ext_vector_type(8)));
typedef float f32x16 __attribute__((ext_vector_type(16)));
__device__ __forceinline__ int crow(int reg, int h) { return (reg & 3) + 8 * (reg >> 2) + 4 * h; }
constexpr int LRU_CH = 64, LRU_NCHUNK = MT / LRU_CH  , LRU_PCHUNK = MP / LRU_CH  , LRU_CPB = SEQ / LRU_CH  ;
constexpr int L_XCF = 0, L_XCB = 32768, L_AA = 50176, L_UU = 82944, XCB_PITCH = 272;
__device__ __forceinline__ void lru_local_phase(const Params& p, PG8_LAS unsigned char* lds) {
    const int tid = threadIdx.x, lane = tid & 63, wave = tid >> 6;
    unsigned char* ws = p.ws;
    const float* Z = (const float*)(ws + WS_Z);
    const float* state_conv = p.in[5]; const float* state_rnn = p.in[6];
    const float* cw = p.in[13]; const float* cb = p.in[14];
    const float* ba = p.in[16]; const float* bi = p.in[18]; const float* lam = p.in[19];
    const bf16_t* WAt = (const bf16_t*)(ws + WS_WAT); const bf16_t* WIt = (const bf16_t*)(ws + WS_WIT);
    float* HL = (float*)(ws + WS_HL); float* PP = (float*)(ws + WS_PP); float* SUMA = (float*)(ws + WS_SUMA); float* SUMH = (float*)(ws + WS_SUMH);
    float* out = p.out;
    PG8_LAS float* XCF = (PG8_LAS float*)(lds + L_XCF); PG8_LAS float* AA = (PG8_LAS float*)(lds + L_AA); PG8_LAS float* UU = (PG8_LAS float*)(lds + L_UU);
    for (int u = blockIdx.x; u < LRU_NCHUNK * 8; u += gridDim.x) {
        const int ck = u >> 3, nb = u & 7;
        {
            const int c = tid & 127, rg = tid >> 7, ch = nb * 128 + c;
            const float w0 = cw[ch], w1 = cw[DRNN + ch], w2 = cw[2 * DRNN + ch], w3 = cw[3 * DRNN + ch], cbv = cb[ch];
            if (ck < LRU_PCHUNK) {
                const int b = ck / LRU_CPB, t0 = (ck % LRU_CPB) * LRU_CH + rg * 16;
                const float* zc = Z + (size_t)(b * SEQ) * ZLD + C_XR + ch;
                float x0 = (t0 - 3 >= 0) ? zc[(size_t)(t0 - 3) * ZLD] : 0.f, x1 = (t0 - 2 >= 0) ? zc[(size_t)(t0 - 2) * ZLD] : 0.f, x2 = (t0 - 1 >= 0) ? zc[(size_t)(t0 - 1) * ZLD] : 0.f;
#pragma unroll
                for (int i = 0; i < 16; ++i) {
                    const int t = t0 + i, lr = rg * 16 + i;
                    const float x3 = zc[(size_t)t * ZLD];
                    const float xc = cbv + w0 * x0 + w1 * x1 + w2 * x2 + w3 * x3;
                    XCF[lr * 128 + c] = xc;
                    *(PG8_LAS bf16_t*)(lds + L_XCB + lr * XCB_PITCH + c * 2) = f2bf(xc);
                    if (t >= SEQ - 3) out[O_CP + (size_t)(b * 3 + (t - (SEQ - 3))) * DRNN + ch] = x3;
                    x0 = x1; x1 = x2; x2 = x3;
                }
            } else {
#pragma unroll
                for (int i = 0; i < 16; ++i) {
                    const int lr = rg * 16 + i, rs = (ck - LRU_PCHUNK) * LRU_CH + lr, bs = rs >> 2, tt = rs & 3;
                    float xv[4];
#pragma unroll
                    for (int j = 0; j < 4; ++j) { const int pp = tt + j; xv[j] = (pp < 3) ? state_conv[(size_t)(bs * 3 + pp) * DRNN + ch] : Z[(size_t)(MP + bs * DS + pp - 3) * ZLD + C_XR + ch]; }
                    const float xc = cbv + w0 * xv[0] + w1 * xv[1] + w2 * xv[2] + w3 * xv[3];
                    XCF[lr * 128 + c] = xc;
                    *(PG8_LAS bf16_t*)(lds + L_XCB + lr * XCB_PITCH + c * 2) = f2bf(xc);
                    if (tt >= 1) out[O_CS + (size_t)(bs * 3 + (tt - 1)) * DRNN + ch] = xv[3];
                }
            }
        }
        __syncthreads();
        {
            const int mt = wave >> 2, nt = wave & 3, r = lane & 31, kh = lane >> 5;
            f32x16 acc_a, acc_i;
#pragma unroll
            for (int i = 0; i < 16; ++i) { acc_a[i] = 0.f; acc_i[i] = 0.f; }
            const bf16_t* wa = WAt + (size_t)nb * 16384 + (size_t)(nt * 32 + r) * 128 + kh * 8;
            const bf16_t* wi = WIt + (size_t)nb * 16384 + (size_t)(nt * 32 + r) * 128 + kh * 8;
#pragma unroll
            for (int ks = 0; ks < 8; ++ks) {
                const bf16x8 af = *(const PG8_LAS bf16x8*)(lds + L_XCB + (mt * 32 + r) * XCB_PITCH + (ks * 16 + kh * 8) * 2);
                const bf16x8 bfa = *(const bf16x8*)(wa + ks * 16);
                const bf16x8 bfi = *(const bf16x8*)(wi + ks * 16);
                acc_a = __builtin_amdgcn_mfma_f32_32x32x16_bf16(af, bfa, acc_a, 0, 0, 0);
                acc_i = __builtin_amdgcn_mfma_f32_32x32x16_bf16(af, bfi, acc_i, 0, 0, 0);
            }
            const int col = nt * 32 + r, ch = nb * 128 + col, hh = lane >> 5;
            const float l = lam[ch], sp = (-l > 20.f) ? -l : log1pf(expf(-l)), bac = ba[ch], bic = bi[ch];
#pragma unroll
            for (int i = 0; i < 16; ++i) {
                const int lr = mt * 32 + crow(i, hh);
                const float xc = XCF[lr * 128 + col];
                const float rg = sigmoidf_(acc_a[i] + bac), ig = sigmoidf_(acc_i[i] + bic);
                const float log_a = -8.0f * rg * sp;
                AA[lr * 128 + col] = expf(log_a);
                UU[lr * 128 + col] = sqrtf(-expm1f(2.0f * log_a)) * ig * xc;
            }
        }
        __syncthreads();
        if (tid < 128) {
            const int c = tid, ch = nb * 128 + c;
            if (ck < LRU_PCHUNK) {
                float h = 0.f, P = 1.f;
#pragma unroll 8
                for (int lr = 0; lr < LRU_CH; ++lr) {
                    const float a = AA[lr * 128 + c], uu = UU[lr * 128 + c];
                    h = a * h + uu; P *= a;
                    const size_t g = (size_t)(ck * LRU_CH + lr) * DRNN + ch;
                    HL[g] = h; PP[g] = P;
                }
                SUMA[(size_t)ck * DRNN + ch] = P; SUMH[(size_t)ck * DRNN + ch] = h;
            } else {
                float h = 0.f;
#pragma unroll 8
                for (int lr = 0; lr < LRU_CH; ++lr) {
                    const int rs = (ck - LRU_PCHUNK) * LRU_CH + lr, bs = rs >> 2, tt = rs & 3;
                    if (tt == 0) h = state_rnn[(size_t)bs * DRNN + ch];
                    const float a = AA[lr * 128 + c], uu = UU[lr * 128 + c];
                    h = a * h + uu;
                    const size_t g = (size_t)(ck * LRU_CH + lr) * DRNN + ch;
                    HL[g] = h; PP[g] = 0.f;
                    if (tt == 3) out[O_HS + (size_t)bs * DRNN + ch] = h;
                }
                SUMA[(size_t)ck * DRNN + ch] = 0.f; SUMH[(size_t)ck * DRNN + ch] = 0.f;
            }
        }
        __syncthreads();
    }
}
__device__ __forceinline__ void lru_fixup_unit(const Params& p, int ck) {
    const int tid = threadIdx.x, ch = tid * 2;
    unsigned char* ws = p.ws;
    const float* Z = (const float*)(ws + WS_Z);
    const float* HL = (const float*)(ws + WS_HL); const float* PP = (const float*)(ws + WS_PP); const float* SUMA = (const float*)(ws + WS_SUMA); const float* SUMH = (const float*)(ws + WS_SUMH);
    bf16_t* CATB = (bf16_t*)(ws + WS_CATB);
    typedef float f32x2 __attribute__((ext_vector_type(2)));
    f32x2 carry = (f32x2){0.f, 0.f};
    const bool prompt = ck < LRU_PCHUNK;
    if (prompt) {
        const int b = ck / LRU_CPB, kk = ck % LRU_CPB;
#pragma unroll 4
        for (int j = 0; j < kk; ++j) {
            const f32x2 A = *(const f32x2*)(SUMA + (size_t)(b * LRU_CPB + j) * DRNN + ch), Hh = *(const f32x2*)(SUMH + (size_t)(b * LRU_CPB + j) * DRNN + ch);
            carry = A * carry + Hh;
        }
    }
#pragma unroll 4
    for (int lr = 0; lr < LRU_CH; ++lr) {
        const size_t grow = (size_t)(ck * LRU_CH + lr);
        const f32x2 hl = *(const f32x2*)(HL + grow * DRNN + ch), pp = *(const f32x2*)(PP + grow * DRNN + ch), gr = *(const f32x2*)(Z + grow * ZLD + C_GR + ch);
        const f32x2 h = hl + pp * carry;
        *(unsigned*)(CATB + grow * D + ch) = cvt_pk_bf16(h.x * gelu_tanh(gr.x), h.y * gelu_tanh(gr.y));
        if (prompt && (ck % LRU_CPB) == LRU_CPB - 1 && lr == LRU_CH - 1) *(f32x2*)(p.out + O_HP + (size_t)(ck / LRU_CPB) * DRNN + ch) = h;
    }
}


constexpr int IDX_SPLIT = 3;
constexpr int SCP_LD = 4096, SCS_LDL = 8200;
__device__ __forceinline__ unsigned fkey(float f) { const unsigned u = __float_as_uint(f); return (u & 0x80000000u) ? ~u : (u | 0x80000000u); }
__device__ __forceinline__ int mbcnt64(unsigned long long m) { return (int)__builtin_amdgcn_mbcnt_hi((unsigned)(m >> 32), __builtin_amdgcn_mbcnt_lo((unsigned)m, 0u)); }
__device__ __forceinline__ void split8(const f32x4 a, const f32x4 b, bf16x8& hi, bf16x8& lo) {
    u32x4 h; h.x = cvt_pk_bf16(a[0], a[1]); h.y = cvt_pk_bf16(a[2], a[3]); h.z = cvt_pk_bf16(b[0], b[1]); h.w = cvt_pk_bf16(b[2], b[3]);
    u32x4 l;
    l.x = cvt_pk_bf16(a[0] - __uint_as_float(h.x << 16), a[1] - __uint_as_float(h.x & 0xffff0000u));
    l.y = cvt_pk_bf16(a[2] - __uint_as_float(h.y << 16), a[3] - __uint_as_float(h.y & 0xffff0000u));
    l.z = cvt_pk_bf16(b[0] - __uint_as_float(h.z << 16), b[1] - __uint_as_float(h.z & 0xffff0000u));
    l.w = cvt_pk_bf16(b[2] - __uint_as_float(h.w << 16), b[3] - __uint_as_float(h.w & 0xffff0000u));
    hi = __builtin_bit_cast(bf16x8, h); lo = __builtin_bit_cast(bf16x8, l);
}
struct IdxQ { bf16x8 hi[4], lo[4]; float w[16]; };
__device__ __forceinline__ void idx_load_q(IdxQ& q, const float* Z, int grow0, int lane) {
    const int rho = lane & 31, kh = lane >> 5, ql = 2 * ((rho >> 2) & 1) + (rho >> 4), head = 4 * ((rho >> 3) & 1) + (rho & 3);
    const float* src = Z + (size_t)(grow0 + ql) * ZLD + C_QI + head * IDD + kh * 8;
#pragma unroll
    for (int ks = 0; ks < 4; ++ks) { const f32x4 a = *(const f32x4*)(src + ks * 16), b = *(const f32x4*)(src + ks * 16 + 4); split8(a, b, q.hi[ks], q.lo[ks]); }
#pragma unroll
    for (int e = 0; e < 2; ++e) {
        const float* wsrc = Z + (size_t)(grow0 + 2 * kh + e) * ZLD + C_WI;
        const f32x4 a = *(const f32x4*)wsrc, b = *(const f32x4*)(wsrc + 4);
#pragma unroll
        for (int i = 0; i < 4; ++i) { q.w[e * 8 + i] = a[i] * IDX_W_SCALE; q.w[e * 8 + 4 + i] = b[i] * IDX_W_SCALE; }
    }
}
__device__ __forceinline__ void idx_tile(const IdxQ& q, const bf16x8 (&khi)[4], const bf16x8 (&klo)[4], PG8_LAS float* sc, int pitch, int col, int hh, bool store = true) {
    f32x16 acc;
#pragma unroll
    for (int i = 0; i < 16; ++i) acc[i] = 0.f;
#pragma unroll
    for (int ks = 0; ks < 4; ++ks) {
        acc = __builtin_amdgcn_mfma_f32_32x32x16_bf16(q.hi[ks], khi[ks], acc, 0, 0, 0);
        if (IDX_SPLIT == 3) { acc = __builtin_amdgcn_mfma_f32_32x32x16_bf16(q.hi[ks], klo[ks], acc, 0, 0, 0); acc = __builtin_amdgcn_mfma_f32_32x32x16_bf16(q.lo[ks], khi[ks], acc, 0, 0, 0); }
    }
#pragma unroll
    for (int e = 0; e < 2; ++e) {
        float t = 0.f;
#pragma unroll
        for (int i = 0; i < 8; ++i) t += fmaxf(acc[e * 8 + i] * IDX_SCALE, 0.f) * q.w[e * 8 + i];
        if (store) sc[(2 * hh + e) * pitch + col] = t;
    }
}
__device__ __forceinline__ void idx_load_key(const float* kp, bf16x8 (&khi)[4], bf16x8 (&klo)[4]) {
#pragma unroll
    for (int ks = 0; ks < 4; ++ks) {
        f32x4 a = (f32x4){0.f, 0.f, 0.f, 0.f}, b = a;
        if (kp) { a = *(const f32x4*)(kp + ks * 16); b = *(const f32x4*)(kp + ks * 16 + 4); }
        split8(a, b, khi[ks], klo[ks]);
    }
}
template <int NJ>
__device__ __forceinline__ void select_row(const PG8_LAS float* sc, int n, int lane, unsigned long long* bm_row, int* sel, int* nsel) {
    unsigned v[NJ];
    const int nj = (n + 63) >> 6;
    const PG8_LAS float* pl = sc + lane;
#pragma unroll
    for (int j = 0; j < NJ; ++j) { const unsigned k = fkey(pl[j * 64]); v[j] = (j * 64 + lane < n) ? k : 0u; }
    unsigned T = 1u; int need = 1 << 30;
    if (n > TOPK) {
        unsigned prefix = 0u; bool exact = false;
        for (int bit = 31; bit >= 0; --bit) {
            const unsigned cand = prefix | (1u << bit);
            int cnt = 0;
#pragma unroll
            for (int j = 0; j < NJ; ++j) if (j < nj) cnt += __popcll(__ballot(v[j] >= cand));
            if (cnt >= TOPK) prefix = cand;
            if (cnt == TOPK) { exact = true; break; }
        }
        T = prefix;
        if (!exact) {
            int cgt = 0;
#pragma unroll
            for (int j = 0; j < NJ; ++j) if (j < nj) cgt += __popcll(__ballot(v[j] > T));
            need = TOPK - cgt;
        }
    }
    int base_eq = 0, base_sel = 0; unsigned long long mymask = 0ull;
#pragma unroll
    for (int j = 0; j < NJ; ++j) if (j < nj) {
        const bool gt = v[j] > T, eq = v[j] == T;
        const unsigned long long eqm = __ballot(eq);
        const bool s = gt || (eq && (base_eq + mbcnt64(eqm)) < need);
        const unsigned long long sm = __ballot(s);
        if (sel && s) sel[base_sel + mbcnt64(sm)] = j * 64 + lane;
        base_eq += __popcll(eqm); base_sel += __popcll(sm);
        if (NJ <= 64 && lane == j) mymask = sm;
    }
    if (bm_row) bm_row[lane] = mymask;
    if (nsel && lane == 0) *nsel = base_sel;
}
__device__ __forceinline__ void idx_select_phase(const Params& p, PG8_LAS unsigned char* lds) {
    const int tid = threadIdx.x, lane = tid & 63, wave = __builtin_amdgcn_readfirstlane(tid >> 6), r = lane & 31, kh = lane >> 5;
    unsigned char* ws = p.ws;
    const float* Z = (const float*)(ws + WS_Z);
    const float* cache_ki = p.in[4]; const int* page_table = (const int*)p.in[7];
    int* SEL = (int*)(ws + WS_SEL); int* NSEL = (int*)(ws + WS_NSEL); unsigned long long* BM = (unsigned long long*)(ws + WS_BM);
    PG8_LAS float* sc = (PG8_LAS float*)lds;
    const int G = gridDim.x;
    for (int bs = blockIdx.x; bs < DB; bs += G) {
        IdxQ q; idx_load_q(q, Z, MP + bs * DS, lane);
        bf16x8 khi[4], klo[4];
        for (int pg = wave; pg < NPAGES; pg += NWAVES) {
            const int phys = page_table[bs * NPAGES + pg];
            const float* pbase = cache_ki + (size_t)phys * PAGE * IDD;
#pragma unroll 1
            for (int tt = 0; tt < 4; ++tt) {
                idx_load_key(pbase + (size_t)(tt * 32 + r) * IDD + kh * 8, khi, klo);
                idx_tile(q, khi, klo, sc, SCS_LDL, pg * PAGE + tt * 32 + r, kh);
            }
        }
        if (wave == 0) {
            idx_load_key(r < DS ? Z + (size_t)(MP + bs * DS + r) * ZLD + C_KI + kh * 8 : nullptr, khi, klo);
            idx_tile(q, khi, klo, sc, SCS_LDL, NPAST + r, kh, r < DS);
        }
        __syncthreads();
        if (wave < DS) { const int row = MP + bs * DS + wave; select_row<129>(sc + wave * SCS_LDL, NPAST + wave + 1, lane, nullptr, SEL + (size_t)row * TOPK, NSEL + row); }
        __syncthreads();
    }
    for (int i = 0;; ++i) {
        const int s = i * G + ((i & 1) ? G - 1 - (int)blockIdx.x : (int)blockIdx.x);
        if (i * G >= MP / 8) break;
        if (s < MP / 8) {
            const int b = s & 1, q0 = (s >> 1) * 8, grow0 = b * SEQ + q0, ntile = (q0 + 8 + 31) >> 5;
            IdxQ qa, qb; idx_load_q(qa, Z, grow0, lane); idx_load_q(qb, Z, grow0 + 4, lane);
            bf16x8 khi[4], klo[4];
            for (int t = wave; t < ntile; t += NWAVES) {
                idx_load_key(Z + (size_t)(b * SEQ + t * 32 + r) * ZLD + C_KI + kh * 8, khi, klo);
                idx_tile(qa, khi, klo, sc, SCP_LD, t * 32 + r, kh);
                idx_tile(qb, khi, klo, sc + 4 * SCP_LD, SCP_LD, t * 32 + r, kh);
            }
            __syncthreads();
            { const int row = grow0 + wave; select_row<64>(sc + wave * SCP_LD, q0 + wave + 1, lane, BM + (size_t)row * 64, SEL + (size_t)row * TOPK, NSEL + row); }
        }
        __syncthreads();
    }
}
__device__ __forceinline__ void copy_kv_phase(const Params& p) {
    const float* Z = (const float*)(p.ws + WS_Z); float* out = p.out;
    for (size_t i = (size_t)blockIdx.x * NTHREADS + threadIdx.x; i < (size_t)MT * 272; i += (size_t)gridDim.x * NTHREADS) {
        const int row = (int)(i / 272), c4 = (int)(i % 272);
        const float* z = Z + (size_t)row * ZLD;
        const bool pr = row < MP; const int rr = pr ? row : row - MP;
        if (c4 < 128) *(f32x4*)(out + (pr ? O_KP : O_KS) + (size_t)rr * 512 + c4 * 4) = *(const f32x4*)(z + C_K + c4 * 4);
        else if (c4 < 256) *(f32x4*)(out + (pr ? O_VP : O_VS) + (size_t)rr * 512 + (c4 - 128) * 4) = *(const f32x4*)(z + C_V + (c4 - 128) * 4);
        else *(f32x4*)(out + (pr ? O_KIP : O_KIS) + (size_t)rr * 64 + (c4 - 256) * 4) = *(const f32x4*)(z + C_KI + (c4 - 256) * 4);
    }
}


__device__ __forceinline__ void attn_gather_unit(const Params& p, PG8_LAS unsigned char* lds, int row) {
    const int tid = threadIdx.x, lane = tid & 63, wave = tid >> 6;
    unsigned char* ws = p.ws;
    const float* Z = (const float*)(ws + WS_Z);
    const float* cache_k = p.in[2]; const float* cache_v = p.in[3]; const int* page_table = (const int*)p.in[7];
    const int* SEL = (const int*)(ws + WS_SEL); const int* NSEL = (const int*)(ws + WS_NSEL);
    bf16_t* CATB = (bf16_t*)(ws + WS_CATB);
    PG8_LAS float* qs = (PG8_LAS float*)lds;
    PG8_LAS float* ps = (PG8_LAS float*)(lds + 4096);
    PG8_LAS unsigned long long* kps = (PG8_LAS unsigned long long*)(lds + 12288);
    PG8_LAS unsigned long long* vps = (PG8_LAS unsigned long long*)(lds + 14336);
    const float* z = Z + (size_t)row * ZLD;
    qs[tid] = z[C_Q + tid]; qs[tid + 512] = z[C_Q + 512 + tid];
    const int ns = NSEL[row];
    if (tid < ns) {
        const int idx = SEL[(size_t)row * TOPK + tid];
        const float* kp; const float* vp;
        if (row < MP) { const int b = row / SEQ; kp = Z + (size_t)(b * SEQ + idx) * ZLD + C_K; vp = Z + (size_t)(b * SEQ + idx) * ZLD + C_V; }
        else {
            const int b = (row - MP) / DS;
            if (idx < NPAST) { const size_t prow = (size_t)page_table[b * NPAGES + idx / PAGE] * PAGE + (idx % PAGE); kp = cache_k + prow * 512; vp = cache_v + prow * 512; }
            else { const size_t zr = (size_t)(MP + b * DS + idx - NPAST); kp = Z + zr * ZLD + C_K; vp = Z + zr * ZLD + C_V; }
        }
        kps[tid] = (unsigned long long)kp; vps[tid] = (unsigned long long)vp;
    }
    __syncthreads();
    {
        const int j = tid & 255, hg = tid >> 8;
        float lg[4] = {-INFINITY, -INFINITY, -INFINITY, -INFINITY};
        if (j < ns) {
            const float* kp = (const float*)kps[j] + hg * 256;
#pragma unroll
            for (int n2 = 0; n2 < 2; ++n2) {
                float d0 = 0.f, d1 = 0.f;
                const PG8_LAS float* q0 = qs + (4 * hg + 2 * n2) * HD; const PG8_LAS float* q1 = q0 + HD;
#pragma unroll 8
                for (int d = 0; d < HD; d += 4) {
                    const f32x4 k4 = *(const f32x4*)(kp + n2 * HD + d);
                    d0 += q0[d] * k4[0] + q0[d + 1] * k4[1] + q0[d + 2] * k4[2] + q0[d + 3] * k4[3];
                    d1 += q1[d] * k4[0] + q1[d + 1] * k4[1] + q1[d + 2] * k4[2] + q1[d + 3] * k4[3];
                }
                lg[2 * n2] = d0 * ATTN_SCALE; lg[2 * n2 + 1] = d1 * ATTN_SCALE;
            }
        }
#pragma unroll
        for (int h = 0; h < 4; ++h) ps[(4 * hg + h) * TOPK + j] = lg[h];
    }
    __syncthreads();
    {
        float v[4]; float m = -INFINITY;
#pragma unroll
        for (int i = 0; i < 4; ++i) { v[i] = ps[wave * TOPK + lane + 64 * i]; m = fmaxf(m, v[i]); }
#pragma unroll
        for (int o = 32; o >= 1; o >>= 1) m = fmaxf(m, __shfl_xor(m, o));
        float sum = 0.f;
#pragma unroll
        for (int i = 0; i < 4; ++i) { v[i] = expf(v[i] - m); sum += v[i]; }
#pragma unroll
        for (int o = 32; o >= 1; o >>= 1) sum += __shfl_xor(sum, o);
        const float inv = 1.0f / sum;
#pragma unroll
        for (int i = 0; i < 4; ++i) ps[wave * TOPK + lane + 64 * i] = v[i] * inv;
    }
    __syncthreads();
#pragma unroll
    for (int i = 0; i < 2; ++i) {
        const int o = tid + 512 * i, hq = o >> 7, d = o & 127, n = hq >> 1;
        float acc = 0.f;
#pragma unroll 8
        for (int j = 0; j < ns; ++j) acc = fmaf(ps[hq * TOPK + j], ((const float*)vps[j])[n * HD + d], acc);
        CATB[(size_t)row * D + 1024 + o] = f2bf(acc);
    }
    __syncthreads();
}

__global__ void __launch_bounds__(NTHREADS, 2) mk_fwd(Params p) {
    extern __shared__ __attribute__((aligned(16))) unsigned char lds_raw[];
    PG8_LAS unsigned char* lds = (PG8_LAS unsigned char*)lds_raw;
    unsigned char* ws = p.ws;
    const int lo = p.ph_lo, hi = p.ph_hi;
    const int G = gridDim.x;
    if (threadIdx.x < 4) ((volatile PG8_LAS unsigned*)(lds + LDS_MISC))[threadIdx.x] = 0u;
    __syncthreads();
    XcdBarrier bar = xcd_barrier_post((unsigned*)(ws + WS_CTL) + (size_t)p.li * XCD_BAR_WORDS, (volatile LAS unsigned*)(lds + LDS_MISC));
#define SEAM(k) do { if (lo <= (k) && (k) + 1 < hi) xcd_barrier(bar); } while (0)
    bf16_t* Wgu1 = (bf16_t*)(ws + WS_WGU1); bf16_t* Wd1 = (bf16_t*)(ws + WS_WD1); bf16_t* Win = (bf16_t*)(ws + WS_WIN); bf16_t* Wout = (bf16_t*)(ws + WS_WOUT);
    bf16_t* Wgu2 = (bf16_t*)(ws + WS_WGU2); bf16_t* Wd2 = (bf16_t*)(ws + WS_WD2);
    bf16_t* XB = (bf16_t*)(ws + WS_XB); bf16_t* H = (bf16_t*)(ws + WS_H); float* T = (float*)(ws + WS_T); float* X1 = (float*)(ws + WS_X1); float* X2 = (float*)(ws + WS_X2);
    float* Z = (float*)(ws + WS_Z); bf16_t* CATB = (bf16_t*)(ws + WS_CATB);
#define IN(k) (lo <= (k) && (k) < hi)
    if (IN(0)) {
        PG8_LAS float* tile = (PG8_LAS float*)lds;
        transpose_cvt<1>(p.in[10], D, 2 * DFF, 2 * DFF, Wgu1, tile);
        transpose_cvt<0>(p.in[11], DFF, D, D, Wd1, tile);
        transpose_cvt<0>(p.in[12], D, DIN, DINP, Win, tile);
        transpose_cvt<0>(p.in[20], D, D, D, Wout, tile);
        transpose_cvt<1>(p.in[23], D, 2 * DFF, 2 * DFF, Wgu2, tile);
        transpose_cvt<0>(p.in[24], DFF, D, D, Wd2, tile);
        cvt_x(p.in[0], p.in[1], XB);
        for (int n = 0; n < 8; ++n) { transpose_cvt<0>(p.in[15] + n * 16384, 128, 128, 128, (bf16_t*)(ws + WS_WAT) + n * 16384, tile); transpose_cvt<0>(p.in[17] + n * 16384, 128, 128, 128, (bf16_t*)(ws + WS_WIT) + n * 16384, tile); }
    }
    SEAM(0);
    if (IN(1)) {
        pg8::Gemm g{XB, Wgu1, MPAD, 2 * DFF, D}; pg8::StaticOrder S; S.init(MPAD, 2 * DFF, G, (int)blockIdx.x);
        EpiSwiGLU E{H};
        pg8::gemm_phase<EpiSwiGLU, pg8::StaticOrder, true, true>(lds, g, S, E);
    }
    SEAM(1);
    if (IN(2)) {
        pg8::Gemm g{H, Wd1, MPAD, D, DFF}; pg8::StaticOrder S; S.init(MPAD, D, G, (int)blockIdx.x);
        EpiResid E{p.in[0], p.in[1], T, 0.5f};
        pg8::gemm_phase<EpiResid, pg8::StaticOrder, true, true>(lds, g, S, E);
    }
    SEAM(2);
    if (IN(3)) ln_phase(T, p.in[8], p.in[9], X1, XB);
    SEAM(3);
    if (IN(4)) {
        pg8::Gemm g{XB, Win, MPAD, DINP, D}; pg8::StaticOrder S; S.init(MPAD, DINP, G, (int)blockIdx.x);
        EpiF32 E{Z, ZLD};
        pg8::gemm_phase<EpiF32, pg8::StaticOrder, true, true>(lds, g, S, E);
    }
    SEAM(4);
    if (IN(5)) { idx_select_phase(p, lds); lru_local_phase(p, lds); copy_kv_phase(p); }
    SEAM(5);
    if (IN(6)) { for (int row = MT - 1 - (int)blockIdx.x; row >= 0; row -= G) attn_gather_unit(p, lds, row); for (int ck = blockIdx.x; ck < LRU_NCHUNK; ck += G) lru_fixup_unit(p, ck); }
    SEAM(6);
    if (IN(7)) {
        pg8::Gemm g{CATB, Wout, MPAD, D, D}; pg8::StaticOrder S; S.init(MPAD, D, G, (int)blockIdx.x);
        EpiResid E{X1, X1 + (size_t)MP * D, T, 1.0f};
        pg8::gemm_phase<EpiResid, pg8::StaticOrder, true, true>(lds, g, S, E);
    }
    SEAM(7);
    if (IN(8)) ln_phase(T, p.in[21], p.in[22], X2, XB);
    SEAM(8);
    if (IN(9)) {
        pg8::Gemm g{XB, Wgu2, MPAD, 2 * DFF, D}; pg8::StaticOrder S; S.init(MPAD, 2 * DFF, G, (int)blockIdx.x);
        EpiSwiGLU E{H};
        pg8::gemm_phase<EpiSwiGLU, pg8::StaticOrder, true, true>(lds, g, S, E);
    }
    SEAM(9);
    if (IN(10)) {
        pg8::Gemm g{H, Wd2, MPAD, D, DFF}; pg8::StaticOrder S; S.init(MPAD, D, G, (int)blockIdx.x);
        EpiResid E{X2, X2 + (size_t)MP * D, T, 0.5f};
        pg8::gemm_phase<EpiResid, pg8::StaticOrder, true, true>(lds, g, S, E);
    }
    SEAM(10);
    if (IN(11)) ln_phase(T, p.in[25], p.in[26], p.out + O_YP, nullptr);
#undef IN
#undef SEAM
}

__global__ __launch_bounds__(256) void sgemm(const float* __restrict__ A, int lda, const float* __restrict__ B, int ldb, float* __restrict__ C, int ldc,
                                             int M, int N, int K, long sA, long sB, long sC) {
    __shared__ float As[16][132];
    __shared__ float Bs[16][132];
    A += sA * blockIdx.z; B += sB * blockIdx.z; C += sC * blockIdx.z;
    const int tid = threadIdx.x, tx = tid & 15, ty = tid >> 4;
    const int m0 = blockIdx.y * 128, n0 = blockIdx.x * 128;
    float acc[8][8];
#pragma unroll
    for (int i = 0; i < 8; ++i)
#pragma unroll
        for (int j = 0; j < 8; ++j) acc[i][j] = 0.f;
    for (int k0 = 0; k0 < K; k0 += 16) {
#pragma unroll
        for (int i = 0; i < 8; ++i) {
            const int e = tid + 256 * i, m = e >> 4, k = e & 15, gm = m0 + m;
            As[k][m] = (gm < M) ? A[(size_t)gm * lda + k0 + k] : 0.f;
        }
#pragma unroll
        for (int i = 0; i < 8; ++i) {
            const int e = tid + 256 * i, k = e >> 7, n = e & 127, gn = n0 + n;
            Bs[k][n] = (gn < N) ? B[(size_t)(k0 + k) * ldb + gn] : 0.f;
        }
        __syncthreads();
#pragma unroll
        for (int k = 0; k < 16; ++k) {
            float a[8], b[8];
#pragma unroll
            for (int i = 0; i < 8; ++i) a[i] = As[k][ty * 8 + i];
#pragma unroll
            for (int j = 0; j < 8; ++j) b[j] = Bs[k][tx * 8 + j];
#pragma unroll
            for (int i = 0; i < 8; ++i)
#pragma unroll
                for (int j = 0; j < 8; ++j) acc[i][j] = fmaf(a[i], b[j], acc[i][j]);
        }
        __syncthreads();
    }
#pragma unroll
    for (int i = 0; i < 8; ++i) {
        const int gm = m0 + ty * 8 + i;
        if (gm < M) {
#pragma unroll
            for (int j = 0; j < 8; ++j) { const int gn = n0 + tx * 8 + j; if (gn < N) C[(size_t)gm * ldc + gn] = acc[i][j]; }
        }
    }
}

__global__ void copy_kv_k(const float* __restrict__ Z, float* __restrict__ out) {
    const int r = blockIdx.x;
    const float* z = Z + (size_t)r * ZLD;
    float* ko; float* vo; float* kio;
    if (r < MP) { ko = out + O_KP + (size_t)r * 512; vo = out + O_VP + (size_t)r * 512; kio = out + O_KIP + (size_t)r * 64; }
    else { const int rs = r - MP; ko = out + O_KS + (size_t)rs * 512; vo = out + O_VS + (size_t)rs * 512; kio = out + O_KIS + (size_t)rs * 64; }
    for (int c = threadIdx.x; c < 512; c += blockDim.x) { ko[c] = z[C_K + c]; vo[c] = z[C_V + c]; }
    for (int c = threadIdx.x; c < 64; c += blockDim.x) kio[c] = z[C_KI + c];
}

__global__ void conv_k(const float* __restrict__ Z, const float* __restrict__ state_conv, const float* __restrict__ cw, const float* __restrict__ cb,
                       float* __restrict__ XC, float* __restrict__ out) {
    const int r = blockIdx.x;
    for (int c = threadIdx.x; c < DRNN; c += blockDim.x) {
        float acc = cb[c];
        if (r < MP) {
            const int b = r / SEQ, t = r % SEQ;
#pragma unroll
            for (int j = 0; j < 4; ++j) { const int tt = t + j - 3; if (tt >= 0) acc += cw[j * DRNN + c] * Z[(size_t)(b * SEQ + tt) * ZLD + C_XR + c]; }
            if (t >= SEQ - 3) out[O_CP + (size_t)(b * 3 + (t - (SEQ - 3))) * DRNN + c] = Z[(size_t)r * ZLD + C_XR + c];
        } else {
            const int rs = r - MP, b = rs / DS, t = rs % DS;
#pragma unroll
            for (int j = 0; j < 4; ++j) { const int pp = t + j; const float xv = (pp < 3) ? state_conv[(size_t)(b * 3 + pp) * DRNN + c] : Z[(size_t)(MP + b * DS + pp - 3) * ZLD + C_XR + c]; acc += cw[j * DRNN + c] * xv; }
            if (t >= 1) out[O_CS + (size_t)(b * 3 + (t - 1)) * DRNN + c] = Z[(size_t)r * ZLD + C_XR + c];
        }
        XC[(size_t)r * DRNN + c] = acc;
    }
}

__global__ void scan_k(const float* __restrict__ XC, const float* __restrict__ GA, const float* __restrict__ GI, const float* __restrict__ Z,
                       const float* __restrict__ ba, const float* __restrict__ bi, const float* __restrict__ lam, const float* __restrict__ state_rnn,
                       bf16_t* __restrict__ CATB, float* __restrict__ out) {
    const int idx = blockIdx.x * blockDim.x + threadIdx.x;
    if (idx >= (NB + DB) * DRNN) return;
    const int s = idx / DRNN, c = idx % DRNN;
    int row0, Tn; float h;
    if (s < NB) { row0 = s * SEQ; Tn = SEQ; h = 0.f; } else { row0 = MP + (s - NB) * DS; Tn = DS; h = state_rnn[(size_t)(s - NB) * DRNN + c]; }
    const float l = lam[c];
    const float sp = (-l > 20.f) ? -l : log1pf(expf(-l));
    const float bac = ba[c], bic = bi[c];
    for (int t = 0; t < Tn; ++t) {
        const size_t r = (size_t)(row0 + t);
        const float xc = XC[r * DRNN + c];
        const float rg = sigmoidf_(GA[r * DRNN + c] + bac), ig = sigmoidf_(GI[r * DRNN + c] + bic);
        const float log_a = -8.0f * rg * sp;
        const float a = expf(log_a);
        const float u = sqrtf(-expm1f(2.0f * log_a)) * ig * xc;
        h = a * h + u;
        CATB[r * D + c] = f2bf(h * gelu_tanh(Z[r * ZLD + C_GR + c]));
    }
    if (s < NB) out[O_HP + (size_t)s * DRNN + c] = h; else out[O_HS + (size_t)(s - NB) * DRNN + c] = h;
}

__global__ __launch_bounds__(256) void idx_score_k(const float* __restrict__ Z, const float* __restrict__ cache_ki, const int* __restrict__ page_table,
                                                   float* __restrict__ SCP, float* __restrict__ SCS) {
    __shared__ float qs[IDH * IDD];
    __shared__ float wsh[IDH];
    const int r = blockIdx.x;
    const float* z = Z + (size_t)r * ZLD;
    for (int i = threadIdx.x; i < IDH * IDD; i += 256) qs[i] = z[C_QI + i];
    if (threadIdx.x < IDH) wsh[threadIdx.x] = z[C_WI + threadIdx.x] * IDX_W_SCALE;
    __syncthreads();
    int nkeys, b; float* sc;
    if (r < MP) { b = r / SEQ; nkeys = (r % SEQ) + 1; sc = SCP + (size_t)r * SEQ; }
    else { const int rs = r - MP; b = rs / DS; nkeys = NPAST + (rs % DS) + 1; sc = SCS + (size_t)rs * SCS_LD; }
    for (int key = threadIdx.x; key < nkeys; key += 256) {
        const float* kp;
        if (r < MP) kp = Z + (size_t)(b * SEQ + key) * ZLD + C_KI;
        else if (key < NPAST) kp = cache_ki + ((size_t)page_table[b * NPAGES + key / PAGE] * PAGE + (key % PAGE)) * IDD;
        else kp = Z + (size_t)(MP + b * DS + key - NPAST) * ZLD + C_KI;
        float kv[IDD];
#pragma unroll
        for (int d = 0; d < IDD; d += 4) { const float4 t4 = *(const float4*)(kp + d); kv[d] = t4.x; kv[d + 1] = t4.y; kv[d + 2] = t4.z; kv[d + 3] = t4.w; }
        float tot = 0.f;
#pragma unroll
        for (int h = 0; h < IDH; ++h) {
            float dot = 0.f;
#pragma unroll
            for (int d = 0; d < IDD; ++d) dot = fmaf(qs[h * IDD + d], kv[d], dot);
            tot += fmaxf(dot * IDX_SCALE, 0.f) * wsh[h];
        }
        sc[key] = tot;
    }
}

__global__ __launch_bounds__(256) void topk_k(const float* __restrict__ SCP, const float* __restrict__ SCS, int* __restrict__ SEL, int* __restrict__ NSEL) {
    __shared__ unsigned cnt_s;
    __shared__ unsigned pos_s;
    __shared__ unsigned cnts[256];
    const int r = blockIdx.x, t = threadIdx.x;
    int n; const float* sc;
    if (r < MP) { n = (r % SEQ) + 1; sc = SCP + (size_t)r * SEQ; } else { const int rs = r - MP; n = NPAST + (rs % DS) + 1; sc = SCS + (size_t)rs * SCS_LD; }
    int* sel = SEL + (size_t)r * TOPK;
    if (n <= TOPK) { if (t < n) sel[t] = t; if (t == 0) NSEL[r] = n; return; }
    unsigned prefix = 0u;
    for (int bit = 31; bit >= 0; --bit) {
        const unsigned cand = prefix | (1u << bit);
        if (t == 0) cnt_s = 0u;
        __syncthreads();
        unsigned c = 0;
        for (int i = t; i < n; i += 256) c += (fkey(sc[i]) >= cand) ? 1u : 0u;
#pragma unroll
        for (int o = 32; o >= 1; o >>= 1) c += __shfl_xor(c, o);
        if ((t & 63) == 0) atomicAdd(&cnt_s, c);
        __syncthreads();
        if (cnt_s >= (unsigned)TOPK) prefix = cand;
        __syncthreads();
    }
    unsigned c = 0;
    for (int i = t; i < n; i += 256) c += (fkey(sc[i]) > prefix) ? 1u : 0u;
    cnts[t] = c;
    __syncthreads();
    unsigned pp = 0;
    for (int j = 0; j < t; ++j) pp += cnts[j];
    for (int i = t; i < n; i += 256) if (fkey(sc[i]) > prefix) sel[pp++] = i;
    if (t == 255) pos_s = pp;
    __syncthreads();
    if (t == 0) {
        unsigned q = pos_s;
        for (int i = 0; i < n && q < (unsigned)TOPK; ++i) if (fkey(sc[i]) == prefix) sel[q++] = i;
        NSEL[r] = TOPK;
    }
}

__global__ __launch_bounds__(256) void attn_k(const float* __restrict__ Z, const float* __restrict__ cache_k, const float* __restrict__ cache_v, const int* __restrict__ page_table,
                                              const int* __restrict__ SEL, const int* __restrict__ NSEL, bf16_t* __restrict__ CATB) {
    __shared__ float qs[1024];
    __shared__ float ps[8][TOPK];
    __shared__ const float* kptr[TOPK];
    __shared__ const float* vptr[TOPK];
    __shared__ float red[8][4];
    const int r = blockIdx.x, t = threadIdx.x;
    const float* z = Z + (size_t)r * ZLD;
    for (int i = t; i < 1024; i += 256) qs[i] = z[C_Q + i];
    const int ns = NSEL[r];
    float lg[8];
    if (t < ns) {
        const int idx = SEL[(size_t)r * TOPK + t];
        const float* kp; const float* vp;
        if (r < MP) { const int b = r / SEQ; kp = Z + (size_t)(b * SEQ + idx) * ZLD + C_K; vp = Z + (size_t)(b * SEQ + idx) * ZLD + C_V; }
        else {
            const int b = (r - MP) / DS;
            if (idx < NPAST) { const size_t row = (size_t)page_table[b * NPAGES + idx / PAGE] * PAGE + (idx % PAGE); kp = cache_k + row * 512; vp = cache_v + row * 512; }
            else { const size_t zr = (size_t)(MP + b * DS + idx - NPAST); kp = Z + zr * ZLD + C_K; vp = Z + zr * ZLD + C_V; }
        }
        kptr[t] = kp; vptr[t] = vp;
    }
    __syncthreads();
    if (t < ns) {
        const float* kp = kptr[t];
#pragma unroll
        for (int h = 0; h < 8; ++h) lg[h] = 0.f;
#pragma unroll
        for (int n = 0; n < NKV; ++n) {
            float d0 = 0.f, d1 = 0.f;
            for (int d = 0; d < HD; d += 4) {
                const float4 k4 = *(const float4*)(kp + n * HD + d);
                const float* q0 = qs + (2 * n) * HD + d; const float* q1 = qs + (2 * n + 1) * HD + d;
                d0 += q0[0] * k4.x + q0[1] * k4.y + q0[2] * k4.z + q0[3] * k4.w;
                d1 += q1[0] * k4.x + q1[1] * k4.y + q1[2] * k4.z + q1[3] * k4.w;
            }
            lg[2 * n] = d0 * ATTN_SCALE; lg[2 * n + 1] = d1 * ATTN_SCALE;
        }
    } else {
#pragma unroll
        for (int h = 0; h < 8; ++h) lg[h] = -INFINITY;
    }
#pragma unroll
    for (int h = 0; h < 8; ++h) {
        float m = lg[h];
#pragma unroll
        for (int o = 32; o >= 1; o >>= 1) m = fmaxf(m, __shfl_xor(m, o));
        if ((t & 63) == 0) red[h][t >> 6] = m;
    }
    __syncthreads();
    float e[8];
#pragma unroll
    for (int h = 0; h < 8; ++h) {
        const float m = fmaxf(fmaxf(red[h][0], red[h][1]), fmaxf(red[h][2], red[h][3]));
        e[h] = (t < ns) ? expf(lg[h] - m) : 0.f;
    }
    __syncthreads();
#pragma unroll
    for (int h = 0; h < 8; ++h) {
        float s = e[h];
#pragma unroll
        for (int o = 32; o >= 1; o >>= 1) s += __shfl_xor(s, o);
        if ((t & 63) == 0) red[h][t >> 6] = s;
    }
    __syncthreads();
#pragma unroll
    for (int h = 0; h < 8; ++h) { const float s = red[h][0] + red[h][1] + red[h][2] + red[h][3]; ps[h][t] = e[h] / s; }
    __syncthreads();
#pragma unroll
    for (int i = 0; i < 4; ++i) {
        const int o = t + 256 * i, hq = o >> 7, d = o & 127, n = hq >> 1;
        float acc = 0.f;
        for (int j = 0; j < ns; ++j) acc = fmaf(ps[hq][j], vptr[j][n * HD + d], acc);
        CATB[(size_t)r * D + 1024 + o] = f2bf(acc);
    }
}
}

extern "C" void kernel_launch(void* const* d_in, const int* in_sizes, int n_in, void* d_out, int out_size, void* d_ws, size_t ws_size, hipStream_t stream) {
    static int grid = 0;
    if (grid == 0) {
        if (n_in != 27 || ws_size < WS_END) { grid = -1; return; }
        int dev = 0, cus = 0;
        if (hipGetDevice(&dev) != hipSuccess || hipDeviceGetAttribute(&cus, hipDeviceAttributeMultiprocessorCount, dev) != hipSuccess) { grid = -1; return; }
        if (hipFuncSetAttribute((const void*)mk_fwd, hipFuncAttributeMaxDynamicSharedMemorySize, LDS_BYTES) != hipSuccess) { grid = -1; return; }
        (void)hipGetLastError();
        grid = cus;
    }
    if (grid < 0) return;
    const float* cache_k = (const float*)d_in[2];    const float* cache_v = (const float*)d_in[3];
    const float* cache_ki = (const float*)d_in[4];   const float* state_conv = (const float*)d_in[5];
    const float* state_rnn = (const float*)d_in[6];  const int* page_table = (const int*)d_in[7];
    const float* conv_w = (const float*)d_in[13];    const float* conv_b = (const float*)d_in[14];
    const float* lru_wa = (const float*)d_in[15];    const float* lru_ba = (const float*)d_in[16];
    const float* lru_wi = (const float*)d_in[17];    const float* lru_bi = (const float*)d_in[18];
    const float* lru_lam = (const float*)d_in[19];
    float* out = (float*)d_out;
    unsigned char* ws = (unsigned char*)d_ws;
    float* Z = (float*)(ws + WS_Z); bf16_t* CATB = (bf16_t*)(ws + WS_CATB);
    float* SCP = (float*)(ws + WS_SCP); float* SCS = (float*)(ws + WS_SCS); int* SEL = (int*)(ws + WS_SEL); int* NSEL = (int*)(ws + WS_NSEL);

    (void)hipMemsetAsync(ws + WS_CTL, 0, CTL_BYTES, stream);
    Params p{};
    for (int i = 0; i < 27; ++i) p.in[i] = (const float*)d_in[i];
    p.out = out; p.ws = ws;
    int nli = 0;
    auto run = [&](int lo, int hi) { p.ph_lo = lo; p.ph_hi = hi; p.li = nli++; hipLaunchKernelGGL(mk_fwd, dim3(grid), dim3(NTHREADS), LDS_BYTES, stream, p); };
    auto gemm = [&](const float* A, int lda, const float* B, int ldb, float* C, int ldc, int M, int N, int K, int batch, long sA, long sB, long sC) {
        dim3 g((N + 127) / 128, (M + 127) / 128, batch);
        sgemm<<<g, 256, 0, stream>>>(A, lda, B, ldb, C, ldc, M, N, K, sA, sB, sC);
    };
    run(0, 12);
}
```

```cpp
#include <hip/hip_runtime.h>
#include <stdint.h>

namespace pg8 {
#define PG8_LAS __attribute__((address_space(3)))
typedef unsigned short bf16_t;
typedef short bf16x8 __attribute__((ext_vector_type(8)));
typedef float f32x4 __attribute__((ext_vector_type(4)));
typedef unsigned u32x4 __attribute__((ext_vector_type(4)));
constexpr int BM = 256, BK = 64, HALF = 128, HTB = HALF * BK * 2  , STAGE_BYTES = 8 * HTB, NXCD = 8, WGM = 8;

__host__ __device__ __forceinline__ int lds_byte(int r, int c) { const int st = (r >> 4) * 2 + (c >> 5), rr = r & 15, cc = c & 31, ob = rr * 64 + cc * 2; return st * 1024 + (ob ^ (((ob >> 9) & 1) << 5)); }
__host__ __device__ __forceinline__ void stage_rc(int b, int& R, int& C) { const int st = b / 1024, sb = b % 1024, swz = sb ^ (((sb >> 9) & 1) << 5); R = (st >> 1) * 16 + swz / 64; C = (st & 1) * 32 + (swz % 64) / 2; }
__host__ __device__ __forceinline__ int perm32(int rho) { const int n = rho >> 4, i = rho & 15; return 8 * (i >> 2) + 4 * n + (i & 3); }

struct Unit { int pm, pn; };
struct Gemm { const bf16_t* A; const bf16_t* Bt; int M, N, K; };

struct StaticOrder {
    int nM, nN, nwg, G, c;
    __host__ __device__ void init(int M, int N, int G_, int c_) { nM = M / BM; nN = N / BM; nwg = nM * nN; G = G_; c = c_; }
    __host__ __device__ bool next(int i, Unit& u) const {
        const long L = (long)i * G + c; if (L >= nwg) return false;
        int wgid = (int)L; { const int q = nwg / NXCD, r = nwg % NXCD, xcd = wgid % NXCD, off = wgid / NXCD; wgid = (xcd < r ? xcd * (q + 1) : r * (q + 1) + (xcd - r) * q) + off; }
        const int nig = WGM * nN, gid = wgid / nig, fm = gid * WGM, gsz = (nM - fm) < WGM ? (nM - fm) : WGM;
        u.pm = fm + ((wgid % nig) % gsz); u.pn = (wgid % nig) / gsz; return true;
    }
    __device__ __forceinline__ void a_ready(const Unit&) const {}
    __device__ __forceinline__ void done(const Unit&) const {}
};

__device__ __forceinline__ unsigned cvt_pk_bf16(float lo, float hi) { unsigned r; asm volatile("v_cvt_pk_bf16_f32 %0, %1, %2" : "=v"(r) : "v"(lo), "v"(hi)); return r; }
typedef float f32x2 __attribute__((ext_vector_type(2)));

template <class Epi, class Sched, bool ALIGN_EPI = false, bool SP2 = false>
__device__ __forceinline__ void gemm_phase(PG8_LAS unsigned char* lds, const Gemm g, const Sched& S, const Epi& E) {
    const int tid = threadIdx.x, wid = __builtin_amdgcn_readfirstlane(tid >> 6), lane = tid & 63, wr = wid >> 2, wc = wid & 3, fr = lane & 15, fq = lane >> 4;
    const int K = g.K, nt = K / BK;
    unsigned voffA[2], voffB[2];
#pragma unroll
    for (int i = 0; i < 2; ++i) { int R, C; stage_rc(tid * 16 + i * 8192, R, C); const int Rb = Epi::PERM ? ((R & ~31) + perm32(R & 31)) : R;
        voffA[i] = (unsigned)(R * K + C) * 2u; voffB[i] = (unsigned)(Rb * K + C) * 2u; }
    const size_t kstep = (size_t)(BK * 2);
    const size_t hstep = (size_t)HALF * K * 2;
    const size_t tstep = 2 * hstep;
    const unsigned ldsw = (unsigned)wid * 1024u;
    const int aoff = lds_byte(wr * 64 + fr, fq * 8), boff = lds_byte(wc * 32 + fr, fq * 8);
#define PG8_SA(b, h) (((b) * 2 + (h)) * HTB)
#define PG8_SB(b, h) ((4 + (b) * 2 + (h)) * HTB)
#define PG8_STAGE(bufoff, gbase, voff) do { _Pragma("unroll") for (int _i = 0; _i < 2; ++_i) \
        __builtin_amdgcn_global_load_lds((const unsigned*)((const char*)(gbase) + (voff)[_i]), (PG8_LAS unsigned*)(lds + (bufoff) + ldsw + _i * 8192), 16, 0, 0); } while (0)
#define PG8_LDA(dst, b, h) do { _Pragma("unroll") for (int m = 0; m < 4; ++m) _Pragma("unroll") for (int k = 0; k < 2; ++k) dst[m][k] = *(const PG8_LAS bf16x8*)(lds + PG8_SA(b, h) + aoff + m * 2048 + k * 1024); } while (0)
#define PG8_LDB(dst, b, h) do { _Pragma("unroll") for (int n = 0; n < 2; ++n) _Pragma("unroll") for (int k = 0; k < 2; ++k) dst[n][k] = *(const PG8_LAS bf16x8*)(lds + PG8_SB(b, h) + boff + n * 2048 + k * 1024); } while (0)
#define PG8_MMA(ai, bj, At, Bt) do { __builtin_amdgcn_s_setprio(1); _Pragma("unroll") for (int m = 0; m < 4; ++m) _Pragma("unroll") for (int n = 0; n < 2; ++n) _Pragma("unroll") for (int k = 0; k < 2; ++k) \
        acc[ai][bj][m][n] = __builtin_amdgcn_mfma_f32_16x16x32_bf16(Bt[n][k], At[m][k], acc[ai][bj][m][n], 0, 0, 0); __builtin_amdgcn_s_setprio(0); } while (0)
#define PG8_WAIT_V(n) asm volatile("s_waitcnt vmcnt(" #n ")" ::: "memory")
#define PG8_WAIT_L(n) asm volatile("s_waitcnt lgkmcnt(" #n ")" ::: "memory")
#define PG8_BAR __builtin_amdgcn_s_barrier()
#define PG8_SCHED __builtin_amdgcn_sched_barrier(0)
    Unit cur, nxt; int ui = 0;
    if (!S.next(0, cur)) return;
    f32x4 acc[2][2][4][2];
#pragma unroll
    for (int a = 0; a < 2; ++a)
#pragma unroll
        for (int b = 0; b < 2; ++b)
#pragma unroll
            for (int m = 0; m < 4; ++m)
#pragma unroll
                for (int n = 0; n < 2; ++n) acc[a][b][m][n] = (f32x4){0.f, 0.f, 0.f, 0.f};
    bf16x8 At[4][2], B0[2][2], B1[2][2];
    const char* cA = (const char*)g.A + (size_t)cur.pm * tstep; const char* cB = (const char*)g.Bt + (size_t)cur.pn * tstep;
    S.a_ready(cur);
    if constexpr (SP2) {
        PG8_STAGE(PG8_SB(0, 0), cB, voffB); PG8_STAGE(PG8_SB(0, 1), cB + hstep, voffB); PG8_STAGE(PG8_SA(0, 0), cA, voffA); PG8_STAGE(PG8_SA(0, 1), cA + hstep, voffA);
        if (wr == 1) PG8_BAR;
        PG8_WAIT_V(2); PG8_BAR;
        PG8_STAGE(PG8_SB(1, 0), cB + kstep, voffB); PG8_STAGE(PG8_SA(1, 0), cA + kstep, voffA); PG8_STAGE(PG8_SB(1, 1), cB + hstep + kstep, voffB);
        PG8_WAIT_V(6); PG8_BAR;
    } else {
        PG8_STAGE(PG8_SB(0, 0), cB, voffB); PG8_STAGE(PG8_SA(0, 0), cA, voffA); PG8_STAGE(PG8_SB(0, 1), cB + hstep, voffB); PG8_STAGE(PG8_SA(0, 1), cA + hstep, voffA);
        if (wr == 1) PG8_BAR;
        PG8_WAIT_V(4); PG8_BAR;
        PG8_STAGE(PG8_SB(1, 0), cB + kstep, voffB); PG8_STAGE(PG8_SA(1, 0), cA + kstep, voffA); PG8_STAGE(PG8_SB(1, 1), cB + hstep + kstep, voffB);
        PG8_WAIT_V(6); PG8_BAR;
    }
    for (;;) {
        const bool has_next = S.next(ui + 1, nxt);
        const char* nA = has_next ? (const char*)g.A + (size_t)nxt.pm * tstep : cA; const char* nB = has_next ? (const char*)g.Bt + (size_t)nxt.pn * tstep : cB;
        for (int t = 0; t < nt; t += 2) {
            const bool last = (t == nt - 2);
            const char* a1 = cA + (size_t)(t + 1) * kstep;
            const char* a2 = last ? nA : cA + (size_t)(t + 2) * kstep; const char* b2 = last ? nB : cB + (size_t)(t + 2) * kstep;
            const char* a3 = a2 + kstep; const char* b3 = b2 + kstep;
            if (last && has_next) S.a_ready(nxt);
            if constexpr (SP2) {
            PG8_LDB(B0, 0, 0); PG8_LDB(B1, 0, 1); PG8_SCHED; PG8_LDA(At, 0, 0); PG8_STAGE(PG8_SA(1, 1), a1 + hstep, voffA);
            PG8_WAIT_V(8); PG8_WAIT_L(0); PG8_BAR; PG8_MMA(0, 0, At, B0); PG8_MMA(0, 1, At, B1); PG8_BAR; PG8_SCHED;
            PG8_LDA(At, 0, 1); PG8_STAGE(PG8_SB(0, 0), b2, voffB); PG8_STAGE(PG8_SB(0, 1), b2 + hstep, voffB); PG8_STAGE(PG8_SA(0, 0), a2, voffA);
            PG8_WAIT_V(8); PG8_WAIT_L(0); PG8_BAR; PG8_MMA(1, 0, At, B0); PG8_MMA(1, 1, At, B1); PG8_BAR; PG8_SCHED;
            PG8_LDB(B0, 1, 0); PG8_LDB(B1, 1, 1); PG8_SCHED; PG8_LDA(At, 1, 0); PG8_STAGE(PG8_SA(0, 1), a2 + hstep, voffA);
            PG8_WAIT_V(8); PG8_WAIT_L(0); PG8_BAR; PG8_MMA(0, 0, At, B0); PG8_MMA(0, 1, At, B1); PG8_BAR; PG8_SCHED;
            PG8_LDA(At, 1, 1); PG8_STAGE(PG8_SB(1, 0), b3, voffB); PG8_STAGE(PG8_SB(1, 1), b3 + hstep, voffB); PG8_STAGE(PG8_SA(1, 0), a3, voffA);
            PG8_WAIT_V(8); PG8_WAIT_L(0); PG8_BAR; PG8_MMA(1, 0, At, B0); PG8_MMA(1, 1, At, B1); PG8_BAR; PG8_SCHED;
            } else {
            PG8_LDB(B0, 0, 0); PG8_SCHED; PG8_LDA(At, 0, 0); PG8_STAGE(PG8_SA(1, 1), a1 + hstep, voffA);
            PG8_WAIT_L(8); PG8_BAR; PG8_WAIT_L(0); PG8_MMA(0, 0, At, B0); PG8_BAR; PG8_SCHED;
            PG8_LDB(B1, 0, 1); PG8_STAGE(PG8_SB(0, 0), b2, voffB);
            PG8_BAR; PG8_WAIT_L(0); PG8_MMA(0, 1, At, B1); PG8_BAR;
            PG8_LDA(At, 0, 1); PG8_STAGE(PG8_SA(0, 0), a2, voffA);
            PG8_BAR; PG8_WAIT_L(0); PG8_MMA(1, 0, At, B0); PG8_BAR; PG8_SCHED;
            PG8_STAGE(PG8_SB(0, 1), b2 + hstep, voffB);
            PG8_WAIT_V(6); PG8_BAR; PG8_MMA(1, 1, At, B1); PG8_BAR;
            PG8_LDB(B0, 1, 0); PG8_SCHED; PG8_LDA(At, 1, 0); PG8_STAGE(PG8_SA(0, 1), a2 + hstep, voffA);
            PG8_WAIT_L(8); PG8_BAR; PG8_WAIT_L(0); PG8_MMA(0, 0, At, B0); PG8_BAR; PG8_SCHED;
            PG8_LDB(B1, 1, 1); PG8_STAGE(PG8_SB(1, 0), b3, voffB);
            PG8_BAR; PG8_WAIT_L(0); PG8_MMA(0, 1, At, B1); PG8_BAR;
            PG8_LDA(At, 1, 1); PG8_STAGE(PG8_SA(1, 0), a3, voffA);
            PG8_BAR; PG8_WAIT_L(0); PG8_MMA(1, 0, At, B0); PG8_BAR; PG8_SCHED;
            PG8_STAGE(PG8_SB(1, 1), b3 + hstep, voffB);
            PG8_WAIT_V(6); PG8_BAR; PG8_MMA(1, 1, At, B1); PG8_BAR;
            }
        }
        if constexpr (ALIGN_EPI) { if (wr == 0) PG8_BAR; }
        if constexpr (!Epi::AFTER_DRAIN) { E(acc, cur, wr, wc, fr, fq); S.done(cur); }
        if (!has_next) break;
#pragma unroll
        for (int a = 0; a < 2; ++a)
#pragma unroll
            for (int b = 0; b < 2; ++b)
#pragma unroll
                for (int m = 0; m < 4; ++m)
#pragma unroll
                    for (int n = 0; n < 2; ++n) acc[a][b][m][n] = (f32x4){0.f, 0.f, 0.f, 0.f};
        cur = nxt; cA = nA; cB = nB; ++ui;
        if constexpr (ALIGN_EPI) { if (wr == 1) PG8_BAR; }
    }
    PG8_WAIT_V(0);
    if constexpr (!ALIGN_EPI) { if (wr == 0) PG8_BAR; }
    PG8_BAR;
    if constexpr (Epi::AFTER_DRAIN) { E.fused(acc, cur, wr, wc, fr, fq, lds, wid, lane); S.done(cur); }
#undef PG8_SA
#undef PG8_SB
#undef PG8_STAGE
#undef PG8_LDA
#undef PG8_LDB
#undef PG8_MMA
#undef PG8_WAIT_V
#undef PG8_WAIT_L
#undef PG8_BAR
#undef PG8_SCHED
}

}

#define XB_TMO      128
#define XB_XCNT(j)  (256  + 64 * (j))
#define XB_XSUB(j)  (1280 + 64 * (j))
#define XB_XGEN(j)  (2304 + 64 * (j))
#define XB_TOP      3328
#define XB_TOPGEN   3392
#define XCD_BAR_WORDS 3456
#define XB_SPIN_CAP (1u << 18)
#define LAS __attribute__((address_space(3)))

__device__ __forceinline__ unsigned xb_ld(unsigned* p)              { return __hip_atomic_load(p, __ATOMIC_RELAXED, __HIP_MEMORY_SCOPE_AGENT); }
__device__ __forceinline__ unsigned xb_add(unsigned* p, unsigned v) { return __hip_atomic_fetch_add(p, v, __ATOMIC_RELAXED, __HIP_MEMORY_SCOPE_AGENT); }
__device__ __forceinline__ unsigned xb_xcc_id() { return (unsigned)__builtin_amdgcn_s_getreg((3 << 11) | 20) & 0xFu; }
#define XB_SPIN(cond, bar) do { unsigned _sp = 0; while (cond) { __builtin_amdgcn_s_sleep(1); \
    if ((++_sp & 255u) == 0u) { if (xb_ld(&(bar)[XB_TMO])) break; if (_sp > XB_SPIN_CAP) { atomicAdd(&(bar)[XB_TMO], 1u); break; } } } } while (0)

struct XcdBarrier {
    unsigned* bar; unsigned x;
    volatile LAS unsigned* st;
};

__device__ __forceinline__ XcdBarrier xcd_barrier_post(unsigned* bar, volatile LAS unsigned* st) {
    XcdBarrier b; b.bar = bar; b.x = xb_xcc_id(); b.st = st;
    if (threadIdx.x == 0) (void)xb_add(&bar[XB_XCNT(b.x)], 1u);
    return b;
}
__device__ __forceinline__ void xcd_barrier_complete(unsigned* bar, unsigned x, unsigned& nloc, unsigned& nx) {
    const unsigned G = gridDim.x * gridDim.y * gridDim.z;
    unsigned sum, cnt, mine, sp = 0u;
    for (;;) {
        sum = 0u; cnt = 0u; mine = 0u;
#pragma unroll
        for (unsigned j = 0; j < 16; ++j) { const unsigned c = xb_ld(&bar[XB_XCNT(j)]); sum += c; cnt += (c > 0u) ? 1u : 0u; mine = (j == x) ? c : mine; }
        if (sum == G) break;
        __builtin_amdgcn_s_sleep(1);
        if ((++sp & 255u) == 0u) { if (xb_ld(&bar[XB_TMO])) break; if (sp > XB_SPIN_CAP) { atomicAdd(&bar[XB_TMO], 1u); break; } }
    }
    nloc = mine > 0u ? mine : 1u; nx = cnt > 0u ? cnt : 1u;
}

__device__ __forceinline__ void xcd_barrier(const XcdBarrier& b) {
    asm volatile("s_waitcnt vmcnt(0)" ::: "memory");
    __syncthreads();
    if (threadIdx.x == 0) {
        unsigned* bar = b.bar;
        __builtin_amdgcn_s_waitcnt(0);
        unsigned nloc = b.st[0], nx = b.st[1];
        if (nloc == 0u) { xcd_barrier_complete(bar, b.x, nloc, nx); b.st[0] = nloc; b.st[1] = nx; }
        const unsigned old = xb_add(&bar[XB_XSUB(b.x)], 1u);
        const unsigned gen = old / nloc;
        if (old + 1u == (gen + 1u) * nloc) {
            __builtin_amdgcn_fence(__ATOMIC_RELEASE, "agent");
            asm volatile("s_waitcnt vmcnt(0)" ::: "memory");
            const unsigned og = xb_add(&bar[XB_TOP], 1u);
            const unsigned tg = og / nx;
            if (og + 1u == (tg + 1u) * nx) xb_add(&bar[XB_TOPGEN], 1u);
            else XB_SPIN(xb_ld(&bar[XB_TOPGEN]) == tg, bar);
            __builtin_amdgcn_fence(__ATOMIC_ACQUIRE, "agent");
            xb_add(&bar[XB_XGEN(b.x)], 1u);
            asm volatile("s_waitcnt vmcnt(0)" ::: "memory");
        } else {
            XB_SPIN(xb_ld(&bar[XB_XGEN(b.x)]) == gen, bar);
            __builtin_amdgcn_fence(__ATOMIC_ACQUIRE, "agent");
            asm volatile("s_waitcnt vmcnt(0)" ::: "memory");
        }
    }
    __syncthreads();
}


namespace {
typedef unsigned short bf16_t;
typedef float f32x4 __attribute__((ext_vector_type(4)));
typedef unsigned u32x4 __attribute__((ext_vector_type(4)));
typedef unsigned u32x2 __attribute__((ext_vector_type(2)));

constexpr int D = 2048, SEQ = 4096, NB = 2, MP = NB * SEQ, DB = 32, DS = 4, MS = DB * DS, MT = MP + MS, MPAD = 8448;
constexpr int DFF = 5504, DRNN = 1024, HD = 128, NKV = 4, IDH = 8, IDD = 64, DIN = 4680, DINP = 4864;
constexpr int NPAGES = 64, PAGE = 128, NPAST = NPAGES * PAGE, LS = NPAST + DS, TOPK = 256;
constexpr int C_XR = 0, C_GR = 1024, C_Q = 2048, C_K = 3072, C_V = 3584, C_QI = 4096, C_KI = 4608, C_WI = 4672;
constexpr float ALPHA = 1.189207115002721f, LN_EPS = 1e-5f, ATTN_SCALE = 0.08838834764831845f, IDX_SCALE = 0.125f, IDX_W_SCALE = 0.35355339059327373f;
constexpr size_t O_YP = 0, O_YS = 16777216, O_KP = 17039360, O_VP = 21233664, O_KIP = 25427968, O_CP = 25952256, O_HP = 25958400,
                 O_KS = 25960448, O_VS = 26025984, O_KIS = 26091520, O_CS = 26099712, O_HS = 26198016;
constexpr int SCS_LD = 8256;
constexpr int ZLD = DINP;

constexpr size_t al256(size_t x) { return (x + 255) & ~(size_t)255; }
constexpr size_t WS_CTL = 0;
constexpr size_t CTL_BYTES = 65536;
constexpr size_t WS_WGU1 = WS_CTL + CTL_BYTES;
constexpr size_t WS_WD1 = WS_WGU1 + al256((size_t)2 * DFF * D * 2);
constexpr size_t WS_WIN = WS_WD1 + al256((size_t)D * DFF * 2);
constexpr size_t WS_WOUT = WS_WIN + al256((size_t)DINP * D * 2);
constexpr size_t WS_WGU2 = WS_WOUT + al256((size_t)D * D * 2);
constexpr size_t WS_WD2 = WS_WGU2 + al256((size_t)2 * DFF * D * 2);
constexpr size_t WS_XB = WS_WD2 + al256((size_t)D * DFF * 2);
constexpr size_t WS_H = WS_XB + al256((size_t)MPAD * D * 2);
constexpr size_t WS_T = WS_H + al256((size_t)MPAD * DFF * 2);
constexpr size_t WS_X1 = WS_T + al256((size_t)MPAD * D * 4);
constexpr size_t WS_X2 = WS_X1 + al256((size_t)MPAD * D * 4);
constexpr size_t WS_Z = WS_X2 + al256((size_t)MPAD * D * 4);
constexpr size_t WS_CATB = WS_Z + al256((size_t)MPAD * DINP * 4);
constexpr size_t WS_HL = WS_CATB + al256((size_t)MPAD * D * 2);
constexpr size_t WS_PP = WS_HL + al256((size_t)MT * DRNN * 4);
constexpr size_t WS_GI = WS_PP + al256((size_t)MT * DRNN * 4);
constexpr size_t WS_SCP = WS_GI + al256((size_t)MT * DRNN * 4);
constexpr size_t WS_SCS = WS_SCP + al256((size_t)MP * SEQ * 4);
constexpr size_t WS_SEL = WS_SCS + al256((size_t)MS * SCS_LD * 4);
constexpr size_t WS_NSEL = WS_SEL + al256((size_t)MT * TOPK * 4);
constexpr size_t WS_SUMA = WS_NSEL + al256((size_t)MT * 4);
constexpr size_t WS_SUMH = WS_SUMA + al256((size_t)130 * DRNN * 4);
constexpr size_t WS_WAT = WS_SUMH + al256((size_t)130 * DRNN * 4);
constexpr size_t WS_WIT = WS_WAT + al256((size_t)8 * 128 * 128 * 2);
constexpr size_t WS_BM = WS_WIT + al256((size_t)8 * 128 * 128 * 2);
constexpr size_t WS_QB = WS_BM + al256((size_t)MP * 64 * 8);
constexpr size_t WS_KB = WS_QB + al256((size_t)MP * 1024 * 2);
constexpr size_t WS_VB = WS_KB + al256((size_t)MP * 512 * 2);
constexpr size_t WS_END = WS_VB + al256((size_t)MP * 512 * 2);
constexpr size_t WS_CTR = WS_CTL + 32768;

constexpr int NWAVES = 8, NTHREADS = 512;
constexpr int LDS_STAGE = 131072, LDS_MISC = 134144, LDS_BYTES = 135168;

struct Params {
    const float* in[27];
    float* out;
    unsigned char* ws;
    int ph_lo, ph_hi, li, pad_;
};

__device__ __forceinline__ unsigned cvt_pk_bf16(float lo, float hi) { unsigned r; asm volatile("v_cvt_pk_bf16_f32 %0, %1, %2" : "=v"(r) : "v"(lo), "v"(hi)); return r; }
__device__ __forceinline__ float sigmoidf_(float x) { return 1.0f / (1.0f + expf(-x)); }
__device__ __forceinline__ float gelu_tanh(float x) { return 0.5f * x * (1.0f + tanhf(0.7978845608028654f * (x + 0.044715f * x * x * x))); }
__device__ __forceinline__ bf16_t f2bf(float f) { return (bf16_t)(cvt_pk_bf16(f, 0.f) & 0xffffu); }

struct EpiSwiGLU {
    static constexpr bool PERM = true, AFTER_DRAIN = false;
    bf16_t* H;
    __device__ __forceinline__ void operator()(const f32x4 (&acc)[2][2][4][2], const pg8::Unit& u, int wr, int wc, int fr, int fq) const {
        const int row0 = u.pm * 256 + wr * 64 + fr, col0 = u.pn * 128 + wc * 32 + 8 * fq;
#pragma unroll
        for (int ai = 0; ai < 2; ++ai)
#pragma unroll
            for (int m = 0; m < 4; ++m) {
                bf16_t* rowp = H + (size_t)(row0 + ai * 128 + m * 16) * DFF + col0;
                float h[8];
#pragma unroll
                for (int n = 0; n < 2; ++n)
#pragma unroll
                    for (int j = 0; j < 4; ++j) {
                        const float g = acc[ai][0][m][n][j], up = acc[ai][1][m][n][j];
                        const float sg = __builtin_amdgcn_rcpf(1.0f + __builtin_amdgcn_exp2f(-1.4426950408889634f * g));
                        h[n * 4 + j] = g * sg * up;
                    }
                u32x4 w; w.x = cvt_pk_bf16(h[0], h[1]); w.y = cvt_pk_bf16(h[2], h[3]); w.z = cvt_pk_bf16(h[4], h[5]); w.w = cvt_pk_bf16(h[6], h[7]);
                *(u32x4*)rowp = w;
            }
    }
};
struct EpiResid {
    static constexpr bool PERM = false, AFTER_DRAIN = false;
    const float* Xp; const float* Xs; float* T; float s;
    __device__ __forceinline__ void operator()(const f32x4 (&acc)[2][2][4][2], const pg8::Unit& u, int wr, int wc, int fr, int fq) const {
        const int row0 = u.pm * 256 + wr * 64 + fr, col0 = u.pn * 256 + wc * 32 + 4 * fq;
#pragma unroll
        for (int ai = 0; ai < 2; ++ai)
#pragma unroll
            for (int m = 0; m < 4; ++m) {
                const int row = row0 + ai * 128 + m * 16;
                if (row < MT) {
                    const float* xr = (row < MP) ? Xp + (size_t)row * D + col0 : Xs + (size_t)(row - MP) * D + col0;
                    float* tr = T + (size_t)row * D + col0;
#pragma unroll
                    for (int bj = 0; bj < 2; ++bj)
#pragma unroll
                        for (int n = 0; n < 2; ++n) { const f32x4 xv = *(const f32x4*)(xr + bj * 128 + n * 16); *(f32x4*)(tr + bj * 128 + n * 16) = xv * ALPHA + acc[ai][bj][m][n] * s; }
                }
            }
    }
};
struct EpiF32 {
    static constexpr bool PERM = false, AFTER_DRAIN = false;
    float* C; int ldc;
    __device__ __forceinline__ void operator()(const f32x4 (&acc)[2][2][4][2], const pg8::Unit& u, int wr, int wc, int fr, int fq) const {
        const int row0 = u.pm * 256 + wr * 64 + fr, col0 = u.pn * 256 + wc * 32 + 4 * fq;
#pragma unroll
        for (int ai = 0; ai < 2; ++ai)
#pragma unroll
            for (int m = 0; m < 4; ++m) {
                float* rowp = C + (size_t)(row0 + ai * 128 + m * 16) * ldc + col0;
#pragma unroll
                for (int bj = 0; bj < 2; ++bj)
#pragma unroll
                    for (int n = 0; n < 2; ++n) *(f32x4*)(rowp + bj * 128 + n * 16) = acc[ai][bj][m][n];
            }
    }
};

template <int MODE>
__device__ __forceinline__ void transpose_cvt(const float* __restrict__ W, int K, int N, int Npad, bf16_t* __restrict__ Wt, PG8_LAS float* tile) {
    const int tid = threadIdx.x, ntn = Npad / 64, ntk = K / 64, ntiles = ntn * ntk;
    for (int t = blockIdx.x; t < ntiles; t += gridDim.x) {
        const int tn = t % ntn, tk = t / ntn, n0 = tn * 64, k0 = tk * 64;
        int s0;
        if (MODE == 1) { const int tile256 = n0 >> 8, j = n0 & 255; s0 = (j < 128) ? tile256 * 128 + j : DFF + tile256 * 128 + (j - 128); } else s0 = n0;
#pragma unroll
        for (int i = 0; i < 8; ++i) {
            const int e = tid + 512 * i, k = e >> 6, n = e & 63;
            tile[k * 65 + n] = (MODE == 1 || s0 + n < N) ? W[(size_t)(k0 + k) * N + s0 + n] : 0.f;
        }
        __syncthreads();
        {
            const int n = tid >> 3, kq = (tid & 7) * 8;
            float v[8];
#pragma unroll
            for (int j = 0; j < 8; ++j) v[j] = tile[(kq + j) * 65 + n];
            u32x4 w; w.x = cvt_pk_bf16(v[0], v[1]); w.y = cvt_pk_bf16(v[2], v[3]); w.z = cvt_pk_bf16(v[4], v[5]); w.w = cvt_pk_bf16(v[6], v[7]);
            *(u32x4*)(Wt + (size_t)(n0 + n) * K + k0 + kq) = w;
        }
        __syncthreads();
    }
}
__device__ __forceinline__ void cvt_x(const float* __restrict__ xp, const float* __restrict__ xs, bf16_t* __restrict__ XB) {
    const size_t n4 = (size_t)MPAD * D / 4;
    for (size_t i = (size_t)blockIdx.x * NTHREADS + threadIdx.x; i < n4; i += (size_t)gridDim.x * NTHREADS) {
        const size_t e = i * 4, row = e / D;
        f32x4 v = (f32x4){0.f, 0.f, 0.f, 0.f};
        if (row < (size_t)MP) v = *(const f32x4*)(xp + e); else if (row < (size_t)MT) v = *(const f32x4*)(xs + (e - (size_t)MP * D));
        u32x2 w; w.x = cvt_pk_bf16(v[0], v[1]); w.y = cvt_pk_bf16(v[2], v[3]);
        *(u32x2*)(XB + e) = w;
    }
}
__device__ __forceinline__ void ln_phase(const float* __restrict__ T, const float* __restrict__ g, const float* __restrict__ b, float* __restrict__ Xo, bf16_t* __restrict__ Xb) {
    const int lane = threadIdx.x & 63, wave = threadIdx.x >> 6;
    f32x4 gv[8], bv[8];
#pragma unroll
    for (int i = 0; i < 8; ++i) { gv[i] = *(const f32x4*)(g + lane * 4 + 256 * i); bv[i] = *(const f32x4*)(b + lane * 4 + 256 * i); }
    for (int row = blockIdx.x * NWAVES + wave; row < MT; row += gridDim.x * NWAVES) {
        const float* tr = T + (size_t)row * D + lane * 4;
        f32x4 v[8]; float s = 0.f;
#pragma unroll
        for (int i = 0; i < 8; ++i) { v[i] = *(const f32x4*)(tr + 256 * i); s += (v[i][0] + v[i][1]) + (v[i][2] + v[i][3]); }
#pragma unroll
        for (int o = 32; o >= 1; o >>= 1) s += __shfl_xor(s, o);
        const float mean = s * (1.0f / D);
        float q = 0.f;
#pragma unroll
        for (int i = 0; i < 8; ++i) { const f32x4 d = v[i] - mean; q += (d[0] * d[0] + d[1] * d[1]) + (d[2] * d[2] + d[3] * d[3]); }
#pragma unroll
        for (int o = 32; o >= 1; o >>= 1) q += __shfl_xor(q, o);
        const float rstd = rsqrtf(q * (1.0f / D) + LN_EPS);
#pragma unroll
        for (int i = 0; i < 8; ++i) {
            const f32x4 o = (v[i] - mean) * rstd * gv[i] + bv[i];
            if (Xo) *(f32x4*)(Xo + (size_t)row * D + lane * 4 + 256 * i) = o;
            if (Xb) { u32x2 w; w.x = cvt_pk_bf16(o[0], o[1]); w.y = cvt_pk_bf16(o[2], o[3]); *(u32x2*)(Xb + (size_t)row * D + lane * 4 + 256 * i) = w; }
        }
    }
}


typedef short bf16x8 __attribute__((ext_vector_type(8)));
typedef float f32x16 __attribute__((ext_vector_type(16)));
__device__ __forceinline__ int crow(int reg, int h) { return (reg & 3) + 8 * (reg >> 2) + 4 * h; }
constexpr int LRU_CH = 64, LRU_NCHUNK = MT / LRU_CH  , LRU_PCHUNK = MP / LRU_CH  , LRU_CPB = SEQ / LRU_CH  ;
constexpr int L_XCF = 0, L_XCB = 32768, L_AA = 50176, L_UU = 82944, XCB_PITCH = 272;
__device__ __forceinline__ void lru_local_phase(const Params& p, PG8_LAS unsigned char* lds) {
    const int tid = threadIdx.x, lane = tid & 63, wave = tid >> 6;
    unsigned char* ws = p.ws;
    const float* Z = (const float*)(ws + WS_Z);
    const float* state_conv = p.in[5]; const float* state_rnn = p.in[6];
    const float* cw = p.in[13]; const float* cb = p.in[14];
    const float* ba = p.in[16]; const float* bi = p.in[18]; const float* lam = p.in[19];
    const bf16_t* WAt = (const bf16_t*)(ws + WS_WAT); const bf16_t* WIt = (const bf16_t*)(ws + WS_WIT);
    float* HL = (float*)(ws + WS_HL); float* PP = (float*)(ws + WS_PP); float* SUMA = (float*)(ws + WS_SUMA); float* SUMH = (float*)(ws + WS_SUMH);
    float* out = p.out;
    PG8_LAS float* XCF = (PG8_LAS float*)(lds + L_XCF); PG8_LAS float* AA = (PG8_LAS float*)(lds + L_AA); PG8_LAS float* UU = (PG8_LAS float*)(lds + L_UU);
    for (int u = blockIdx.x; u < LRU_NCHUNK * 8; u += gridDim.x) {
        const int ck = u >> 3, nb = u & 7;
        {
            const int c = tid & 127, rg = tid >> 7, ch = nb * 128 + c;
            const float w0 = cw[ch], w1 = cw[DRNN + ch], w2 = cw[2 * DRNN + ch], w3 = cw[3 * DRNN + ch], cbv = cb[ch];
            if (ck < LRU_PCHUNK) {
                const int b = ck / LRU_CPB, t0 = (ck % LRU_CPB) * LRU_CH + rg * 16;
                const float* zc = Z + (size_t)(b * SEQ) * ZLD + C_XR + ch;
                float x0 = (t0 - 3 >= 0) ? zc[(size_t)(t0 - 3) * ZLD] : 0.f, x1 = (t0 - 2 >= 0) ? zc[(size_t)(t0 - 2) * ZLD] : 0.f, x2 = (t0 - 1 >= 0) ? zc[(size_t)(t0 - 1) * ZLD] : 0.f;
#pragma unroll
                for (int i = 0; i < 16; ++i) {
                    const int t = t0 + i, lr = rg * 16 + i;
                    const float x3 = zc[(size_t)t * ZLD];
                    const float xc = cbv + w0 * x0 + w1 * x1 + w2 * x2 + w3 * x3;
                    XCF[lr * 128 + c] = xc;
                    *(PG8_LAS bf16_t*)(lds + L_XCB + lr * XCB_PITCH + c * 2) = f2bf(xc);
                    if (t >= SEQ - 3) out[O_CP + (size_t)(b * 3 + (t - (SEQ - 3))) * DRNN + ch] = x3;
                    x0 = x1; x1 = x2; x2 = x3;
                }
            } else {
#pragma unroll
                for (int i = 0; i < 16; ++i) {
                    const int lr = rg * 16 + i, rs = (ck - LRU_PCHUNK) * LRU_CH + lr, bs = rs >> 2, tt = rs & 3;
                    float xv[4];
#pragma unroll
                    for (int j = 0; j < 4; ++j) { const int pp = tt + j; xv[j] = (pp < 3) ? state_conv[(size_t)(bs * 3 + pp) * DRNN + ch] : Z[(size_t)(MP + bs * DS + pp - 3) * ZLD + C_XR + ch]; }
                    const float xc = cbv + w0 * xv[0] + w1 * xv[1] + w2 * xv[2] + w3 * xv[3];
                    XCF[lr * 128 + c] = xc;
                    *(PG8_LAS bf16_t*)(lds + L_XCB + lr * XCB_PITCH + c * 2) = f2bf(xc);
                    if (tt >= 1) out[O_CS + (size_t)(bs * 3 + (tt - 1)) * DRNN + ch] = xv[3];
                }
            }
        }
        __syncthreads();
        {
            const int mt = wave >> 2, nt = wave & 3, r = lane & 31, kh = lane >> 5;
            f32x16 acc_a, acc_i;
#pragma unroll
            for (int i = 0; i < 16; ++i) { acc_a[i] = 0.f; acc_i[i] = 0.f; }
            const bf16_t* wa = WAt + (size_t)nb * 16384 + (size_t)(nt * 32 + r) * 128 + kh * 8;
            const bf16_t* wi = WIt + (size_t)nb * 16384 + (size_t)(nt * 32 + r) * 128 + kh * 8;
#pragma unroll
            for (int ks = 0; ks < 8; ++ks) {
                const bf16x8 af = *(const PG8_LAS bf16x8*)(lds + L_XCB + (mt * 32 + r) * XCB_PITCH + (ks * 16 + kh * 8) * 2);
                const bf16x8 bfa = *(const bf16x8*)(wa + ks * 16);
                const bf16x8 bfi = *(const bf16x8*)(wi + ks * 16);
                acc_a = __builtin_amdgcn_mfma_f32_32x32x16_bf16(af, bfa, acc_a, 0, 0, 0);
                acc_i = __builtin_amdgcn_mfma_f32_32x32x16_bf16(af, bfi, acc_i, 0, 0, 0);
            }
            const int col = nt * 32 + r, ch = nb * 128 + col, hh = lane >> 5;
            const float l = lam[ch], sp = (-l > 20.f) ? -l : log1pf(expf(-l)), bac = ba[ch], bic = bi[ch];
#pragma unroll
            for (int i = 0; i < 16; ++i) {
                const int lr = mt * 32 + crow(i, hh);
                const float xc = XCF[lr * 128 + col];
                const float rg = sigmoidf_(acc_a[i] + bac), ig = sigmoidf_(acc_i[i] + bic);
                const float log_a = -8.0f * rg * sp;
                AA[lr * 128 + col] = expf(log_a);
                UU[lr * 128 + col] = sqrtf(-expm1f(2.0f * log_a)) * ig * xc;
            }
        }
        __syncthreads();
        if (tid < 128) {
            const int c = tid, ch = nb * 128 + c;
            if (ck < LRU_PCHUNK) {
                float h = 0.f, P = 1.f;
#pragma unroll 8
                for (int lr = 0; lr < LRU_CH; ++lr) {
                    const float a = AA[lr * 128 + c], uu = UU[lr * 128 + c];
                    h = a * h + uu; P *= a;
                    const size_t g = (size_t)(ck * LRU_CH + lr) * DRNN + ch;
                    HL[g] = h; PP[g] = P;
                }
                SUMA[(size_t)ck * DRNN + ch] = P; SUMH[(size_t)ck * DRNN + ch] = h;
            } else {
                float h = 0.f;
#pragma unroll 8
                for (int lr = 0; lr < LRU_CH; ++lr) {
                    const int rs = (ck - LRU_PCHUNK) * LRU_CH + lr, bs = rs >> 2, tt = rs & 3;
                    if (tt == 0) h = state_rnn[(size_t)bs * DRNN + ch];
                    const float a = AA[lr * 128 + c], uu = UU[lr * 128 + c];
                    h = a * h + uu;
                    const size_t g = (size_t)(ck * LRU_CH + lr) * DRNN + ch;
                    HL[g] = h; PP[g] = 0.f;
                    if (tt == 3) out[O_HS + (size_t)bs * DRNN + ch] = h;
                }
                SUMA[(size_t)ck * DRNN + ch] = 0.f; SUMH[(size_t)ck * DRNN + ch] = 0.f;
            }
        }
        __syncthreads();
    }
}
__device__ __forceinline__ void lru_fixup_unit(const Params& p, int ck) {
    const int tid = threadIdx.x, ch = tid * 2;
    unsigned char* ws = p.ws;
    const float* Z = (const float*)(ws + WS_Z);
    const float* HL = (const float*)(ws + WS_HL); const float* PP = (const float*)(ws + WS_PP); const float* SUMA = (const float*)(ws + WS_SUMA); const float* SUMH = (const float*)(ws + WS_SUMH);
    bf16_t* CATB = (bf16_t*)(ws + WS_CATB);
    typedef float f32x2 __attribute__((ext_vector_type(2)));
    f32x2 carry = (f32x2){0.f, 0.f};
    const bool prompt = ck < LRU_PCHUNK;
    if (prompt) {
        const int b = ck / LRU_CPB, kk = ck % LRU_CPB;
#pragma unroll 4
        for (int j = 0; j < kk; ++j) {
            const f32x2 A = *(const f32x2*)(SUMA + (size_t)(b * LRU_CPB + j) * DRNN + ch), Hh = *(const f32x2*)(SUMH + (size_t)(b * LRU_CPB + j) * DRNN + ch);
            carry = A * carry + Hh;
        }
    }
#pragma unroll 4
    for (int lr = 0; lr < LRU_CH; ++lr) {
        const size_t grow = (size_t)(ck * LRU_CH + lr);
        const f32x2 hl = *(const f32x2*)(HL + grow * DRNN + ch), pp = *(const f32x2*)(PP + grow * DRNN + ch), gr = *(const f32x2*)(Z + grow * ZLD + C_GR + ch);
        const f32x2 h = hl + pp * carry;
        *(unsigned*)(CATB + grow * D + ch) = cvt_pk_bf16(h.x * gelu_tanh(gr.x), h.y * gelu_tanh(gr.y));
        if (prompt && (ck % LRU_CPB) == LRU_CPB - 1 && lr == LRU_CH - 1) *(f32x2*)(p.out + O_HP + (size_t)(ck / LRU_CPB) * DRNN + ch) = h;
    }
}


constexpr int IDX_SPLIT = 3;
constexpr int SCP_LD = 4096, SCS_LDL = 8200;
__device__ __forceinline__ unsigned fkey(float f) { const unsigned u = __float_as_uint(f); return (u & 0x80000000u) ? ~u : (u | 0x80000000u); }
__device__ __forceinline__ int mbcnt64(unsigned long long m) { return (int)__builtin_amdgcn_mbcnt_hi((unsigned)(m >> 32), __builtin_amdgcn_mbcnt_lo((unsigned)m, 0u)); }
__device__ __forceinline__ void split8(const f32x4 a, const f32x4 b, bf16x8& hi, bf16x8& lo) {
    u32x4 h; h.x = cvt_pk_bf16(a[0], a[1]); h.y = cvt_pk_bf16(a[2], a[3]); h.z = cvt_pk_bf16(b[0], b[1]); h.w = cvt_pk_bf16(b[2], b[3]);
    u32x4 l;
    l.x = cvt_pk_bf16(a[0] - __uint_as_float(h.x << 16), a[1] - __uint_as_float(h.x & 0xffff0000u));
    l.y = cvt_pk_bf16(a[2] - __uint_as_float(h.y << 16), a[3] - __uint_as_float(h.y & 0xffff0000u));
    l.z = cvt_pk_bf16(b[0] - __uint_as_float(h.z << 16), b[1] - __uint_as_float(h.z & 0xffff0000u));
    l.w = cvt_pk_bf16(b[2] - __uint_as_float(h.w << 16), b[3] - __uint_as_float(h.w & 0xffff0000u));
    hi = __builtin_bit_cast(bf16x8, h); lo = __builtin_bit_cast(bf16x8, l);
}
struct IdxQ { bf16x8 hi[4], lo[4]; float w[16]; };
__device__ __forceinline__ void idx_load_q(IdxQ& q, const float* Z, int grow0, int lane) {
    const int rho = lane & 31, kh = lane >> 5, ql = 2 * ((rho >> 2) & 1) + (rho >> 4), head = 4 * ((rho >> 3) & 1) + (rho & 3);
    const float* src = Z + (size_t)(grow0 + ql) * ZLD + C_QI + head * IDD + kh * 8;
#pragma unroll
    for (int ks = 0; ks < 4; ++ks) { const f32x4 a = *(const f32x4*)(src + ks * 16), b = *(const f32x4*)(src + ks * 16 + 4); split8(a, b, q.hi[ks], q.lo[ks]); }
#pragma unroll
    for (int e = 0; e < 2; ++e) {
        const float* wsrc = Z + (size_t)(grow0 + 2 * kh + e) * ZLD + C_WI;
        const f32x4 a = *(const f32x4*)wsrc, b = *(const f32x4*)(wsrc + 4);
#pragma unroll
        for (int i = 0; i < 4; ++i) { q.w[e * 8 + i] = a[i] * IDX_W_SCALE; q.w[e * 8 + 4 + i] = b[i] * IDX_W_SCALE; }
    }
}
__device__ __forceinline__ void idx_tile(const IdxQ& q, const bf16x8 (&khi)[4], const bf16x8 (&klo)[4], PG8_LAS float* sc, int pitch, int col, int hh, bool store = true) {
    f32x16 acc;
#pragma unroll
    for (int i = 0; i < 16; ++i) acc[i] = 0.f;
#pragma unroll
    for (int ks = 0; ks < 4; ++ks) {
        acc = __builtin_amdgcn_mfma_f32_32x32x16_bf16(q.hi[ks], khi[ks], acc, 0, 0, 0);
        if (IDX_SPLIT == 3) { acc = __builtin_amdgcn_mfma_f32_32x32x16_bf16(q.hi[ks], klo[ks], acc, 0, 0, 0); acc = __builtin_amdgcn_mfma_f32_32x32x16_bf16(q.lo[ks], khi[ks], acc, 0, 0, 0); }
    }
#pragma unroll
    for (int e = 0; e < 2; ++e) {
        float t = 0.f;
#pragma unroll
        for (int i = 0; i < 8; ++i) t += fmaxf(acc[e * 8 + i] * IDX_SCALE, 0.f) * q.w[e * 8 + i];
        if (store) sc[(2 * hh + e) * pitch + col] = t;
    }
}
__device__ __forceinline__ void idx_load_key(const float* kp, bf16x8 (&khi)[4], bf16x8 (&klo)[4]) {
#pragma unroll
    for (int ks = 0; ks < 4; ++ks) {
        f32x4 a = (f32x4){0.f, 0.f, 0.f, 0.f}, b = a;
        if (kp) { a = *(const f32x4*)(kp + ks * 16); b = *(const f32x4*)(kp + ks * 16 + 4); }
        split8(a, b, khi[ks], klo[ks]);
    }
}
template <int NJ>
__device__ __forceinline__ void select_row(const PG8_LAS float* sc, int n, int lane, unsigned long long* bm_row, int* sel, int* nsel) {
    unsigned v[NJ];
    const int nj = (n + 63) >> 6;
    const PG8_LAS float* pl = sc + lane;
#pragma unroll
    for (int j = 0; j < NJ; ++j) { const unsigned k = fkey(pl[j * 64]); v[j] = (j * 64 + lane < n) ? k : 0u; }
    unsigned T = 1u; int need = 1 << 30;
    if (n > TOPK) {
        unsigned prefix = 0u; bool exact = false;
        for (int bit = 31; bit >= 0; --bit) {
            const unsigned cand = prefix | (1u << bit);
            int cnt = 0;
#pragma unroll
            for (int j = 0; j < NJ; ++j) if (j < nj) cnt += __popcll(__ballot(v[j] >= cand));
            if (cnt >= TOPK) prefix = cand;
            if (cnt == TOPK) { exact = true; break; }
        }
        T = prefix;
        if (!exact) {
            int cgt = 0;
#pragma unroll
            for (int j = 0; j < NJ; ++j) if (j < nj) cgt += __popcll(__ballot(v[j] > T));
            need = TOPK - cgt;
        }
    }
    int base_eq = 0, base_sel = 0; unsigned long long mymask = 0ull;
#pragma unroll
    for (int j = 0; j < NJ; ++j) if (j < nj) {
        const bool gt = v[j] > T, eq = v[j] == T;
        const unsigned long long eqm = __ballot(eq);
        const bool s = gt || (eq && (base_eq + mbcnt64(eqm)) < need);
        const unsigned long long sm = __ballot(s);
        if (sel && s) sel[base_sel + mbcnt64(sm)] = j * 64 + lane;
        base_eq += __popcll(eqm); base_sel += __popcll(sm);
        if (NJ <= 64 && lane == j) mymask = sm;
    }
    if (bm_row) bm_row[lane] = mymask;
    if (nsel && lane == 0) *nsel = base_sel;
}
__device__ __forceinline__ void idx_select_phase(const Params& p, PG8_LAS unsigned char* lds) {
    const int tid = threadIdx.x, lane = tid & 63, wave = __builtin_amdgcn_readfirstlane(tid >> 6), r = lane & 31, kh = lane >> 5;
    unsigned char* ws = p.ws;
    const float* Z = (const float*)(ws + WS_Z);
    const float* cache_ki = p.in[4]; const int* page_table = (const int*)p.in[7];
    int* SEL = (int*)(ws + WS_SEL); int* NSEL = (int*)(ws + WS_NSEL); unsigned long long* BM = (unsigned long long*)(ws + WS_BM);
    PG8_LAS float* sc = (PG8_LAS float*)lds;
    const int G = gridDim.x;
    for (int bs = blockIdx.x; bs < DB; bs += G) {
        IdxQ q; idx_load_q(q, Z, MP + bs * DS, lane);
        bf16x8 khi[4], klo[4];
        for (int pg = wave; pg < NPAGES; pg += NWAVES) {
            const int phys = page_table[bs * NPAGES + pg];
            const float* pbase = cache_ki + (size_t)phys * PAGE * IDD;
#pragma unroll 1
            for (int tt = 0; tt < 4; ++tt) {
                idx_load_key(pbase + (size_t)(tt * 32 + r) * IDD + kh * 8, khi, klo);
                idx_tile(q, khi, klo, sc, SCS_LDL, pg * PAGE + tt * 32 + r, kh);
            }
        }
        if (wave == 0) {
            idx_load_key(r < DS ? Z + (size_t)(MP + bs * DS + r) * ZLD + C_KI + kh * 8 : nullptr, khi, klo);
            idx_tile(q, khi, klo, sc, SCS_LDL, NPAST + r, kh, r < DS);
        }
        __syncthreads();
        if (wave < DS) { const int row = MP + bs * DS + wave; select_row<129>(sc + wave * SCS_LDL, NPAST + wave + 1, lane, nullptr, SEL + (size_t)row * TOPK, NSEL + row); }
        __syncthreads();
    }
    for (int i = 0;; ++i) {
        const int s = i * G + ((i & 1) ? G - 1 - (int)blockIdx.x : (int)blockIdx.x);
        if (i * G >= MP / 8) break;
        if (s < MP / 8) {
            const int b = s & 1, q0 = (s >> 1) * 8, grow0 = b * SEQ + q0, ntile = (q0 + 8 + 31) >> 5;
            IdxQ qa, qb; idx_load_q(qa, Z, grow0, lane); idx_load_q(qb, Z, grow0 + 4, lane);
            bf16x8 khi[4], klo[4];
            for (int t = wave; t < ntile; t += NWAVES) {
                idx_load_key(Z + (size_t)(b * SEQ + t * 32 + r) * ZLD + C_KI + kh * 8, khi, klo);
                idx_tile(qa, khi, klo, sc, SCP_LD, t * 32 + r, kh);
                idx_tile(qb, khi, klo, sc + 4 * SCP_LD, SCP_LD, t * 32 + r, kh);
            }
            __syncthreads();
            { const int row = grow0 + wave; select_row<64>(sc + wave * SCP_LD, q0 + wave + 1, lane, BM + (size_t)row * 64, SEL + (size_t)row * TOPK, NSEL + row); }
        }
        __syncthreads();
    }
}
__device__ __forceinline__ void copy_kv_phase(const Params& p) {
    const float* Z = (const float*)(p.ws + WS_Z); float* out = p.out;
    bf16_t* QBb = (bf16_t*)(p.ws + WS_QB); bf16_t* KBb = (bf16_t*)(p.ws + WS_KB); bf16_t* VBb = (bf16_t*)(p.ws + WS_VB);
    for (size_t i = (size_t)blockIdx.x * NTHREADS + threadIdx.x; i < (size_t)MP * 512; i += (size_t)gridDim.x * NTHREADS) {
        const int row = (int)(i >> 9), c4 = (int)(i & 511);
        const f32x4 v = *(const f32x4*)(Z + (size_t)row * ZLD + C_Q + c4 * 4);
        u32x2 w; w.x = cvt_pk_bf16(v[0], v[1]); w.y = cvt_pk_bf16(v[2], v[3]);
        if (c4 < 256) *(u32x2*)(QBb + (size_t)row * 1024 + c4 * 4) = w;
        else if (c4 < 384) *(u32x2*)(KBb + (size_t)row * 512 + (c4 - 256) * 4) = w;
        else *(u32x2*)(VBb + (size_t)row * 512 + (c4 - 384) * 4) = w;
    }
    for (size_t i = (size_t)blockIdx.x * NTHREADS + threadIdx.x; i < (size_t)MT * 272; i += (size_t)gridDim.x * NTHREADS) {
        const int row = (int)(i / 272), c4 = (int)(i % 272);
        const float* z = Z + (size_t)row * ZLD;
        const bool pr = row < MP; const int rr = pr ? row : row - MP;
        if (c4 < 128) *(f32x4*)(out + (pr ? O_KP : O_KS) + (size_t)rr * 512 + c4 * 4) = *(const f32x4*)(z + C_K + c4 * 4);
        else if (c4 < 256) *(f32x4*)(out + (pr ? O_VP : O_VS) + (size_t)rr * 512 + (c4 - 128) * 4) = *(const f32x4*)(z + C_V + (c4 - 128) * 4);
        else *(f32x4*)(out + (pr ? O_KIP : O_KIS) + (size_t)rr * 64 + (c4 - 256) * 4) = *(const f32x4*)(z + C_KI + (c4 - 256) * 4);
    }
}


__device__ __forceinline__ void attn_gather_unit(const Params& p, PG8_LAS unsigned char* lds, int row) {
    const int tid = threadIdx.x, lane = tid & 63, wave = tid >> 6;
    unsigned char* ws = p.ws;
    const float* Z = (const float*)(ws + WS_Z);
    const float* cache_k = p.in[2]; const float* cache_v = p.in[3]; const int* page_table = (const int*)p.in[7];
    const int* SEL = (const int*)(ws + WS_SEL); const int* NSEL = (const int*)(ws + WS_NSEL);
    bf16_t* CATB = (bf16_t*)(ws + WS_CATB);
    PG8_LAS float* qs = (PG8_LAS float*)lds;
    PG8_LAS float* ps = (PG8_LAS float*)(lds + 4096);
    PG8_LAS unsigned long long* kps = (PG8_LAS unsigned long long*)(lds + 12288);
    PG8_LAS unsigned long long* vps = (PG8_LAS unsigned long long*)(lds + 14336);
    const float* z = Z + (size_t)row * ZLD;
    qs[tid] = z[C_Q + tid]; qs[tid + 512] = z[C_Q + 512 + tid];
    const int ns = NSEL[row];
    if (tid < ns) {
        const int idx = SEL[(size_t)row * TOPK + tid];
        const float* kp; const float* vp;
        if (row < MP) { const int b = row / SEQ; kp = Z + (size_t)(b * SEQ + idx) * ZLD + C_K; vp = Z + (size_t)(b * SEQ + idx) * ZLD + C_V; }
        else {
            const int b = (row - MP) / DS;
            if (idx < NPAST) { const size_t prow = (size_t)page_table[b * NPAGES + idx / PAGE] * PAGE + (idx % PAGE); kp = cache_k + prow * 512; vp = cache_v + prow * 512; }
            else { const size_t zr = (size_t)(MP + b * DS + idx - NPAST); kp = Z + zr * ZLD + C_K; vp = Z + zr * ZLD + C_V; }
        }
        kps[tid] = (unsigned long long)kp; vps[tid] = (unsigned long long)vp;
    }
    __syncthreads();
    {
        const int j = tid & 255, hg = tid >> 8;
        float lg[4] = {-INFINITY, -INFINITY, -INFINITY, -INFINITY};
        if (j < ns) {
            const float* kp = (const float*)kps[j] + hg * 256;
#pragma unroll
            for (int n2 = 0; n2 < 2; ++n2) {
                float d0 = 0.f, d1 = 0.f;
                const PG8_LAS float* q0 = qs + (4 * hg + 2 * n2) * HD; const PG8_LAS float* q1 = q0 + HD;
#pragma unroll 8
                for (int d = 0; d < HD; d += 4) {
                    const f32x4 k4 = *(const f32x4*)(kp + n2 * HD + d);
                    d0 += q0[d] * k4[0] + q0[d + 1] * k4[1] + q0[d + 2] * k4[2] + q0[d + 3] * k4[3];
                    d1 += q1[d] * k4[0] + q1[d + 1] * k4[1] + q1[d + 2] * k4[2] + q1[d + 3] * k4[3];
                }
                lg[2 * n2] = d0 * ATTN_SCALE; lg[2 * n2 + 1] = d1 * ATTN_SCALE;
            }
        }
#pragma unroll
        for (int h = 0; h < 4; ++h) ps[(4 * hg + h) * TOPK + j] = lg[h];
    }
    __syncthreads();
    {
        float v[4]; float m = -INFINITY;
#pragma unroll
        for (int i = 0; i < 4; ++i) { v[i] = ps[wave * TOPK + lane + 64 * i]; m = fmaxf(m, v[i]); }
#pragma unroll
        for (int o = 32; o >= 1; o >>= 1) m = fmaxf(m, __shfl_xor(m, o));
        float sum = 0.f;
#pragma unroll
        for (int i = 0; i < 4; ++i) { v[i] = expf(v[i] - m); sum += v[i]; }
#pragma unroll
        for (int o = 32; o >= 1; o >>= 1) sum += __shfl_xor(sum, o);
        const float inv = 1.0f / sum;
#pragma unroll
        for (int i = 0; i < 4; ++i) ps[wave * TOPK + lane + 64 * i] = v[i] * inv;
    }
    __syncthreads();
#pragma unroll
    for (int i = 0; i < 2; ++i) {
        const int o = tid + 512 * i, hq = o >> 7, d = o & 127, n = hq >> 1;
        float acc = 0.f;
#pragma unroll 8
        for (int j = 0; j < ns; ++j) acc = fmaf(ps[hq * TOPK + j], ((const float*)vps[j])[n * HD + d], acc);
        CATB[(size_t)row * D + 1024 + o] = f2bf(acc);
    }
    __syncthreads();
}


typedef short s16x4 __attribute__((ext_vector_type(4)));
constexpr int A_KP = 272, A_VP = 320, A_KBYTES = 64 * A_KP, A_VBYTES = 64 * A_VP, A_STAGE = A_KBYTES + A_VBYTES;
constexpr float A_SC = 0.08838834764831845f * 1.4426950408889634f;
__device__ __forceinline__ float xhalf_max(float x) { const auto sw = __builtin_amdgcn_permlane32_swap(__float_as_uint(x), __float_as_uint(x), false, false); return fmaxf(__uint_as_float(sw[0]), __uint_as_float(sw[1])); }
__device__ __forceinline__ float xhalf_sum(float x) { const auto sw = __builtin_amdgcn_permlane32_swap(__float_as_uint(x), __float_as_uint(x), false, false); return __uint_as_float(sw[0]) + __uint_as_float(sw[1]); }
__device__ __forceinline__ void attn_dense_unit(const Params& p, PG8_LAS unsigned char* lds, int b, int n, int qb) {
    const int tid = threadIdx.x, lane = tid & 63, wave = __builtin_amdgcn_readfirstlane(tid >> 6), r = lane & 31, kh = lane >> 5;
    unsigned char* ws = p.ws;
    const bf16_t* QB = (const bf16_t*)(ws + WS_QB); const bf16_t* KB = (const bf16_t*)(ws + WS_KB); const bf16_t* VB = (const bf16_t*)(ws + WS_VB);
    const unsigned long long* BM = (const unsigned long long*)(ws + WS_BM);
    bf16_t* CATB = (bf16_t*)(ws + WS_CATB);
    const int q = qb * 128 + wave * 16 + (r & 15), head = 2 * n + (r >> 4);
    const size_t qrow = (size_t)b * SEQ + q;
    bf16x8 qf[8];
#pragma unroll
    for (int ks = 0; ks < 8; ++ks) qf[ks] = *(const bf16x8*)(QB + qrow * 1024 + head * HD + ks * 16 + kh * 8);
    f32x16 O[4];
#pragma unroll
    for (int dt = 0; dt < 4; ++dt)
#pragma unroll
        for (int i = 0; i < 16; ++i) O[dt][i] = 0.f;
    float m = -INFINITY, l = 0.f;
    const int ntile = 2 * qb + 2, qmax_w = qb * 128 + wave * 16 + 15;
    const int srow = tid >> 4, sch = tid & 15;
    const bf16_t* kg = KB + ((size_t)b * SEQ + srow) * 512 + n * HD + sch * 8;
    const bf16_t* vg = VB + ((size_t)b * SEQ + srow) * 512 + n * HD + sch * 8;
    u32x4 kst[2], vst[2];
#define A_GLOAD(t) do { _Pragma("unroll") for (int _i = 0; _i < 2; ++_i) { kst[_i] = *(const u32x4*)(kg + (size_t)((t) * 64 + _i * 32) * 512); vst[_i] = *(const u32x4*)(vg + (size_t)((t) * 64 + _i * 32) * 512); } } while (0)
#define A_LSTORE(buf) do { _Pragma("unroll") for (int _i = 0; _i < 2; ++_i) { *(PG8_LAS u32x4*)(lds + (buf) * A_STAGE + (srow + _i * 32) * A_KP + sch * 16) = kst[_i]; \
        *(PG8_LAS u32x4*)(lds + (buf) * A_STAGE + A_KBYTES + (srow + _i * 32) * A_VP + sch * 16) = vst[_i]; } } while (0)
    A_GLOAD(0); A_LSTORE(0);
    unsigned long long mw = BM[qrow * 64];
    __syncthreads();
    const int i16 = lane & 15, g2 = (lane >> 4) & 1;
    const int vlane_off = (4 * kh + (i16 >> 2)) * A_VP + (16 * g2 + 4 * (i16 & 3)) * 2;
    for (int t = 0; t < ntile; ++t) {
        const bool more = (t + 1 < ntile);
        if (more) A_GLOAD(t + 1);
        const unsigned long long mw_next = more ? BM[qrow * 64 + t + 1] : 0ull;
        const int buf = t & 1;
        if (t * 64 <= qmax_w) {
            PG8_LAS unsigned char* kb = lds + buf * A_STAGE; PG8_LAS unsigned char* vb = kb + A_KBYTES;
            f32x16 s0, s1;
#pragma unroll
            for (int i = 0; i < 16; ++i) { s0[i] = 0.f; s1[i] = 0.f; }
#pragma unroll
            for (int ks = 0; ks < 8; ++ks) {
                const bf16x8 k0 = *(const PG8_LAS bf16x8*)(kb + r * A_KP + (ks * 16 + kh * 8) * 2);
                const bf16x8 k1 = *(const PG8_LAS bf16x8*)(kb + (32 + r) * A_KP + (ks * 16 + kh * 8) * 2);
                s0 = __builtin_amdgcn_mfma_f32_32x32x16_bf16(k0, qf[ks], s0, 0, 0, 0);
                s1 = __builtin_amdgcn_mfma_f32_32x32x16_bf16(k1, qf[ks], s1, 0, 0, 0);
            }
            const unsigned lo = (unsigned)mw >> (4 * kh), hi = (unsigned)(mw >> 32) >> (4 * kh);
            float mx = -INFINITY;
#pragma unroll
            for (int i = 0; i < 16; ++i) {
                const unsigned bit = 1u << ((i & 3) + 8 * (i >> 2));
                s0[i] = (lo & bit) ? s0[i] * A_SC : -INFINITY; s1[i] = (hi & bit) ? s1[i] * A_SC : -INFINITY;
                mx = fmaxf(mx, fmaxf(s0[i], s1[i]));
            }
            mx = xhalf_max(mx);
            const float m_new = fmaxf(m, mx), m_safe = (m_new == -INFINITY) ? 0.f : m_new;
            const float alpha = __builtin_amdgcn_exp2f(m - m_safe);
            float lsum = 0.f;
#pragma unroll
            for (int i = 0; i < 16; ++i) { s0[i] = __builtin_amdgcn_exp2f(s0[i] - m_safe); s1[i] = __builtin_amdgcn_exp2f(s1[i] - m_safe); lsum += s0[i] + s1[i]; }
            l = l * alpha + lsum; m = m_new;
            if (__ballot(alpha != 1.0f) != 0ull) {
#pragma unroll
                for (int dt = 0; dt < 4; ++dt)
#pragma unroll
                    for (int i = 0; i < 16; ++i) O[dt][i] *= alpha;
            }
            bf16x8 pf[2][2];
#pragma unroll
            for (int sx = 0; sx < 2; ++sx) {
                u32x4 w0, w1;
                w0.x = cvt_pk_bf16(s0[8 * sx], s0[8 * sx + 1]); w0.y = cvt_pk_bf16(s0[8 * sx + 2], s0[8 * sx + 3]); w0.z = cvt_pk_bf16(s0[8 * sx + 4], s0[8 * sx + 5]); w0.w = cvt_pk_bf16(s0[8 * sx + 6], s0[8 * sx + 7]);
                w1.x = cvt_pk_bf16(s1[8 * sx], s1[8 * sx + 1]); w1.y = cvt_pk_bf16(s1[8 * sx + 2], s1[8 * sx + 3]); w1.z = cvt_pk_bf16(s1[8 * sx + 4], s1[8 * sx + 5]); w1.w = cvt_pk_bf16(s1[8 * sx + 6], s1[8 * sx + 7]);
                pf[0][sx] = __builtin_bit_cast(bf16x8, w0); pf[1][sx] = __builtin_bit_cast(bf16x8, w1);
            }
#pragma unroll
            for (int st = 0; st < 2; ++st)
#pragma unroll
                for (int sx = 0; sx < 2; ++sx)
#pragma unroll
                    for (int dt = 0; dt < 4; ++dt) {
                        PG8_LAS unsigned char* a = vb + vlane_off + (st * 32 + 16 * sx) * A_VP + dt * 64;
                        const s16x4 vlo = __builtin_amdgcn_ds_read_tr16_b64_v4i16((PG8_LAS s16x4*)a);
                        const s16x4 vhi = __builtin_amdgcn_ds_read_tr16_b64_v4i16((PG8_LAS s16x4*)(a + 8 * A_VP));
                        const bf16x8 vf = __builtin_shufflevector(vlo, vhi, 0, 1, 2, 3, 4, 5, 6, 7);
                        O[dt] = __builtin_amdgcn_mfma_f32_32x32x16_bf16(vf, pf[st][sx], O[dt], 0, 0, 0);
                    }
        }
        if (more) A_LSTORE(buf ^ 1);
        __syncthreads();
        mw = mw_next;
    }
#undef A_GLOAD
#undef A_LSTORE
    const float inv = 1.0f / xhalf_sum(l);
    bf16_t* orow = CATB + qrow * D + 1024 + head * HD;
#pragma unroll
    for (int dt = 0; dt < 4; ++dt)
#pragma unroll
        for (int a = 0; a < 4; ++a) {
            u32x2 w; w.x = cvt_pk_bf16(O[dt][4 * a] * inv, O[dt][4 * a + 1] * inv); w.y = cvt_pk_bf16(O[dt][4 * a + 2] * inv, O[dt][4 * a + 3] * inv);
            *(u32x2*)(orow + 32 * dt + 8 * a + 4 * kh) = w;
        }
}
__device__ __forceinline__ void attn_phase(const Params& p, PG8_LAS unsigned char* lds) {
    const int G = gridDim.x;
    for (int u = blockIdx.x; u < 256; u += G) { const int qb = 31 - (u >> 3), bn = u & 7; attn_dense_unit(p, lds, bn >> 2, bn & 3, qb); }
    unsigned* ctr = (unsigned*)(p.ws + WS_CTR);
    volatile PG8_LAS unsigned* slot = (volatile PG8_LAS unsigned*)(lds + LDS_MISC + 64);
    for (;;) {
        __syncthreads();
        if (threadIdx.x == 0) *slot = atomicAdd(ctr, 1u);
        __syncthreads();
        const unsigned idx = *slot;
        if (idx >= (unsigned)(MS + LRU_NCHUNK)) break;
        if (idx < (unsigned)MS) attn_gather_unit(p, lds, MP + (int)idx); else lru_fixup_unit(p, (int)idx - MS);
    }
}

__global__ void __launch_bounds__(NTHREADS, 2) mk_fwd(Params p) {
    extern __shared__ __attribute__((aligned(16))) unsigned char lds_raw[];
    PG8_LAS unsigned char* lds = (PG8_LAS unsigned char*)lds_raw;
    unsigned char* ws = p.ws;
    const int lo = p.ph_lo, hi = p.ph_hi;
    const int G = gridDim.x;
    if (threadIdx.x < 4) ((volatile PG8_LAS unsigned*)(lds + LDS_MISC))[threadIdx.x] = 0u;
    __syncthreads();
    XcdBarrier bar = xcd_barrier_post((unsigned*)(ws + WS_CTL) + (size_t)p.li * XCD_BAR_WORDS, (volatile LAS unsigned*)(lds + LDS_MISC));
#define SEAM(k) do { if (lo <= (k) && (k) + 1 < hi) xcd_barrier(bar); } while (0)
    bf16_t* Wgu1 = (bf16_t*)(ws + WS_WGU1); bf16_t* Wd1 = (bf16_t*)(ws + WS_WD1); bf16_t* Win = (bf16_t*)(ws + WS_WIN); bf16_t* Wout = (bf16_t*)(ws + WS_WOUT);
    bf16_t* Wgu2 = (bf16_t*)(ws + WS_WGU2); bf16_t* Wd2 = (bf16_t*)(ws + WS_WD2);
    bf16_t* XB = (bf16_t*)(ws + WS_XB); bf16_t* H = (bf16_t*)(ws + WS_H); float* T = (float*)(ws + WS_T); float* X1 = (float*)(ws + WS_X1); float* X2 = (float*)(ws + WS_X2);
    float* Z = (float*)(ws + WS_Z); bf16_t* CATB = (bf16_t*)(ws + WS_CATB);
#define IN(k) (lo <= (k) && (k) < hi)
    if (IN(0)) {
        PG8_LAS float* tile = (PG8_LAS float*)lds;
        transpose_cvt<1>(p.in[10], D, 2 * DFF, 2 * DFF, Wgu1, tile);
        transpose_cvt<0>(p.in[11], DFF, D, D, Wd1, tile);
        transpose_cvt<0>(p.in[12], D, DIN, DINP, Win, tile);
        transpose_cvt<0>(p.in[20], D, D, D, Wout, tile);
        transpose_cvt<1>(p.in[23], D, 2 * DFF, 2 * DFF, Wgu2, tile);
        transpose_cvt<0>(p.in[24], DFF, D, D, Wd2, tile);
        cvt_x(p.in[0], p.in[1], XB);
        for (int n = 0; n < 8; ++n) { transpose_cvt<0>(p.in[15] + n * 16384, 128, 128, 128, (bf16_t*)(ws + WS_WAT) + n * 16384, tile); transpose_cvt<0>(p.in[17] + n * 16384, 128, 128, 128, (bf16_t*)(ws + WS_WIT) + n * 16384, tile); }
    }
    SEAM(0);
    if (IN(1)) {
        pg8::Gemm g{XB, Wgu1, MPAD, 2 * DFF, D}; pg8::StaticOrder S; S.init(MPAD, 2 * DFF, G, (int)blockIdx.x);
        EpiSwiGLU E{H};
        pg8::gemm_phase<EpiSwiGLU, pg8::StaticOrder, true, true>(lds, g, S, E);
    }
    SEAM(1);
    if (IN(2)) {
        pg8::Gemm g{H, Wd1, MPAD, D, DFF}; pg8::StaticOrder S; S.init(MPAD, D, G, (int)blockIdx.x);
        EpiResid E{p.in[0], p.in[1], T, 0.5f};
        pg8::gemm_phase<EpiResid, pg8::StaticOrder, true, true>(lds, g, S, E);
    }
    SEAM(2);
    if (IN(3)) ln_phase(T, p.in[8], p.in[9], X1, XB);
    SEAM(3);
    if (IN(4)) {
        pg8::Gemm g{XB, Win, MPAD, DINP, D}; pg8::StaticOrder S; S.init(MPAD, DINP, G, (int)blockIdx.x);
        EpiF32 E{Z, ZLD};
        pg8::gemm_phase<EpiF32, pg8::StaticOrder, true, true>(lds, g, S, E);
    }
    SEAM(4);
    if (IN(5)) { idx_select_phase(p, lds); lru_local_phase(p, lds); copy_kv_phase(p); }
    SEAM(5);
    if (IN(6)) attn_phase(p, lds);
    SEAM(6);
    if (IN(7)) {
        pg8::Gemm g{CATB, Wout, MPAD, D, D}; pg8::StaticOrder S; S.init(MPAD, D, G, (int)blockIdx.x);
        EpiResid E{X1, X1 + (size_t)MP * D, T, 1.0f};
        pg8::gemm_phase<EpiResid, pg8::StaticOrder, true, true>(lds, g, S, E);
    }
    SEAM(7);
    if (IN(8)) ln_phase(T, p.in[21], p.in[22], X2, XB);
    SEAM(8);
    if (IN(9)) {
        pg8::Gemm g{XB, Wgu2, MPAD, 2 * DFF, D}; pg8::StaticOrder S; S.init(MPAD, 2 * DFF, G, (int)blockIdx.x);
        EpiSwiGLU E{H};
        pg8::gemm_phase<EpiSwiGLU, pg8::StaticOrder, true, true>(lds, g, S, E);
    }
    SEAM(9);
    if (IN(10)) {
        pg8::Gemm g{H, Wd2, MPAD, D, DFF}; pg8::StaticOrder S; S.init(MPAD, D, G, (int)blockIdx.x);
        EpiResid E{X2, X2 + (size_t)MP * D, T, 0.5f};
        pg8::gemm_phase<EpiResid, pg8::StaticOrder, true, true>(lds, g, S, E);
    }
    SEAM(10);
    if (IN(11)) ln_phase(T, p.in[25], p.in[26], p.out + O_YP, nullptr);
#undef IN
#undef SEAM
}

__global__ __launch_bounds__(256) void sgemm(const float* __restrict__ A, int lda, const float* __restrict__ B, int ldb, float* __restrict__ C, int ldc,
                                             int M, int N, int K, long sA, long sB, long sC) {
    __shared__ float As[16][132];
    __shared__ float Bs[16][132];
    A += sA * blockIdx.z; B += sB * blockIdx.z; C += sC * blockIdx.z;
    const int tid = threadIdx.x, tx = tid & 15, ty = tid >> 4;
    const int m0 = blockIdx.y * 128, n0 = blockIdx.x * 128;
    float acc[8][8];
#pragma unroll
    for (int i = 0; i < 8; ++i)
#pragma unroll
        for (int j = 0; j < 8; ++j) acc[i][j] = 0.f;
    for (int k0 = 0; k0 < K; k0 += 16) {
#pragma unroll
        for (int i = 0; i < 8; ++i) {
            const int e = tid + 256 * i, m = e >> 4, k = e & 15, gm = m0 + m;
            As[k][m] = (gm < M) ? A[(size_t)gm * lda + k0 + k] : 0.f;
        }
#pragma unroll
        for (int i = 0; i < 8; ++i) {
            const int e = tid + 256 * i, k = e >> 7, n = e & 127, gn = n0 + n;
            Bs[k][n] = (gn < N) ? B[(size_t)(k0 + k) * ldb + gn] : 0.f;
        }
        __syncthreads();
#pragma unroll
        for (int k = 0; k < 16; ++k) {
            float a[8], b[8];
#pragma unroll
            for (int i = 0; i < 8; ++i) a[i] = As[k][ty * 8 + i];
#pragma unroll
            for (int j = 0; j < 8; ++j) b[j] = Bs[k][tx * 8 + j];
#pragma unroll
            for (int i = 0; i < 8; ++i)
#pragma unroll
                for (int j = 0; j < 8; ++j) acc[i][j] = fmaf(a[i], b[j], acc[i][j]);
        }
        __syncthreads();
    }
#pragma unroll
    for (int i = 0; i < 8; ++i) {
        const int gm = m0 + ty * 8 + i;
        if (gm < M) {
#pragma unroll
            for (int j = 0; j < 8; ++j) { const int gn = n0 + tx * 8 + j; if (gn < N) C[(size_t)gm * ldc + gn] = acc[i][j]; }
        }
    }
}

__global__ void copy_kv_k(const float* __restrict__ Z, float* __restrict__ out) {
    const int r = blockIdx.x;
    const float* z = Z + (size_t)r * ZLD;
    float* ko; float* vo; float* kio;
    if (r < MP) { ko = out + O_KP + (size_t)r * 512; vo = out + O_VP + (size_t)r * 512; kio = out + O_KIP + (size_t)r * 64; }
    else { const int rs = r - MP; ko = out + O_KS + (size_t)rs * 512; vo = out + O_VS + (size_t)rs * 512; kio = out + O_KIS + (size_t)rs * 64; }
    for (int c = threadIdx.x; c < 512; c += blockDim.x) { ko[c] = z[C_K + c]; vo[c] = z[C_V + c]; }
    for (int c = threadIdx.x; c < 64; c += blockDim.x) kio[c] = z[C_KI + c];
}

__global__ void conv_k(const float* __restrict__ Z, const float* __restrict__ state_conv, const float* __restrict__ cw, const float* __restrict__ cb,
                       float* __restrict__ XC, float* __restrict__ out) {
    const int r = blockIdx.x;
    for (int c = threadIdx.x; c < DRNN; c += blockDim.x) {
        float acc = cb[c];
        if (r < MP) {
            const int b = r / SEQ, t = r % SEQ;
#pragma unroll
            for (int j = 0; j < 4; ++j) { const int tt = t + j - 3; if (tt >= 0) acc += cw[j * DRNN + c] * Z[(size_t)(b * SEQ + tt) * ZLD + C_XR + c]; }
            if (t >= SEQ - 3) out[O_CP + (size_t)(b * 3 + (t - (SEQ - 3))) * DRNN + c] = Z[(size_t)r * ZLD + C_XR + c];
        } else {
            const int rs = r - MP, b = rs / DS, t = rs % DS;
#pragma unroll
            for (int j = 0; j < 4; ++j) { const int pp = t + j; const float xv = (pp < 3) ? state_conv[(size_t)(b * 3 + pp) * DRNN + c] : Z[(size_t)(MP + b * DS + pp - 3) * ZLD + C_XR + c]; acc += cw[j * DRNN + c] * xv; }
            if (t >= 1) out[O_CS + (size_t)(b * 3 + (t - 1)) * DRNN + c] = Z[(size_t)r * ZLD + C_XR + c];
        }
        XC[(size_t)r * DRNN + c] = acc;
    }
}

__global__ void scan_k(const float* __restrict__ XC, const float* __restrict__ GA, const float* __restrict__ GI, const float* __restrict__ Z,
                       const float* __restrict__ ba, const float* __restrict__ bi, const float* __restrict__ lam, const float* __restrict__ state_rnn,
                       bf16_t* __restrict__ CATB, float* __restrict__ out) {
    const int idx = blockIdx.x * blockDim.x + threadIdx.x;
    if (idx >= (NB + DB) * DRNN) return;
    const int s = idx / DRNN, c = idx % DRNN;
    int row0, Tn; float h;
    if (s < NB) { row0 = s * SEQ; Tn = SEQ; h = 0.f; } else { row0 = MP + (s - NB) * DS; Tn = DS; h = state_rnn[(size_t)(s - NB) * DRNN + c]; }
    const float l = lam[c];
    const float sp = (-l > 20.f) ? -l : log1pf(expf(-l));
    const float bac = ba[c], bic = bi[c];
    for (int t = 0; t < Tn; ++t) {
        const size_t r = (size_t)(row0 + t);
        const float xc = XC[r * DRNN + c];
        const float rg = sigmoidf_(GA[r * DRNN + c] + bac), ig = sigmoidf_(GI[r * DRNN + c] + bic);
        const float log_a = -8.0f * rg * sp;
        const float a = expf(log_a);
        const float u = sqrtf(-expm1f(2.0f * log_a)) * ig * xc;
        h = a * h + u;
        CATB[r * D + c] = f2bf(h * gelu_tanh(Z[r * ZLD + C_GR + c]));
    }
    if (s < NB) out[O_HP + (size_t)s * DRNN + c] = h; else out[O_HS + (size_t)(s - NB) * DRNN + c] = h;
}

__global__ __launch_bounds__(256) void idx_score_k(const float* __restrict__ Z, const float* __restrict__ cache_ki, const int* __restrict__ page_table,
                                                   float* __restrict__ SCP, float* __restrict__ SCS) {
    __shared__ float qs[IDH * IDD];
    __shared__ float wsh[IDH];
    const int r = blockIdx.x;
    const float* z = Z + (size_t)r * ZLD;
    for (int i = threadIdx.x; i < IDH * IDD; i += 256) qs[i] = z[C_QI + i];
    if (threadIdx.x < IDH) wsh[threadIdx.x] = z[C_WI + threadIdx.x] * IDX_W_SCALE;
    __syncthreads();
    int nkeys, b; float* sc;
    if (r < MP) { b = r / SEQ; nkeys = (r % SEQ) + 1; sc = SCP + (size_t)r * SEQ; }
    else { const int rs = r - MP; b = rs / DS; nkeys = NPAST + (rs % DS) + 1; sc = SCS + (size_t)rs * SCS_LD; }
    for (int key = threadIdx.x; key < nkeys; key += 256) {
        const float* kp;
        if (r < MP) kp = Z + (size_t)(b * SEQ + key) * ZLD + C_KI;
        else if (key < NPAST) kp = cache_ki + ((size_t)page_table[b * NPAGES + key / PAGE] * PAGE + (key % PAGE)) * IDD;
        else kp = Z + (size_t)(MP + b * DS + key - NPAST) * ZLD + C_KI;
        float kv[IDD];
#pragma unroll
        for (int d = 0; d < IDD; d += 4) { const float4 t4 = *(const float4*)(kp + d); kv[d] = t4.x; kv[d + 1] = t4.y; kv[d + 2] = t4.z; kv[d + 3] = t4.w; }
        float tot = 0.f;
#pragma unroll
        for (int h = 0; h < IDH; ++h) {
            float dot = 0.f;
#pragma unroll
            for (int d = 0; d < IDD; ++d) dot = fmaf(qs[h * IDD + d], kv[d], dot);
            tot += fmaxf(dot * IDX_SCALE, 0.f) * wsh[h];
        }
        sc[key] = tot;
    }
}

__global__ __launch_bounds__(256) void topk_k(const float* __restrict__ SCP, const float* __restrict__ SCS, int* __restrict__ SEL, int* __restrict__ NSEL) {
    __shared__ unsigned cnt_s;
    __shared__ unsigned pos_s;
    __shared__ unsigned cnts[256];
    const int r = blockIdx.x, t = threadIdx.x;
    int n; const float* sc;
    if (r < MP) { n = (r % SEQ) + 1; sc = SCP + (size_t)r * SEQ; } else { const int rs = r - MP; n = NPAST + (rs % DS) + 1; sc = SCS + (size_t)rs * SCS_LD; }
    int* sel = SEL + (size_t)r * TOPK;
    if (n <= TOPK) { if (t < n) sel[t] = t; if (t == 0) NSEL[r] = n; return; }
    unsigned prefix = 0u;
    for (int bit = 31; bit >= 0; --bit) {
        const unsigned cand = prefix | (1u << bit);
        if (t == 0) cnt_s = 0u;
        __syncthreads();
        unsigned c = 0;
        for (int i = t; i < n; i += 256) c += (fkey(sc[i]) >= cand) ? 1u : 0u;
#pragma unroll
        for (int o = 32; o >= 1; o >>= 1) c += __shfl_xor(c, o);
        if ((t & 63) == 0) atomicAdd(&cnt_s, c);
        __syncthreads();
        if (cnt_s >= (unsigned)TOPK) prefix = cand;
        __syncthreads();
    }
    unsigned c = 0;
    for (int i = t; i < n; i += 256) c += (fkey(sc[i]) > prefix) ? 1u : 0u;
    cnts[t] = c;
    __syncthreads();
    unsigned pp = 0;
    for (int j = 0; j < t; ++j) pp += cnts[j];
    for (int i = t; i < n; i += 256) if (fkey(sc[i]) > prefix) sel[pp++] = i;
    if (t == 255) pos_s = pp;
    __syncthreads();
    if (t == 0) {
        unsigned q = pos_s;
        for (int i = 0; i < n && q < (unsigned)TOPK; ++i) if (fkey(sc[i]) == prefix) sel[q++] = i;
        NSEL[r] = TOPK;
    }
}

__global__ __launch_bounds__(256) void attn_k(const float* __restrict__ Z, const float* __restrict__ cache_k, const float* __restrict__ cache_v, const int* __restrict__ page_table,
                                              const int* __restrict__ SEL, const int* __restrict__ NSEL, bf16_t* __restrict__ CATB) {
    __shared__ float qs[1024];
    __shared__ float ps[8][TOPK];
    __shared__ const float* kptr[TOPK];
    __shared__ const float* vptr[TOPK];
    __shared__ float red[8][4];
    const int r = blockIdx.x, t = threadIdx.x;
    const float* z = Z + (size_t)r * ZLD;
    for (int i = t; i < 1024; i += 256) qs[i] = z[C_Q + i];
    const int ns = NSEL[r];
    float lg[8];
    if (t < ns) {
        const int idx = SEL[(size_t)r * TOPK + t];
        const float* kp; const float* vp;
        if (r < MP) { const int b = r / SEQ; kp = Z + (size_t)(b * SEQ + idx) * ZLD + C_K; vp = Z + (size_t)(b * SEQ + idx) * ZLD + C_V; }
        else {
            const int b = (r - MP) / DS;
            if (idx < NPAST) { const size_t row = (size_t)page_table[b * NPAGES + idx / PAGE] * PAGE + (idx % PAGE); kp = cache_k + row * 512; vp = cache_v + row * 512; }
            else { const size_t zr = (size_t)(MP + b * DS + idx - NPAST); kp = Z + zr * ZLD + C_K; vp = Z + zr * ZLD + C_V; }
        }
        kptr[t] = kp; vptr[t] = vp;
    }
    __syncthreads();
    if (t < ns) {
        const float* kp = kptr[t];
#pragma unroll
        for (int h = 0; h < 8; ++h) lg[h] = 0.f;
#pragma unroll
        for (int n = 0; n < NKV; ++n) {
            float d0 = 0.f, d1 = 0.f;
            for (int d = 0; d < HD; d += 4) {
                const float4 k4 = *(const float4*)(kp + n * HD + d);
                const float* q0 = qs + (2 * n) * HD + d; const float* q1 = qs + (2 * n + 1) * HD + d;
                d0 += q0[0] * k4.x + q0[1] * k4.y + q0[2] * k4.z + q0[3] * k4.w;
                d1 += q1[0] * k4.x + q1[1] * k4.y + q1[2] * k4.z + q1[3] * k4.w;
            }
            lg[2 * n] = d0 * ATTN_SCALE; lg[2 * n + 1] = d1 * ATTN_SCALE;
        }
    } else {
#pragma unroll
        for (int h = 0; h < 8; ++h) lg[h] = -INFINITY;
    }
#pragma unroll
    for (int h = 0; h < 8; ++h) {
        float m = lg[h];
#pragma unroll
        for (int o = 32; o >= 1; o >>= 1) m = fmaxf(m, __shfl_xor(m, o));
        if ((t & 63) == 0) red[h][t >> 6] = m;
    }
    __syncthreads();
    float e[8];
#pragma unroll
    for (int h = 0; h < 8; ++h) {
        const float m = fmaxf(fmaxf(red[h][0], red[h][1]), fmaxf(red[h][2], red[h][3]));
        e[h] = (t < ns) ? expf(lg[h] - m) : 0.f;
    }
    __syncthreads();
#pragma unroll
    for (int h = 0; h < 8; ++h) {
        float s = e[h];
#pragma unroll
        for (int o = 32; o >= 1; o >>= 1) s += __shfl_xor(s, o);
        if ((t & 63) == 0) red[h][t >> 6] = s;
    }
    __syncthreads();
#pragma unroll
    for (int h = 0; h < 8; ++h) { const float s = red[h][0] + red[h][1] + red[h][2] + red[h][3]; ps[h][t] = e[h] / s; }
    __syncthreads();
#pragma unroll
    for (int i = 0; i < 4; ++i) {
        const int o = t + 256 * i, hq = o >> 7, d = o & 127, n = hq >> 1;
        float acc = 0.f;
        for (int j = 0; j < ns; ++j) acc = fmaf(ps[hq][j], vptr[j][n * HD + d], acc);
        CATB[(size_t)r * D + 1024 + o] = f2bf(acc);
    }
}
}

extern "C" void kernel_launch(void* const* d_in, const int* in_sizes, int n_in, void* d_out, int out_size, void* d_ws, size_t ws_size, hipStream_t stream) {
    static int grid = 0;
    if (grid == 0) {
        if (n_in != 27 || ws_size < WS_END) { grid = -1; return; }
        int dev = 0, cus = 0;
        if (hipGetDevice(&dev) != hipSuccess || hipDeviceGetAttribute(&cus, hipDeviceAttributeMultiprocessorCount, dev) != hipSuccess) { grid = -1; return; }
        if (hipFuncSetAttribute((const void*)mk_fwd, hipFuncAttributeMaxDynamicSharedMemorySize, LDS_BYTES) != hipSuccess) { grid = -1; return; }
        (void)hipGetLastError();
        grid = cus;
    }
    if (grid < 0) return;
    const float* cache_k = (const float*)d_in[2];    const float* cache_v = (const float*)d_in[3];
    const float* cache_ki = (const float*)d_in[4];   const float* state_conv = (const float*)d_in[5];
    const float* state_rnn = (const float*)d_in[6];  const int* page_table = (const int*)d_in[7];
    const float* conv_w = (const float*)d_in[13];    const float* conv_b = (const float*)d_in[14];
    const float* lru_wa = (const float*)d_in[15];    const float* lru_ba = (const float*)d_in[16];
    const float* lru_wi = (const float*)d_in[17];    const float* lru_bi = (const float*)d_in[18];
    const float* lru_lam = (const float*)d_in[19];
    float* out = (float*)d_out;
    unsigned char* ws = (unsigned char*)d_ws;
    float* Z = (float*)(ws + WS_Z); bf16_t* CATB = (bf16_t*)(ws + WS_CATB);
    float* SCP = (float*)(ws + WS_SCP); float* SCS = (float*)(ws + WS_SCS); int* SEL = (int*)(ws + WS_SEL); int* NSEL = (int*)(ws + WS_NSEL);

    (void)hipMemsetAsync(ws + WS_CTL, 0, CTL_BYTES, stream);
    Params p{};
    for (int i = 0; i < 27; ++i) p.in[i] = (const float*)d_in[i];
    p.out = out; p.ws = ws;
    int nli = 0;
    auto run = [&](int lo, int hi) { p.ph_lo = lo; p.ph_hi = hi; p.li = nli++; hipLaunchKernelGGL(mk_fwd, dim3(grid), dim3(NTHREADS), LDS_BYTES, stream, p); };
    auto gemm = [&](const float* A, int lda, const float* B, int ldb, float* C, int ldc, int M, int N, int K, int batch, long sA, long sB, long sC) {
        dim3 g((N + 127) / 128, (M + 127) / 128, batch);
        sgemm<<<g, 256, 0, stream>>>(A, lda, B, ldb, C, ldc, M, N, K, sA, sB, sC);
    };
    run(0, 12);
}
```

```cpp
#include <hip/hip_runtime.h>
#include <stdint.h>

namespace pg8 {
#define PG8_LAS __attribute__((address_space(3)))
typedef unsigned short bf16_t;
typedef short bf16x8 __attribute__((ext_vector_type(8)));
typedef float f32x4 __attribute__((ext_vector_type(4)));
typedef unsigned u32x4 __attribute__((ext_vector_type(4)));
constexpr int BM = 256, BK = 64, HALF = 128, HTB = HALF * BK * 2  , STAGE_BYTES = 8 * HTB, NXCD = 8, WGM = 8;

__host__ __device__ __forceinline__ int lds_byte(int r, int c) { const int st = (r >> 4) * 2 + (c >> 5), rr = r & 15, cc = c & 31, ob = rr * 64 + cc * 2; return st * 1024 + (ob ^ (((ob >> 9) & 1) << 5)); }
__host__ __device__ __forceinline__ void stage_rc(int b, int& R, int& C) { const int st = b / 1024, sb = b % 1024, swz = sb ^ (((sb >> 9) & 1) << 5); R = (st >> 1) * 16 + swz / 64; C = (st & 1) * 32 + (swz % 64) / 2; }
__host__ __device__ __forceinline__ int perm32(int rho) { const int n = rho >> 4, i = rho & 15; return 8 * (i >> 2) + 4 * n + (i & 3); }

struct Unit { int pm, pn; };
struct Gemm { const bf16_t* A; const bf16_t* Bt; int M, N, K; };

struct StaticOrder {
    int nM, nN, nwg, G, c;
    __host__ __device__ void init(int M, int N, int G_, int c_) { nM = M / BM; nN = N / BM; nwg = nM * nN; G = G_; c = c_; }
    __host__ __device__ bool next(int i, Unit& u) const {
        const long L = (long)i * G + c; if (L >= nwg) return false;
        int wgid = (int)L; { const int q = nwg / NXCD, r = nwg % NXCD, xcd = wgid % NXCD, off = wgid / NXCD; wgid = (xcd < r ? xcd * (q + 1) : r * (q + 1) + (xcd - r) * q) + off; }
        const int nig = WGM * nN, gid = wgid / nig, fm = gid * WGM, gsz = (nM - fm) < WGM ? (nM - fm) : WGM;
        u.pm = fm + ((wgid % nig) % gsz); u.pn = (wgid % nig) / gsz; return true;
    }
    __device__ __forceinline__ void a_ready(const Unit&) const {}
    __device__ __forceinline__ void done(const Unit&) const {}
};

__device__ __forceinline__ unsigned cvt_pk_bf16(float lo, float hi) { unsigned r; asm volatile("v_cvt_pk_bf16_f32 %0, %1, %2" : "=v"(r) : "v"(lo), "v"(hi)); return r; }
typedef float f32x2 __attribute__((ext_vector_type(2)));

template <class Epi, class Sched, bool ALIGN_EPI = false, bool SP2 = false>
__device__ __forceinline__ void gemm_phase(PG8_LAS unsigned char* lds, const Gemm g, const Sched& S, const Epi& E) {
    const int tid = threadIdx.x, wid = __builtin_amdgcn_readfirstlane(tid >> 6), lane = tid & 63, wr = wid >> 2, wc = wid & 3, fr = lane & 15, fq = lane >> 4;
    const int K = g.K, nt = K / BK;
    unsigned voffA[2], voffB[2];
#pragma unroll
    for (int i = 0; i < 2; ++i) { int R, C; stage_rc(tid * 16 + i * 8192, R, C); const int Rb = Epi::PERM ? ((R & ~31) + perm32(R & 31)) : R;
        voffA[i] = (unsigned)(R * K + C) * 2u; voffB[i] = (unsigned)(Rb * K + C) * 2u; }
    const size_t kstep = (size_t)(BK * 2);
    const size_t hstep = (size_t)HALF * K * 2;
    const size_t tstep = 2 * hstep;
    const unsigned ldsw = (unsigned)wid * 1024u;
    const int aoff = lds_byte(wr * 64 + fr, fq * 8), boff = lds_byte(wc * 32 + fr, fq * 8);
#define PG8_SA(b, h) (((b) * 2 + (h)) * HTB)
#define PG8_SB(b, h) ((4 + (b) * 2 + (h)) * HTB)
#define PG8_STAGE(bufoff, gbase, voff) do { _Pragma("unroll") for (int _i = 0; _i < 2; ++_i) \
        __builtin_amdgcn_global_load_lds((const unsigned*)((const char*)(gbase) + (voff)[_i]), (PG8_LAS unsigned*)(lds + (bufoff) + ldsw + _i * 8192), 16, 0, 0); } while (0)
#define PG8_LDA(dst, b, h) do { _Pragma("unroll") for (int m = 0; m < 4; ++m) _Pragma("unroll") for (int k = 0; k < 2; ++k) dst[m][k] = *(const PG8_LAS bf16x8*)(lds + PG8_SA(b, h) + aoff + m * 2048 + k * 1024); } while (0)
#define PG8_LDB(dst, b, h) do { _Pragma("unroll") for (int n = 0; n < 2; ++n) _Pragma("unroll") for (int k = 0; k < 2; ++k) dst[n][k] = *(const PG8_LAS bf16x8*)(lds + PG8_SB(b, h) + boff + n * 2048 + k * 1024); } while (0)
#define PG8_MMA(ai, bj, At, Bt) do { __builtin_amdgcn_s_setprio(1); _Pragma("unroll") for (int m = 0; m < 4; ++m) _Pragma("unroll") for (int n = 0; n < 2; ++n) _Pragma("unroll") for (int k = 0; k < 2; ++k) \
        acc[ai][bj][m][n] = __builtin_amdgcn_mfma_f32_16x16x32_bf16(Bt[n][k], At[m][k], acc[ai][bj][m][n], 0, 0, 0); __builtin_amdgcn_s_setprio(0); } while (0)
#define PG8_WAIT_V(n) asm volatile("s_waitcnt vmcnt(" #n ")" ::: "memory")
#define PG8_WAIT_L(n) asm volatile("s_waitcnt lgkmcnt(" #n ")" ::: "memory")
#define PG8_BAR __builtin_amdgcn_s_barrier()
#define PG8_SCHED __builtin_amdgcn_sched_barrier(0)
    Unit cur, nxt; int ui = 0;
    if (!S.next(0, cur)) return;
    f32x4 acc[2][2][4][2];
#pragma unroll
    for (int a = 0; a < 2; ++a)
#pragma unroll
        for (int b = 0; b < 2; ++b)
#pragma unroll
            for (int m = 0; m < 4; ++m)
#pragma unroll
                for (int n = 0; n < 2; ++n) acc[a][b][m][n] = (f32x4){0.f, 0.f, 0.f, 0.f};
    bf16x8 At[4][2], B0[2][2], B1[2][2];
    const char* cA = (const char*)g.A + (size_t)cur.pm * tstep; const char* cB = (const char*)g.Bt + (size_t)cur.pn * tstep;
    S.a_ready(cur);
    if constexpr (SP2) {
        PG8_STAGE(PG8_SB(0, 0), cB, voffB); PG8_STAGE(PG8_SB(0, 1), cB + hstep, voffB); PG8_STAGE(PG8_SA(0, 0), cA, voffA); PG8_STAGE(PG8_SA(0, 1), cA + hstep, voffA);
        if (wr == 1) PG8_BAR;
        PG8_WAIT_V(2); PG8_BAR;
        PG8_STAGE(PG8_SB(1, 0), cB + kstep, voffB); PG8_STAGE(PG8_SA(1, 0), cA + kstep, voffA); PG8_STAGE(PG8_SB(1, 1), cB + hstep + kstep, voffB);
        PG8_WAIT_V(6); PG8_BAR;
    } else {
        PG8_STAGE(PG8_SB(0, 0), cB, voffB); PG8_STAGE(PG8_SA(0, 0), cA, voffA); PG8_STAGE(PG8_SB(0, 1), cB + hstep, voffB); PG8_STAGE(PG8_SA(0, 1), cA + hstep, voffA);
        if (wr == 1) PG8_BAR;
        PG8_WAIT_V(4); PG8_BAR;
        PG8_STAGE(PG8_SB(1, 0), cB + kstep, voffB); PG8_STAGE(PG8_SA(1, 0), cA + kstep, voffA); PG8_STAGE(PG8_SB(1, 1), cB + hstep + kstep, voffB);
        PG8_WAIT_V(6); PG8_BAR;
    }
    for (;;) {
        const bool has_next = S.next(ui + 1, nxt);
        const char* nA = has_next ? (const char*)g.A + (size_t)nxt.pm * tstep : cA; const char* nB = has_next ? (const char*)g.Bt + (size_t)nxt.pn * tstep : cB;
        for (int t = 0; t < nt; t += 2) {
            const bool last = (t == nt - 2);
            const char* a1 = cA + (size_t)(t + 1) * kstep;
            const char* a2 = last ? nA : cA + (size_t)(t + 2) * kstep; const char* b2 = last ? nB : cB + (size_t)(t + 2) * kstep;
            const char* a3 = a2 + kstep; const char* b3 = b2 + kstep;
            if (last && has_next) S.a_ready(nxt);
            if constexpr (SP2) {
            PG8_LDB(B0, 0, 0); PG8_LDB(B1, 0, 1); PG8_SCHED; PG8_LDA(At, 0, 0); PG8_STAGE(PG8_SA(1, 1), a1 + hstep, voffA);
            PG8_WAIT_V(8); PG8_WAIT_L(0); PG8_BAR; PG8_MMA(0, 0, At, B0); PG8_MMA(0, 1, At, B1); PG8_BAR; PG8_SCHED;
            PG8_LDA(At, 0, 1); PG8_STAGE(PG8_SB(0, 0), b2, voffB); PG8_STAGE(PG8_SB(0, 1), b2 + hstep, voffB); PG8_STAGE(PG8_SA(0, 0), a2, voffA);
            PG8_WAIT_V(8); PG8_WAIT_L(0); PG8_BAR; PG8_MMA(1, 0, At, B0); PG8_MMA(1, 1, At, B1); PG8_BAR; PG8_SCHED;
            PG8_LDB(B0, 1, 0); PG8_LDB(B1, 1, 1); PG8_SCHED; PG8_LDA(At, 1, 0); PG8_STAGE(PG8_SA(0, 1), a2 + hstep, voffA);
            PG8_WAIT_V(8); PG8_WAIT_L(0); PG8_BAR; PG8_MMA(0, 0, At, B0); PG8_MMA(0, 1, At, B1); PG8_BAR; PG8_SCHED;
            PG8_LDA(At, 1, 1); PG8_STAGE(PG8_SB(1, 0), b3, voffB); PG8_STAGE(PG8_SB(1, 1), b3 + hstep, voffB); PG8_STAGE(PG8_SA(1, 0), a3, voffA);
            PG8_WAIT_V(8); PG8_WAIT_L(0); PG8_BAR; PG8_MMA(1, 0, At, B0); PG8_MMA(1, 1, At, B1); PG8_BAR; PG8_SCHED;
            } else {
            PG8_LDB(B0, 0, 0); PG8_SCHED; PG8_LDA(At, 0, 0); PG8_STAGE(PG8_SA(1, 1), a1 + hstep, voffA);
            PG8_WAIT_L(8); PG8_BAR; PG8_WAIT_L(0); PG8_MMA(0, 0, At, B0); PG8_BAR; PG8_SCHED;
            PG8_LDB(B1, 0, 1); PG8_STAGE(PG8_SB(0, 0), b2, voffB);
            PG8_BAR; PG8_WAIT_L(0); PG8_MMA(0, 1, At, B1); PG8_BAR;
            PG8_LDA(At, 0, 1); PG8_STAGE(PG8_SA(0, 0), a2, voffA);
            PG8_BAR; PG8_WAIT_L(0); PG8_MMA(1, 0, At, B0); PG8_BAR; PG8_SCHED;
            PG8_STAGE(PG8_SB(0, 1), b2 + hstep, voffB);
            PG8_WAIT_V(6); PG8_BAR; PG8_MMA(1, 1, At, B1); PG8_BAR;
            PG8_LDB(B0, 1, 0); PG8_SCHED; PG8_LDA(At, 1, 0); PG8_STAGE(PG8_SA(0, 1), a2 + hstep, voffA);
            PG8_WAIT_L(8); PG8_BAR; PG8_WAIT_L(0); PG8_MMA(0, 0, At, B0); PG8_BAR; PG8_SCHED;
            PG8_LDB(B1, 1, 1); PG8_STAGE(PG8_SB(1, 0), b3, voffB);
            PG8_BAR; PG8_WAIT_L(0); PG8_MMA(0, 1, At, B1); PG8_BAR;
            PG8_LDA(At, 1, 1); PG8_STAGE(PG8_SA(1, 0), a3, voffA);
            PG8_BAR; PG8_WAIT_L(0); PG8_MMA(1, 0, At, B0); PG8_BAR; PG8_SCHED;
            PG8_STAGE(PG8_SB(1, 1), b3 + hstep, voffB);
            PG8_WAIT_V(6); PG8_BAR; PG8_MMA(1, 1, At, B1); PG8_BAR;
            }
        }
        if constexpr (ALIGN_EPI) { if (wr == 0) PG8_BAR; }
        if constexpr (!Epi::AFTER_DRAIN) { E(acc, cur, wr, wc, fr, fq); S.done(cur); }
        if (!has_next) break;
#pragma unroll
        for (int a = 0; a < 2; ++a)
#pragma unroll
            for (int b = 0; b < 2; ++b)
#pragma unroll
                for (int m = 0; m < 4; ++m)
#pragma unroll
                    for (int n = 0; n < 2; ++n) acc[a][b][m][n] = (f32x4){0.f, 0.f, 0.f, 0.f};
        cur = nxt; cA = nA; cB = nB; ++ui;
        if constexpr (ALIGN_EPI) { if (wr == 1) PG8_BAR; }
    }
    PG8_WAIT_V(0);
    if constexpr (!ALIGN_EPI) { if (wr == 0) PG8_BAR; }
    PG8_BAR;
    if constexpr (Epi::AFTER_DRAIN) { E.fused(acc, cur, wr, wc, fr, fq, lds, wid, lane); S.done(cur); }
#undef PG8_SA
#undef PG8_SB
#undef PG8_STAGE
#undef PG8_LDA
#undef PG8_LDB
#undef PG8_MMA
#undef PG8_WAIT_V
#undef PG8_WAIT_L
#undef PG8_BAR
#undef PG8_SCHED
}

}

#define XB_TMO      128
#define XB_XCNT(j)  (256  + 64 * (j))
#define XB_XSUB(j)  (1280 + 64 * (j))
#define XB_XGEN(j)  (2304 + 64 * (j))
#define XB_TOP      3328
#define XB_TOPGEN   3392
#define XCD_BAR_WORDS 3456
#define XB_SPIN_CAP (1u << 18)
#define LAS __attribute__((address_space(3)))

__device__ __forceinline__ unsigned xb_ld(unsigned* p)              { return __hip_atomic_load(p, __ATOMIC_RELAXED, __HIP_MEMORY_SCOPE_AGENT); }
__device__ __forceinline__ unsigned xb_add(unsigned* p, unsigned v) { return __hip_atomic_fetch_add(p, v, __ATOMIC_RELAXED, __HIP_MEMORY_SCOPE_AGENT); }
__device__ __forceinline__ unsigned xb_xcc_id() { return (unsigned)__builtin_amdgcn_s_getreg((3 << 11) | 20) & 0xFu; }
#define XB_SPIN(cond, bar) do { unsigned _sp = 0; while (cond) { __builtin_amdgcn_s_sleep(1); \
    if ((++_sp & 255u) == 0u) { if (xb_ld(&(bar)[XB_TMO])) break; if (_sp > XB_SPIN_CAP) { atomicAdd(&(bar)[XB_TMO], 1u); break; } } } } while (0)

struct XcdBarrier {
    unsigned* bar; unsigned x;
    volatile LAS unsigned* st;
};

__device__ __forceinline__ XcdBarrier xcd_barrier_post(unsigned* bar, volatile LAS unsigned* st) {
    XcdBarrier b; b.bar = bar; b.x = xb_xcc_id(); b.st = st;
    if (threadIdx.x == 0) (void)xb_add(&bar[XB_XCNT(b.x)], 1u);
    return b;
}
__device__ __forceinline__ void xcd_barrier_complete(unsigned* bar, unsigned x, unsigned& nloc, unsigned& nx) {
    const unsigned G = gridDim.x * gridDim.y * gridDim.z;
    unsigned sum, cnt, mine, sp = 0u;
    for (;;) {
        sum = 0u; cnt = 0u; mine = 0u;
#pragma unroll
        for (unsigned j = 0; j < 16; ++j) { const unsigned c = xb_ld(&bar[XB_XCNT(j)]); sum += c; cnt += (c > 0u) ? 1u : 0u; mine = (j == x) ? c : mine; }
        if (sum == G) break;
        __builtin_amdgcn_s_sleep(1);
        if ((++sp & 255u) == 0u) { if (xb_ld(&bar[XB_TMO])) break; if (sp > XB_SPIN_CAP) { atomicAdd(&bar[XB_TMO], 1u); break; } }
    }
    nloc = mine > 0u ? mine : 1u; nx = cnt > 0u ? cnt : 1u;
}

__device__ __forceinline__ void xcd_barrier(const XcdBarrier& b) {
    asm volatile("s_waitcnt vmcnt(0)" ::: "memory");
    __syncthreads();
    if (threadIdx.x == 0) {
        unsigned* bar = b.bar;
        __builtin_amdgcn_s_waitcnt(0);
        unsigned nloc = b.st[0], nx = b.st[1];
        if (nloc == 0u) { xcd_barrier_complete(bar, b.x, nloc, nx); b.st[0] = nloc; b.st[1] = nx; }
        const unsigned old = xb_add(&bar[XB_XSUB(b.x)], 1u);
        const unsigned gen = old / nloc;
        if (old + 1u == (gen + 1u) * nloc) {
            __builtin_amdgcn_fence(__ATOMIC_RELEASE, "agent");
            asm volatile("s_waitcnt vmcnt(0)" ::: "memory");
            const unsigned og = xb_add(&bar[XB_TOP], 1u);
            const unsigned tg = og / nx;
            if (og + 1u == (tg + 1u) * nx) xb_add(&bar[XB_TOPGEN], 1u);
            else XB_SPIN(xb_ld(&bar[XB_TOPGEN]) == tg, bar);
            __builtin_amdgcn_fence(__ATOMIC_ACQUIRE, "agent");
            xb_add(&bar[XB_XGEN(b.x)], 1u);
            asm volatile("s_waitcnt vmcnt(0)" ::: "memory");
        } else {
            XB_SPIN(xb_ld(&bar[XB_XGEN(b.x)]) == gen, bar);
            __builtin_amdgcn_fence(__ATOMIC_ACQUIRE, "agent");
            asm volatile("s_waitcnt vmcnt(0)" ::: "memory");
        }
    }
    __syncthreads();
}


namespace {
typedef unsigned short bf16_t;
typedef float f32x4 __attribute__((ext_vector_type(4)));
typedef unsigned u32x4 __attribute__((ext_vector_type(4)));
typedef unsigned u32x2 __attribute__((ext_vector_type(2)));

constexpr int D = 2048, SEQ = 4096, NB = 2, MP = NB * SEQ, DB = 32, DS = 4, MS = DB * DS, MT = MP + MS, MPAD = 8448;
constexpr int DFF = 5504, DRNN = 1024, HD = 128, NKV = 4, IDH = 8, IDD = 64, DIN = 4680, DINP = 4864;
constexpr int NPAGES = 64, PAGE = 128, NPAST = NPAGES * PAGE, LS = NPAST + DS, TOPK = 256;
constexpr int C_XR = 0, C_GR = 1024, C_Q = 2048, C_K = 3072, C_V = 3584, C_QI = 4096, C_KI = 4608, C_WI = 4672;
constexpr float ALPHA = 1.189207115002721f, LN_EPS = 1e-5f, ATTN_SCALE = 0.08838834764831845f, IDX_SCALE = 0.125f, IDX_W_SCALE = 0.35355339059327373f;
constexpr size_t O_YP = 0, O_YS = 16777216, O_KP = 17039360, O_VP = 21233664, O_KIP = 25427968, O_CP = 25952256, O_HP = 25958400,
                 O_KS = 25960448, O_VS = 26025984, O_KIS = 26091520, O_CS = 26099712, O_HS = 26198016;
constexpr int SCS_LD = 8256;
constexpr int ZLD = DINP;

constexpr size_t al256(size_t x) { return (x + 255) & ~(size_t)255; }
constexpr size_t WS_CTL = 0;
constexpr size_t CTL_BYTES = 65536;
constexpr size_t WS_WGU1 = WS_CTL + CTL_BYTES;
constexpr size_t WS_WD1 = WS_WGU1 + al256((size_t)2 * DFF * D * 2);
constexpr size_t WS_WIN = WS_WD1 + al256((size_t)D * DFF * 2);
constexpr size_t WS_WOUT = WS_WIN + al256((size_t)DINP * D * 2);
constexpr size_t WS_WGU2 = WS_WOUT + al256((size_t)D * D * 2);
constexpr size_t WS_WD2 = WS_WGU2 + al256((size_t)2 * DFF * D * 2);
constexpr size_t WS_XB = WS_WD2 + al256((size_t)D * DFF * 2);
constexpr size_t WS_H = WS_XB + al256((size_t)MPAD * D * 2);
constexpr size_t WS_T = WS_H + al256((size_t)MPAD * DFF * 2);
constexpr size_t WS_X1 = WS_T + al256((size_t)MPAD * D * 4);
constexpr size_t WS_X2 = WS_X1 + al256((size_t)MPAD * D * 4);
constexpr size_t WS_Z = WS_X2 + al256((size_t)MPAD * D * 4);
constexpr size_t WS_CATB = WS_Z + al256((size_t)MPAD * DINP * 4);
constexpr size_t WS_HL = WS_CATB + al256((size_t)MPAD * D * 2);
constexpr size_t WS_PP = WS_HL + al256((size_t)MT * DRNN * 4);
constexpr size_t WS_GI = WS_PP + al256((size_t)MT * DRNN * 4);
constexpr size_t WS_SCP = WS_GI + al256((size_t)MT * DRNN * 4);
constexpr size_t WS_SCS = WS_SCP + al256((size_t)MP * SEQ * 4);
constexpr size_t WS_SEL = WS_SCS + al256((size_t)MS * SCS_LD * 4);
constexpr size_t WS_NSEL = WS_SEL + al256((size_t)MT * TOPK * 4);
constexpr size_t WS_SUMA = WS_NSEL + al256((size_t)MT * 4);
constexpr size_t WS_SUMH = WS_SUMA + al256((size_t)130 * DRNN * 4);
constexpr size_t WS_WAT = WS_SUMH + al256((size_t)130 * DRNN * 4);
constexpr size_t WS_WIT = WS_WAT + al256((size_t)8 * 128 * 128 * 2);
constexpr size_t WS_BM = WS_WIT + al256((size_t)8 * 128 * 128 * 2);
constexpr size_t WS_QB = WS_BM + al256((size_t)MP * 64 * 8);
constexpr size_t WS_KB = WS_QB + al256((size_t)MP * 1024 * 2);
constexpr size_t WS_VB = WS_KB + al256((size_t)MP * 512 * 2);
constexpr size_t WS_END = WS_VB + al256((size_t)MP * 512 * 2);
constexpr size_t WS_CTR = WS_CTL + 32768;

constexpr int NWAVES = 8, NTHREADS = 512;
#ifndef REP_G
#define REP_G 1
#endif
#ifndef REP_T
#define REP_T 1
#endif
#ifndef REP_5
#define REP_5 2
#endif
constexpr int LDS_STAGE = 131072, LDS_MISC = 134144, LDS_BYTES = 135168;

struct Params {
    const float* in[27];
    float* out;
    unsigned char* ws;
    int ph_lo, ph_hi, li, pad_;
};

__device__ __forceinline__ unsigned cvt_pk_bf16(float lo, float hi) { unsigned r; asm volatile("v_cvt_pk_bf16_f32 %0, %1, %2" : "=v"(r) : "v"(lo), "v"(hi)); return r; }
__device__ __forceinline__ float sigmoidf_(float x) { return 1.0f / (1.0f + expf(-x)); }
__device__ __forceinline__ float gelu_tanh(float x) { return 0.5f * x * (1.0f + tanhf(0.7978845608028654f * (x + 0.044715f * x * x * x))); }
__device__ __forceinline__ bf16_t f2bf(float f) { return (bf16_t)(cvt_pk_bf16(f, 0.f) & 0xffffu); }

struct EpiSwiGLU {
    static constexpr bool PERM = true, AFTER_DRAIN = false;
    bf16_t* H;
    __device__ __forceinline__ void operator()(const f32x4 (&acc)[2][2][4][2], const pg8::Unit& u, int wr, int wc, int fr, int fq) const {
        const int row0 = u.pm * 256 + wr * 64 + fr, col0 = u.pn * 128 + wc * 32 + 8 * fq;
#pragma unroll
        for (int ai = 0; ai < 2; ++ai)
#pragma unroll
            for (int m = 0; m < 4; ++m) {
                bf16_t* rowp = H + (size_t)(row0 + ai * 128 + m * 16) * DFF + col0;
                float h[8];
#pragma unroll
                for (int n = 0; n < 2; ++n)
#pragma unroll
                    for (int j = 0; j < 4; ++j) {
                        const float g = acc[ai][0][m][n][j], up = acc[ai][1][m][n][j];
                        const float sg = __builtin_amdgcn_rcpf(1.0f + __builtin_amdgcn_exp2f(-1.4426950408889634f * g));
                        h[n * 4 + j] = g * sg * up;
                    }
                u32x4 w; w.x = cvt_pk_bf16(h[0], h[1]); w.y = cvt_pk_bf16(h[2], h[3]); w.z = cvt_pk_bf16(h[4], h[5]); w.w = cvt_pk_bf16(h[6], h[7]);
                *(u32x4*)rowp = w;
            }
    }
};
struct EpiResid {
    static constexpr bool PERM = false, AFTER_DRAIN = false;
    const float* Xp; const float* Xs; float* T; float s;
    __device__ __forceinline__ void operator()(const f32x4 (&acc)[2][2][4][2], const pg8::Unit& u, int wr, int wc, int fr, int fq) const {
        const int row0 = u.pm * 256 + wr * 64 + fr, col0 = u.pn * 256 + wc * 32 + 4 * fq;
#pragma unroll
        for (int ai = 0; ai < 2; ++ai)
#pragma unroll
            for (int m = 0; m < 4; ++m) {
                const int row = row0 + ai * 128 + m * 16;
                if (row < MT) {
                    const float* xr = (row < MP) ? Xp + (size_t)row * D + col0 : Xs + (size_t)(row - MP) * D + col0;
                    float* tr = T + (size_t)row * D + col0;
#pragma unroll
                    for (int bj = 0; bj < 2; ++bj)
#pragma unroll
                        for (int n = 0; n < 2; ++n) { const f32x4 xv = *(const f32x4*)(xr + bj * 128 + n * 16); *(f32x4*)(tr + bj * 128 + n * 16) = xv * ALPHA + acc[ai][bj][m][n] * s; }
                }
            }
    }
};
struct EpiF32 {
    static constexpr bool PERM = false, AFTER_DRAIN = false;
    float* C; int ldc;
    __device__ __forceinline__ void operator()(const f32x4 (&acc)[2][2][4][2], const pg8::Unit& u, int wr, int wc, int fr, int fq) const {
        const int row0 = u.pm * 256 + wr * 64 + fr, col0 = u.pn * 256 + wc * 32 + 4 * fq;
#pragma unroll
        for (int ai = 0; ai < 2; ++ai)
#pragma unroll
            for (int m = 0; m < 4; ++m) {
                float* rowp = C + (size_t)(row0 + ai * 128 + m * 16) * ldc + col0;
#pragma unroll
                for (int bj = 0; bj < 2; ++bj)
#pragma unroll
                    for (int n = 0; n < 2; ++n) *(f32x4*)(rowp + bj * 128 + n * 16) = acc[ai][bj][m][n];
            }
    }
};

template <int MODE>
__device__ __forceinline__ void transpose_cvt(const float* __restrict__ W, int K, int N, int Npad, bf16_t* __restrict__ Wt, PG8_LAS float* tile) {
    const int tid = threadIdx.x, ntn = Npad / 64, ntk = K / 64, ntiles = ntn * ntk;
    for (int t = blockIdx.x; t < ntiles; t += gridDim.x) {
        const int tn = t % ntn, tk = t / ntn, n0 = tn * 64, k0 = tk * 64;
        int s0;
        if (MODE == 1) { const int tile256 = n0 >> 8, j = n0 & 255; s0 = (j < 128) ? tile256 * 128 + j : DFF + tile256 * 128 + (j - 128); } else s0 = n0;
#pragma unroll
        for (int i = 0; i < 8; ++i) {
            const int e = tid + 512 * i, k = e >> 6, n = e & 63;
            tile[k * 65 + n] = (MODE == 1 || s0 + n < N) ? W[(size_t)(k0 + k) * N + s0 + n] : 0.f;
        }
        __syncthreads();
        {
            const int n = tid >> 3, kq = (tid & 7) * 8;
            float v[8];
#pragma unroll
            for (int j = 0; j < 8; ++j) v[j] = tile[(kq + j) * 65 + n];
            u32x4 w; w.x = cvt_pk_bf16(v[0], v[1]); w.y = cvt_pk_bf16(v[2], v[3]); w.z = cvt_pk_bf16(v[4], v[5]); w.w = cvt_pk_bf16(v[6], v[7]);
            *(u32x4*)(Wt + (size_t)(n0 + n) * K + k0 + kq) = w;
        }
        __syncthreads();
    }
}
__device__ __forceinline__ void cvt_x(const float* __restrict__ xp, const float* __restrict__ xs, bf16_t* __restrict__ XB) {
    const size_t n4 = (size_t)MPAD * D / 4;
    for (size_t i = (size_t)blockIdx.x * NTHREADS + threadIdx.x; i < n4; i += (size_t)gridDim.x * NTHREADS) {
        const size_t e = i * 4, row = e / D;
        f32x4 v = (f32x4){0.f, 0.f, 0.f, 0.f};
        if (row < (size_t)MP) v = *(const f32x4*)(xp + e); else if (row < (size_t)MT) v = *(const f32x4*)(xs + (e - (size_t)MP * D));
        u32x2 w; w.x = cvt_pk_bf16(v[0], v[1]); w.y = cvt_pk_bf16(v[2], v[3]);
        *(u32x2*)(XB + e) = w;
    }
}
__device__ __forceinline__ void ln_phase(const float* __restrict__ T, const float* __restrict__ g, const float* __restrict__ b, float* __restrict__ Xo, bf16_t* __restrict__ Xb) {
    const int lane = threadIdx.x & 63, wave = threadIdx.x >> 6;
    f32x4 gv[8], bv[8];
#pragma unroll
    for (int i = 0; i < 8; ++i) { gv[i] = *(const f32x4*)(g + lane * 4 + 256 * i); bv[i] = *(const f32x4*)(b + lane * 4 + 256 * i); }
    for (int row = blockIdx.x * NWAVES + wave; row < MT; row += gridDim.x * NWAVES) {
        const float* tr = T + (size_t)row * D + lane * 4;
        f32x4 v[8]; float s = 0.f;
#pragma unroll
        for (int i = 0; i < 8; ++i) { v[i] = *(const f32x4*)(tr + 256 * i); s += (v[i][0] + v[i][1]) + (v[i][2] + v[i][3]); }
#pragma unroll
        for (int o = 32; o >= 1; o >>= 1) s += __shfl_xor(s, o);
        const float mean = s * (1.0f / D);
        float q = 0.f;
#pragma unroll
        for (int i = 0; i < 8; ++i) { const f32x4 d = v[i] - mean; q += (d[0] * d[0] + d[1] * d[1]) + (d[2] * d[2] + d[3] * d[3]); }
#pragma unroll
        for (int o = 32; o >= 1; o >>= 1) q += __shfl_xor(q, o);
        const float rstd = rsqrtf(q * (1.0f / D) + LN_EPS);
#pragma unroll
        for (int i = 0; i < 8; ++i) {
            const f32x4 o = (v[i] - mean) * rstd * gv[i] + bv[i];
            if (Xo) *(f32x4*)(Xo + (size_t)row * D + lane * 4 + 256 * i) = o;
            if (Xb) { u32x2 w; w.x = cvt_pk_bf16(o[0], o[1]); w.y = cvt_pk_bf16(o[2], o[3]); *(u32x2*)(Xb + (size_t)row * D + lane * 4 + 256 * i) = w; }
        }
    }
}


typedef short bf16x8 __attribute__((ext_vector_type(8)));
typedef float f32x16 __attribute__((ext_vector_type(16)));
__device__ __forceinline__ int crow(int reg, int h) { return (reg & 3) + 8 * (reg >> 2) + 4 * h; }
constexpr int LRU_CH = 64, LRU_NCHUNK = MT / LRU_CH  , LRU_PCHUNK = MP / LRU_CH  , LRU_CPB = SEQ / LRU_CH  ;
constexpr int L_XCF = 0, L_XCB = 32768, L_AA = 50176, L_UU = 82944, XCB_PITCH = 272;
__device__ __forceinline__ void lru_local_unit(const Params& p, PG8_LAS unsigned char* lds, int u) {
    const int tid = threadIdx.x, lane = tid & 63, wave = tid >> 6;
    unsigned char* ws = p.ws;
    const float* Z = (const float*)(ws + WS_Z);
    const float* state_conv = p.in[5]; const float* state_rnn = p.in[6];
    const float* cw = p.in[13]; const float* cb = p.in[14];
    const float* ba = p.in[16]; const float* bi = p.in[18]; const float* lam = p.in[19];
    const bf16_t* WAt = (const bf16_t*)(ws + WS_WAT); const bf16_t* WIt = (const bf16_t*)(ws + WS_WIT);
    float* HL = (float*)(ws + WS_HL); float* PP = (float*)(ws + WS_PP); float* SUMA = (float*)(ws + WS_SUMA); float* SUMH = (float*)(ws + WS_SUMH);
    float* out = p.out;
    PG8_LAS float* XCF = (PG8_LAS float*)(lds + L_XCF); PG8_LAS float* AA = (PG8_LAS float*)(lds + L_AA); PG8_LAS float* UU = (PG8_LAS float*)(lds + L_UU);
    {
        const int ck = u >> 3, nb = u & 7;
        {
            const int c = tid & 127, rg = tid >> 7, ch = nb * 128 + c;
            const float w0 = cw[ch], w1 = cw[DRNN + ch], w2 = cw[2 * DRNN + ch], w3 = cw[3 * DRNN + ch], cbv = cb[ch];
            if (ck < LRU_PCHUNK) {
                const int b = ck / LRU_CPB, t0 = (ck % LRU_CPB) * LRU_CH + rg * 16;
                const float* zc = Z + (size_t)(b * SEQ) * ZLD + C_XR + ch;
                float x0 = (t0 - 3 >= 0) ? zc[(size_t)(t0 - 3) * ZLD] : 0.f, x1 = (t0 - 2 >= 0) ? zc[(size_t)(t0 - 2) * ZLD] : 0.f, x2 = (t0 - 1 >= 0) ? zc[(size_t)(t0 - 1) * ZLD] : 0.f;
#pragma unroll
                for (int i = 0; i < 16; ++i) {
                    const int t = t0 + i, lr = rg * 16 + i;
                    const float x3 = zc[(size_t)t * ZLD];
                    const float xc = cbv + w0 * x0 + w1 * x1 + w2 * x2 + w3 * x3;
                    XCF[lr * 128 + c] = xc;
                    *(PG8_LAS bf16_t*)(lds + L_XCB + lr * XCB_PITCH + c * 2) = f2bf(xc);
                    if (t >= SEQ - 3) out[O_CP + (size_t)(b * 3 + (t - (SEQ - 3))) * DRNN + ch] = x3;
                    x0 = x1; x1 = x2; x2 = x3;
                }
            } else {
#pragma unroll
                for (int i = 0; i < 16; ++i) {
                    const int lr = rg * 16 + i, rs = (ck - LRU_PCHUNK) * LRU_CH + lr, bs = rs >> 2, tt = rs & 3;
                    float xv[4];
#pragma unroll
                    for (int j = 0; j < 4; ++j) { const int pp = tt + j; xv[j] = (pp < 3) ? state_conv[(size_t)(bs * 3 + pp) * DRNN + ch] : Z[(size_t)(MP + bs * DS + pp - 3) * ZLD + C_XR + ch]; }
                    const float xc = cbv + w0 * xv[0] + w1 * xv[1] + w2 * xv[2] + w3 * xv[3];
                    XCF[lr * 128 + c] = xc;
                    *(PG8_LAS bf16_t*)(lds + L_XCB + lr * XCB_PITCH + c * 2) = f2bf(xc);
                    if (tt >= 1) out[O_CS + (size_t)(bs * 3 + (tt - 1)) * DRNN + ch] = xv[3];
                }
            }
        }
        __syncthreads();
        {
            const int mt = wave >> 2, nt = wave & 3, r = lane & 31, kh = lane >> 5;
            f32x16 acc_a, acc_i;
#pragma unroll
            for (int i = 0; i < 16; ++i) { acc_a[i] = 0.f; acc_i[i] = 0.f; }
            const bf16_t* wa = WAt + (size_t)nb * 16384 + (size_t)(nt * 32 + r) * 128 + kh * 8;
            const bf16_t* wi = WIt + (size_t)nb * 16384 + (size_t)(nt * 32 + r) * 128 + kh * 8;
#pragma unroll
            for (int ks = 0; ks < 8; ++ks) {
                const bf16x8 af = *(const PG8_LAS bf16x8*)(lds + L_XCB + (mt * 32 + r) * XCB_PITCH + (ks * 16 + kh * 8) * 2);
                const bf16x8 bfa = *(const bf16x8*)(wa + ks * 16);
                const bf16x8 bfi = *(const bf16x8*)(wi + ks * 16);
                acc_a = __builtin_amdgcn_mfma_f32_32x32x16_bf16(af, bfa, acc_a, 0, 0, 0);
                acc_i = __builtin_amdgcn_mfma_f32_32x32x16_bf16(af, bfi, acc_i, 0, 0, 0);
            }
            const int col = nt * 32 + r, ch = nb * 128 + col, hh = lane >> 5;
            const float l = lam[ch], sp = (-l > 20.f) ? -l : log1pf(expf(-l)), bac = ba[ch], bic = bi[ch];
#pragma unroll
            for (int i = 0; i < 16; ++i) {
                const int lr = mt * 32 + crow(i, hh);
                const float xc = XCF[lr * 128 + col];
                const float rg = sigmoidf_(acc_a[i] + bac), ig = sigmoidf_(acc_i[i] + bic);
                const float log_a = -8.0f * rg * sp;
                AA[lr * 128 + col] = expf(log_a);
                UU[lr * 128 + col] = sqrtf(-expm1f(2.0f * log_a)) * ig * xc;
            }
        }
        __syncthreads();
        if (tid < 128) {
            const int c = tid, ch = nb * 128 + c;
            if (ck < LRU_PCHUNK) {
                float h = 0.f, P = 1.f;
#pragma unroll 8
                for (int lr = 0; lr < LRU_CH; ++lr) {
                    const float a = AA[lr * 128 + c], uu = UU[lr * 128 + c];
                    h = a * h + uu; P *= a;
                    const size_t g = (size_t)(ck * LRU_CH + lr) * DRNN + ch;
                    HL[g] = h; PP[g] = P;
                }
                SUMA[(size_t)ck * DRNN + ch] = P; SUMH[(size_t)ck * DRNN + ch] = h;
            } else {
                float h = 0.f;
#pragma unroll 8
                for (int lr = 0; lr < LRU_CH; ++lr) {
                    const int rs = (ck - LRU_PCHUNK) * LRU_CH + lr, bs = rs >> 2, tt = rs & 3;
                    if (tt == 0) h = state_rnn[(size_t)bs * DRNN + ch];
                    const float a = AA[lr * 128 + c], uu = UU[lr * 128 + c];
                    h = a * h + uu;
                    const size_t g = (size_t)(ck * LRU_CH + lr) * DRNN + ch;
                    HL[g] = h; PP[g] = 0.f;
                    if (tt == 3) out[O_HS + (size_t)bs * DRNN + ch] = h;
                }
                SUMA[(size_t)ck * DRNN + ch] = 0.f; SUMH[(size_t)ck * DRNN + ch] = 0.f;
            }
        }
        __syncthreads();
    }
}
__device__ __forceinline__ void lru_fixup_unit(const Params& p, int ck) {
    const int tid = threadIdx.x, ch = tid * 2;
    unsigned char* ws = p.ws;
    const float* Z = (const float*)(ws + WS_Z);
    const float* HL = (const float*)(ws + WS_HL); const float* PP = (const float*)(ws + WS_PP); const float* SUMA = (const float*)(ws + WS_SUMA); const float* SUMH = (const float*)(ws + WS_SUMH);
    bf16_t* CATB = (bf16_t*)(ws + WS_CATB);
    typedef float f32x2 __attribute__((ext_vector_type(2)));
    f32x2 carry = (f32x2){0.f, 0.f};
    const bool prompt = ck < LRU_PCHUNK;
    if (prompt) {
        const int b = ck / LRU_CPB, kk = ck % LRU_CPB;
#pragma unroll 4
        for (int j = 0; j < kk; ++j) {
            const f32x2 A = *(const f32x2*)(SUMA + (size_t)(b * LRU_CPB + j) * DRNN + ch), Hh = *(const f32x2*)(SUMH + (size_t)(b * LRU_CPB + j) * DRNN + ch);
            carry = A * carry + Hh;
        }
    }
#pragma unroll 4
    for (int lr = 0; lr < LRU_CH; ++lr) {
        const size_t grow = (size_t)(ck * LRU_CH + lr);
        const f32x2 hl = *(const f32x2*)(HL + grow * DRNN + ch), pp = *(const f32x2*)(PP + grow * DRNN + ch), gr = *(const f32x2*)(Z + grow * ZLD + C_GR + ch);
        const f32x2 h = hl + pp * carry;
        *(unsigned*)(CATB + grow * D + ch) = cvt_pk_bf16(h.x * gelu_tanh(gr.x), h.y * gelu_tanh(gr.y));
        if (prompt && (ck % LRU_CPB) == LRU_CPB - 1 && lr == LRU_CH - 1) *(f32x2*)(p.out + O_HP + (size_t)(ck / LRU_CPB) * DRNN + ch) = h;
    }
}


constexpr int IDX_SPLIT = 3;
constexpr int SCP_LD = 4096, SCS_LDL = 8200;
__device__ __forceinline__ unsigned fkey(float f) { const unsigned u = __float_as_uint(f); return (u & 0x80000000u) ? ~u : (u | 0x80000000u); }
__device__ __forceinline__ int mbcnt64(unsigned long long m) { return (int)__builtin_amdgcn_mbcnt_hi((unsigned)(m >> 32), __builtin_amdgcn_mbcnt_lo((unsigned)m, 0u)); }
template <int NB> __device__ __forceinline__ int wave_sum_small(unsigned c) {
    int t = 0;
#pragma unroll
    for (int b = 0; b < NB; ++b) t += __popcll(__ballot((c >> b) & 1u)) << b;
    return t;
}
__device__ __forceinline__ void split8(const f32x4 a, const f32x4 b, bf16x8& hi, bf16x8& lo) {
    u32x4 h; h.x = cvt_pk_bf16(a[0], a[1]); h.y = cvt_pk_bf16(a[2], a[3]); h.z = cvt_pk_bf16(b[0], b[1]); h.w = cvt_pk_bf16(b[2], b[3]);
    u32x4 l;
    l.x = cvt_pk_bf16(a[0] - __uint_as_float(h.x << 16), a[1] - __uint_as_float(h.x & 0xffff0000u));
    l.y = cvt_pk_bf16(a[2] - __uint_as_float(h.y << 16), a[3] - __uint_as_float(h.y & 0xffff0000u));
    l.z = cvt_pk_bf16(b[0] - __uint_as_float(h.z << 16), b[1] - __uint_as_float(h.z & 0xffff0000u));
    l.w = cvt_pk_bf16(b[2] - __uint_as_float(h.w << 16), b[3] - __uint_as_float(h.w & 0xffff0000u));
    hi = __builtin_bit_cast(bf16x8, h); lo = __builtin_bit_cast(bf16x8, l);
}
struct IdxQ { bf16x8 hi[4], lo[4]; float w[16]; };
struct IdxRaw { f32x4 v[8]; };
__device__ __forceinline__ void idx_load_q(IdxQ& q, const float* Z, int grow0, int lane) {
    const int rho = lane & 31, kh = lane >> 5, ql = 2 * ((rho >> 2) & 1) + (rho >> 4), head = 4 * ((rho >> 3) & 1) + (rho & 3);
    const float* src = Z + (size_t)(grow0 + ql) * ZLD + C_QI + head * IDD + kh * 8;
#pragma unroll
    for (int ks = 0; ks < 4; ++ks) { const f32x4 a = *(const f32x4*)(src + ks * 16), b = *(const f32x4*)(src + ks * 16 + 4); split8(a, b, q.hi[ks], q.lo[ks]); }
#pragma unroll
    for (int e = 0; e < 2; ++e) {
        const float* wsrc = Z + (size_t)(grow0 + 2 * kh + e) * ZLD + C_WI;
        const f32x4 a = *(const f32x4*)wsrc, b = *(const f32x4*)(wsrc + 4);
#pragma unroll
        for (int i = 0; i < 4; ++i) { q.w[e * 8 + i] = a[i] * IDX_W_SCALE; q.w[e * 8 + 4 + i] = b[i] * IDX_W_SCALE; }
    }
}
__device__ __forceinline__ void idx_load_raw(IdxRaw& raw, const float* kp) {
#pragma unroll
    for (int ks = 0; ks < 4; ++ks) {
        raw.v[2 * ks] = (f32x4){0.f, 0.f, 0.f, 0.f}; raw.v[2 * ks + 1] = raw.v[2 * ks];
        if (kp) { raw.v[2 * ks] = *(const f32x4*)(kp + ks * 16); raw.v[2 * ks + 1] = *(const f32x4*)(kp + ks * 16 + 4); }
    }
}
__device__ __forceinline__ void idx_cvt_key(const IdxRaw& raw, bf16x8 (&khi)[4], bf16x8 (&klo)[4]) {
#pragma unroll
    for (int ks = 0; ks < 4; ++ks) split8(raw.v[2 * ks], raw.v[2 * ks + 1], khi[ks], klo[ks]);
}
__device__ __forceinline__ void idx_tile(const IdxQ& q, const bf16x8 (&khi)[4], const bf16x8 (&klo)[4], float (&s)[2]) {
    f32x16 acc;
#pragma unroll
    for (int i = 0; i < 16; ++i) acc[i] = 0.f;
#pragma unroll
    for (int ks = 0; ks < 4; ++ks) {
        acc = __builtin_amdgcn_mfma_f32_32x32x16_bf16(q.hi[ks], khi[ks], acc, 0, 0, 0);
        if (IDX_SPLIT == 3) { acc = __builtin_amdgcn_mfma_f32_32x32x16_bf16(q.hi[ks], klo[ks], acc, 0, 0, 0); acc = __builtin_amdgcn_mfma_f32_32x32x16_bf16(q.lo[ks], khi[ks], acc, 0, 0, 0); }
    }
#pragma unroll
    for (int e = 0; e < 2; ++e) {
        float t = 0.f;
#pragma unroll
        for (int i = 0; i < 8; ++i) t += fmaxf(acc[e * 8 + i] * IDX_SCALE, 0.f) * q.w[e * 8 + i];
        s[e] = t;
    }
}
template <int NJ>
__device__ __forceinline__ void select_row(const PG8_LAS float* sc, int n, int lane, unsigned long long* bm_row) {
    constexpr int NG = (NJ + 7) / 8;
    unsigned v[NJ];
    const int nj = (n + 63) >> 6, ng = (nj + 7) >> 3;
    const PG8_LAS float* pl = sc + lane;
#pragma unroll
    for (int j = 0; j < NJ; ++j) { const unsigned k = fkey(pl[j * 64]); v[j] = (lane < n - j * 64) ? k : 0u; }
    unsigned T = 1u; int need = 1 << 30;
    if (n > TOPK) {
        unsigned prefix = 0u; bool exact = false;
        for (int bit = 31; bit >= 0; --bit) {
            const unsigned cand = prefix | (1u << bit);
            unsigned c = 0u;
#pragma unroll
            for (int g = 0; g < NG; ++g) if (g < ng) {
#pragma unroll
                for (int jj = 0; jj < 8; ++jj) if (g * 8 + jj < NJ) c += (v[g * 8 + jj] >= cand) ? 1u : 0u;
            }
            const int cnt = wave_sum_small<7>(c);
            if (cnt >= TOPK) prefix = cand;
            if (cnt == TOPK) { exact = true; break; }
        }
        T = prefix;
        if (!exact) {
            unsigned c = 0u;
#pragma unroll
            for (int g = 0; g < NG; ++g) if (g < ng) {
#pragma unroll
                for (int jj = 0; jj < 8; ++jj) if (g * 8 + jj < NJ) c += (v[g * 8 + jj] > T) ? 1u : 0u;
            }
            need = TOPK - wave_sum_small<7>(c);
        }
    }
    int base_eq = 0; unsigned long long mymask = 0ull;
#pragma unroll
    for (int j = 0; j < NJ; ++j) if (j < nj) {
        const bool gt = v[j] > T, eq = v[j] == T;
        const unsigned long long eqm = __ballot(eq);
        const bool s = gt || (eq && (base_eq + mbcnt64(eqm)) < need);
        const unsigned long long sm = __ballot(s);
        base_eq += __popcll(eqm);
        if (lane == j) mymask = sm;
    }
    bm_row[lane] = mymask;
}
__device__ __forceinline__ void select_row_wg(const PG8_LAS float* sc, int n, PG8_LAS int* sel, volatile PG8_LAS int* red) {
    constexpr int NC = 17;
    const int lane = threadIdx.x & 63, wave = __builtin_amdgcn_readfirstlane(threadIdx.x >> 6);
    unsigned v[NC];
    const PG8_LAS float* pl = sc + wave * NC * 64 + lane;
    const int nrem = n - wave * NC * 64;
#pragma unroll
    for (int j = 0; j < NC; ++j) { const unsigned k = fkey(pl[j * 64]); v[j] = (lane < nrem - j * 64) ? k : 0u; }
    unsigned prefix = 0u; bool exact = false; int it = 0;
    for (int bit = 31; bit >= 0; --bit, ++it) {
        const unsigned cand = prefix | (1u << bit);
        unsigned c = 0u;
#pragma unroll
        for (int j = 0; j < NC; ++j) c += (v[j] >= cand) ? 1u : 0u;
        const int wc = wave_sum_small<5>(c);
        if (lane == 0) red[(it & 1) * 8 + wave] = wc;
        __syncthreads();
        int cnt = 0;
#pragma unroll
        for (int w = 0; w < 8; ++w) cnt += red[(it & 1) * 8 + w];
        if (cnt >= TOPK) prefix = cand;
        if (cnt == TOPK) { exact = true; break; }
    }
    const unsigned T = prefix;
    unsigned cg = 0u, ce = 0u;
#pragma unroll
    for (int j = 0; j < NC; ++j) { cg += (v[j] > T) ? 1u : 0u; ce += (v[j] == T) ? 1u : 0u; }
    const int wg_ = wave_sum_small<5>(cg), we_ = wave_sum_small<5>(ce);
    __syncthreads();
    if (lane == 0) { red[16 + wave] = wg_; red[24 + wave] = we_; }
    __syncthreads();
    int tot_gt = 0, eq_before = 0, gt_before = 0;
#pragma unroll
    for (int w = 0; w < 8; ++w) { const int g = red[16 + w], e = red[24 + w]; tot_gt += g; if (w < wave) { gt_before += g; eq_before += e; } }
    const int need = exact ? (1 << 30) : TOPK - tot_gt;
    int base_sel = gt_before + (eq_before < need ? eq_before : need), base_eq = eq_before;
    int ln = lane; asm volatile("" : "+v"(ln));
#pragma unroll
    for (int j = 0; j < NC; ++j) {
        const bool gt = v[j] > T, eq = v[j] == T;
        const unsigned long long eqm = __ballot(eq);
        const bool s = gt || (eq && (base_eq + mbcnt64(eqm)) < need);
        const unsigned long long sm = __ballot(s);
        if (s) sel[base_sel + mbcnt64(sm)] = (wave * NC + j) * 64 + ln;
        base_eq += __popcll(eqm); base_sel += __popcll(sm);
    }
    __syncthreads();
}
__device__ __forceinline__ void idx_sample_score_unit(const Params& p, int bs, int pg8) {
    const int lane = threadIdx.x & 63, wave = __builtin_amdgcn_readfirstlane(threadIdx.x >> 6), r = lane & 31, kh = lane >> 5;
    const float* Z = (const float*)(p.ws + WS_Z); float* SCS = (float*)(p.ws + WS_SCS);
    const float* cache_ki = p.in[4]; const int* page_table = (const int*)p.in[7];
    IdxQ q; idx_load_q(q, Z, MP + bs * DS, lane);
    const int pg = pg8 * 8 + wave, phys = page_table[bs * NPAGES + pg];
    const float* pbase = cache_ki + (size_t)phys * PAGE * IDD + (size_t)r * IDD + kh * 8;
    float* out0 = SCS + (size_t)(bs * DS + 2 * kh) * SCS_LD;
    IdxRaw raw; idx_load_raw(raw, pbase);
    bf16x8 khi[4], klo[4];
#pragma unroll
    for (int tt = 0; tt < 4; ++tt) {
        idx_cvt_key(raw, khi, klo);
        if (tt < 3) idx_load_raw(raw, pbase + (size_t)(tt + 1) * 32 * IDD);
        float s[2]; idx_tile(q, khi, klo, s);
        const int col = pg * PAGE + tt * 32 + r;
        out0[col] = s[0]; out0[SCS_LD + col] = s[1];
    }
    if (pg8 == 0 && wave == 0) {
        idx_load_raw(raw, r < DS ? Z + (size_t)(MP + bs * DS + r) * ZLD + C_KI + kh * 8 : nullptr);
        idx_cvt_key(raw, khi, klo);
        float s[2]; idx_tile(q, khi, klo, s);
        if (r < DS) { out0[NPAST + r] = s[0]; out0[SCS_LD + NPAST + r] = s[1]; }
    }
}
__device__ __forceinline__ void idx_prompt_unit(const Params& p, PG8_LAS unsigned char* lds, int s) {
    const int lane = threadIdx.x & 63, wave = __builtin_amdgcn_readfirstlane(threadIdx.x >> 6), r = lane & 31, kh = lane >> 5;
    const float* Z = (const float*)(p.ws + WS_Z); unsigned long long* BM = (unsigned long long*)(p.ws + WS_BM);
    PG8_LAS float* sc = (PG8_LAS float*)lds;
    const int b = s & 1, q0 = (s >> 1) * 8, grow0 = b * SEQ + q0, ntile = (q0 + 8 + 31) >> 5;
    IdxQ qa, qb; idx_load_q(qa, Z, grow0, lane); idx_load_q(qb, Z, grow0 + 4, lane);
    const float* kbase = Z + (size_t)(b * SEQ + r) * ZLD + C_KI + kh * 8;
    IdxRaw raw;
    if (wave < ntile) idx_load_raw(raw, kbase + (size_t)wave * 32 * ZLD);
    bf16x8 khi[4], klo[4];
    for (int t = wave; t < ntile; t += NWAVES) {
        idx_cvt_key(raw, khi, klo);
        if (t + NWAVES < ntile) idx_load_raw(raw, kbase + (size_t)(t + NWAVES) * 32 * ZLD);
        float sa[2], sb[2]; idx_tile(qa, khi, klo, sa); idx_tile(qb, khi, klo, sb);
        const int col = t * 32 + r;
        sc[(2 * kh) * SCP_LD + col] = sa[0]; sc[(2 * kh + 1) * SCP_LD + col] = sa[1];
        sc[(4 + 2 * kh) * SCP_LD + col] = sb[0]; sc[(5 + 2 * kh) * SCP_LD + col] = sb[1];
    }
    __syncthreads();
    select_row<64>(sc + wave * SCP_LD, q0 + wave + 1, lane, BM + (size_t)(grow0 + wave) * 64);
}
__device__ __forceinline__ void copy_kv_phase(const Params& p) {
    const float* Z = (const float*)(p.ws + WS_Z); float* out = p.out;
    bf16_t* QBb = (bf16_t*)(p.ws + WS_QB); bf16_t* KBb = (bf16_t*)(p.ws + WS_KB); bf16_t* VBb = (bf16_t*)(p.ws + WS_VB);
    for (size_t i = (size_t)blockIdx.x * NTHREADS + threadIdx.x; i < (size_t)MP * 512; i += (size_t)gridDim.x * NTHREADS) {
        const int row = (int)(i >> 9), c4 = (int)(i & 511);
        const f32x4 v = *(const f32x4*)(Z + (size_t)row * ZLD + C_Q + c4 * 4);
        u32x2 w; w.x = cvt_pk_bf16(v[0], v[1]); w.y = cvt_pk_bf16(v[2], v[3]);
        if (c4 < 256) *(u32x2*)(QBb + (size_t)row * 1024 + c4 * 4) = w;
        else if (c4 < 384) *(u32x2*)(KBb + (size_t)row * 512 + (c4 - 256) * 4) = w;
        else *(u32x2*)(VBb + (size_t)row * 512 + (c4 - 384) * 4) = w;
    }
    for (size_t i = (size_t)blockIdx.x * NTHREADS + threadIdx.x; i < (size_t)MT * 272; i += (size_t)gridDim.x * NTHREADS) {
        const int row = (int)(i / 272), c4 = (int)(i % 272);
        const float* z = Z + (size_t)row * ZLD;
        const bool pr = row < MP; const int rr = pr ? row : row - MP;
        if (c4 < 128) *(f32x4*)(out + (pr ? O_KP : O_KS) + (size_t)rr * 512 + c4 * 4) = *(const f32x4*)(z + C_K + c4 * 4);
        else if (c4 < 256) *(f32x4*)(out + (pr ? O_VP : O_VS) + (size_t)rr * 512 + (c4 - 128) * 4) = *(const f32x4*)(z + C_V + (c4 - 128) * 4);
        else *(f32x4*)(out + (pr ? O_KIP : O_KIS) + (size_t)rr * 64 + (c4 - 256) * 4) = *(const f32x4*)(z + C_KI + (c4 - 256) * 4);
    }
}
__device__ __forceinline__ unsigned wq_next(unsigned* ctr, PG8_LAS unsigned char* lds) {
    volatile PG8_LAS unsigned* slot = (volatile PG8_LAS unsigned*)(lds + LDS_MISC + 64);
    __syncthreads();
    if (threadIdx.x == 0) *slot = atomicAdd(ctr, 1u);
    __syncthreads();
    return *slot;
}

constexpr int G_SC = 0, G_SEL = 32800, G_RED = 33824, G_QS = 34304, G_PS = 38400, G_KP = 46592, G_VP = 48640, G_OP = 50688;
__device__ __forceinline__ void sample_row_unit(const Params& p, PG8_LAS unsigned char* lds, int rs) {
    const int tid = threadIdx.x, lane = tid & 63, wave = tid >> 6;
    unsigned char* ws = p.ws;
    const float* Z = (const float*)(ws + WS_Z); const float* SCS = (const float*)(ws + WS_SCS);
    const float* cache_k = p.in[2]; const float* cache_v = p.in[3]; const int* page_table = (const int*)p.in[7];
    bf16_t* CATB = (bf16_t*)(ws + WS_CATB);
    const int row = MP + rs, b = rs / DS, n = NPAST + (rs % DS) + 1;
    PG8_LAS float* sc = (PG8_LAS float*)(lds + G_SC);
    PG8_LAS int* sel = (PG8_LAS int*)(lds + G_SEL);
    PG8_LAS float* qs = (PG8_LAS float*)(lds + G_QS);
    PG8_LAS float* ps = (PG8_LAS float*)(lds + G_PS);
    PG8_LAS unsigned long long* kps = (PG8_LAS unsigned long long*)(lds + G_KP);
    PG8_LAS unsigned long long* vps = (PG8_LAS unsigned long long*)(lds + G_VP);
    PG8_LAS float* op = (PG8_LAS float*)(lds + G_OP);
    for (int e = tid; e < SCS_LDL; e += NTHREADS) sc[e] = SCS[(size_t)rs * SCS_LD + e];
    { const float* z = Z + (size_t)row * ZLD; qs[tid] = z[C_Q + tid]; qs[tid + 512] = z[C_Q + 512 + tid]; }
    __syncthreads();
    select_row_wg(sc, n, sel, (volatile PG8_LAS int*)(lds + G_RED));
    if (tid < TOPK) {
        const int idx = sel[tid];
        const float* kp; const float* vp;
        if (idx < NPAST) { const size_t prow = (size_t)page_table[b * NPAGES + idx / PAGE] * PAGE + (idx % PAGE); kp = cache_k + prow * 512; vp = cache_v + prow * 512; }
        else { const size_t zr = (size_t)(MP + b * DS + idx - NPAST); kp = Z + zr * ZLD + C_K; vp = Z + zr * ZLD + C_V; }
        kps[tid] = (unsigned long long)kp; vps[tid] = (unsigned long long)vp;
    }
    __syncthreads();
    {
        const int j = tid & 255, hg = tid >> 8;
        const float* kp = (const float*)kps[j] + hg * 256;
#pragma unroll
        for (int n2 = 0; n2 < 2; ++n2) {
            float d0 = 0.f, d1 = 0.f;
            const PG8_LAS float* q0 = qs + (4 * hg + 2 * n2) * HD; const PG8_LAS float* q1 = q0 + HD;
#pragma unroll 8
            for (int d = 0; d < HD; d += 4) {
                const f32x4 k4 = *(const f32x4*)(kp + n2 * HD + d);
                d0 += q0[d] * k4[0] + q0[d + 1] * k4[1] + q0[d + 2] * k4[2] + q0[d + 3] * k4[3];
                d1 += q1[d] * k4[0] + q1[d + 1] * k4[1] + q1[d + 2] * k4[2] + q1[d + 3] * k4[3];
            }
            ps[(4 * hg + 2 * n2) * TOPK + j] = d0 * ATTN_SCALE; ps[(4 * hg + 2 * n2 + 1) * TOPK + j] = d1 * ATTN_SCALE;
        }
    }
    __syncthreads();
    {
        float v[4]; float m = -INFINITY;
#pragma unroll
        for (int i = 0; i < 4; ++i) { v[i] = ps[wave * TOPK + lane + 64 * i]; m = fmaxf(m, v[i]); }
#pragma unroll
        for (int o = 32; o >= 1; o >>= 1) m = fmaxf(m, __shfl_xor(m, o));
        float sum = 0.f;
#pragma unroll
        for (int i = 0; i < 4; ++i) { v[i] = expf(v[i] - m); sum += v[i]; }
#pragma unroll
        for (int o = 32; o >= 1; o >>= 1) sum += __shfl_xor(sum, o);
        const float inv = 1.0f / sum;
#pragma unroll
        for (int i = 0; i < 4; ++i) ps[wave * TOPK + lane + 64 * i] = v[i] * inv;
    }
    __syncthreads();
    {
        const int o4 = tid & 255, kq = tid >> 8, hq = o4 >> 5, d = (o4 & 31) * 4, nkv = hq >> 1;
        f32x4 acc = (f32x4){0.f, 0.f, 0.f, 0.f};
#pragma unroll 8
        for (int j = kq * 128; j < kq * 128 + 128; ++j) acc += *(const f32x4*)((const float*)vps[j] + nkv * HD + d) * ps[hq * TOPK + j];
        if (kq == 1) *(PG8_LAS f32x4*)(op + o4 * 4) = acc;
        __syncthreads();
        if (kq == 0) {
            acc += *(const PG8_LAS f32x4*)(op + o4 * 4);
            u32x2 w; w.x = cvt_pk_bf16(acc[0], acc[1]); w.y = cvt_pk_bf16(acc[2], acc[3]);
            *(u32x2*)(CATB + (size_t)row * D + 1024 + o4 * 4) = w;
        }
    }
    __syncthreads();
}

typedef short s16x4 __attribute__((ext_vector_type(4)));
constexpr int A_KP = 272, A_VP = 320, A_KBYTES = 64 * A_KP, A_VBYTES = 64 * A_VP, A_STAGE = A_KBYTES + A_VBYTES;
constexpr float A_SC = 0.08838834764831845f * 1.4426950408889634f;
__device__ __forceinline__ float xhalf_max(float x) { const auto sw = __builtin_amdgcn_permlane32_swap(__float_as_uint(x), __float_as_uint(x), false, false); return fmaxf(__uint_as_float(sw[0]), __uint_as_float(sw[1])); }
__device__ __forceinline__ float xhalf_sum(float x) { const auto sw = __builtin_amdgcn_permlane32_swap(__float_as_uint(x), __float_as_uint(x), false, false); return __uint_as_float(sw[0]) + __uint_as_float(sw[1]); }
__device__ __forceinline__ void attn_dense_unit(const Params& p, PG8_LAS unsigned char* lds, int b, int n, int qb) {
    const int tid = threadIdx.x, lane = tid & 63, wave = __builtin_amdgcn_readfirstlane(tid >> 6), r = lane & 31, kh = lane >> 5;
    unsigned char* ws = p.ws;
    const bf16_t* QB = (const bf16_t*)(ws + WS_QB); const bf16_t* KB = (const bf16_t*)(ws + WS_KB); const bf16_t* VB = (const bf16_t*)(ws + WS_VB);
    const unsigned long long* BM = (const unsigned long long*)(ws + WS_BM);
    bf16_t* CATB = (bf16_t*)(ws + WS_CATB);
    const int q = qb * 128 + wave * 16 + (r & 15), head = 2 * n + (r >> 4);
    const size_t qrow = (size_t)b * SEQ + q;
    bf16x8 qf[8];
#pragma unroll
    for (int ks = 0; ks < 8; ++ks) qf[ks] = *(const bf16x8*)(QB + qrow * 1024 + head * HD + ks * 16 + kh * 8);
    f32x16 O[4];
#pragma unroll
    for (int dt = 0; dt < 4; ++dt)
#pragma unroll
        for (int i = 0; i < 16; ++i) O[dt][i] = 0.f;
    float m = -INFINITY, l = 0.f;
    const int ntile = 2 * qb + 2, qmax_w = qb * 128 + wave * 16 + 15;
    const int srow = tid >> 4, sch = tid & 15;
    const bf16_t* kg = KB + ((size_t)b * SEQ + srow) * 512 + n * HD + sch * 8;
    const bf16_t* vg = VB + ((size_t)b * SEQ + srow) * 512 + n * HD + sch * 8;
    u32x4 kst[2], vst[2];
#define A_GLOAD(t) do { _Pragma("unroll") for (int _i = 0; _i < 2; ++_i) { kst[_i] = *(const u32x4*)(kg + (size_t)((t) * 64 + _i * 32) * 512); vst[_i] = *(const u32x4*)(vg + (size_t)((t) * 64 + _i * 32) * 512); } } while (0)
#define A_LSTORE(buf) do { _Pragma("unroll") for (int _i = 0; _i < 2; ++_i) { *(PG8_LAS u32x4*)(lds + (buf) * A_STAGE + (srow + _i * 32) * A_KP + sch * 16) = kst[_i]; \
        *(PG8_LAS u32x4*)(lds + (buf) * A_STAGE + A_KBYTES + (srow + _i * 32) * A_VP + sch * 16) = vst[_i]; } } while (0)
    A_GLOAD(0); A_LSTORE(0);
    unsigned long long mw = BM[qrow * 64];
    __syncthreads();
    const int i16 = lane & 15, g2 = (lane >> 4) & 1;
    const int vlane_off = (4 * kh + (i16 >> 2)) * A_VP + (16 * g2 + 4 * (i16 & 3)) * 2;
    for (int t = 0; t < ntile; ++t) {
        const bool more = (t + 1 < ntile);
        if (more) A_GLOAD(t + 1);
        const unsigned long long mw_next = more ? BM[qrow * 64 + t + 1] : 0ull;
        const int buf = t & 1;
        if (t * 64 <= qmax_w) {
            PG8_LAS unsigned char* kb = lds + buf * A_STAGE; PG8_LAS unsigned char* vb = kb + A_KBYTES;
            f32x16 s0, s1;
#pragma unroll
            for (int i = 0; i < 16; ++i) { s0[i] = 0.f; s1[i] = 0.f; }
#pragma unroll
            for (int ks = 0; ks < 8; ++ks) {
                const bf16x8 k0 = *(const PG8_LAS bf16x8*)(kb + r * A_KP + (ks * 16 + kh * 8) * 2);
                const bf16x8 k1 = *(const PG8_LAS bf16x8*)(kb + (32 + r) * A_KP + (ks * 16 + kh * 8) * 2);
                s0 = __builtin_amdgcn_mfma_f32_32x32x16_bf16(k0, qf[ks], s0, 0, 0, 0);
                s1 = __builtin_amdgcn_mfma_f32_32x32x16_bf16(k1, qf[ks], s1, 0, 0, 0);
            }
            const unsigned lo = (unsigned)mw >> (4 * kh), hi = (unsigned)(mw >> 32) >> (4 * kh);
            float mx = -INFINITY;
#pragma unroll
            for (int i = 0; i < 16; ++i) {
                const unsigned bit = 1u << ((i & 3) + 8 * (i >> 2));
                s0[i] = (lo & bit) ? s0[i] * A_SC : -INFINITY; s1[i] = (hi & bit) ? s1[i] * A_SC : -INFINITY;
                mx = fmaxf(mx, fmaxf(s0[i], s1[i]));
            }
            mx = xhalf_max(mx);
            const float m_new = fmaxf(m, mx), m_safe = (m_new == -INFINITY) ? 0.f : m_new;
            const float alpha = __builtin_amdgcn_exp2f(m - m_safe);
            float lsum = 0.f;
#pragma unroll
            for (int i = 0; i < 16; ++i) { s0[i] = __builtin_amdgcn_exp2f(s0[i] - m_safe); s1[i] = __builtin_amdgcn_exp2f(s1[i] - m_safe); lsum += s0[i] + s1[i]; }
            l = l * alpha + lsum; m = m_new;
            if (__ballot(alpha != 1.0f) != 0ull) {
#pragma unroll
                for (int dt = 0; dt < 4; ++dt)
#pragma unroll
                    for (int i = 0; i < 16; ++i) O[dt][i] *= alpha;
            }
            bf16x8 pf[2][2];
#pragma unroll
            for (int sx = 0; sx < 2; ++sx) {
                u32x4 w0, w1;
                w0.x = cvt_pk_bf16(s0[8 * sx], s0[8 * sx + 1]); w0.y = cvt_pk_bf16(s0[8 * sx + 2], s0[8 * sx + 3]); w0.z = cvt_pk_bf16(s0[8 * sx + 4], s0[8 * sx + 5]); w0.w = cvt_pk_bf16(s0[8 * sx + 6], s0[8 * sx + 7]);
                w1.x = cvt_pk_bf16(s1[8 * sx], s1[8 * sx + 1]); w1.y = cvt_pk_bf16(s1[8 * sx + 2], s1[8 * sx + 3]); w1.z = cvt_pk_bf16(s1[8 * sx + 4], s1[8 * sx + 5]); w1.w = cvt_pk_bf16(s1[8 * sx + 6], s1[8 * sx + 7]);
                pf[0][sx] = __builtin_bit_cast(bf16x8, w0); pf[1][sx] = __builtin_bit_cast(bf16x8, w1);
            }
#pragma unroll
            for (int st = 0; st < 2; ++st)
#pragma unroll
                for (int sx = 0; sx < 2; ++sx)
#pragma unroll
                    for (int dt = 0; dt < 4; ++dt) {
                        PG8_LAS unsigned char* a = vb + vlane_off + (st * 32 + 16 * sx) * A_VP + dt * 64;
                        const s16x4 vlo = __builtin_amdgcn_ds_read_tr16_b64_v4i16((PG8_LAS s16x4*)a);
                        const s16x4 vhi = __builtin_amdgcn_ds_read_tr16_b64_v4i16((PG8_LAS s16x4*)(a + 8 * A_VP));
                        const bf16x8 vf = __builtin_shufflevector(vlo, vhi, 0, 1, 2, 3, 4, 5, 6, 7);
                        O[dt] = __builtin_amdgcn_mfma_f32_32x32x16_bf16(vf, pf[st][sx], O[dt], 0, 0, 0);
                    }
        }
        if (more) A_LSTORE(buf ^ 1);
        __syncthreads();
        mw = mw_next;
    }
#undef A_GLOAD
#undef A_LSTORE
    const float inv = 1.0f / xhalf_sum(l);
    bf16_t* orow = CATB + qrow * D + 1024 + head * HD;
#pragma unroll
    for (int dt = 0; dt < 4; ++dt)
#pragma unroll
        for (int a = 0; a < 4; ++a) {
            u32x2 w; w.x = cvt_pk_bf16(O[dt][4 * a] * inv, O[dt][4 * a + 1] * inv); w.y = cvt_pk_bf16(O[dt][4 * a + 2] * inv, O[dt][4 * a + 3] * inv);
            *(u32x2*)(orow + 32 * dt + 8 * a + 4 * kh) = w;
        }
}
__device__ __forceinline__ void attn_phase(const Params& p, PG8_LAS unsigned char* lds) {
    const int G = gridDim.x;
    for (int u = blockIdx.x; u < 256; u += G) { const int qb = 31 - (u >> 3), bn = u & 7; attn_dense_unit(p, lds, bn >> 2, bn & 3, qb); }
    unsigned* ctr = (unsigned*)(p.ws + WS_CTR);
    for (;;) {
        const unsigned idx = wq_next(ctr, lds);
        if (idx >= (unsigned)(MS + LRU_NCHUNK)) break;
        if (idx < (unsigned)MS) sample_row_unit(p, lds, (int)idx); else lru_fixup_unit(p, (int)idx - MS);
    }
}
__device__ __forceinline__ void mid1_phase(const Params& p, PG8_LAS unsigned char* lds) {
    unsigned* ctr = (unsigned*)(p.ws + WS_CTR) + 64;
    constexpr unsigned NA = DB * 8, NB_ = MP / 8, NC_ = LRU_NCHUNK * 8;
    for (;;) {
        const unsigned idx = wq_next(ctr, lds);
        if (idx >= NA + NB_ + NC_) break;
        if (idx < NA) idx_sample_score_unit(p, (int)(idx >> 3), (int)(idx & 7));
        else if (idx < NA + NB_) idx_prompt_unit(p, lds, (int)(NB_ - 1 - (idx - NA)));
        else lru_local_unit(p, lds, (int)(idx - NA - NB_));
    }
    copy_kv_phase(p);
}

__device__ __forceinline__ void prep_phase(const Params& p, PG8_LAS unsigned char* lds) {
    unsigned char* ws = p.ws;
    bf16_t* Wgu1 = (bf16_t*)(ws + WS_WGU1); bf16_t* Wd1 = (bf16_t*)(ws + WS_WD1); bf16_t* Win = (bf16_t*)(ws + WS_WIN); bf16_t* Wout = (bf16_t*)(ws + WS_WOUT);
    bf16_t* Wgu2 = (bf16_t*)(ws + WS_WGU2); bf16_t* Wd2 = (bf16_t*)(ws + WS_WD2); bf16_t* XB = (bf16_t*)(ws + WS_XB);
        PG8_LAS float* tile = (PG8_LAS float*)lds;
        transpose_cvt<1>(p.in[10], D, 2 * DFF, 2 * DFF, Wgu1, tile);
        transpose_cvt<0>(p.in[11], DFF, D, D, Wd1, tile);
        transpose_cvt<0>(p.in[12], D, DIN, DINP, Win, tile);
        transpose_cvt<0>(p.in[20], D, D, D, Wout, tile);
        transpose_cvt<1>(p.in[23], D, 2 * DFF, 2 * DFF, Wgu2, tile);
        transpose_cvt<0>(p.in[24], DFF, D, D, Wd2, tile);
        cvt_x(p.in[0], p.in[1], XB);
        for (int n = 0; n < 8; ++n) { transpose_cvt<0>(p.in[15] + n * 16384, 128, 128, 128, (bf16_t*)(ws + WS_WAT) + n * 16384, tile); transpose_cvt<0>(p.in[17] + n * 16384, 128, 128, 128, (bf16_t*)(ws + WS_WIT) + n * 16384, tile); }
    }

__global__ void __launch_bounds__(NTHREADS, 2) mk_fwd(Params p) {
    extern __shared__ __attribute__((aligned(16))) unsigned char lds_raw[];
    PG8_LAS unsigned char* lds = (PG8_LAS unsigned char*)lds_raw;
    unsigned char* ws = p.ws;
    const int lo = p.ph_lo, hi = p.ph_hi;
    const int G = gridDim.x;
    if (threadIdx.x < 4) ((volatile PG8_LAS unsigned*)(lds + LDS_MISC))[threadIdx.x] = 0u;
    __syncthreads();
    XcdBarrier bar = xcd_barrier_post((unsigned*)(ws + WS_CTL) + (size_t)p.li * XCD_BAR_WORDS, (volatile LAS unsigned*)(lds + LDS_MISC));
#define SEAM(k) do { if (lo <= (k) && (k) + 1 < hi) xcd_barrier(bar); } while (0)
    bf16_t* Wgu1 = (bf16_t*)(ws + WS_WGU1); bf16_t* Wd1 = (bf16_t*)(ws + WS_WD1); bf16_t* Win = (bf16_t*)(ws + WS_WIN); bf16_t* Wout = (bf16_t*)(ws + WS_WOUT);
    bf16_t* Wgu2 = (bf16_t*)(ws + WS_WGU2); bf16_t* Wd2 = (bf16_t*)(ws + WS_WD2);
    bf16_t* XB = (bf16_t*)(ws + WS_XB); bf16_t* H = (bf16_t*)(ws + WS_H); float* T = (float*)(ws + WS_T); float* X1 = (float*)(ws + WS_X1); float* X2 = (float*)(ws + WS_X2);
    float* Z = (float*)(ws + WS_Z); bf16_t* CATB = (bf16_t*)(ws + WS_CATB);
#define IN(k) (lo <= (k) && (k) < hi)
    if (IN(0)) { prep_phase(p, lds); if (REP_T > 1) { __syncthreads(); prep_phase(p, lds); } }
    SEAM(0);
    if (IN(1)) {
        pg8::Gemm g{XB, Wgu1, MPAD, 2 * DFF, D}; pg8::StaticOrder S; S.init(MPAD, 2 * DFF, G, (int)blockIdx.x);
        EpiSwiGLU E{H};
        pg8::gemm_phase<EpiSwiGLU, pg8::StaticOrder, true, true>(lds, g, S, E); if (REP_G > 1) { pg8::gemm_phase<EpiSwiGLU, pg8::StaticOrder, true, true>(lds, g, S, E); }
    }
    SEAM(1);
    if (IN(2)) {
        pg8::Gemm g{H, Wd1, MPAD, D, DFF}; pg8::StaticOrder S; S.init(MPAD, D, G, (int)blockIdx.x);
        EpiResid E{p.in[0], p.in[1], T, 0.5f};
        pg8::gemm_phase<EpiResid, pg8::StaticOrder, true, true>(lds, g, S, E); if (REP_G > 1) { pg8::gemm_phase<EpiResid, pg8::StaticOrder, true, true>(lds, g, S, E); }
    }
    SEAM(2);
    if (IN(3)) { ln_phase(T, p.in[8], p.in[9], X1, XB); if (REP_T > 1) ln_phase(T, p.in[8], p.in[9], X1, XB); }
    SEAM(3);
    if (IN(4)) {
        pg8::Gemm g{XB, Win, MPAD, DINP, D}; pg8::StaticOrder S; S.init(MPAD, DINP, G, (int)blockIdx.x);
        EpiF32 E{Z, ZLD};
        pg8::gemm_phase<EpiF32, pg8::StaticOrder, true, true>(lds, g, S, E); if (REP_G > 1) { pg8::gemm_phase<EpiF32, pg8::StaticOrder, true, true>(lds, g, S, E); }
    }
    SEAM(4);
    if (IN(5)) mid1_phase(p, lds);
    SEAM(5);
    if (IN(6)) attn_phase(p, lds);
    SEAM(6);
    if (IN(7)) {
        pg8::Gemm g{CATB, Wout, MPAD, D, D}; pg8::StaticOrder S; S.init(MPAD, D, G, (int)blockIdx.x);
        EpiResid E{X1, X1 + (size_t)MP * D, T, 1.0f};
        pg8::gemm_phase<EpiResid, pg8::StaticOrder, true, true>(lds, g, S, E); if (REP_G > 1) { pg8::gemm_phase<EpiResid, pg8::StaticOrder, true, true>(lds, g, S, E); }
    }
    SEAM(7);
    if (IN(8)) { ln_phase(T, p.in[21], p.in[22], X2, XB); if (REP_T > 1) ln_phase(T, p.in[21], p.in[22], X2, XB); }
    SEAM(8);
    if (IN(9)) {
        pg8::Gemm g{XB, Wgu2, MPAD, 2 * DFF, D}; pg8::StaticOrder S; S.init(MPAD, 2 * DFF, G, (int)blockIdx.x);
        EpiSwiGLU E{H};
        pg8::gemm_phase<EpiSwiGLU, pg8::StaticOrder, true, true>(lds, g, S, E); if (REP_G > 1) { pg8::gemm_phase<EpiSwiGLU, pg8::StaticOrder, true, true>(lds, g, S, E); }
    }
    SEAM(9);
    if (IN(10)) {
        pg8::Gemm g{H, Wd2, MPAD, D, DFF}; pg8::StaticOrder S; S.init(MPAD, D, G, (int)blockIdx.x);
        EpiResid E{X2, X2 + (size_t)MP * D, T, 0.5f};
        pg8::gemm_phase<EpiResid, pg8::StaticOrder, true, true>(lds, g, S, E); if (REP_G > 1) { pg8::gemm_phase<EpiResid, pg8::StaticOrder, true, true>(lds, g, S, E); }
    }
    SEAM(10);
    if (IN(11)) { ln_phase(T, p.in[25], p.in[26], p.out + O_YP, nullptr); if (REP_T > 1) ln_phase(T, p.in[25], p.in[26], p.out + O_YP, nullptr); }
#undef IN
#undef SEAM
}

}

extern "C" void kernel_launch(void* const* d_in, const int* in_sizes, int n_in, void* d_out, int out_size, void* d_ws, size_t ws_size, hipStream_t stream) {
    static int grid = 0;
    if (grid == 0) {
        if (n_in != 27 || ws_size < WS_END) { grid = -1; return; }
        int dev = 0, cus = 0;
        if (hipGetDevice(&dev) != hipSuccess || hipDeviceGetAttribute(&cus, hipDeviceAttributeMultiprocessorCount, dev) != hipSuccess) { grid = -1; return; }
        if (hipFuncSetAttribute((const void*)mk_fwd, hipFuncAttributeMaxDynamicSharedMemorySize, LDS_BYTES) != hipSuccess) { grid = -1; return; }
        (void)hipGetLastError();
        grid = cus;
    }
    if (grid < 0) return;
    float* out = (float*)d_out;
    unsigned char* ws = (unsigned char*)d_ws;

    (void)hipMemsetAsync(ws + WS_CTL, 0, CTL_BYTES, stream);
    Params p{};
    for (int i = 0; i < 27; ++i) p.in[i] = (const float*)d_in[i];
    p.out = out; p.ws = ws;
    int nli = 0;
    auto run = [&](int lo, int hi) { p.ph_lo = lo; p.ph_hi = hi; p.li = nli++; hipLaunchKernelGGL(mk_fwd, dim3(grid), dim3(NTHREADS), LDS_BYTES, stream, p); };
    run(0, 12);
}
```

```cpp
#include <hip/hip_runtime.h>
#include <stdint.h>

namespace pg8 {
#define PG8_LAS __attribute__((address_space(3)))
typedef unsigned short bf16_t;
typedef short bf16x8 __attribute__((ext_vector_type(8)));
typedef float f32x4 __attribute__((ext_vector_type(4)));
typedef unsigned u32x4 __attribute__((ext_vector_type(4)));
constexpr int BM = 256, BK = 64, HALF = 128, HTB = HALF * BK * 2  , STAGE_BYTES = 8 * HTB, NXCD = 8, WGM = 8;

__host__ __device__ __forceinline__ int lds_byte(int r, int c) { const int st = (r >> 4) * 2 + (c >> 5), rr = r & 15, cc = c & 31, ob = rr * 64 + cc * 2; return st * 1024 + (ob ^ (((ob >> 9) & 1) << 5)); }
__host__ __device__ __forceinline__ void stage_rc(int b, int& R, int& C) { const int st = b / 1024, sb = b % 1024, swz = sb ^ (((sb >> 9) & 1) << 5); R = (st >> 1) * 16 + swz / 64; C = (st & 1) * 32 + (swz % 64) / 2; }
__host__ __device__ __forceinline__ int perm32(int rho) { const int n = rho >> 4, i = rho & 15; return 8 * (i >> 2) + 4 * n + (i & 3); }

struct Unit { int pm, pn, k0, nt, aux; };
struct Gemm { const bf16_t* A; const bf16_t* Bt; int M, N, K; };

struct StaticOrder {
    int nM, nN, nwg, G, c, ntk;
    __host__ __device__ __forceinline__ void init(int M, int N, int G_, int c_, int K_ = 0) { nM = M / BM; nN = N / BM; nwg = nM * nN; G = G_; c = c_; ntk = K_ / BK; }
    __host__ __device__ __forceinline__ bool next(int i, Unit& u) const {
        const long L = (long)i * G + c; if (L >= nwg) return false;
        int wgid = (int)L; { const int q = nwg / NXCD, r = nwg % NXCD, xcd = wgid % NXCD, off = wgid / NXCD; wgid = (xcd < r ? xcd * (q + 1) : r * (q + 1) + (xcd - r) * q) + off; }
        const int nig = WGM * nN, gid = wgid / nig, fm = gid * WGM, gsz = (nM - fm) < WGM ? (nM - fm) : WGM;
        u.pm = fm + ((wgid % nig) % gsz); u.pn = (wgid % nig) / gsz; u.k0 = 0; u.nt = ntk; u.aux = -1; return true;
    }
    __device__ __forceinline__ void a_ready(const Unit&) const {}
    __device__ __forceinline__ void done(const Unit&) const {}
};

__device__ __forceinline__ unsigned cvt_pk_bf16(float lo, float hi) { unsigned r; asm volatile("v_cvt_pk_bf16_f32 %0, %1, %2" : "=v"(r) : "v"(lo), "v"(hi)); return r; }
typedef float f32x2 __attribute__((ext_vector_type(2)));

template <class Epi, class Sched, bool ALIGN_EPI = false, bool SP2 = false>
__device__ __forceinline__ void gemm_phase(PG8_LAS unsigned char* lds, const Gemm g, const Sched& S, const Epi& E) {
    int tid_v = threadIdx.x; asm volatile("" : "+v"(tid_v));
    const int tid = tid_v, wid = __builtin_amdgcn_readfirstlane(tid >> 6), lane = tid & 63, wr = wid >> 2, wc = wid & 3, fr = lane & 15, fq = lane >> 4;
    const int K = g.K;
    unsigned voffA[2], voffB[2];
#pragma unroll
    for (int i = 0; i < 2; ++i) { int R, C; stage_rc(tid * 16 + i * 8192, R, C); const int Rb = Epi::PERM ? ((R & ~31) + perm32(R & 31)) : R;
        voffA[i] = (unsigned)(R * K + C) * 2u; voffB[i] = (unsigned)(Rb * K + C) * 2u; }
    const size_t kstep = (size_t)(BK * 2);
    const size_t hstep = (size_t)HALF * K * 2;
    const size_t tstep = 2 * hstep;
    const unsigned ldsw = (unsigned)wid * 1024u;
    const int aoff = lds_byte(wr * 64 + fr, fq * 8), boff = lds_byte(wc * 32 + fr, fq * 8);
#define PG8_SA(b, h) (((b) * 2 + (h)) * HTB)
#define PG8_SB(b, h) ((4 + (b) * 2 + (h)) * HTB)
#define PG8_STAGE(bufoff, gbase, voff) do { _Pragma("unroll") for (int _i = 0; _i < 2; ++_i) \
        __builtin_amdgcn_global_load_lds((const unsigned*)((const char*)(gbase) + (voff)[_i]), (PG8_LAS unsigned*)(lds + (bufoff) + ldsw + _i * 8192), 16, 0, 0); } while (0)
#define PG8_LDA(dst, b, h) do { _Pragma("unroll") for (int m = 0; m < 4; ++m) _Pragma("unroll") for (int k = 0; k < 2; ++k) dst[m][k] = *(const PG8_LAS bf16x8*)(lds + PG8_SA(b, h) + aoff + m * 2048 + k * 1024); } while (0)
#define PG8_LDB(dst, b, h) do { _Pragma("unroll") for (int n = 0; n < 2; ++n) _Pragma("unroll") for (int k = 0; k < 2; ++k) dst[n][k] = *(const PG8_LAS bf16x8*)(lds + PG8_SB(b, h) + boff + n * 2048 + k * 1024); } while (0)
#define PG8_MMA(ai, bj, At, Bt) do { __builtin_amdgcn_s_setprio(1); _Pragma("unroll") for (int m = 0; m < 4; ++m) _Pragma("unroll") for (int n = 0; n < 2; ++n) _Pragma("unroll") for (int k = 0; k < 2; ++k) \
        acc[ai][bj][m][n] = __builtin_amdgcn_mfma_f32_16x16x32_bf16(Bt[n][k], At[m][k], acc[ai][bj][m][n], 0, 0, 0); __builtin_amdgcn_s_setprio(0); } while (0)
#define PG8_WAIT_V(n) asm volatile("s_waitcnt vmcnt(" #n ")" ::: "memory")
#define PG8_WAIT_L(n) asm volatile("s_waitcnt lgkmcnt(" #n ")" ::: "memory")
#define PG8_BAR __builtin_amdgcn_s_barrier()
#define PG8_SCHED __builtin_amdgcn_sched_barrier(0)
    Unit cur, nxt; int ui = 0;
    if (!S.next(0, cur)) return;
    f32x4 acc[2][2][4][2];
#pragma unroll
    for (int a = 0; a < 2; ++a)
#pragma unroll
        for (int b = 0; b < 2; ++b)
#pragma unroll
            for (int m = 0; m < 4; ++m)
#pragma unroll
                for (int n = 0; n < 2; ++n) acc[a][b][m][n] = (f32x4){0.f, 0.f, 0.f, 0.f};
    bf16x8 At[4][2], B0[2][2], B1[2][2];
    const char* cA = (const char*)g.A + (size_t)cur.pm * tstep + (size_t)cur.k0 * 2; const char* cB = (const char*)g.Bt + (size_t)cur.pn * tstep + (size_t)cur.k0 * 2;
    S.a_ready(cur);
    if constexpr (SP2) {
        PG8_STAGE(PG8_SB(0, 0), cB, voffB); PG8_STAGE(PG8_SB(0, 1), cB + hstep, voffB); PG8_STAGE(PG8_SA(0, 0), cA, voffA); PG8_STAGE(PG8_SA(0, 1), cA + hstep, voffA);
        if (wr == 1) PG8_BAR;
        PG8_WAIT_V(2); PG8_BAR;
        PG8_STAGE(PG8_SB(1, 0), cB + kstep, voffB); PG8_STAGE(PG8_SA(1, 0), cA + kstep, voffA); PG8_STAGE(PG8_SB(1, 1), cB + hstep + kstep, voffB);
        PG8_WAIT_V(6); PG8_BAR;
    } else {
        PG8_STAGE(PG8_SB(0, 0), cB, voffB); PG8_STAGE(PG8_SA(0, 0), cA, voffA); PG8_STAGE(PG8_SB(0, 1), cB + hstep, voffB); PG8_STAGE(PG8_SA(0, 1), cA + hstep, voffA);
        if (wr == 1) PG8_BAR;
        PG8_WAIT_V(4); PG8_BAR;
        PG8_STAGE(PG8_SB(1, 0), cB + kstep, voffB); PG8_STAGE(PG8_SA(1, 0), cA + kstep, voffA); PG8_STAGE(PG8_SB(1, 1), cB + hstep + kstep, voffB);
        PG8_WAIT_V(6); PG8_BAR;
    }
    for (;;) {
        const bool has_next = S.next(ui + 1, nxt);
        const char* nA = has_next ? (const char*)g.A + (size_t)nxt.pm * tstep + (size_t)nxt.k0 * 2 : cA; const char* nB = has_next ? (const char*)g.Bt + (size_t)nxt.pn * tstep + (size_t)nxt.k0 * 2 : cB;
        const int nt = cur.nt;
        for (int t = 0; t < nt; t += 2) {
            const bool last = (t == nt - 2);
            const char* a1 = cA + (size_t)(t + 1) * kstep;
            const char* a2 = last ? nA : cA + (size_t)(t + 2) * kstep; const char* b2 = last ? nB : cB + (size_t)(t + 2) * kstep;
            const char* a3 = a2 + kstep; const char* b3 = b2 + kstep;
            if (last && has_next) S.a_ready(nxt);
            if constexpr (SP2) {
            PG8_LDB(B0, 0, 0); PG8_LDB(B1, 0, 1); PG8_SCHED; PG8_LDA(At, 0, 0); PG8_STAGE(PG8_SA(1, 1), a1 + hstep, voffA);
            PG8_WAIT_V(8); PG8_WAIT_L(0); PG8_BAR; PG8_MMA(0, 0, At, B0); PG8_MMA(0, 1, At, B1); PG8_BAR; PG8_SCHED;
            PG8_LDA(At, 0, 1); PG8_STAGE(PG8_SB(0, 0), b2, voffB); PG8_STAGE(PG8_SB(0, 1), b2 + hstep, voffB); PG8_STAGE(PG8_SA(0, 0), a2, voffA);
            PG8_WAIT_V(8); PG8_WAIT_L(0); PG8_BAR; PG8_MMA(1, 0, At, B0); PG8_MMA(1, 1, At, B1); PG8_BAR; PG8_SCHED;
            PG8_LDB(B0, 1, 0); PG8_LDB(B1, 1, 1); PG8_SCHED; PG8_LDA(At, 1, 0); PG8_STAGE(PG8_SA(0, 1), a2 + hstep, voffA);
            PG8_WAIT_V(8); PG8_WAIT_L(0); PG8_BAR; PG8_MMA(0, 0, At, B0); PG8_MMA(0, 1, At, B1); PG8_BAR; PG8_SCHED;
            PG8_LDA(At, 1, 1); PG8_STAGE(PG8_SB(1, 0), b3, voffB); PG8_STAGE(PG8_SB(1, 1), b3 + hstep, voffB); PG8_STAGE(PG8_SA(1, 0), a3, voffA);
            PG8_WAIT_V(8); PG8_WAIT_L(0); PG8_BAR; PG8_MMA(1, 0, At, B0); PG8_MMA(1, 1, At, B1); PG8_BAR; PG8_SCHED;
            } else {
            PG8_LDB(B0, 0, 0); PG8_SCHED; PG8_LDA(At, 0, 0); PG8_STAGE(PG8_SA(1, 1), a1 + hstep, voffA);
            PG8_WAIT_L(8); PG8_BAR; PG8_WAIT_L(0); PG8_MMA(0, 0, At, B0); PG8_BAR; PG8_SCHED;
            PG8_LDB(B1, 0, 1); PG8_STAGE(PG8_SB(0, 0), b2, voffB);
            PG8_BAR; PG8_WAIT_L(0); PG8_MMA(0, 1, At, B1); PG8_BAR;
            PG8_LDA(At, 0, 1); PG8_STAGE(PG8_SA(0, 0), a2, voffA);
            PG8_BAR; PG8_WAIT_L(0); PG8_MMA(1, 0, At, B0); PG8_BAR; PG8_SCHED;
            PG8_STAGE(PG8_SB(0, 1), b2 + hstep, voffB);
            PG8_WAIT_V(6); PG8_BAR; PG8_MMA(1, 1, At, B1); PG8_BAR;
            PG8_LDB(B0, 1, 0); PG8_SCHED; PG8_LDA(At, 1, 0); PG8_STAGE(PG8_SA(0, 1), a2 + hstep, voffA);
            PG8_WAIT_L(8); PG8_BAR; PG8_WAIT_L(0); PG8_MMA(0, 0, At, B0); PG8_BAR; PG8_SCHED;
            PG8_LDB(B1, 1, 1); PG8_STAGE(PG8_SB(1, 0), b3, voffB);
            PG8_BAR; PG8_WAIT_L(0); PG8_MMA(0, 1, At, B1); PG8_BAR;
            PG8_LDA(At, 1, 1); PG8_STAGE(PG8_SA(1, 0), a3, voffA);
            PG8_BAR; PG8_WAIT_L(0); PG8_MMA(1, 0, At, B0); PG8_BAR; PG8_SCHED;
            PG8_STAGE(PG8_SB(1, 1), b3 + hstep, voffB);
            PG8_WAIT_V(6); PG8_BAR; PG8_MMA(1, 1, At, B1); PG8_BAR;
            }
        }
        if constexpr (ALIGN_EPI) { if (wr == 0) PG8_BAR; }
        if constexpr (!Epi::AFTER_DRAIN) { E(acc, cur, wr, wc, fr, fq); S.done(cur); }
        if (!has_next) break;
#pragma unroll
        for (int a = 0; a < 2; ++a)
#pragma unroll
            for (int b = 0; b < 2; ++b)
#pragma unroll
                for (int m = 0; m < 4; ++m)
#pragma unroll
                    for (int n = 0; n < 2; ++n) acc[a][b][m][n] = (f32x4){0.f, 0.f, 0.f, 0.f};
        cur = nxt; cA = nA; cB = nB; ++ui;
        if constexpr (ALIGN_EPI) { if (wr == 1) PG8_BAR; }
    }
    PG8_WAIT_V(0);
    if constexpr (!ALIGN_EPI) { if (wr == 0) PG8_BAR; }
    PG8_BAR;
    if constexpr (Epi::AFTER_DRAIN) { E.fused(acc, cur, wr, wc, fr, fq, lds, wid, lane); S.done(cur); }
#undef PG8_SA
#undef PG8_SB
#undef PG8_STAGE
#undef PG8_LDA
#undef PG8_LDB
#undef PG8_MMA
#undef PG8_WAIT_V
#undef PG8_WAIT_L
#undef PG8_BAR
#undef PG8_SCHED
}

}

#define XB_TMO      128
#define XB_XCNT(j)  (256  + 64 * (j))
#define XB_XSUB(j)  (1280 + 64 * (j))
#define XB_XGEN(j)  (2304 + 64 * (j))
#define XB_TOP      3328
#define XB_TOPGEN   3392
#define XCD_BAR_WORDS 3456
#define XB_SPIN_CAP (1u << 18)
#define LAS __attribute__((address_space(3)))

__device__ __forceinline__ unsigned xb_ld(unsigned* p)              { return __hip_atomic_load(p, __ATOMIC_RELAXED, __HIP_MEMORY_SCOPE_AGENT); }
__device__ __forceinline__ unsigned xb_add(unsigned* p, unsigned v) { return __hip_atomic_fetch_add(p, v, __ATOMIC_RELAXED, __HIP_MEMORY_SCOPE_AGENT); }
__device__ __forceinline__ unsigned xb_xcc_id() { return (unsigned)__builtin_amdgcn_s_getreg((3 << 11) | 20) & 0xFu; }
#define XB_SPIN(cond, bar) do { unsigned _sp = 0; while (cond) { __builtin_amdgcn_s_sleep(1); \
    if ((++_sp & 255u) == 0u) { if (xb_ld(&(bar)[XB_TMO])) break; if (_sp > XB_SPIN_CAP) { atomicAdd(&(bar)[XB_TMO], 1u); break; } } } } while (0)

struct XcdBarrier {
    unsigned* bar; unsigned x;
    volatile LAS unsigned* st;
};

__device__ __forceinline__ XcdBarrier xcd_barrier_post(unsigned* bar, volatile LAS unsigned* st) {
    XcdBarrier b; b.bar = bar; b.x = xb_xcc_id(); b.st = st;
    if (threadIdx.x == 0) (void)xb_add(&bar[XB_XCNT(b.x)], 1u);
    return b;
}
__device__ __forceinline__ void xcd_barrier_complete(unsigned* bar, unsigned x, unsigned& nloc, unsigned& nx) {
    const unsigned G = gridDim.x * gridDim.y * gridDim.z;
    unsigned sum, cnt, mine, sp = 0u;
    for (;;) {
        sum = 0u; cnt = 0u; mine = 0u;
#pragma unroll
        for (unsigned j = 0; j < 16; ++j) { const unsigned c = xb_ld(&bar[XB_XCNT(j)]); sum += c; cnt += (c > 0u) ? 1u : 0u; mine = (j == x) ? c : mine; }
        if (sum == G) break;
        __builtin_amdgcn_s_sleep(1);
        if ((++sp & 255u) == 0u) { if (xb_ld(&bar[XB_TMO])) break; if (sp > XB_SPIN_CAP) { atomicAdd(&bar[XB_TMO], 1u); break; } }
    }
    nloc = mine > 0u ? mine : 1u; nx = cnt > 0u ? cnt : 1u;
}

__device__ __forceinline__ void xcd_barrier(const XcdBarrier& b) {
    asm volatile("s_waitcnt vmcnt(0)" ::: "memory");
    __syncthreads();
    if (threadIdx.x == 0) {
        unsigned* bar = b.bar;
        __builtin_amdgcn_s_waitcnt(0);
        unsigned nloc = b.st[0], nx = b.st[1];
        if (nloc == 0u) { xcd_barrier_complete(bar, b.x, nloc, nx); b.st[0] = nloc; b.st[1] = nx; }
        const unsigned old = xb_add(&bar[XB_XSUB(b.x)], 1u);
        const unsigned gen = old / nloc;
        if (old + 1u == (gen + 1u) * nloc) {
            __builtin_amdgcn_fence(__ATOMIC_RELEASE, "agent");
            asm volatile("s_waitcnt vmcnt(0)" ::: "memory");
            const unsigned og = xb_add(&bar[XB_TOP], 1u);
            const unsigned tg = og / nx;
            if (og + 1u == (tg + 1u) * nx) xb_add(&bar[XB_TOPGEN], 1u);
            else XB_SPIN(xb_ld(&bar[XB_TOPGEN]) == tg, bar);
            __builtin_amdgcn_fence(__ATOMIC_ACQUIRE, "agent");
            xb_add(&bar[XB_XGEN(b.x)], 1u);
            asm volatile("s_waitcnt vmcnt(0)" ::: "memory");
        } else {
            XB_SPIN(xb_ld(&bar[XB_XGEN(b.x)]) == gen, bar);
            __builtin_amdgcn_fence(__ATOMIC_ACQUIRE, "agent");
            asm volatile("s_waitcnt vmcnt(0)" ::: "memory");
        }
    }
    __syncthreads();
}


namespace {
typedef unsigned short bf16_t;
typedef float f32x4 __attribute__((ext_vector_type(4)));
typedef unsigned u32x4 __attribute__((ext_vector_type(4)));
typedef unsigned u32x2 __attribute__((ext_vector_type(2)));

constexpr int D = 2048, SEQ = 4096, NB = 2, MP = NB * SEQ, DB = 32, DS = 4, MS = DB * DS, MT = MP + MS, MPAD = 8448;
constexpr int DFF = 5504, DRNN = 1024, HD = 128, NKV = 4, IDH = 8, IDD = 64, DIN = 4680, DINP = 4864;
constexpr int NPAGES = 64, PAGE = 128, NPAST = NPAGES * PAGE, LS = NPAST + DS, TOPK = 256;
constexpr int C_XR = 0, C_GR = 1024, C_Q = 2048, C_K = 3072, C_V = 3584, C_QI = 4096, C_KI = 4608, C_WI = 4672;
constexpr float ALPHA = 1.189207115002721f, LN_EPS = 1e-5f, ATTN_SCALE = 0.08838834764831845f, IDX_SCALE = 0.125f, IDX_W_SCALE = 0.35355339059327373f;
constexpr size_t O_YP = 0, O_YS = 16777216, O_KP = 17039360, O_VP = 21233664, O_KIP = 25427968, O_CP = 25952256, O_HP = 25958400,
                 O_KS = 25960448, O_VS = 26025984, O_KIS = 26091520, O_CS = 26099712, O_HS = 26198016;
constexpr int SCS_LD = 8256;
constexpr int ZLD = DINP;

constexpr size_t al256(size_t x) { return (x + 255) & ~(size_t)255; }
constexpr size_t WS_CTL = 0;
constexpr size_t CTL_BYTES = 65536;
constexpr size_t WS_WGU1 = WS_CTL + CTL_BYTES;
constexpr size_t WS_WD1 = WS_WGU1 + al256((size_t)2 * DFF * D * 2);
constexpr size_t WS_WIN = WS_WD1 + al256((size_t)D * DFF * 2);
constexpr size_t WS_WOUT = WS_WIN + al256((size_t)DINP * D * 2);
constexpr size_t WS_WGU2 = WS_WOUT + al256((size_t)D * D * 2);
constexpr size_t WS_WD2 = WS_WGU2 + al256((size_t)2 * DFF * D * 2);
constexpr size_t WS_XB = WS_WD2 + al256((size_t)D * DFF * 2);
constexpr size_t WS_H = WS_XB + al256((size_t)MPAD * D * 2);
constexpr size_t WS_T = WS_H + al256((size_t)MPAD * DFF * 2);
constexpr size_t WS_X1 = WS_T + al256((size_t)MPAD * D * 4);
constexpr size_t WS_X2 = WS_X1 + al256((size_t)MPAD * D * 4);
constexpr size_t WS_XR = WS_X2 + al256((size_t)MPAD * D * 4);
constexpr size_t WS_GG = WS_XR + al256((size_t)MPAD * DRNN * 4);
constexpr size_t WS_QI = WS_GG + al256((size_t)MPAD * DRNN * 4);
constexpr size_t WS_WI = WS_QI + al256((size_t)MPAD * 512 * 4);
constexpr size_t WS_KIH = WS_WI + al256((size_t)MPAD * 8 * 4);
constexpr size_t WS_KIL = WS_KIH + al256((size_t)MPAD * 64 * 2);
constexpr size_t WS_ZEND = WS_KIL + al256((size_t)MPAD * 64 * 2);
constexpr size_t WS_CATB = WS_ZEND;
constexpr size_t WS_HL = WS_CATB + al256((size_t)MPAD * D * 2);
constexpr size_t WS_PP = WS_HL + al256((size_t)MT * DRNN * 4);
constexpr size_t WS_GI = WS_PP + al256((size_t)MT * DRNN * 4);
constexpr size_t WS_SCP = WS_GI + al256((size_t)MT * DRNN * 4);
constexpr size_t WS_SCS = WS_SCP + al256((size_t)MP * SEQ * 4);
constexpr size_t WS_SEL = WS_SCS + al256((size_t)MS * SCS_LD * 4);
constexpr size_t WS_NSEL = WS_SEL + al256((size_t)MT * TOPK * 4);
constexpr size_t WS_SUMA = WS_NSEL + al256((size_t)MT * 4);
constexpr size_t WS_SUMH = WS_SUMA + al256((size_t)130 * DRNN * 4);
constexpr size_t WS_WAT = WS_SUMH + al256((size_t)130 * DRNN * 4);
constexpr size_t WS_WIT = WS_WAT + al256((size_t)8 * 128 * 128 * 2);
constexpr size_t WS_BM = WS_WIT + al256((size_t)8 * 128 * 128 * 2);
constexpr size_t WS_QB = WS_BM + al256((size_t)MP * 64 * 8);
constexpr size_t WS_KB = WS_QB + al256((size_t)MPAD * 1024 * 2);
constexpr size_t WS_VB = WS_KB + al256((size_t)MPAD * 512 * 2);
constexpr size_t WS_END = WS_VB + al256((size_t)MPAD * 512 * 2);
constexpr size_t WS_PS = WS_END;
constexpr size_t WS_END2 = WS_PS + al256((size_t)21 * MS * D * 4);
constexpr size_t WS_CTR = WS_CTL + 32768;

constexpr int NWAVES = 8, NTHREADS = 512;
#ifndef MID_DUP
#define MID_DUP 0
#endif
#ifndef REP_G
#define REP_G 1
#endif
#ifndef REP_T
#define REP_T 1
#endif
#ifndef REP_5
#define REP_5 2
#endif
constexpr int LDS_STAGE = 131072, LDS_MISC = 134144, LDS_BYTES = 135168;

struct Params {
    const float* in[27];
    float* out;
    unsigned char* ws;
    int ph_lo, ph_hi, li, pad_;
};

__device__ __forceinline__ unsigned cvt_pk_bf16(float lo, float hi) { unsigned r; asm volatile("v_cvt_pk_bf16_f32 %0, %1, %2" : "=v"(r) : "v"(lo), "v"(hi)); return r; }
__device__ __forceinline__ int fresh_tid() { int t = threadIdx.x; asm volatile("" : "+v"(t)); return t; }
__device__ __forceinline__ float sigmoidf_(float x) { return 1.0f / (1.0f + expf(-x)); }
__device__ __forceinline__ float gelu_tanh(float x) { return 0.5f * x * (1.0f + tanhf(0.7978845608028654f * (x + 0.044715f * x * x * x))); }
__device__ __forceinline__ bf16_t f2bf(float f) { return (bf16_t)(cvt_pk_bf16(f, 0.f) & 0xffffu); }

struct EpiSwiGLU {
    static constexpr bool PERM = true, AFTER_DRAIN = false;
    bf16_t* H;
    __device__ __forceinline__ void operator()(const f32x4 (&acc)[2][2][4][2], const pg8::Unit& u, int wr, int wc, int fr, int fq) const {
        const int row0 = u.pm * 256 + wr * 64 + fr, col0 = u.pn * 128 + wc * 32 + 8 * fq;
#pragma unroll
        for (int ai = 0; ai < 2; ++ai)
#pragma unroll
            for (int m = 0; m < 4; ++m) {
                bf16_t* rowp = H + (size_t)(row0 + ai * 128 + m * 16) * DFF + col0;
                float h[8];
#pragma unroll
                for (int n = 0; n < 2; ++n)
#pragma unroll
                    for (int j = 0; j < 4; ++j) {
                        const float g = acc[ai][0][m][n][j], up = acc[ai][1][m][n][j];
                        const float sg = __builtin_amdgcn_rcpf(1.0f + __builtin_amdgcn_exp2f(-1.4426950408889634f * g));
                        h[n * 4 + j] = g * sg * up;
                    }
                u32x4 w; w.x = cvt_pk_bf16(h[0], h[1]); w.y = cvt_pk_bf16(h[2], h[3]); w.z = cvt_pk_bf16(h[4], h[5]); w.w = cvt_pk_bf16(h[6], h[7]);
                *(u32x4*)rowp = w;
            }
    }
};
struct EpiResid {
    static constexpr bool PERM = false, AFTER_DRAIN = false;
    const float* Xp; const float* Xs; float* T; float s;
    __device__ __forceinline__ void operator()(const f32x4 (&acc)[2][2][4][2], const pg8::Unit& u, int wr, int wc, int fr, int fq) const {
        const int row0 = u.pm * 256 + wr * 64 + fr, col0 = u.pn * 256 + wc * 32 + 4 * fq;
#pragma unroll
        for (int ai = 0; ai < 2; ++ai)
#pragma unroll
            for (int m = 0; m < 4; ++m) {
                const int row = row0 + ai * 128 + m * 16;
                if (row < MT) {
                    const float* xr = (row < MP) ? Xp + (size_t)row * D + col0 : Xs + (size_t)(row - MP) * D + col0;
                    float* tr = T + (size_t)row * D + col0;
#pragma unroll
                    for (int bj = 0; bj < 2; ++bj)
#pragma unroll
                        for (int n = 0; n < 2; ++n) { const f32x4 xv = *(const f32x4*)(xr + bj * 128 + n * 16); *(f32x4*)(tr + bj * 128 + n * 16) = xv * ALPHA + acc[ai][bj][m][n] * s; }
                }
            }
    }
};
struct EpiF32 {
    static constexpr bool PERM = false, AFTER_DRAIN = false;
    float* C; int ldc;
    __device__ __forceinline__ void operator()(const f32x4 (&acc)[2][2][4][2], const pg8::Unit& u, int wr, int wc, int fr, int fq) const {
        const int row0 = u.pm * 256 + wr * 64 + fr, col0 = u.pn * 256 + wc * 32 + 4 * fq;
#pragma unroll
        for (int ai = 0; ai < 2; ++ai)
#pragma unroll
            for (int m = 0; m < 4; ++m) {
                float* rowp = C + (size_t)(row0 + ai * 128 + m * 16) * ldc + col0;
#pragma unroll
                for (int bj = 0; bj < 2; ++bj)
#pragma unroll
                    for (int n = 0; n < 2; ++n) *(f32x4*)(rowp + bj * 128 + n * 16) = acc[ai][bj][m][n];
            }
    }
};


struct EpiWin {
    static constexpr bool PERM = false, AFTER_DRAIN = false;
    float* XR; float* GG; bf16_t* QB; bf16_t* KB; bf16_t* VB; float* QI; bf16_t* KIH; bf16_t* KIL; float* WI; float* out;
    template <class F> __device__ __forceinline__ void each(const f32x4 (&acc)[2][2][4][2], const pg8::Unit& u, int wr, int wc, int fr, int fq, F f) const {
        const int row0 = u.pm * 256 + wr * 64 + fr, cl = wc * 32 + 4 * fq;
#pragma unroll
        for (int ai = 0; ai < 2; ++ai)
#pragma unroll
            for (int m = 0; m < 4; ++m)
#pragma unroll
                for (int bj = 0; bj < 2; ++bj)
#pragma unroll
                    for (int n = 0; n < 2; ++n) f(row0 + ai * 128 + m * 16, cl + 128 * bj + 16 * n, acc[ai][bj][m][n]);
    }
    static __device__ __forceinline__ u32x2 pk4(const f32x4 v) { u32x2 w; w.x = cvt_pk_bf16(v[0], v[1]); w.y = cvt_pk_bf16(v[2], v[3]); return w; }
    __device__ __forceinline__ void operator()(const f32x4 (&acc)[2][2][4][2], const pg8::Unit& u, int wr, int wc, int fr, int fq) const {
        const int pn = u.pn;
        if (pn < 4) each(acc, u, wr, wc, fr, fq, [&](int row, int c, const f32x4 v) { *(f32x4*)(XR + (size_t)row * DRNN + pn * 256 + c) = v; });
        else if (pn < 8) each(acc, u, wr, wc, fr, fq, [&](int row, int c, const f32x4 v) { *(f32x4*)(GG + (size_t)row * DRNN + (pn - 4) * 256 + c) = (f32x4){gelu_tanh(v[0]), gelu_tanh(v[1]), gelu_tanh(v[2]), gelu_tanh(v[3])}; });
        else if (pn < 12) each(acc, u, wr, wc, fr, fq, [&](int row, int c, const f32x4 v) { *(u32x2*)(QB + (size_t)row * 1024 + (pn - 8) * 256 + c) = pk4(v); });
        else if (pn < 16) {
            bf16_t* B = (pn < 14) ? KB : VB; const size_t op = (pn < 14) ? O_KP : O_VP, os = (pn < 14) ? O_KS : O_VS; const int c0 = (pn & 1) * 256;
            each(acc, u, wr, wc, fr, fq, [&](int row, int c, const f32x4 v) {
                *(u32x2*)(B + (size_t)row * 512 + c0 + c) = pk4(v);
                if (row < MT) *(f32x4*)(out + (row < MP ? op + (size_t)row * 512 : os + (size_t)(row - MP) * 512) + c0 + c) = v; });
        }
        else if (pn < 18) each(acc, u, wr, wc, fr, fq, [&](int row, int c, const f32x4 v) { *(f32x4*)(QI + (size_t)row * 512 + (pn - 16) * 256 + c) = v; });
        else each(acc, u, wr, wc, fr, fq, [&](int row, int c, const f32x4 v) {
            if (c < 64) {
                const u32x2 h = pk4(v);
                u32x2 l; l.x = cvt_pk_bf16(v[0] - __uint_as_float(h.x << 16), v[1] - __uint_as_float(h.x & 0xffff0000u)); l.y = cvt_pk_bf16(v[2] - __uint_as_float(h.y << 16), v[3] - __uint_as_float(h.y & 0xffff0000u));
                *(u32x2*)(KIH + (size_t)row * 64 + c) = h; *(u32x2*)(KIL + (size_t)row * 64 + c) = l;
                if (row < MT) *(f32x4*)(out + (row < MP ? O_KIP + (size_t)row * 64 : O_KIS + (size_t)(row - MP) * 64) + c) = v;
            } else if (c < 72) *(f32x4*)(WI + (size_t)row * 8 + (c - 64)) = v; });
    }
};


struct SplitOrder {
    pg8::StaticOrder base; int G, c, nmine, npiece, ntk, nN;
    __device__ __forceinline__ void init(int N, int K, int G_, int c_) { base.init(MP, N, G_, c_, K); G = G_; c = c_; nN = N / 256; ntk = K / 64; npiece = ntk / 4; nmine = (c_ < base.nwg) ? (base.nwg - c_ + G_ - 1) / G_ : 0; }
    __device__ __forceinline__ bool next(int i, pg8::Unit& u) const {
        if (i < nmine) return base.next(i, u);
        const int mi = (i - nmine) * G + c; if (mi >= npiece * nN) return false;
        const int kp = mi / nN; u.pm = MP / 256; u.pn = mi % nN; u.k0 = kp * 256; u.nt = (kp == npiece - 1) ? ntk - 4 * (npiece - 1) : 4; u.aux = kp; return true;
    }
    __device__ __forceinline__ void a_ready(const pg8::Unit&) const {}
    __device__ __forceinline__ void done(const pg8::Unit&) const {}
};
struct EpiResidSplit {
    static constexpr bool PERM = false, AFTER_DRAIN = false;
    const float* X; float* T; float* PS; float s;
    __device__ __forceinline__ void operator()(const f32x4 (&acc)[2][2][4][2], const pg8::Unit& u, int wr, int wc, int fr, int fq) const {
        const int col0 = u.pn * 256 + wc * 32 + 4 * fq;
        if (u.aux < 0) {
            const int row0 = u.pm * 256 + wr * 64 + fr;
#pragma unroll
            for (int ai = 0; ai < 2; ++ai)
#pragma unroll
                for (int m = 0; m < 4; ++m) {
                    const size_t off = (size_t)(row0 + ai * 128 + m * 16) * D + col0;
#pragma unroll
                    for (int bj = 0; bj < 2; ++bj)
#pragma unroll
                        for (int n = 0; n < 2; ++n) { const f32x4 xv = *(const f32x4*)(X + off + bj * 128 + n * 16); *(f32x4*)(T + off + bj * 128 + n * 16) = xv * ALPHA + acc[ai][bj][m][n] * s; }
                }
        } else {
            float* slab = PS + (size_t)u.aux * MS * D;
#pragma unroll
            for (int m = 0; m < 4; ++m) {
                float* rp = slab + (size_t)(wr * 64 + m * 16 + fr) * D + col0;
#pragma unroll
                for (int bj = 0; bj < 2; ++bj)
#pragma unroll
                    for (int n = 0; n < 2; ++n) *(f32x4*)(rp + bj * 128 + n * 16) = acc[0][bj][m][n];
            }
        }
    }
};

template <int MODE>
__device__ __forceinline__ void transpose_cvt(const float* __restrict__ W, int K, int N, int Npad, bf16_t* __restrict__ Wt, PG8_LAS float* tile) {
    const int tid = fresh_tid(), ntn = Npad / 64, ntk = K / 64, ntiles = ntn * ntk;
    for (int t = blockIdx.x; t < ntiles; t += gridDim.x) {
        const int tn = t % ntn, tk = t / ntn, n0 = tn * 64, k0 = tk * 64;
        int s0;
        if (MODE == 1) { const int tile256 = n0 >> 8, j = n0 & 255; s0 = (j < 128) ? tile256 * 128 + j : DFF + tile256 * 128 + (j - 128); } else s0 = n0;
#pragma unroll
        for (int i = 0; i < 8; ++i) {
            const int e = tid + 512 * i, k = e >> 6, n = e & 63;
            tile[k * 65 + n] = (MODE == 1 || s0 + n < N) ? W[(size_t)(k0 + k) * N + s0 + n] : 0.f;
        }
        __syncthreads();
        {
            const int n = tid >> 3, kq = (tid & 7) * 8;
            float v[8];
#pragma unroll
            for (int j = 0; j < 8; ++j) v[j] = tile[(kq + j) * 65 + n];
            u32x4 w; w.x = cvt_pk_bf16(v[0], v[1]); w.y = cvt_pk_bf16(v[2], v[3]); w.z = cvt_pk_bf16(v[4], v[5]); w.w = cvt_pk_bf16(v[6], v[7]);
            *(u32x4*)(Wt + (size_t)(n0 + n) * K + k0 + kq) = w;
        }
        __syncthreads();
    }
}
__device__ __forceinline__ void cvt_x(const float* __restrict__ xp, const float* __restrict__ xs, bf16_t* __restrict__ XB) {
    const size_t n4 = (size_t)MPAD * D / 4;
    for (size_t i = (size_t)blockIdx.x * NTHREADS + threadIdx.x; i < n4; i += (size_t)gridDim.x * NTHREADS) {
        const size_t e = i * 4, row = e / D;
        f32x4 v = (f32x4){0.f, 0.f, 0.f, 0.f};
        if (row < (size_t)MP) v = *(const f32x4*)(xp + e); else if (row < (size_t)MT) v = *(const f32x4*)(xs + (e - (size_t)MP * D));
        u32x2 w; w.x = cvt_pk_bf16(v[0], v[1]); w.y = cvt_pk_bf16(v[2], v[3]);
        *(u32x2*)(XB + e) = w;
    }
}
__device__ __forceinline__ void ln_phase(const float* __restrict__ T, const float* __restrict__ g, const float* __restrict__ b, float* __restrict__ Xo, bf16_t* __restrict__ Xb,
                                         const float* __restrict__ PS, int npiece, const float* __restrict__ Xs, float sres) {
    const int tid_ = fresh_tid(), lane = tid_ & 63, wave = tid_ >> 6;
    for (int row = blockIdx.x * NWAVES + wave; row < MT; row += gridDim.x * NWAVES) {
        f32x4 v[8]; float s = 0.f;
        if (row < MP) {
            const float* tr = T + (size_t)row * D + lane * 4;
#pragma unroll
            for (int i = 0; i < 8; ++i) v[i] = *(const f32x4*)(tr + 256 * i);
        } else {
            const size_t ro = (size_t)(row - MP) * D + lane * 4;
#pragma unroll
            for (int i = 0; i < 8; ++i) v[i] = (f32x4){0.f, 0.f, 0.f, 0.f};
#pragma unroll 1
            for (int pz = 0; pz < npiece; ++pz) {
                const float* sp = PS + (size_t)pz * MS * D + ro;
#pragma unroll
                for (int i = 0; i < 8; ++i) v[i] += *(const f32x4*)(sp + 256 * i);
            }
#pragma unroll
            for (int i = 0; i < 8; ++i) v[i] = *(const f32x4*)(Xs + ro + 256 * i) * ALPHA + v[i] * sres;
        }
#pragma unroll
        for (int i = 0; i < 8; ++i) s += (v[i][0] + v[i][1]) + (v[i][2] + v[i][3]);
#pragma unroll
        for (int o = 32; o >= 1; o >>= 1) s += __shfl_xor(s, o);
        const float mean = s * (1.0f / D);
        float q = 0.f;
#pragma unroll
        for (int i = 0; i < 8; ++i) { const f32x4 d = v[i] - mean; q += (d[0] * d[0] + d[1] * d[1]) + (d[2] * d[2] + d[3] * d[3]); }
#pragma unroll
        for (int o = 32; o >= 1; o >>= 1) q += __shfl_xor(q, o);
        const float rstd = rsqrtf(q * (1.0f / D) + LN_EPS);
        const float* gq = g; const float* bq = b; asm volatile("" : "+s"(gq), "+s"(bq));
#pragma unroll
        for (int i = 0; i < 8; ++i) {
            const f32x4 o = (v[i] - mean) * rstd * *(const f32x4*)(gq + lane * 4 + 256 * i) + *(const f32x4*)(bq + lane * 4 + 256 * i);
            if (Xo) *(f32x4*)(Xo + (size_t)row * D + lane * 4 + 256 * i) = o;
            if (Xb) { u32x2 w; w.x = cvt_pk_bf16(o[0], o[1]); w.y = cvt_pk_bf16(o[2], o[3]); *(u32x2*)(Xb + (size_t)row * D + lane * 4 + 256 * i) = w; }
        }
    }
}

typedef short bf16x8 __attribute__((ext_vector_type(8)));
typedef float f32x16 __attribute__((ext_vector_type(16)));
__device__ __forceinline__ int crow(int reg, int h) { return (reg & 3) + 8 * (reg >> 2) + 4 * h; }
constexpr int LRU_CH = 64, LRU_NCHUNK = MT / LRU_CH  , LRU_PCHUNK = MP / LRU_CH  , LRU_CPB = SEQ / LRU_CH  ;
constexpr int L_XCF = 0, L_XCB = 32768, L_AA = 50176, L_UU = 82944, XCB_PITCH = 272;
__device__ __forceinline__ void lru_local_unit(const Params& p, PG8_LAS unsigned char* lds, int u) {
    const int tid = fresh_tid(), lane = tid & 63, wave = tid >> 6;
    unsigned char* ws = p.ws;
    const float* XR = (const float*)(ws + WS_XR);
    const float* state_conv = p.in[5]; const float* state_rnn = p.in[6];
    const float* cw = p.in[13]; const float* cb = p.in[14];
    const float* ba = p.in[16]; const float* bi = p.in[18]; const float* lam = p.in[19];
    const bf16_t* WAt = (const bf16_t*)(ws + WS_WAT); const bf16_t* WIt = (const bf16_t*)(ws + WS_WIT);
    float* HL = (float*)(ws + WS_HL); float* PP = (float*)(ws + WS_PP); float* SUMA = (float*)(ws + WS_SUMA); float* SUMH = (float*)(ws + WS_SUMH);
    float* out = p.out;
    PG8_LAS float* XCF = (PG8_LAS float*)(lds + L_XCF); PG8_LAS float* AA = (PG8_LAS float*)(lds + L_AA); PG8_LAS float* UU = (PG8_LAS float*)(lds + L_UU);
    {
        const int ck = u >> 3, nb = u & 7;
        {
            const int c = tid & 127, rg = tid >> 7, ch = nb * 128 + c;
            const float w0 = cw[ch], w1 = cw[DRNN + ch], w2 = cw[2 * DRNN + ch], w3 = cw[3 * DRNN + ch], cbv = cb[ch];
            if (ck < LRU_PCHUNK) {
                const int b = ck / LRU_CPB, t0 = (ck % LRU_CPB) * LRU_CH + rg * 16;
                const float* zc = XR + (size_t)(b * SEQ) * DRNN + ch;
                float x0 = (t0 - 3 >= 0) ? zc[(size_t)(t0 - 3) * DRNN] : 0.f, x1 = (t0 - 2 >= 0) ? zc[(size_t)(t0 - 2) * DRNN] : 0.f, x2 = (t0 - 1 >= 0) ? zc[(size_t)(t0 - 1) * DRNN] : 0.f;
#pragma unroll
                for (int i = 0; i < 16; ++i) {
                    const int t = t0 + i, lr = rg * 16 + i;
                    const float x3 = zc[(size_t)t * DRNN];
                    const float xc = cbv + w0 * x0 + w1 * x1 + w2 * x2 + w3 * x3;
                    XCF[lr * 128 + c] = xc;
                    *(PG8_LAS bf16_t*)(lds + L_XCB + lr * XCB_PITCH + c * 2) = f2bf(xc);
                    if (t >= SEQ - 3) out[O_CP + (size_t)(b * 3 + (t - (SEQ - 3))) * DRNN + ch] = x3;
                    x0 = x1; x1 = x2; x2 = x3;
                }
            } else {
#pragma unroll
                for (int i = 0; i < 16; ++i) {
                    const int lr = rg * 16 + i, rs = (ck - LRU_PCHUNK) * LRU_CH + lr, bs = rs >> 2, tt = rs & 3;
                    float xv[4];
#pragma unroll
                    for (int j = 0; j < 4; ++j) { const int pp = tt + j; xv[j] = (pp < 3) ? state_conv[(size_t)(bs * 3 + pp) * DRNN + ch] : XR[(size_t)(MP + bs * DS + pp - 3) * DRNN + ch]; }
                    const float xc = cbv + w0 * xv[0] + w1 * xv[1] + w2 * xv[2] + w3 * xv[3];
                    XCF[lr * 128 + c] = xc;
                    *(PG8_LAS bf16_t*)(lds + L_XCB + lr * XCB_PITCH + c * 2) = f2bf(xc);
                    if (tt >= 1) out[O_CS + (size_t)(bs * 3 + (tt - 1)) * DRNN + ch] = xv[3];
                }
            }
        }
        __syncthreads();
        {
            const int mt = wave >> 2, nt = wave & 3, r = lane & 31, kh = lane >> 5;
            f32x16 acc_a, acc_i;
#pragma unroll
            for (int i = 0; i < 16; ++i) { acc_a[i] = 0.f; acc_i[i] = 0.f; }
            const bf16_t* wa = WAt + (size_t)nb * 16384 + (size_t)(nt * 32 + r) * 128 + kh * 8;
            const bf16_t* wi = WIt + (size_t)nb * 16384 + (size_t)(nt * 32 + r) * 128 + kh * 8;
#pragma unroll
            for (int ks = 0; ks < 8; ++ks) {
                const bf16x8 af = *(const PG8_LAS bf16x8*)(lds + L_XCB + (mt * 32 + r) * XCB_PITCH + (ks * 16 + kh * 8) * 2);
                const bf16x8 bfa = *(const bf16x8*)(wa + ks * 16);
                const bf16x8 bfi = *(const bf16x8*)(wi + ks * 16);
                acc_a = __builtin_amdgcn_mfma_f32_32x32x16_bf16(af, bfa, acc_a, 0, 0, 0);
                acc_i = __builtin_amdgcn_mfma_f32_32x32x16_bf16(af, bfi, acc_i, 0, 0, 0);
            }
            const int col = nt * 32 + r, ch = nb * 128 + col, hh = lane >> 5;
            const float l = lam[ch], sp = (-l > 20.f) ? -l : log1pf(expf(-l)), bac = ba[ch], bic = bi[ch];
#pragma unroll
            for (int i = 0; i < 16; ++i) {
                const int lr = mt * 32 + crow(i, hh);
                const float xc = XCF[lr * 128 + col];
                const float rg = sigmoidf_(acc_a[i] + bac), ig = sigmoidf_(acc_i[i] + bic);
                const float log_a = -8.0f * rg * sp;
                AA[lr * 128 + col] = expf(log_a);
                UU[lr * 128 + col] = sqrtf(-expm1f(2.0f * log_a)) * ig * xc;
            }
        }
        __syncthreads();
        {
            const int c = tid & 127, sg = tid >> 7, ch = nb * 128 + c;
            PG8_LAS float* SEG = (PG8_LAS float*)(lds + L_XCF);
            float hv[16], pv[16];
            float h = 0.f, P = 1.f;
            const bool prompt = ck < LRU_PCHUNK;
#pragma unroll
            for (int i = 0; i < 16; ++i) {
                const int lr = sg * 16 + i;
                const float a = AA[lr * 128 + c], uu = UU[lr * 128 + c];
                if (!prompt && (i & 3) == 0) { h = state_rnn[(size_t)(((ck - LRU_PCHUNK) * LRU_CH + lr) >> 2) * DRNN + ch]; P = 0.f; }
                h = a * h + uu; P *= a;
                hv[i] = h; pv[i] = P;
            }
            SEG[(sg * 128 + c) * 2] = P; SEG[(sg * 128 + c) * 2 + 1] = h;
            __syncthreads();
            float cin = 0.f, pin = 1.f;
            if (prompt) {
#pragma unroll
                for (int s2 = 0; s2 < 3; ++s2) if (s2 < sg) { const float ps = SEG[(s2 * 128 + c) * 2], hs = SEG[(s2 * 128 + c) * 2 + 1]; cin = ps * cin + hs; pin *= ps; }
            }
#pragma unroll
            for (int i = 0; i < 16; ++i) {
                const int lr = sg * 16 + i;
                const size_t g = (size_t)(ck * LRU_CH + lr) * DRNN + ch;
                const float hf = prompt ? hv[i] + pv[i] * cin : hv[i];
                HL[g] = hf; PP[g] = prompt ? pv[i] * pin : 0.f;
                if (!prompt && (i & 3) == 3) out[O_HS + (size_t)(((ck - LRU_PCHUNK) * LRU_CH + lr) >> 2) * DRNN + ch] = hf;
            }
            if (sg == 3) { SUMA[(size_t)ck * DRNN + ch] = prompt ? pv[15] * pin : 0.f; SUMH[(size_t)ck * DRNN + ch] = prompt ? hv[15] + pv[15] * cin : 0.f; }
        }
        __syncthreads();
    }
}
__device__ __forceinline__ void lru_fixup_unit(const Params& p, int ck) {
    const int tid = fresh_tid(), ch = tid * 2;
    unsigned char* ws = p.ws;
    const float* GG = (const float*)(ws + WS_GG);
    const float* HL = (const float*)(ws + WS_HL); const float* PP = (const float*)(ws + WS_PP); const float* SUMA = (const float*)(ws + WS_SUMA); const float* SUMH = (const float*)(ws + WS_SUMH);
    bf16_t* CATB = (bf16_t*)(ws + WS_CATB); float* PS = (float*)(ws + WS_PS);
    typedef float f32x2 __attribute__((ext_vector_type(2)));
    f32x2 carry = (f32x2){0.f, 0.f};
    const bool prompt = ck < LRU_PCHUNK;
    if (prompt) {
        const int b = ck / LRU_CPB, kk = ck % LRU_CPB;
#pragma unroll 4
        for (int j = 0; j < kk; ++j) {
            const f32x2 A = *(const f32x2*)(SUMA + (size_t)(b * LRU_CPB + j) * DRNN + ch), Hh = *(const f32x2*)(SUMH + (size_t)(b * LRU_CPB + j) * DRNN + ch);
            carry = A * carry + Hh;
        }
    }
#pragma unroll 4
    for (int lr = 0; lr < LRU_CH; ++lr) {
        const size_t grow = (size_t)(ck * LRU_CH + lr);
        const f32x2 hl = *(const f32x2*)(HL + grow * DRNN + ch), pp = *(const f32x2*)(PP + grow * DRNN + ch), gg = *(const f32x2*)(GG + grow * DRNN + ch);
        const f32x2 h = hl + pp * carry;
        *(unsigned*)(CATB + grow * D + ch) = cvt_pk_bf16(h.x * gg.x, h.y * gg.y);
        if (prompt && (ck % LRU_CPB) == LRU_CPB - 1 && lr == LRU_CH - 1) *(f32x2*)(p.out + O_HP + (size_t)(ck / LRU_CPB) * DRNN + ch) = h;
    }
}


constexpr int IDX_SPLIT = 1;
constexpr int SCP_LD = 4096, SCS_LDL = 8200;
__device__ __forceinline__ unsigned fkey(float f) { const unsigned u = __float_as_uint(f); return (u & 0x80000000u) ? ~u : (u | 0x80000000u); }
__device__ __forceinline__ int mbcnt64(unsigned long long m) { return (int)__builtin_amdgcn_mbcnt_hi((unsigned)(m >> 32), __builtin_amdgcn_mbcnt_lo((unsigned)m, 0u)); }
template <int NB> __device__ __forceinline__ int wave_sum_small(unsigned c) {
    int t = 0;
#pragma unroll
    for (int b = 0; b < NB; ++b) t += __popcll(__ballot((c >> b) & 1u)) << b;
    return t;
}
__device__ __forceinline__ void split8(const f32x4 a, const f32x4 b, bf16x8& hi, bf16x8& lo) {
    u32x4 h; h.x = cvt_pk_bf16(a[0], a[1]); h.y = cvt_pk_bf16(a[2], a[3]); h.z = cvt_pk_bf16(b[0], b[1]); h.w = cvt_pk_bf16(b[2], b[3]);
    u32x4 l;
    l.x = cvt_pk_bf16(a[0] - __uint_as_float(h.x << 16), a[1] - __uint_as_float(h.x & 0xffff0000u));
    l.y = cvt_pk_bf16(a[2] - __uint_as_float(h.y << 16), a[3] - __uint_as_float(h.y & 0xffff0000u));
    l.z = cvt_pk_bf16(b[0] - __uint_as_float(h.z << 16), b[1] - __uint_as_float(h.z & 0xffff0000u));
    l.w = cvt_pk_bf16(b[2] - __uint_as_float(h.w << 16), b[3] - __uint_as_float(h.w & 0xffff0000u));
    hi = __builtin_bit_cast(bf16x8, h); lo = __builtin_bit_cast(bf16x8, l);
}
struct IdxQ { bf16x8 hi[4], lo[4]; float w[16]; };
struct IdxRaw { f32x4 v[8]; };
struct IdxKey { bf16x8 hi[4], lo[4]; };
__device__ __forceinline__ void idx_load_q(IdxQ& q, const float* QI, const float* WI, int grow0, int lane) {
    const int rho = lane & 31, kh = lane >> 5, ql = 2 * ((rho >> 2) & 1) + (rho >> 4), head = 4 * ((rho >> 3) & 1) + (rho & 3);
    const float* src = QI + (size_t)(grow0 + ql) * 512 + head * IDD + kh * 8;
#pragma unroll
    for (int ks = 0; ks < 4; ++ks) { const f32x4 a = *(const f32x4*)(src + ks * 16), b = *(const f32x4*)(src + ks * 16 + 4); split8(a, b, q.hi[ks], q.lo[ks]); }
#pragma unroll
    for (int e = 0; e < 2; ++e) {
        const float* wsrc = WI + (size_t)(grow0 + 2 * kh + e) * 8;
        const f32x4 a = *(const f32x4*)wsrc, b = *(const f32x4*)(wsrc + 4);
#pragma unroll
        for (int i = 0; i < 4; ++i) { q.w[e * 8 + i] = a[i] * IDX_W_SCALE; q.w[e * 8 + 4 + i] = b[i] * IDX_W_SCALE; }
    }
}
__device__ __forceinline__ void idx_load_raw(IdxRaw& raw, const float* kp) {
#pragma unroll
    for (int ks = 0; ks < 4; ++ks) { raw.v[2 * ks] = *(const f32x4*)(kp + ks * 16); raw.v[2 * ks + 1] = *(const f32x4*)(kp + ks * 16 + 4); }
}
__device__ __forceinline__ void idx_cvt_key(const IdxRaw& raw, IdxKey& k) {
#pragma unroll
    for (int ks = 0; ks < 4; ++ks) split8(raw.v[2 * ks], raw.v[2 * ks + 1], k.hi[ks], k.lo[ks]);
}
__device__ __forceinline__ void idx_load_keyb(IdxKey& k, const bf16_t* ph, const bf16_t* pl) {
#pragma unroll
    for (int ks = 0; ks < 4; ++ks) { k.hi[ks] = *(const bf16x8*)(ph + ks * 16); if (IDX_SPLIT == 3) k.lo[ks] = *(const bf16x8*)(pl + ks * 16); else k.lo[ks] = k.hi[ks]; }
}
__device__ __forceinline__ void idx_tile(const IdxQ& q, const IdxKey& k, float (&s)[2]) {
    f32x16 acc;
#pragma unroll
    for (int i = 0; i < 16; ++i) acc[i] = 0.f;
#pragma unroll
    for (int ks = 0; ks < 4; ++ks) {
        acc = __builtin_amdgcn_mfma_f32_32x32x16_bf16(q.hi[ks], k.hi[ks], acc, 0, 0, 0);
        if (IDX_SPLIT == 3) { acc = __builtin_amdgcn_mfma_f32_32x32x16_bf16(q.hi[ks], k.lo[ks], acc, 0, 0, 0); acc = __builtin_amdgcn_mfma_f32_32x32x16_bf16(q.lo[ks], k.hi[ks], acc, 0, 0, 0); }
    }
#pragma unroll
    for (int e = 0; e < 2; ++e) {
        float t = 0.f;
#pragma unroll
        for (int i = 0; i < 8; ++i) t += fmaxf(acc[e * 8 + i] * IDX_SCALE, 0.f) * q.w[e * 8 + i];
        s[e] = t;
    }
}
template <int NJ>
__device__ __forceinline__ void select_row(const PG8_LAS float* sc, int n, int lane, unsigned long long* bm_row) {
    constexpr int NG = (NJ + 7) / 8;
    unsigned v[NJ];
    const int nj = __builtin_amdgcn_readfirstlane((n + 63) >> 6), ng = (nj + 7) >> 3;
    const PG8_LAS float* pl = sc + lane;
#pragma unroll
    for (int j = 0; j < NJ; ++j) { const unsigned k = fkey(pl[j * 64]); v[j] = (lane < n - j * 64) ? k : 0u; }
    unsigned T = 1u; int need = 1 << 30;
    if (n > TOPK) {
        unsigned prefix = 0u; bool exact = false;
        for (int bit = 31; bit >= 0; --bit) {
            const unsigned cand = prefix | (1u << bit);
            int cnt = 0;
#pragma unroll
            for (int g = 0; g < NG; ++g) if (g < ng) {
#pragma unroll
                for (int jj = 0; jj < 8; ++jj) if (g * 8 + jj < NJ) cnt += __popcll(__ballot(v[g * 8 + jj] >= cand));
            }
            if (cnt >= TOPK) prefix = cand;
            if (cnt == TOPK) { exact = true; break; }
        }
        T = prefix;
        if (!exact) {
            int cgt = 0;
#pragma unroll
            for (int g = 0; g < NG; ++g) if (g < ng) {
#pragma unroll
                for (int jj = 0; jj < 8; ++jj) if (g * 8 + jj < NJ) cgt += __popcll(__ballot(v[g * 8 + jj] > T));
            }
            need = TOPK - cgt;
        }
    }
    int base_eq = 0; unsigned long long mymask = 0ull;
#pragma unroll
    for (int j = 0; j < NJ; ++j) if (j < nj) {
        const bool gt = v[j] > T, eq = v[j] == T;
        const unsigned long long eqm = __ballot(eq);
        const bool s = gt || (eq && (base_eq + mbcnt64(eqm)) < need);
        const unsigned long long sm = __ballot(s);
        base_eq += __popcll(eqm);
        if (lane == j) mymask = sm;
    }
    bm_row[lane] = mymask;
}
__device__ __forceinline__ void select_row_wg(const PG8_LAS float* sc, int n, PG8_LAS int* sel, volatile PG8_LAS int* red) {
    constexpr int NC = 17;
    const int tid_ = fresh_tid(), lane = tid_ & 63, wave = __builtin_amdgcn_readfirstlane(tid_ >> 6);
    unsigned v[NC];
    const PG8_LAS float* pl = sc + wave * NC * 64 + lane;
    const int nrem = n - wave * NC * 64;
#pragma unroll
    for (int j = 0; j < NC; ++j) { const unsigned k = fkey(pl[j * 64]); v[j] = (lane < nrem - j * 64) ? k : 0u; }
    unsigned prefix = 0u; bool exact = false; int it = 0;
    for (int bit = 31; bit >= 0; --bit, ++it) {
        const unsigned cand = prefix | (1u << bit);
        int wc = 0;
#pragma unroll
        for (int j = 0; j < NC; ++j) wc += __popcll(__ballot(v[j] >= cand));
        if (lane == 0) red[(it & 1) * 8 + wave] = wc;
        __syncthreads();
        int cnt = 0;
#pragma unroll
        for (int w = 0; w < 8; ++w) cnt += red[(it & 1) * 8 + w];
        if (cnt >= TOPK) prefix = cand;
        if (cnt == TOPK) { exact = true; break; }
    }
    const unsigned T = prefix;
    unsigned cg = 0u, ce = 0u;
#pragma unroll
    for (int j = 0; j < NC; ++j) { cg += (v[j] > T) ? 1u : 0u; ce += (v[j] == T) ? 1u : 0u; }
    const int wg_ = wave_sum_small<5>(cg), we_ = wave_sum_small<5>(ce);
    __syncthreads();
    if (lane == 0) { red[16 + wave] = wg_; red[24 + wave] = we_; }
    __syncthreads();
    int tot_gt = 0, eq_before = 0, gt_before = 0;
#pragma unroll
    for (int w = 0; w < 8; ++w) { const int g = red[16 + w], e = red[24 + w]; tot_gt += g; if (w < wave) { gt_before += g; eq_before += e; } }
    const int need = exact ? (1 << 30) : TOPK - tot_gt;
    int base_sel = gt_before + (eq_before < need ? eq_before : need), base_eq = eq_before;
    int ln = lane; asm volatile("" : "+v"(ln));
#pragma unroll
    for (int j = 0; j < NC; ++j) {
        const bool gt = v[j] > T, eq = v[j] == T;
        const unsigned long long eqm = __ballot(eq);
        const bool s = gt || (eq && (base_eq + mbcnt64(eqm)) < need);
        const unsigned long long sm = __ballot(s);
        if (s) sel[base_sel + mbcnt64(sm)] = (wave * NC + j) * 64 + ln;
        base_eq += __popcll(eqm); base_sel += __popcll(sm);
    }
    __syncthreads();
}
__device__ __forceinline__ void idx_sample_score_unit(const Params& p, int bs, int pg8) {
    const int tid_ = fresh_tid(), lane = tid_ & 63, wave = __builtin_amdgcn_readfirstlane(tid_ >> 6), r = lane & 31, kh = lane >> 5;
    unsigned char* ws = p.ws;
    const float* QI = (const float*)(ws + WS_QI); const float* WI = (const float*)(ws + WS_WI); float* SCS = (float*)(ws + WS_SCS);
    const bf16_t* KIH = (const bf16_t*)(ws + WS_KIH); const bf16_t* KIL = (const bf16_t*)(ws + WS_KIL);
    const float* cache_ki = p.in[4]; const int* page_table = (const int*)p.in[7];
    IdxQ q; idx_load_q(q, QI, WI, MP + bs * DS, lane);
    const int pg = pg8 * 8 + wave, phys = page_table[bs * NPAGES + pg];
    const float* pbase = cache_ki + (size_t)phys * PAGE * IDD + (size_t)r * IDD + kh * 8;
    float* out0 = SCS + (size_t)(bs * DS + 2 * kh) * SCS_LD;
    IdxRaw raw; idx_load_raw(raw, pbase);
    IdxKey k;
#pragma unroll
    for (int tt = 0; tt < 4; ++tt) {
        idx_cvt_key(raw, k);
        if (tt < 3) idx_load_raw(raw, pbase + (size_t)(tt + 1) * 32 * IDD);
        float s[2]; idx_tile(q, k, s);
        const int col = pg * PAGE + tt * 32 + r;
        out0[col] = s[0]; out0[SCS_LD + col] = s[1];
    }
    if (pg8 == 0 && wave == 0) {
        const size_t kr = (size_t)(MP + bs * DS + (r & 3)) * IDD + kh * 8;
        idx_load_keyb(k, KIH + kr, KIL + kr);
        float s[2]; idx_tile(q, k, s);
        if (r < DS) { out0[NPAST + r] = s[0]; out0[SCS_LD + NPAST + r] = s[1]; }
    }
}
__device__ __forceinline__ void idx_prompt_unit(const Params& p, PG8_LAS unsigned char* lds, int s, bool do_select = true) {
    const int tid_ = fresh_tid(), lane = tid_ & 63, wave = __builtin_amdgcn_readfirstlane(tid_ >> 6), r = lane & 31, kh = lane >> 5;
    unsigned char* ws = p.ws;
    const float* QI = (const float*)(ws + WS_QI); const float* WI = (const float*)(ws + WS_WI); unsigned long long* BM = (unsigned long long*)(ws + WS_BM);
    const bf16_t* KIH = (const bf16_t*)(ws + WS_KIH); const bf16_t* KIL = (const bf16_t*)(ws + WS_KIL);
    PG8_LAS float* sc = (PG8_LAS float*)lds;
    const int b = s & 1, q0 = (s >> 1) * 8, grow0 = b * SEQ + q0, ntile = (q0 + 8 + 31) >> 5;
    IdxQ qa, qb; idx_load_q(qa, QI, WI, grow0, lane); idx_load_q(qb, QI, WI, grow0 + 4, lane);
    const size_t kbase = (size_t)(b * SEQ + r) * IDD + kh * 8;
    IdxKey kn;
    if (wave < ntile) idx_load_keyb(kn, KIH + kbase + (size_t)wave * 32 * IDD, KIL + kbase + (size_t)wave * 32 * IDD);
    for (int t = wave; t < ntile; t += NWAVES) {
        const IdxKey k = kn;
        if (t + NWAVES < ntile) idx_load_keyb(kn, KIH + kbase + (size_t)(t + NWAVES) * 32 * IDD, KIL + kbase + (size_t)(t + NWAVES) * 32 * IDD);
        float sa[2], sb[2]; idx_tile(qa, k, sa); idx_tile(qb, k, sb);
        const int col = t * 32 + r;
        sc[(2 * kh) * SCP_LD + col] = sa[0]; sc[(2 * kh + 1) * SCP_LD + col] = sa[1];
        sc[(4 + 2 * kh) * SCP_LD + col] = sb[0]; sc[(5 + 2 * kh) * SCP_LD + col] = sb[1];
    }
    __syncthreads();
    if (do_select) select_row<64>(sc + wave * SCP_LD, q0 + wave + 1, lane, BM + (size_t)(grow0 + wave) * 64);
}
__device__ __forceinline__ unsigned wq_next(unsigned* ctr, PG8_LAS unsigned char* lds) {
    volatile PG8_LAS unsigned* slot = (volatile PG8_LAS unsigned*)(lds + LDS_MISC + 64);
    __syncthreads();
    if (threadIdx.x == 0) *slot = atomicAdd(ctr, 1u);
    __syncthreads();
    return *slot;
}

constexpr int G_SC = 0, G_SEL = 32800, G_RED = 33824, G_QS = 34304, G_PS = 38400, G_KP = 46592, G_VP = 48640, G_OP = 50688;
__device__ __forceinline__ void sample_row_unit(const Params& p, PG8_LAS unsigned char* lds, int rs) {
    const int tid = fresh_tid(), lane = tid & 63, wave = tid >> 6;
    unsigned char* ws = p.ws;
    const bf16_t* QB = (const bf16_t*)(ws + WS_QB); const float* SCS = (const float*)(ws + WS_SCS);
    const float* cache_k = p.in[2]; const float* cache_v = p.in[3]; const int* page_table = (const int*)p.in[7];
    bf16_t* CATB = (bf16_t*)(ws + WS_CATB); float* PS = (float*)(ws + WS_PS);
    const int row = MP + rs, b = rs / DS, n = NPAST + (rs % DS) + 1;
    PG8_LAS float* sc = (PG8_LAS float*)(lds + G_SC);
    PG8_LAS int* sel = (PG8_LAS int*)(lds + G_SEL);
    PG8_LAS float* qs = (PG8_LAS float*)(lds + G_QS);
    PG8_LAS float* ps = (PG8_LAS float*)(lds + G_PS);
    PG8_LAS unsigned long long* kps = (PG8_LAS unsigned long long*)(lds + G_KP);
    PG8_LAS unsigned long long* vps = (PG8_LAS unsigned long long*)(lds + G_VP);
    PG8_LAS float* op = (PG8_LAS float*)(lds + G_OP);
    for (int e = tid; e < SCS_LDL; e += NTHREADS) sc[e] = SCS[(size_t)rs * SCS_LD + e];
    { const bf16_t* z = QB + (size_t)row * 1024; qs[tid] = __uint_as_float((unsigned)z[tid] << 16); qs[tid + 512] = __uint_as_float((unsigned)z[tid + 512] << 16); }
    __syncthreads();
    select_row_wg(sc, n, sel, (volatile PG8_LAS int*)(lds + G_RED));
    if (tid < TOPK) {
        const int idx = sel[tid];
        const float* kp; const float* vp;
        if (idx < NPAST) { const size_t prow = (size_t)page_table[b * NPAGES + idx / PAGE] * PAGE + (idx % PAGE); kp = cache_k + prow * 512; vp = cache_v + prow * 512; }
        else { const size_t zr = (size_t)(b * DS + idx - NPAST); kp = p.out + O_KS + zr * 512; vp = p.out + O_VS + zr * 512; }
        kps[tid] = (unsigned long long)kp; vps[tid] = (unsigned long long)vp;
    }
    __syncthreads();
    {
        const int j = tid & 255, hg = tid >> 8;
        const float* kp = (const float*)kps[j] + hg * 256;
#pragma unroll
        for (int n2 = 0; n2 < 2; ++n2) {
            float d0 = 0.f, d1 = 0.f;
            const PG8_LAS float* q0 = qs + (4 * hg + 2 * n2) * HD; const PG8_LAS float* q1 = q0 + HD;
#pragma unroll 8
            for (int d = 0; d < HD; d += 4) {
                const f32x4 k4 = *(const f32x4*)(kp + n2 * HD + d);
                d0 += q0[d] * k4[0] + q0[d + 1] * k4[1] + q0[d + 2] * k4[2] + q0[d + 3] * k4[3];
                d1 += q1[d] * k4[0] + q1[d + 1] * k4[1] + q1[d + 2] * k4[2] + q1[d + 3] * k4[3];
            }
            ps[(4 * hg + 2 * n2) * TOPK + j] = d0 * ATTN_SCALE; ps[(4 * hg + 2 * n2 + 1) * TOPK + j] = d1 * ATTN_SCALE;
        }
    }
    __syncthreads();
    {
        float v[4]; float m = -INFINITY;
#pragma unroll
        for (int i = 0; i < 4; ++i) { v[i] = ps[wave * TOPK + lane + 64 * i]; m = fmaxf(m, v[i]); }
#pragma unroll
        for (int o = 32; o >= 1; o >>= 1) m = fmaxf(m, __shfl_xor(m, o));
        float sum = 0.f;
#pragma unroll
        for (int i = 0; i < 4; ++i) { v[i] = expf(v[i] - m); sum += v[i]; }
#pragma unroll
        for (int o = 32; o >= 1; o >>= 1) sum += __shfl_xor(sum, o);
        const float inv = 1.0f / sum;
#pragma unroll
        for (int i = 0; i < 4; ++i) ps[wave * TOPK + lane + 64 * i] = v[i] * inv;
    }
    __syncthreads();
    {
        const int o4 = tid & 255, kq = tid >> 8, hq = o4 >> 5, d = (o4 & 31) * 4, nkv = hq >> 1;
        f32x4 acc = (f32x4){0.f, 0.f, 0.f, 0.f};
#pragma unroll 8
        for (int j = kq * 128; j < kq * 128 + 128; ++j) acc += *(const f32x4*)((const float*)vps[j] + nkv * HD + d) * ps[hq * TOPK + j];
        if (kq == 1) *(PG8_LAS f32x4*)(op + o4 * 4) = acc;
        __syncthreads();
        if (kq == 0) {
            acc += *(const PG8_LAS f32x4*)(op + o4 * 4);
            u32x2 w; w.x = cvt_pk_bf16(acc[0], acc[1]); w.y = cvt_pk_bf16(acc[2], acc[3]);
            *(u32x2*)(CATB + (size_t)row * D + 1024 + o4 * 4) = w;
        }
    }
    __syncthreads();
}

typedef short s16x4 __attribute__((ext_vector_type(4)));
constexpr int A_KP = 272, A_VP = 320, A_KBYTES = 64 * A_KP, A_VBYTES = 64 * A_VP, A_STAGE = A_KBYTES + A_VBYTES;
constexpr float A_SC = 0.08838834764831845f * 1.4426950408889634f;
__device__ __forceinline__ float xhalf_max(float x) { const auto sw = __builtin_amdgcn_permlane32_swap(__float_as_uint(x), __float_as_uint(x), false, false); return fmaxf(__uint_as_float(sw[0]), __uint_as_float(sw[1])); }
__device__ __forceinline__ float xhalf_sum(float x) { const auto sw = __builtin_amdgcn_permlane32_swap(__float_as_uint(x), __float_as_uint(x), false, false); return __uint_as_float(sw[0]) + __uint_as_float(sw[1]); }
__device__ __forceinline__ void attn_dense_unit(const Params& p, PG8_LAS unsigned char* lds, int b, int n, int qb) {
    const int tid = fresh_tid(), lane = tid & 63, wave = __builtin_amdgcn_readfirstlane(tid >> 6), r = lane & 31, kh = lane >> 5;
    unsigned char* ws = p.ws;
    const bf16_t* QB = (const bf16_t*)(ws + WS_QB); const bf16_t* KB = (const bf16_t*)(ws + WS_KB); const bf16_t* VB = (const bf16_t*)(ws + WS_VB);
    const unsigned long long* BM = (const unsigned long long*)(ws + WS_BM);
    bf16_t* CATB = (bf16_t*)(ws + WS_CATB); float* PS = (float*)(ws + WS_PS);
    const int q = qb * 128 + wave * 16 + (r & 15), head = 2 * n + (r >> 4);
    const size_t qrow = (size_t)b * SEQ + q;
    bf16x8 qf[8];
#pragma unroll
    for (int ks = 0; ks < 8; ++ks) qf[ks] = *(const bf16x8*)(QB + qrow * 1024 + head * HD + ks * 16 + kh * 8);
    f32x16 O[4];
#pragma unroll
    for (int dt = 0; dt < 4; ++dt)
#pragma unroll
        for (int i = 0; i < 16; ++i) O[dt][i] = 0.f;
    float m = -INFINITY, l = 0.f;
    const int ntile = 2 * qb + 2, qmax_w = qb * 128 + wave * 16 + 15;
    const int srow = tid >> 4, sch = tid & 15;
    const bf16_t* kg = KB + ((size_t)b * SEQ + srow) * 512 + n * HD + sch * 8;
    const bf16_t* vg = VB + ((size_t)b * SEQ + srow) * 512 + n * HD + sch * 8;
    u32x4 kst[2], vst[2];
#define A_GLOAD(t) do { _Pragma("unroll") for (int _i = 0; _i < 2; ++_i) { kst[_i] = *(const u32x4*)(kg + (size_t)((t) * 64 + _i * 32) * 512); vst[_i] = *(const u32x4*)(vg + (size_t)((t) * 64 + _i * 32) * 512); } } while (0)
#define A_LSTORE(buf) do { _Pragma("unroll") for (int _i = 0; _i < 2; ++_i) { *(PG8_LAS u32x4*)(lds + (buf) * A_STAGE + (srow + _i * 32) * A_KP + sch * 16) = kst[_i]; \
        *(PG8_LAS u32x4*)(lds + (buf) * A_STAGE + A_KBYTES + (srow + _i * 32) * A_VP + sch * 16) = vst[_i]; } } while (0)
    A_GLOAD(0); A_LSTORE(0);
    unsigned long long mw = BM[qrow * 64];
    __syncthreads();
    const int i16 = lane & 15, g2 = (lane >> 4) & 1;
    const int vlane_off = (4 * kh + (i16 >> 2)) * A_VP + (16 * g2 + 4 * (i16 & 3)) * 2;
    for (int t = 0; t < ntile; ++t) {
        const bool more = (t + 1 < ntile);
        if (more) A_GLOAD(t + 1);
        const unsigned long long mw_next = more ? BM[qrow * 64 + t + 1] : 0ull;
        const int buf = t & 1;
        if (t * 64 <= qmax_w) {
            PG8_LAS unsigned char* kb = lds + buf * A_STAGE; PG8_LAS unsigned char* vb = kb + A_KBYTES;
            f32x16 s0, s1;
#pragma unroll
            for (int i = 0; i < 16; ++i) { s0[i] = 0.f; s1[i] = 0.f; }
#pragma unroll
            for (int ks = 0; ks < 8; ++ks) {
                const bf16x8 k0 = *(const PG8_LAS bf16x8*)(kb + r * A_KP + (ks * 16 + kh * 8) * 2);
                const bf16x8 k1 = *(const PG8_LAS bf16x8*)(kb + (32 + r) * A_KP + (ks * 16 + kh * 8) * 2);
                s0 = __builtin_amdgcn_mfma_f32_32x32x16_bf16(k0, qf[ks], s0, 0, 0, 0);
                s1 = __builtin_amdgcn_mfma_f32_32x32x16_bf16(k1, qf[ks], s1, 0, 0, 0);
            }
            const unsigned lo = (unsigned)mw >> (4 * kh), hi = (unsigned)(mw >> 32) >> (4 * kh);
            float mx = -INFINITY;
#pragma unroll
            for (int i = 0; i < 16; ++i) {
                const unsigned bit = 1u << ((i & 3) + 8 * (i >> 2));
                s0[i] = (lo & bit) ? s0[i] * A_SC : -INFINITY; s1[i] = (hi & bit) ? s1[i] * A_SC : -INFINITY;
                mx = fmaxf(mx, fmaxf(s0[i], s1[i]));
            }
            mx = xhalf_max(mx);
            const float m_new = fmaxf(m, mx), m_safe = (m_new == -INFINITY) ? 0.f : m_new;
            const float alpha = __builtin_amdgcn_exp2f(m - m_safe);
            float lsum = 0.f;
#pragma unroll
            for (int i = 0; i < 16; ++i) { s0[i] = __builtin_amdgcn_exp2f(s0[i] - m_safe); s1[i] = __builtin_amdgcn_exp2f(s1[i] - m_safe); lsum += s0[i] + s1[i]; }
            l = l * alpha + lsum; m = m_new;
            if (__ballot(alpha != 1.0f) != 0ull) {
#pragma unroll
                for (int dt = 0; dt < 4; ++dt)
#pragma unroll
                    for (int i = 0; i < 16; ++i) O[dt][i] *= alpha;
            }
            bf16x8 pf[2][2];
#pragma unroll
            for (int sx = 0; sx < 2; ++sx) {
                u32x4 w0, w1;
                w0.x = cvt_pk_bf16(s0[8 * sx], s0[8 * sx + 1]); w0.y = cvt_pk_bf16(s0[8 * sx + 2], s0[8 * sx + 3]); w0.z = cvt_pk_bf16(s0[8 * sx + 4], s0[8 * sx + 5]); w0.w = cvt_pk_bf16(s0[8 * sx + 6], s0[8 * sx + 7]);
                w1.x = cvt_pk_bf16(s1[8 * sx], s1[8 * sx + 1]); w1.y = cvt_pk_bf16(s1[8 * sx + 2], s1[8 * sx + 3]); w1.z = cvt_pk_bf16(s1[8 * sx + 4], s1[8 * sx + 5]); w1.w = cvt_pk_bf16(s1[8 * sx + 6], s1[8 * sx + 7]);
                pf[0][sx] = __builtin_bit_cast(bf16x8, w0); pf[1][sx] = __builtin_bit_cast(bf16x8, w1);
            }
#pragma unroll
            for (int st = 0; st < 2; ++st)
#pragma unroll
                for (int sx = 0; sx < 2; ++sx)
#pragma unroll
                    for (int dt = 0; dt < 4; ++dt) {
                        PG8_LAS unsigned char* a = vb + vlane_off + (st * 32 + 16 * sx) * A_VP + dt * 64;
                        const s16x4 vlo = __builtin_amdgcn_ds_read_tr16_b64_v4i16((PG8_LAS s16x4*)a);
                        const s16x4 vhi = __builtin_amdgcn_ds_read_tr16_b64_v4i16((PG8_LAS s16x4*)(a + 8 * A_VP));
                        const bf16x8 vf = __builtin_shufflevector(vlo, vhi, 0, 1, 2, 3, 4, 5, 6, 7);
                        O[dt] = __builtin_amdgcn_mfma_f32_32x32x16_bf16(vf, pf[st][sx], O[dt], 0, 0, 0);
                    }
        }
        if (more) A_LSTORE(buf ^ 1);
        __syncthreads();
        mw = mw_next;
    }
#undef A_GLOAD
#undef A_LSTORE
    const float inv = 1.0f / xhalf_sum(l);
    bf16_t* orow = CATB + qrow * D + 1024 + head * HD;
#pragma unroll
    for (int dt = 0; dt < 4; ++dt)
#pragma unroll
        for (int a = 0; a < 4; ++a) {
            u32x2 w; w.x = cvt_pk_bf16(O[dt][4 * a] * inv, O[dt][4 * a + 1] * inv); w.y = cvt_pk_bf16(O[dt][4 * a + 2] * inv, O[dt][4 * a + 3] * inv);
            *(u32x2*)(orow + 32 * dt + 8 * a + 4 * kh) = w;
        }
}
__device__ __forceinline__ void attn_phase(const Params& p, PG8_LAS unsigned char* lds) {
    const int G = gridDim.x;
    for (int u = blockIdx.x; u < 256; u += G) { const int qb = 31 - (u >> 3), bn = u & 7; attn_dense_unit(p, lds, bn >> 2, bn & 3, qb); }
    unsigned* ctr = (unsigned*)(p.ws + WS_CTR);
    for (;;) {
        const unsigned idx = wq_next(ctr, lds);
        if (idx >= (unsigned)(MS + LRU_NCHUNK)) break;
        if (idx < (unsigned)MS) sample_row_unit(p, lds, (int)idx); else lru_fixup_unit(p, (int)idx - MS);
    }
}
__device__ __forceinline__ void mid1_phase(const Params& p, PG8_LAS unsigned char* lds) {
    const int G = gridDim.x, c = blockIdx.x;
    constexpr int NA = DB * 8, NB_ = MP / 8, NC_ = LRU_NCHUNK * 8;
    for (int u = c; u < NA; u += G) idx_sample_score_unit(p, u >> 3, u & 7);
    for (int i = 0; i * G < NB_; ++i) { const int sidx = i * G + ((i & 1) ? G - 1 - c : c); __syncthreads(); if (sidx < NB_) idx_prompt_unit(p, lds, NB_ - 1 - sidx); }
    if (MID_DUP == 2 || MID_DUP == 5) for (int i = 0; i * G < NB_; ++i) { const int sidx = i * G + ((i & 1) ? G - 1 - c : c); __syncthreads(); if (sidx < NB_) idx_prompt_unit(p, lds, NB_ - 1 - sidx, MID_DUP == 2); }
    __syncthreads();
    for (int rep = 0; rep < (MID_DUP == 3 ? 2 : 1); ++rep)
        for (int u = c; u < NC_; u += G) lru_local_unit(p, lds, u);
}

__device__ __forceinline__ void prep_phase(const Params& p, PG8_LAS unsigned char* lds) {
    unsigned char* ws = p.ws;
    bf16_t* Wgu1 = (bf16_t*)(ws + WS_WGU1); bf16_t* Wd1 = (bf16_t*)(ws + WS_WD1); bf16_t* Win = (bf16_t*)(ws + WS_WIN); bf16_t* Wout = (bf16_t*)(ws + WS_WOUT);
    bf16_t* Wgu2 = (bf16_t*)(ws + WS_WGU2); bf16_t* Wd2 = (bf16_t*)(ws + WS_WD2); bf16_t* XB = (bf16_t*)(ws + WS_XB);
        PG8_LAS float* tile = (PG8_LAS float*)lds;
        transpose_cvt<1>(p.in[10], D, 2 * DFF, 2 * DFF, Wgu1, tile);
        transpose_cvt<0>(p.in[11], DFF, D, D, Wd1, tile);
        transpose_cvt<0>(p.in[12], D, DIN, DINP, Win, tile);
        transpose_cvt<0>(p.in[20], D, D, D, Wout, tile);
        transpose_cvt<1>(p.in[23], D, 2 * DFF, 2 * DFF, Wgu2, tile);
        transpose_cvt<0>(p.in[24], DFF, D, D, Wd2, tile);
        cvt_x(p.in[0], p.in[1], XB);
        for (int n = 0; n < 8; ++n) { transpose_cvt<0>(p.in[15] + n * 16384, 128, 128, 128, (bf16_t*)(ws + WS_WAT) + n * 16384, tile); transpose_cvt<0>(p.in[17] + n * 16384, 128, 128, 128, (bf16_t*)(ws + WS_WIT) + n * 16384, tile); }
    }

__global__ void __launch_bounds__(NTHREADS, 2) mk_fwd(Params p) {
    extern __shared__ __attribute__((aligned(16))) unsigned char lds_raw[];
    PG8_LAS unsigned char* lds = (PG8_LAS unsigned char*)lds_raw;
    unsigned char* ws = p.ws;
    const int lo = p.ph_lo, hi = p.ph_hi;
    const int G = gridDim.x;
    if (threadIdx.x < 4) ((volatile PG8_LAS unsigned*)(lds + LDS_MISC))[threadIdx.x] = 0u;
    __syncthreads();
    XcdBarrier bar = xcd_barrier_post((unsigned*)(ws + WS_CTL) + (size_t)p.li * XCD_BAR_WORDS, (volatile LAS unsigned*)(lds + LDS_MISC));
#define SEAM(k) do { if (lo <= (k) && (k) + 1 < hi) xcd_barrier(bar); } while (0)
    bf16_t* Wgu1 = (bf16_t*)(ws + WS_WGU1); bf16_t* Wd1 = (bf16_t*)(ws + WS_WD1); bf16_t* Win = (bf16_t*)(ws + WS_WIN); bf16_t* Wout = (bf16_t*)(ws + WS_WOUT);
    bf16_t* Wgu2 = (bf16_t*)(ws + WS_WGU2); bf16_t* Wd2 = (bf16_t*)(ws + WS_WD2);
    bf16_t* XB = (bf16_t*)(ws + WS_XB); bf16_t* H = (bf16_t*)(ws + WS_H); float* T = (float*)(ws + WS_T); float* X1 = (float*)(ws + WS_X1); float* X2 = (float*)(ws + WS_X2);
    bf16_t* CATB = (bf16_t*)(ws + WS_CATB); float* PS = (float*)(ws + WS_PS);
#define IN(k) (lo <= (k) && (k) < hi)
    if (IN(0)) { prep_phase(p, lds); if (REP_T > 1) { __syncthreads(); prep_phase(p, lds); } }
    SEAM(0);
    if (IN(1)) {
        pg8::Gemm g{XB, Wgu1, MPAD, 2 * DFF, D}; pg8::StaticOrder S; S.init(MPAD, 2 * DFF, G, (int)blockIdx.x, D);
        EpiSwiGLU E{H};
        pg8::gemm_phase<EpiSwiGLU, pg8::StaticOrder, true, true>(lds, g, S, E); if (REP_G > 1) { pg8::gemm_phase<EpiSwiGLU, pg8::StaticOrder, true, true>(lds, g, S, E); }
    }
    SEAM(1);
    if (IN(2)) {
        pg8::Gemm g{H, Wd1, MPAD, D, DFF}; SplitOrder S; S.init(D, DFF, G, (int)blockIdx.x);
        EpiResidSplit E{p.in[0], T, PS, 0.5f};
        pg8::gemm_phase<EpiResidSplit, SplitOrder, true, true>(lds, g, S, E); if (REP_G > 1) { pg8::gemm_phase<EpiResidSplit, SplitOrder, true, true>(lds, g, S, E); }
    }
    SEAM(2);
    if (IN(3)) { ln_phase(T, p.in[8], p.in[9], X1, XB, PS, DFF / 256, p.in[1], 0.5f); if (REP_T > 1) ln_phase(T, p.in[8], p.in[9], X1, XB, PS, DFF / 256, p.in[1], 0.5f); }
    SEAM(3);
    if (IN(4)) {
        pg8::Gemm g{XB, Win, MPAD, DINP, D}; pg8::StaticOrder S; S.init(MPAD, DINP, G, (int)blockIdx.x, D);
        EpiWin E{(float*)(ws + WS_XR), (float*)(ws + WS_GG), (bf16_t*)(ws + WS_QB), (bf16_t*)(ws + WS_KB), (bf16_t*)(ws + WS_VB), (float*)(ws + WS_QI), (bf16_t*)(ws + WS_KIH), (bf16_t*)(ws + WS_KIL), (float*)(ws + WS_WI), p.out};
        pg8::gemm_phase<EpiWin, pg8::StaticOrder, true, true>(lds, g, S, E); if (REP_G > 1) { pg8::gemm_phase<EpiWin, pg8::StaticOrder, true, true>(lds, g, S, E); }
    }
    SEAM(4);
    if (IN(5)) mid1_phase(p, lds);
    SEAM(5);
    if (IN(6)) attn_phase(p, lds);
    SEAM(6);
    if (IN(7)) {
        pg8::Gemm g{CATB, Wout, MPAD, D, D}; SplitOrder S; S.init(D, D, G, (int)blockIdx.x);
        EpiResidSplit E{X1, T, PS, 1.0f};
        pg8::gemm_phase<EpiResidSplit, SplitOrder, true, true>(lds, g, S, E); if (REP_G > 1) { pg8::gemm_phase<EpiResidSplit, SplitOrder, true, true>(lds, g, S, E); }
    }
    SEAM(7);
    if (IN(8)) { ln_phase(T, p.in[21], p.in[22], X2, XB, PS, D / 256, X1 + (size_t)MP * D, 1.0f); if (REP_T > 1) ln_phase(T, p.in[21], p.in[22], X2, XB, PS, D / 256, X1 + (size_t)MP * D, 1.0f); }
    SEAM(8);
    if (IN(9)) {
        pg8::Gemm g{XB, Wgu2, MPAD, 2 * DFF, D}; pg8::StaticOrder S; S.init(MPAD, 2 * DFF, G, (int)blockIdx.x, D);
        EpiSwiGLU E{H};
        pg8::gemm_phase<EpiSwiGLU, pg8::StaticOrder, true, true>(lds, g, S, E); if (REP_G > 1) { pg8::gemm_phase<EpiSwiGLU, pg8::StaticOrder, true, true>(lds, g, S, E); }
    }
    SEAM(9);
    if (IN(10)) {
        pg8::Gemm g{H, Wd2, MPAD, D, DFF}; SplitOrder S; S.init(D, DFF, G, (int)blockIdx.x);
        EpiResidSplit E{X2, T, PS, 0.5f};
        pg8::gemm_phase<EpiResidSplit, SplitOrder, true, true>(lds, g, S, E); if (REP_G > 1) { pg8::gemm_phase<EpiResidSplit, SplitOrder, true, true>(lds, g, S, E); }
    }
    SEAM(10);
    if (IN(11)) { ln_phase(T, p.in[25], p.in[26], p.out + O_YP, nullptr, PS, DFF / 256, X2 + (size_t)MP * D, 0.5f); if (REP_T > 1) ln_phase(T, p.in[25], p.in[26], p.out + O_YP, nullptr, PS, DFF / 256, X2 + (size_t)MP * D, 0.5f); }
#undef IN
#undef SEAM
}

}

extern "C" void kernel_launch(void* const* d_in, const int* in_sizes, int n_in, void* d_out, int out_size, void* d_ws, size_t ws_size, hipStream_t stream) {
    static int grid = 0;
    if (grid == 0) {
        if (n_in != 27 || ws_size < WS_END2) { grid = -1; return; }
        int dev = 0, cus = 0;
        if (hipGetDevice(&dev) != hipSuccess || hipDeviceGetAttribute(&cus, hipDeviceAttributeMultiprocessorCount, dev) != hipSuccess) { grid = -1; return; }
        if (hipFuncSetAttribute((const void*)mk_fwd, hipFuncAttributeMaxDynamicSharedMemorySize, LDS_BYTES) != hipSuccess) { grid = -1; return; }
        (void)hipGetLastError();
        grid = cus;
    }
    if (grid < 0) return;
    float* out = (float*)d_out;
    unsigned char* ws = (unsigned char*)d_ws;

    (void)hipMemsetAsync(ws + WS_CTL, 0, CTL_BYTES, stream);
    Params p{};
    for (int i = 0; i < 27; ++i) p.in[i] = (const float*)d_in[i];
    p.out = out; p.ws = ws;
    int nli = 0;
    auto run = [&](int lo, int hi) { p.ph_lo = lo; p.ph_hi = hi; p.li = nli++; hipLaunchKernelGGL(mk_fwd, dim3(grid), dim3(NTHREADS), LDS_BYTES, stream, p); };
    run(0, 12);
}
```

```cpp
#include <hip/hip_runtime.h>
#include <stdint.h>

namespace pg8 {
#define PG8_LAS __attribute__((address_space(3)))
typedef unsigned short bf16_t;
typedef short bf16x8 __attribute__((ext_vector_type(8)));
typedef float f32x4 __attribute__((ext_vector_type(4)));
typedef unsigned u32x4 __attribute__((ext_vector_type(4)));
constexpr int BM = 256, BK = 64, HALF = 128, HTB = HALF * BK * 2  , STAGE_BYTES = 8 * HTB, NXCD = 8, WGM = 8;

__host__ __device__ __forceinline__ int lds_byte(int r, int c) { const int st = (r >> 4) * 2 + (c >> 5), rr = r & 15, cc = c & 31, ob = rr * 64 + cc * 2; return st * 1024 + (ob ^ (((ob >> 9) & 1) << 5)); }
__host__ __device__ __forceinline__ void stage_rc(int b, int& R, int& C) { const int st = b / 1024, sb = b % 1024, swz = sb ^ (((sb >> 9) & 1) << 5); R = (st >> 1) * 16 + swz / 64; C = (st & 1) * 32 + (swz % 64) / 2; }
__host__ __device__ __forceinline__ int perm32(int rho) { const int n = rho >> 4, i = rho & 15; return 8 * (i >> 2) + 4 * n + (i & 3); }

struct Unit { int pm, pn, k0, nt, aux; };
struct Gemm { const bf16_t* A; const bf16_t* Bt; int M, N, K; };

struct StaticOrder {
    int nM, nN, nwg, G, c, ntk;
    __host__ __device__ __forceinline__ void init(int M, int N, int G_, int c_, int K_ = 0) { nM = M / BM; nN = N / BM; nwg = nM * nN; G = G_; c = c_; ntk = K_ / BK; }
    __host__ __device__ __forceinline__ bool next(int i, Unit& u) const {
        const long L = (long)i * G + c; if (L >= nwg) return false;
        int wgid = (int)L; { const int q = nwg / NXCD, r = nwg % NXCD, xcd = wgid % NXCD, off = wgid / NXCD; wgid = (xcd < r ? xcd * (q + 1) : r * (q + 1) + (xcd - r) * q) + off; }
        const int nig = WGM * nN, gid = wgid / nig, fm = gid * WGM, gsz = (nM - fm) < WGM ? (nM - fm) : WGM;
        u.pm = fm + ((wgid % nig) % gsz); u.pn = (wgid % nig) / gsz; u.k0 = 0; u.nt = ntk; u.aux = -1; return true;
    }
    __device__ __forceinline__ void a_ready(const Unit&) const {}
    __device__ __forceinline__ void done(const Unit&) const {}
};

__device__ __forceinline__ unsigned cvt_pk_bf16(float lo, float hi) { unsigned r; asm volatile("v_cvt_pk_bf16_f32 %0, %1, %2" : "=v"(r) : "v"(lo), "v"(hi)); return r; }
typedef float f32x2 __attribute__((ext_vector_type(2)));

template <class Epi, class Sched, bool ALIGN_EPI = false, bool SP2 = false>
__device__ __forceinline__ void gemm_phase(PG8_LAS unsigned char* lds, const Gemm g, const Sched& S, const Epi& E) {
    int tid_v = threadIdx.x; asm volatile("" : "+v"(tid_v));
    const int tid = tid_v, wid = __builtin_amdgcn_readfirstlane(tid >> 6), lane = tid & 63, wr = wid >> 2, wc = wid & 3, fr = lane & 15, fq = lane >> 4;
    const int K = g.K;
    unsigned voffA[2], voffB[2];
#pragma unroll
    for (int i = 0; i < 2; ++i) { int R, C; stage_rc(tid * 16 + i * 8192, R, C); const int Rb = Epi::PERM ? ((R & ~31) + perm32(R & 31)) : R;
        voffA[i] = (unsigned)(R * K + C) * 2u; voffB[i] = (unsigned)(Rb * K + C) * 2u; }
    const size_t kstep = (size_t)(BK * 2);
    const size_t hstep = (size_t)HALF * K * 2;
    const size_t tstep = 2 * hstep;
    const unsigned ldsw = (unsigned)wid * 1024u;
    const int aoff = lds_byte(wr * 64 + fr, fq * 8), boff = lds_byte(wc * 32 + fr, fq * 8);
#define PG8_SA(b, h) (((b) * 2 + (h)) * HTB)
#define PG8_SB(b, h) ((4 + (b) * 2 + (h)) * HTB)
#define PG8_STAGE(bufoff, gbase, voff) do { _Pragma("unroll") for (int _i = 0; _i < 2; ++_i) \
        __builtin_amdgcn_global_load_lds((const unsigned*)((const char*)(gbase) + (voff)[_i]), (PG8_LAS unsigned*)(lds + (bufoff) + ldsw + _i * 8192), 16, 0, 0); } while (0)
#define PG8_LDA(dst, b, h) do { _Pragma("unroll") for (int m = 0; m < 4; ++m) _Pragma("unroll") for (int k = 0; k < 2; ++k) dst[m][k] = *(const PG8_LAS bf16x8*)(lds + PG8_SA(b, h) + aoff + m * 2048 + k * 1024); } while (0)
#define PG8_LDB(dst, b, h) do { _Pragma("unroll") for (int n = 0; n < 2; ++n) _Pragma("unroll") for (int k = 0; k < 2; ++k) dst[n][k] = *(const PG8_LAS bf16x8*)(lds + PG8_SB(b, h) + boff + n * 2048 + k * 1024); } while (0)
#define PG8_MMA(ai, bj, At, Bt) do { __builtin_amdgcn_s_setprio(1); _Pragma("unroll") for (int m = 0; m < 4; ++m) _Pragma("unroll") for (int n = 0; n < 2; ++n) _Pragma("unroll") for (int k = 0; k < 2; ++k) \
        acc[ai][bj][m][n] = __builtin_amdgcn_mfma_f32_16x16x32_bf16(Bt[n][k], At[m][k], acc[ai][bj][m][n], 0, 0, 0); __builtin_amdgcn_s_setprio(0); } while (0)
#define PG8_WAIT_V(n) asm volatile("s_waitcnt vmcnt(" #n ")" ::: "memory")
#define PG8_WAIT_L(n) asm volatile("s_waitcnt lgkmcnt(" #n ")" ::: "memory")
#define PG8_BAR __builtin_amdgcn_s_barrier()
#define PG8_SCHED __builtin_amdgcn_sched_barrier(0)
    Unit cur, nxt; int ui = 0;
    if (!S.next(0, cur)) return;
    f32x4 acc[2][2][4][2];
#pragma unroll
    for (int a = 0; a < 2; ++a)
#pragma unroll
        for (int b = 0; b < 2; ++b)
#pragma unroll
            for (int m = 0; m < 4; ++m)
#pragma unroll
                for (int n = 0; n < 2; ++n) acc[a][b][m][n] = (f32x4){0.f, 0.f, 0.f, 0.f};
    bf16x8 At[4][2], B0[2][2], B1[2][2];
    const char* cA = (const char*)g.A + (size_t)cur.pm * tstep + (size_t)cur.k0 * 2; const char* cB = (const char*)g.Bt + (size_t)cur.pn * tstep + (size_t)cur.k0 * 2;
    S.a_ready(cur);
    if constexpr (SP2) {
        PG8_STAGE(PG8_SB(0, 0), cB, voffB); PG8_STAGE(PG8_SB(0, 1), cB + hstep, voffB); PG8_STAGE(PG8_SA(0, 0), cA, voffA); PG8_STAGE(PG8_SA(0, 1), cA + hstep, voffA);
        if (wr == 1) PG8_BAR;
        PG8_WAIT_V(2); PG8_BAR;
        PG8_STAGE(PG8_SB(1, 0), cB + kstep, voffB); PG8_STAGE(PG8_SA(1, 0), cA + kstep, voffA); PG8_STAGE(PG8_SB(1, 1), cB + hstep + kstep, voffB);
        PG8_WAIT_V(6); PG8_BAR;
    } else {
        PG8_STAGE(PG8_SB(0, 0), cB, voffB); PG8_STAGE(PG8_SA(0, 0), cA, voffA); PG8_STAGE(PG8_SB(0, 1), cB + hstep, voffB); PG8_STAGE(PG8_SA(0, 1), cA + hstep, voffA);
        if (wr == 1) PG8_BAR;
        PG8_WAIT_V(4); PG8_BAR;
        PG8_STAGE(PG8_SB(1, 0), cB + kstep, voffB); PG8_STAGE(PG8_SA(1, 0), cA + kstep, voffA); PG8_STAGE(PG8_SB(1, 1), cB + hstep + kstep, voffB);
        PG8_WAIT_V(6); PG8_BAR;
    }
    for (;;) {
        const bool has_next = S.next(ui + 1, nxt);
        const char* nA = has_next ? (const char*)g.A + (size_t)nxt.pm * tstep + (size_t)nxt.k0 * 2 : cA; const char* nB = has_next ? (const char*)g.Bt + (size_t)nxt.pn * tstep + (size_t)nxt.k0 * 2 : cB;
        const int nt = cur.nt;
        for (int t = 0; t < nt; t += 2) {
            const bool last = (t == nt - 2);
            const char* a1 = cA + (size_t)(t + 1) * kstep;
            const char* a2 = last ? nA : cA + (size_t)(t + 2) * kstep; const char* b2 = last ? nB : cB + (size_t)(t + 2) * kstep;
            const char* a3 = a2 + kstep; const char* b3 = b2 + kstep;
            if (last && has_next) S.a_ready(nxt);
            if constexpr (SP2) {
            PG8_LDB(B0, 0, 0); PG8_LDB(B1, 0, 1); PG8_SCHED; PG8_LDA(At, 0, 0); PG8_STAGE(PG8_SA(1, 1), a1 + hstep, voffA);
            PG8_WAIT_V(8); PG8_WAIT_L(0); PG8_BAR; PG8_MMA(0, 0, At, B0); PG8_MMA(0, 1, At, B1); PG8_BAR; PG8_SCHED;
            PG8_LDA(At, 0, 1); PG8_STAGE(PG8_SB(0, 0), b2, voffB); PG8_STAGE(PG8_SB(0, 1), b2 + hstep, voffB); PG8_STAGE(PG8_SA(0, 0), a2, voffA);
            PG8_WAIT_V(8); PG8_WAIT_L(0); PG8_BAR; PG8_MMA(1, 0, At, B0); PG8_MMA(1, 1, At, B1); PG8_BAR; PG8_SCHED;
            PG8_LDB(B0, 1, 0); PG8_LDB(B1, 1, 1); PG8_SCHED; PG8_LDA(At, 1, 0); PG8_STAGE(PG8_SA(0, 1), a2 + hstep, voffA);
            PG8_WAIT_V(8); PG8_WAIT_L(0); PG8_BAR; PG8_MMA(0, 0, At, B0); PG8_MMA(0, 1, At, B1); PG8_BAR; PG8_SCHED;
            PG8_LDA(At, 1, 1); PG8_STAGE(PG8_SB(1, 0), b3, voffB); PG8_STAGE(PG8_SB(1, 1), b3 + hstep, voffB); PG8_STAGE(PG8_SA(1, 0), a3, voffA);
            PG8_WAIT_V(8); PG8_WAIT_L(0); PG8_BAR; PG8_MMA(1, 0, At, B0); PG8_MMA(1, 1, At, B1); PG8_BAR; PG8_SCHED;
            } else {
            PG8_LDB(B0, 0, 0); PG8_SCHED; PG8_LDA(At, 0, 0); PG8_STAGE(PG8_SA(1, 1), a1 + hstep, voffA);
            PG8_WAIT_L(8); PG8_BAR; PG8_WAIT_L(0); PG8_MMA(0, 0, At, B0); PG8_BAR; PG8_SCHED;
            PG8_LDB(B1, 0, 1); PG8_STAGE(PG8_SB(0, 0), b2, voffB);
            PG8_BAR; PG8_WAIT_L(0); PG8_MMA(0, 1, At, B1); PG8_BAR;
            PG8_LDA(At, 0, 1); PG8_STAGE(PG8_SA(0, 0), a2, voffA);
            PG8_BAR; PG8_WAIT_L(0); PG8_MMA(1, 0, At, B0); PG8_BAR; PG8_SCHED;
            PG8_STAGE(PG8_SB(0, 1), b2 + hstep, voffB);
            PG8_WAIT_V(6); PG8_BAR; PG8_MMA(1, 1, At, B1); PG8_BAR;
            PG8_LDB(B0, 1, 0); PG8_SCHED; PG8_LDA(At, 1, 0); PG8_STAGE(PG8_SA(0, 1), a2 + hstep, voffA);
            PG8_WAIT_L(8); PG8_BAR; PG8_WAIT_L(0); PG8_MMA(0, 0, At, B0); PG8_BAR; PG8_SCHED;
            PG8_LDB(B1, 1, 1); PG8_STAGE(PG8_SB(1, 0), b3, voffB);
            PG8_BAR; PG8_WAIT_L(0); PG8_MMA(0, 1, At, B1); PG8_BAR;
            PG8_LDA(At, 1, 1); PG8_STAGE(PG8_SA(1, 0), a3, voffA);
            PG8_BAR; PG8_WAIT_L(0); PG8_MMA(1, 0, At, B0); PG8_BAR; PG8_SCHED;
            PG8_STAGE(PG8_SB(1, 1), b3 + hstep, voffB);
            PG8_WAIT_V(6); PG8_BAR; PG8_MMA(1, 1, At, B1); PG8_BAR;
            }
        }
        if constexpr (ALIGN_EPI) { if (wr == 0) PG8_BAR; }
        if constexpr (!Epi::AFTER_DRAIN) { E(acc, cur, wr, wc, fr, fq); S.done(cur); }
        if (!has_next) break;
#pragma unroll
        for (int a = 0; a < 2; ++a)
#pragma unroll
            for (int b = 0; b < 2; ++b)
#pragma unroll
                for (int m = 0; m < 4; ++m)
#pragma unroll
                    for (int n = 0; n < 2; ++n) acc[a][b][m][n] = (f32x4){0.f, 0.f, 0.f, 0.f};
        cur = nxt; cA = nA; cB = nB; ++ui;
        if constexpr (ALIGN_EPI) { if (wr == 1) PG8_BAR; }
    }
    PG8_WAIT_V(0);
    if constexpr (!ALIGN_EPI) { if (wr == 0) PG8_BAR; }
    PG8_BAR;
    if constexpr (Epi::AFTER_DRAIN) { E.fused(acc, cur, wr, wc, fr, fq, lds, wid, lane); S.done(cur); }
#undef PG8_SA
#undef PG8_SB
#undef PG8_STAGE
#undef PG8_LDA
#undef PG8_LDB
#undef PG8_MMA
#undef PG8_WAIT_V
#undef PG8_WAIT_L
#undef PG8_BAR
#undef PG8_SCHED
}

}

#define XB_TMO      128
#define XB_XCNT(j)  (256  + 64 * (j))
#define XB_XSUB(j)  (1280 + 64 * (j))
#define XB_XGEN(j)  (2304 + 64 * (j))
#define XB_TOP      3328
#define XB_TOPGEN   3392
#define XCD_BAR_WORDS 3456
#define XB_SPIN_CAP (1u << 18)
#define LAS __attribute__((address_space(3)))

__device__ __forceinline__ unsigned xb_ld(unsigned* p)              { return __hip_atomic_load(p, __ATOMIC_RELAXED, __HIP_MEMORY_SCOPE_AGENT); }
__device__ __forceinline__ unsigned xb_add(unsigned* p, unsigned v) { return __hip_atomic_fetch_add(p, v, __ATOMIC_RELAXED, __HIP_MEMORY_SCOPE_AGENT); }
__device__ __forceinline__ unsigned xb_xcc_id() { return (unsigned)__builtin_amdgcn_s_getreg((3 << 11) | 20) & 0xFu; }
#define XB_SPIN(cond, bar) do { unsigned _sp = 0; while (cond) { __builtin_amdgcn_s_sleep(1); \
    if ((++_sp & 255u) == 0u) { if (xb_ld(&(bar)[XB_TMO])) break; if (_sp > XB_SPIN_CAP) { atomicAdd(&(bar)[XB_TMO], 1u); break; } } } } while (0)

struct XcdBarrier {
    unsigned* bar; unsigned x;
    volatile LAS unsigned* st;
};

__device__ __forceinline__ XcdBarrier xcd_barrier_post(unsigned* bar, volatile LAS unsigned* st) {
    XcdBarrier b; b.bar = bar; b.x = xb_xcc_id(); b.st = st;
    if (threadIdx.x == 0) (void)xb_add(&bar[XB_XCNT(b.x)], 1u);
    return b;
}
__device__ __forceinline__ void xcd_barrier_complete(unsigned* bar, unsigned x, unsigned& nloc, unsigned& nx) {
    const unsigned G = gridDim.x * gridDim.y * gridDim.z;
    unsigned sum, cnt, mine, sp = 0u;
    for (;;) {
        sum = 0u; cnt = 0u; mine = 0u;
#pragma unroll
        for (unsigned j = 0; j < 16; ++j) { const unsigned c = xb_ld(&bar[XB_XCNT(j)]); sum += c; cnt += (c > 0u) ? 1u : 0u; mine = (j == x) ? c : mine; }
        if (sum == G) break;
        __builtin_amdgcn_s_sleep(1);
        if ((++sp & 255u) == 0u) { if (xb_ld(&bar[XB_TMO])) break; if (sp > XB_SPIN_CAP) { atomicAdd(&bar[XB_TMO], 1u); break; } }
    }
    nloc = mine > 0u ? mine : 1u; nx = cnt > 0u ? cnt : 1u;
}

__device__ __forceinline__ void xcd_barrier(const XcdBarrier& b) {
    asm volatile("s_waitcnt vmcnt(0)" ::: "memory");
    __syncthreads();
    if (threadIdx.x == 0) {
        unsigned* bar = b.bar;
        __builtin_amdgcn_s_waitcnt(0);
        unsigned nloc = b.st[0], nx = b.st[1];
        if (nloc == 0u) { xcd_barrier_complete(bar, b.x, nloc, nx); b.st[0] = nloc; b.st[1] = nx; }
        const unsigned old = xb_add(&bar[XB_XSUB(b.x)], 1u);
        const unsigned gen = old / nloc;
        if (old + 1u == (gen + 1u) * nloc) {
            __builtin_amdgcn_fence(__ATOMIC_RELEASE, "agent");
            asm volatile("s_waitcnt vmcnt(0)" ::: "memory");
            const unsigned og = xb_add(&bar[XB_TOP], 1u);
            const unsigned tg = og / nx;
            if (og + 1u == (tg + 1u) * nx) xb_add(&bar[XB_TOPGEN], 1u);
            else XB_SPIN(xb_ld(&bar[XB_TOPGEN]) == tg, bar);
            __builtin_amdgcn_fence(__ATOMIC_ACQUIRE, "agent");
            xb_add(&bar[XB_XGEN(b.x)], 1u);
            asm volatile("s_waitcnt vmcnt(0)" ::: "memory");
        } else {
            XB_SPIN(xb_ld(&bar[XB_XGEN(b.x)]) == gen, bar);
            __builtin_amdgcn_fence(__ATOMIC_ACQUIRE, "agent");
            asm volatile("s_waitcnt vmcnt(0)" ::: "memory");
        }
    }
    __syncthreads();
}


namespace {
typedef unsigned short bf16_t;
typedef float f32x4 __attribute__((ext_vector_type(4)));
typedef unsigned u32x4 __attribute__((ext_vector_type(4)));
typedef unsigned u32x2 __attribute__((ext_vector_type(2)));

constexpr int D = 2048, SEQ = 4096, NB = 2, MP = NB * SEQ, DB = 32, DS = 4, MS = DB * DS, MT = MP + MS, MPAD = 8448;
constexpr int DFF = 5504, DRNN = 1024, HD = 128, NKV = 4, IDH = 8, IDD = 64, DIN = 4680, DINP = 4864;
constexpr int NPAGES = 64, PAGE = 128, NPAST = NPAGES * PAGE, LS = NPAST + DS, TOPK = 256;
constexpr int C_XR = 0, C_GR = 1024, C_Q = 2048, C_K = 3072, C_V = 3584, C_QI = 4096, C_KI = 4608, C_WI = 4672;
constexpr float ALPHA = 1.189207115002721f, LN_EPS = 1e-5f, ATTN_SCALE = 0.08838834764831845f, IDX_SCALE = 0.125f, IDX_W_SCALE = 0.35355339059327373f;
constexpr size_t O_YP = 0, O_YS = 16777216, O_KP = 17039360, O_VP = 21233664, O_KIP = 25427968, O_CP = 25952256, O_HP = 25958400,
                 O_KS = 25960448, O_VS = 26025984, O_KIS = 26091520, O_CS = 26099712, O_HS = 26198016;
constexpr int SCS_LD = 8256;
constexpr int ZLD = DINP;

constexpr size_t al256(size_t x) { return (x + 255) & ~(size_t)255; }
constexpr size_t WS_CTL = 0;
constexpr size_t CTL_BYTES = 65536;
constexpr size_t WS_WGU1 = WS_CTL + CTL_BYTES;
constexpr size_t WS_WD1 = WS_WGU1 + al256((size_t)2 * DFF * D * 2);
constexpr size_t WS_WIN = WS_WD1 + al256((size_t)D * DFF * 2);
constexpr size_t WS_WOUT = WS_WIN + al256((size_t)DINP * D * 2);
constexpr size_t WS_WGU2 = WS_WOUT + al256((size_t)D * D * 2);
constexpr size_t WS_WD2 = WS_WGU2 + al256((size_t)2 * DFF * D * 2);
constexpr size_t WS_XB = WS_WD2 + al256((size_t)D * DFF * 2);
constexpr size_t WS_H = WS_XB + al256((size_t)MPAD * D * 2);
constexpr size_t WS_T = WS_H + al256((size_t)MPAD * DFF * 2);
constexpr size_t WS_X1 = WS_T + al256((size_t)MPAD * D * 4);
constexpr size_t WS_X2 = WS_X1 + al256((size_t)MPAD * D * 4);
constexpr size_t WS_XR = WS_X2 + al256((size_t)MPAD * D * 4);
constexpr size_t WS_GG = WS_XR + al256((size_t)MPAD * DRNN * 4);
constexpr size_t WS_QI = WS_GG + al256((size_t)MPAD * DRNN * 4);
constexpr size_t WS_WI = WS_QI + al256((size_t)MPAD * 512 * 4);
constexpr size_t WS_KIH = WS_WI + al256((size_t)MPAD * 8 * 4);
constexpr size_t WS_KIL = WS_KIH + al256((size_t)MPAD * 64 * 2);
constexpr size_t WS_ZEND = WS_KIL + al256((size_t)MPAD * 64 * 2);
constexpr size_t WS_CATB = WS_ZEND;
constexpr size_t WS_HL = WS_CATB + al256((size_t)MPAD * D * 2);
constexpr size_t WS_PP = WS_HL + al256((size_t)MT * DRNN * 4);
constexpr size_t WS_GI = WS_PP + al256((size_t)MT * DRNN * 4);
constexpr size_t WS_SCP = WS_GI + al256((size_t)MT * DRNN * 4);
constexpr size_t WS_SCS = WS_SCP + al256((size_t)MP * SEQ * 4);
constexpr size_t WS_SEL = WS_SCS + al256((size_t)MS * SCS_LD * 4);
constexpr size_t WS_NSEL = WS_SEL + al256((size_t)MT * TOPK * 4);
constexpr size_t WS_SUMA = WS_NSEL + al256((size_t)MT * 4);
constexpr size_t WS_SUMH = WS_SUMA + al256((size_t)130 * DRNN * 4);
constexpr size_t WS_WAT = WS_SUMH + al256((size_t)130 * DRNN * 4);
constexpr size_t WS_WIT = WS_WAT + al256((size_t)8 * 128 * 128 * 2);
constexpr size_t WS_BM = WS_WIT + al256((size_t)8 * 128 * 128 * 2);
constexpr size_t WS_QB = WS_BM + al256((size_t)MP * 64 * 8);
constexpr size_t WS_KB = WS_QB + al256((size_t)MPAD * 1024 * 2);
constexpr size_t WS_VB = WS_KB + al256((size_t)MPAD * 512 * 2);
constexpr size_t WS_END = WS_VB + al256((size_t)MPAD * 512 * 2);
constexpr size_t WS_PS = WS_END;
constexpr size_t WS_END2 = WS_PS + al256((size_t)21 * MS * D * 4);
constexpr size_t WS_ST = WS_END2;
constexpr size_t WS_END3 = WS_ST + al256((size_t)2 * MP * 2 * 4);
constexpr size_t WS_CTR = WS_CTL + 32768;

constexpr int NWAVES = 8, NTHREADS = 512;
#ifndef REP_6
#define REP_6 1
#endif
#ifndef MID_DUP
#define MID_DUP 0
#endif
#ifndef REP_G
#define REP_G 1
#endif
#ifndef REP_T
#define REP_T 1
#endif
#ifndef REP_5
#define REP_5 2
#endif
constexpr int LDS_STAGE = 131072, LDS_MISC = 134144, LDS_BYTES = 135168;

struct Params {
    const float* in[27];
    float* out;
    unsigned char* ws;
    int ph_lo, ph_hi, li, pad_;
};

__device__ __forceinline__ unsigned cvt_pk_bf16(float lo, float hi) { unsigned r; asm volatile("v_cvt_pk_bf16_f32 %0, %1, %2" : "=v"(r) : "v"(lo), "v"(hi)); return r; }
__device__ __forceinline__ int fresh_tid() { int t = threadIdx.x; asm volatile("" : "+v"(t)); return t; }
__device__ __forceinline__ float sigmoidf_(float x) { return 1.0f / (1.0f + expf(-x)); }
__device__ __forceinline__ float gelu_tanh(float x) { return 0.5f * x * (1.0f + tanhf(0.7978845608028654f * (x + 0.044715f * x * x * x))); }
__device__ __forceinline__ bf16_t f2bf(float f) { return (bf16_t)(cvt_pk_bf16(f, 0.f) & 0xffffu); }

struct EpiSwiGLU {
    static constexpr bool PERM = true, AFTER_DRAIN = false;
    bf16_t* H;
    __device__ __forceinline__ void operator()(const f32x4 (&acc)[2][2][4][2], const pg8::Unit& u, int wr, int wc, int fr, int fq) const {
        const int row0 = u.pm * 256 + wr * 64 + fr, col0 = u.pn * 128 + wc * 32 + 8 * fq;
#pragma unroll
        for (int ai = 0; ai < 2; ++ai)
#pragma unroll
            for (int m = 0; m < 4; ++m) {
                bf16_t* rowp = H + (size_t)(row0 + ai * 128 + m * 16) * DFF + col0;
                float h[8];
#pragma unroll
                for (int n = 0; n < 2; ++n)
#pragma unroll
                    for (int j = 0; j < 4; ++j) {
                        const float g = acc[ai][0][m][n][j], up = acc[ai][1][m][n][j];
                        const float sg = __builtin_amdgcn_rcpf(1.0f + __builtin_amdgcn_exp2f(-1.4426950408889634f * g));
                        h[n * 4 + j] = g * sg * up;
                    }
                u32x4 w; w.x = cvt_pk_bf16(h[0], h[1]); w.y = cvt_pk_bf16(h[2], h[3]); w.z = cvt_pk_bf16(h[4], h[5]); w.w = cvt_pk_bf16(h[6], h[7]);
                *(u32x4*)rowp = w;
            }
    }
};
struct EpiResid {
    static constexpr bool PERM = false, AFTER_DRAIN = false;
    const float* Xp; const float* Xs; float* T; float s;
    __device__ __forceinline__ void operator()(const f32x4 (&acc)[2][2][4][2], const pg8::Unit& u, int wr, int wc, int fr, int fq) const {
        const int row0 = u.pm * 256 + wr * 64 + fr, col0 = u.pn * 256 + wc * 32 + 4 * fq;
#pragma unroll
        for (int ai = 0; ai < 2; ++ai)
#pragma unroll
            for (int m = 0; m < 4; ++m) {
                const int row = row0 + ai * 128 + m * 16;
                if (row < MT) {
                    const float* xr = (row < MP) ? Xp + (size_t)row * D + col0 : Xs + (size_t)(row - MP) * D + col0;
                    float* tr = T + (size_t)row * D + col0;
#pragma unroll
                    for (int bj = 0; bj < 2; ++bj)
#pragma unroll
                        for (int n = 0; n < 2; ++n) { const f32x4 xv = *(const f32x4*)(xr + bj * 128 + n * 16); *(f32x4*)(tr + bj * 128 + n * 16) = xv * ALPHA + acc[ai][bj][m][n] * s; }
                }
            }
    }
};
struct EpiF32 {
    static constexpr bool PERM = false, AFTER_DRAIN = false;
    float* C; int ldc;
    __device__ __forceinline__ void operator()(const f32x4 (&acc)[2][2][4][2], const pg8::Unit& u, int wr, int wc, int fr, int fq) const {
        const int row0 = u.pm * 256 + wr * 64 + fr, col0 = u.pn * 256 + wc * 32 + 4 * fq;
#pragma unroll
        for (int ai = 0; ai < 2; ++ai)
#pragma unroll
            for (int m = 0; m < 4; ++m) {
                float* rowp = C + (size_t)(row0 + ai * 128 + m * 16) * ldc + col0;
#pragma unroll
                for (int bj = 0; bj < 2; ++bj)
#pragma unroll
                    for (int n = 0; n < 2; ++n) *(f32x4*)(rowp + bj * 128 + n * 16) = acc[ai][bj][m][n];
            }
    }
};


struct EpiWin {
    static constexpr bool PERM = false, AFTER_DRAIN = false;
    float* XR; float* GG; bf16_t* QB; bf16_t* KB; bf16_t* VB; float* QI; bf16_t* KIH; bf16_t* KIL; float* WI; float* out;
    template <class F> __device__ __forceinline__ void each(const f32x4 (&acc)[2][2][4][2], const pg8::Unit& u, int wr, int wc, int fr, int fq, F f) const {
        const int row0 = u.pm * 256 + wr * 64 + fr, cl = wc * 32 + 4 * fq;
#pragma unroll
        for (int ai = 0; ai < 2; ++ai)
#pragma unroll
            for (int m = 0; m < 4; ++m)
#pragma unroll
                for (int bj = 0; bj < 2; ++bj)
#pragma unroll
                    for (int n = 0; n < 2; ++n) f(row0 + ai * 128 + m * 16, cl + 128 * bj + 16 * n, acc[ai][bj][m][n]);
    }
    static __device__ __forceinline__ u32x2 pk4(const f32x4 v) { u32x2 w; w.x = cvt_pk_bf16(v[0], v[1]); w.y = cvt_pk_bf16(v[2], v[3]); return w; }
    __device__ __forceinline__ void operator()(const f32x4 (&acc)[2][2][4][2], const pg8::Unit& u, int wr, int wc, int fr, int fq) const {
        const int pn = u.pn;
        if (pn < 4) each(acc, u, wr, wc, fr, fq, [&](int row, int c, const f32x4 v) { *(f32x4*)(XR + (size_t)row * DRNN + pn * 256 + c) = v; });
        else if (pn < 8) each(acc, u, wr, wc, fr, fq, [&](int row, int c, const f32x4 v) { *(f32x4*)(GG + (size_t)row * DRNN + (pn - 4) * 256 + c) = (f32x4){gelu_tanh(v[0]), gelu_tanh(v[1]), gelu_tanh(v[2]), gelu_tanh(v[3])}; });
        else if (pn < 12) each(acc, u, wr, wc, fr, fq, [&](int row, int c, const f32x4 v) { *(u32x2*)(QB + (size_t)row * 1024 + (pn - 8) * 256 + c) = pk4(v); });
        else if (pn < 16) {
            bf16_t* B = (pn < 14) ? KB : VB; const size_t op = (pn < 14) ? O_KP : O_VP, os = (pn < 14) ? O_KS : O_VS; const int c0 = (pn & 1) * 256;
            each(acc, u, wr, wc, fr, fq, [&](int row, int c, const f32x4 v) {
                *(u32x2*)(B + (size_t)row * 512 + c0 + c) = pk4(v);
                if (row < MT) *(f32x4*)(out + (row < MP ? op + (size_t)row * 512 : os + (size_t)(row - MP) * 512) + c0 + c) = v; });
        }
        else if (pn < 18) each(acc, u, wr, wc, fr, fq, [&](int row, int c, const f32x4 v) { *(f32x4*)(QI + (size_t)row * 512 + (pn - 16) * 256 + c) = v; });
        else each(acc, u, wr, wc, fr, fq, [&](int row, int c, const f32x4 v) {
            if (c < 64) {
                const u32x2 h = pk4(v);
                u32x2 l; l.x = cvt_pk_bf16(v[0] - __uint_as_float(h.x << 16), v[1] - __uint_as_float(h.x & 0xffff0000u)); l.y = cvt_pk_bf16(v[2] - __uint_as_float(h.y << 16), v[3] - __uint_as_float(h.y & 0xffff0000u));
                *(u32x2*)(KIH + (size_t)row * 64 + c) = h; *(u32x2*)(KIL + (size_t)row * 64 + c) = l;
                if (row < MT) *(f32x4*)(out + (row < MP ? O_KIP + (size_t)row * 64 : O_KIS + (size_t)(row - MP) * 64) + c) = v;
            } else if (c < 72) *(f32x4*)(WI + (size_t)row * 8 + (c - 64)) = v; });
    }
};


struct SplitOrder {
    pg8::StaticOrder base; int G, c, nmine, npiece, ntk, nN;
    __device__ __forceinline__ void init(int N, int K, int G_, int c_) { base.init(MP, N, G_, c_, K); G = G_; c = c_; nN = N / 256; ntk = K / 64; npiece = ntk / 4; nmine = (c_ < base.nwg) ? (base.nwg - c_ + G_ - 1) / G_ : 0; }
    __device__ __forceinline__ bool next(int i, pg8::Unit& u) const {
        if (i < nmine) return base.next(i, u);
        const int mi = (i - nmine) * G + c; if (mi >= npiece * nN) return false;
        const int kp = mi / nN; u.pm = MP / 256; u.pn = mi % nN; u.k0 = kp * 256; u.nt = (kp == npiece - 1) ? ntk - 4 * (npiece - 1) : 4; u.aux = kp; return true;
    }
    __device__ __forceinline__ void a_ready(const pg8::Unit&) const {}
    __device__ __forceinline__ void done(const pg8::Unit&) const {}
};
struct EpiResidSplit {
    static constexpr bool PERM = false, AFTER_DRAIN = false;
    const float* X; float* T; float* PS; float s; const float* ST; const float* gn; const float* bn;
    __device__ __forceinline__ void operator()(const f32x4 (&acc)[2][2][4][2], const pg8::Unit& u, int wr, int wc, int fr, int fq) const {
        const int col0 = u.pn * 256 + wc * 32 + 4 * fq;
        if (u.aux < 0) {
            const int row0 = u.pm * 256 + wr * 64 + fr;
            if (ST == nullptr) {
#pragma unroll
                for (int ai = 0; ai < 2; ++ai)
#pragma unroll
                    for (int m = 0; m < 4; ++m) {
                        const size_t off = (size_t)(row0 + ai * 128 + m * 16) * D + col0;
#pragma unroll
                        for (int bj = 0; bj < 2; ++bj)
#pragma unroll
                            for (int n = 0; n < 2; ++n) { const f32x4 xv = *(const f32x4*)(X + off + bj * 128 + n * 16); *(f32x4*)(T + off + bj * 128 + n * 16) = xv * ALPHA + acc[ai][bj][m][n] * s; }
                    }
            } else {
                f32x4 gv[2][2], bv[2][2];
#pragma unroll
                for (int bj = 0; bj < 2; ++bj)
#pragma unroll
                    for (int n = 0; n < 2; ++n) { gv[bj][n] = *(const f32x4*)(gn + col0 + bj * 128 + n * 16); bv[bj][n] = *(const f32x4*)(bn + col0 + bj * 128 + n * 16); }
#pragma unroll
                for (int ai = 0; ai < 2; ++ai)
#pragma unroll
                    for (int m = 0; m < 4; ++m) {
                        const int row = row0 + ai * 128 + m * 16;
                        const size_t off = (size_t)row * D + col0;
                        const float mean = ST[2 * row], rstd = ST[2 * row + 1];
#pragma unroll
                        for (int bj = 0; bj < 2; ++bj)
#pragma unroll
                            for (int n = 0; n < 2; ++n) { const f32x4 tv = *(const f32x4*)(T + off + bj * 128 + n * 16); const f32x4 xv = (tv - mean) * rstd * gv[bj][n] + bv[bj][n];
                                *(f32x4*)(T + off + bj * 128 + n * 16) = xv * ALPHA + acc[ai][bj][m][n] * s; }
                    }
            }
        } else {
            float* slab = PS + (size_t)u.aux * MS * D;
#pragma unroll
            for (int m = 0; m < 4; ++m) {
                float* rp = slab + (size_t)(wr * 64 + m * 16 + fr) * D + col0;
#pragma unroll
                for (int bj = 0; bj < 2; ++bj)
#pragma unroll
                    for (int n = 0; n < 2; ++n) *(f32x4*)(rp + bj * 128 + n * 16) = acc[0][bj][m][n];
            }
        }
    }
};

template <int MODE>
__device__ __forceinline__ void transpose_cvt(const float* __restrict__ W, int K, int N, int Npad, bf16_t* __restrict__ Wt, PG8_LAS float* tile, int wid, int nw) {
    const int tid = fresh_tid(), ntn = Npad / 64, ntk = K / 128, ntiles = ntn * ntk;
    const int lk = tid >> 4, ln4 = (tid & 15) * 4;
    f32x4 v[4];
    auto src0 = [&](int t) { const int n0 = (t % ntn) * 64; if (MODE == 1) { const int t256 = n0 >> 8, j = n0 & 255; return (j < 128) ? t256 * 128 + j : DFF + t256 * 128 + (j - 128); } return n0; };
    auto gload = [&](int t) {
        const int k0 = (t / ntn) * 128, s0 = src0(t);
#pragma unroll
        for (int i = 0; i < 4; ++i) {
            const float* q = W + (size_t)(k0 + lk + 32 * i) * N + s0 + ln4;
            if (MODE == 1 || s0 + ln4 + 3 < N) v[i] = *(const f32x4*)q;
            else { v[i] = (f32x4){0.f, 0.f, 0.f, 0.f}; for (int e = 0; e < 4; ++e) if (s0 + ln4 + e < N) v[i][e] = q[e]; }
        }
    };
    int t = wid;
    if (t < ntiles) gload(t);
    for (; t < ntiles; t += nw) {
#pragma unroll
        for (int i = 0; i < 4; ++i)
#pragma unroll
            for (int e = 0; e < 4; ++e) tile[(lk + 32 * i) * 65 + ln4 + e] = v[i][e];
        const int tn = t + nw;
        if (tn < ntiles) gload(tn);
        __syncthreads();
        {
            const int n0 = (t % ntn) * 64, k0 = (t / ntn) * 128;
            const int n = tid >> 3, kq = (tid & 7) * 16;
#pragma unroll
            for (int h = 0; h < 2; ++h) {
                float x[8];
#pragma unroll
                for (int j = 0; j < 8; ++j) x[j] = tile[(kq + 8 * h + j) * 65 + n];
                u32x4 w; w.x = cvt_pk_bf16(x[0], x[1]); w.y = cvt_pk_bf16(x[2], x[3]); w.z = cvt_pk_bf16(x[4], x[5]); w.w = cvt_pk_bf16(x[6], x[7]);
                *(u32x4*)(Wt + (size_t)(n0 + n) * K + k0 + kq + 8 * h) = w;
            }
        }
        __syncthreads();
    }
}
__device__ __forceinline__ void cvt_x(const float* __restrict__ xp, const float* __restrict__ xs, bf16_t* __restrict__ XB) {
    const size_t n4 = (size_t)MPAD * D / 4;
    for (size_t i = (size_t)blockIdx.x * NTHREADS + threadIdx.x; i < n4; i += (size_t)gridDim.x * NTHREADS) {
        const size_t e = i * 4, row = e / D;
        f32x4 v = (f32x4){0.f, 0.f, 0.f, 0.f};
        if (row < (size_t)MP) v = *(const f32x4*)(xp + e); else if (row < (size_t)MT) v = *(const f32x4*)(xs + (e - (size_t)MP * D));
        u32x2 w; w.x = cvt_pk_bf16(v[0], v[1]); w.y = cvt_pk_bf16(v[2], v[3]);
        *(u32x2*)(XB + e) = w;
    }
}
__device__ __forceinline__ void ln_phase(const float* __restrict__ T, const float* __restrict__ g, const float* __restrict__ b, float* __restrict__ Xo, bf16_t* __restrict__ Xb,
                                         const float* __restrict__ PS, int npiece, const float* __restrict__ Xs, float sres, float* __restrict__ ST) {
    const int tid_ = fresh_tid(), lane = tid_ & 63, wave = tid_ >> 6;
    for (int row = blockIdx.x * NWAVES + wave; row < MT; row += gridDim.x * NWAVES) {
        f32x4 v[8]; float s = 0.f;
        if (row < MP) {
            const float* tr = T + (size_t)row * D + lane * 4;
#pragma unroll
            for (int i = 0; i < 8; ++i) v[i] = *(const f32x4*)(tr + 256 * i);
        } else {
            const size_t ro = (size_t)(row - MP) * D + lane * 4;
#pragma unroll
            for (int i = 0; i < 8; ++i) v[i] = (f32x4){0.f, 0.f, 0.f, 0.f};
#pragma unroll 1
            for (int pz = 0; pz < npiece; ++pz) {
                const float* sp = PS + (size_t)pz * MS * D + ro;
#pragma unroll
                for (int i = 0; i < 8; ++i) v[i] += *(const f32x4*)(sp + 256 * i);
            }
#pragma unroll
            for (int i = 0; i < 8; ++i) v[i] = *(const f32x4*)(Xs + ro + 256 * i) * ALPHA + v[i] * sres;
        }
#pragma unroll
        for (int i = 0; i < 8; ++i) s += (v[i][0] + v[i][1]) + (v[i][2] + v[i][3]);
#pragma unroll
        for (int o = 32; o >= 1; o >>= 1) s += __shfl_xor(s, o);
        const float mean = s * (1.0f / D);
        float q = 0.f;
#pragma unroll
        for (int i = 0; i < 8; ++i) { const f32x4 d = v[i] - mean; q += (d[0] * d[0] + d[1] * d[1]) + (d[2] * d[2] + d[3] * d[3]); }
#pragma unroll
        for (int o = 32; o >= 1; o >>= 1) q += __shfl_xor(q, o);
        const float rstd = rsqrtf(q * (1.0f / D) + LN_EPS);
        if (ST && row < MP && lane == 0) { ST[2 * row] = mean; ST[2 * row + 1] = rstd; }
        const float* gq = g; const float* bq = b; asm volatile("" : "+s"(gq), "+s"(bq));
#pragma unroll
        for (int i = 0; i < 8; ++i) {
            const f32x4 o = (v[i] - mean) * rstd * *(const f32x4*)(gq + lane * 4 + 256 * i) + *(const f32x4*)(bq + lane * 4 + 256 * i);
            if (Xo && (ST == nullptr || row >= MP)) *(f32x4*)(Xo + (size_t)row * D + lane * 4 + 256 * i) = o;
            if (Xb) { u32x2 w; w.x = cvt_pk_bf16(o[0], o[1]); w.y = cvt_pk_bf16(o[2], o[3]); *(u32x2*)(Xb + (size_t)row * D + lane * 4 + 256 * i) = w; }
        }
    }
}

typedef short bf16x8 __attribute__((ext_vector_type(8)));
typedef float f32x16 __attribute__((ext_vector_type(16)));
__device__ __forceinline__ int crow(int reg, int h) { return (reg & 3) + 8 * (reg >> 2) + 4 * h; }
constexpr int LRU_CH = 64, LRU_NCHUNK = MT / LRU_CH  , LRU_PCHUNK = MP / LRU_CH  , LRU_CPB = SEQ / LRU_CH  ;
constexpr int L_XCF = 0, L_XCB = 32768, L_AA = 50176, L_UU = 82944, XCB_PITCH = 272;
__device__ __forceinline__ void lru_local_unit(const Params& p, PG8_LAS unsigned char* lds, int u) {
    const int tid = fresh_tid(), lane = tid & 63, wave = tid >> 6;
    unsigned char* ws = p.ws;
    const float* XR = (const float*)(ws + WS_XR);
    const float* state_conv = p.in[5]; const float* state_rnn = p.in[6];
    const float* cw = p.in[13]; const float* cb = p.in[14];
    const float* ba = p.in[16]; const float* bi = p.in[18]; const float* lam = p.in[19];
    const bf16_t* WAt = (const bf16_t*)(ws + WS_WAT); const bf16_t* WIt = (const bf16_t*)(ws + WS_WIT);
    float* HL = (float*)(ws + WS_HL); float* PP = (float*)(ws + WS_PP); float* SUMA = (float*)(ws + WS_SUMA); float* SUMH = (float*)(ws + WS_SUMH);
    float* out = p.out;
    PG8_LAS float* XCF = (PG8_LAS float*)(lds + L_XCF); PG8_LAS float* AA = (PG8_LAS float*)(lds + L_AA); PG8_LAS float* UU = (PG8_LAS float*)(lds + L_UU);
    {
        const int ck = u >> 3, nb = u & 7;
        {
            const int c = tid & 127, rg = tid >> 7, ch = nb * 128 + c;
            const float w0 = cw[ch], w1 = cw[DRNN + ch], w2 = cw[2 * DRNN + ch], w3 = cw[3 * DRNN + ch], cbv = cb[ch];
            if (ck < LRU_PCHUNK) {
                const int b = ck / LRU_CPB, t0 = (ck % LRU_CPB) * LRU_CH + rg * 16;
                const float* zc = XR + (size_t)(b * SEQ) * DRNN + ch;
                float x0 = (t0 - 3 >= 0) ? zc[(size_t)(t0 - 3) * DRNN] : 0.f, x1 = (t0 - 2 >= 0) ? zc[(size_t)(t0 - 2) * DRNN] : 0.f, x2 = (t0 - 1 >= 0) ? zc[(size_t)(t0 - 1) * DRNN] : 0.f;
#pragma unroll
                for (int i = 0; i < 16; ++i) {
                    const int t = t0 + i, lr = rg * 16 + i;
                    const float x3 = zc[(size_t)t * DRNN];
                    const float xc = cbv + w0 * x0 + w1 * x1 + w2 * x2 + w3 * x3;
                    XCF[lr * 128 + c] = xc;
                    *(PG8_LAS bf16_t*)(lds + L_XCB + lr * XCB_PITCH + c * 2) = f2bf(xc);
                    if (t >= SEQ - 3) out[O_CP + (size_t)(b * 3 + (t - (SEQ - 3))) * DRNN + ch] = x3;
                    x0 = x1; x1 = x2; x2 = x3;
                }
            } else {
#pragma unroll
                for (int i = 0; i < 16; ++i) {
                    const int lr = rg * 16 + i, rs = (ck - LRU_PCHUNK) * LRU_CH + lr, bs = rs >> 2, tt = rs & 3;
                    float xv[4];
#pragma unroll
                    for (int j = 0; j < 4; ++j) { const int pp = tt + j; xv[j] = (pp < 3) ? state_conv[(size_t)(bs * 3 + pp) * DRNN + ch] : XR[(size_t)(MP + bs * DS + pp - 3) * DRNN + ch]; }
                    const float xc = cbv + w0 * xv[0] + w1 * xv[1] + w2 * xv[2] + w3 * xv[3];
                    XCF[lr * 128 + c] = xc;
                    *(PG8_LAS bf16_t*)(lds + L_XCB + lr * XCB_PITCH + c * 2) = f2bf(xc);
                    if (tt >= 1) out[O_CS + (size_t)(bs * 3 + (tt - 1)) * DRNN + ch] = xv[3];
                }
            }
        }
        __syncthreads();
        {
            const int mt = wave >> 2, nt = wave & 3, r = lane & 31, kh = lane >> 5;
            f32x16 acc_a, acc_i;
#pragma unroll
            for (int i = 0; i < 16; ++i) { acc_a[i] = 0.f; acc_i[i] = 0.f; }
            const bf16_t* wa = WAt + (size_t)nb * 16384 + (size_t)(nt * 32 + r) * 128 + kh * 8;
            const bf16_t* wi = WIt + (size_t)nb * 16384 + (size_t)(nt * 32 + r) * 128 + kh * 8;
#pragma unroll
            for (int ks = 0; ks < 8; ++ks) {
                const bf16x8 af = *(const PG8_LAS bf16x8*)(lds + L_XCB + (mt * 32 + r) * XCB_PITCH + (ks * 16 + kh * 8) * 2);
                const bf16x8 bfa = *(const bf16x8*)(wa + ks * 16);
                const bf16x8 bfi = *(const bf16x8*)(wi + ks * 16);
                acc_a = __builtin_amdgcn_mfma_f32_32x32x16_bf16(af, bfa, acc_a, 0, 0, 0);
                acc_i = __builtin_amdgcn_mfma_f32_32x32x16_bf16(af, bfi, acc_i, 0, 0, 0);
            }
            const int col = nt * 32 + r, ch = nb * 128 + col, hh = lane >> 5;
            const float l = lam[ch], sp = (-l > 20.f) ? -l : log1pf(expf(-l)), bac = ba[ch], bic = bi[ch];
#pragma unroll
            for (int i = 0; i < 16; ++i) {
                const int lr = mt * 32 + crow(i, hh);
                const float xc = XCF[lr * 128 + col];
                const float rg = __builtin_amdgcn_rcpf(1.0f + __builtin_amdgcn_exp2f(-1.4426950408889634f * (acc_a[i] + bac)));
                const float ig = __builtin_amdgcn_rcpf(1.0f + __builtin_amdgcn_exp2f(-1.4426950408889634f * (acc_i[i] + bic)));
                const float log_a = -8.0f * rg * sp, x = 2.0f * log_a;
                float om;
                if (x > -0.25f) { float q = 1.0f / 720.0f; q = q * x + 1.0f / 120.0f; q = q * x + 1.0f / 24.0f; q = q * x + 1.0f / 6.0f; q = q * x + 0.5f; q = q * x + 1.0f; om = -x * q; }
                else om = -expm1f(x);
                AA[lr * 128 + col] = __builtin_amdgcn_exp2f(1.4426950408889634f * log_a);
                UU[lr * 128 + col] = __builtin_amdgcn_sqrtf(om) * ig * xc;
            }
        }
        __syncthreads();
        {
            const int c = tid & 127, sg = tid >> 7, ch = nb * 128 + c;
            PG8_LAS float* SEG = (PG8_LAS float*)(lds + L_XCF);
            float hv[16], pv[16];
            float h = 0.f, P = 1.f;
            const bool prompt = ck < LRU_PCHUNK;
#pragma unroll
            for (int i = 0; i < 16; ++i) {
                const int lr = sg * 16 + i;
                const float a = AA[lr * 128 + c], uu = UU[lr * 128 + c];
                if (!prompt && (i & 3) == 0) { h = state_rnn[(size_t)(((ck - LRU_PCHUNK) * LRU_CH + lr) >> 2) * DRNN + ch]; P = 0.f; }
                h = a * h + uu; P *= a;
                hv[i] = h; pv[i] = P;
            }
            SEG[(sg * 128 + c) * 2] = P; SEG[(sg * 128 + c) * 2 + 1] = h;
            __syncthreads();
            float cin = 0.f, pin = 1.f;
            if (prompt) {
#pragma unroll
                for (int s2 = 0; s2 < 3; ++s2) if (s2 < sg) { const float ps = SEG[(s2 * 128 + c) * 2], hs = SEG[(s2 * 128 + c) * 2 + 1]; cin = ps * cin + hs; pin *= ps; }
            }
#pragma unroll
            for (int i = 0; i < 16; ++i) {
                const int lr = sg * 16 + i;
                const size_t g = (size_t)(ck * LRU_CH + lr) * DRNN + ch;
                const float hf = prompt ? hv[i] + pv[i] * cin : hv[i];
                HL[g] = hf; PP[g] = prompt ? pv[i] * pin : 0.f;
                if (!prompt && (i & 3) == 3) out[O_HS + (size_t)(((ck - LRU_PCHUNK) * LRU_CH + lr) >> 2) * DRNN + ch] = hf;
            }
            if (sg == 3) { SUMA[(size_t)ck * DRNN + ch] = prompt ? pv[15] * pin : 0.f; SUMH[(size_t)ck * DRNN + ch] = prompt ? hv[15] + pv[15] * cin : 0.f; }
        }
        __syncthreads();
    }
}
__device__ __forceinline__ void lru_fixup_unit(const Params& p, int ck) {
    const int tid = fresh_tid(), ch = tid * 2;
    unsigned char* ws = p.ws;
    const float* GG = (const float*)(ws + WS_GG);
    const float* HL = (const float*)(ws + WS_HL); const float* PP = (const float*)(ws + WS_PP); const float* SUMA = (const float*)(ws + WS_SUMA); const float* SUMH = (const float*)(ws + WS_SUMH);
    bf16_t* CATB = (bf16_t*)(ws + WS_CATB); float* PS = (float*)(ws + WS_PS);
    typedef float f32x2 __attribute__((ext_vector_type(2)));
    f32x2 carry = (f32x2){0.f, 0.f};
    const bool prompt = ck < LRU_PCHUNK;
    if (prompt) {
        const int b = ck / LRU_CPB, kk = ck % LRU_CPB;
#pragma unroll 4
        for (int j = 0; j < kk; ++j) {
            const f32x2 A = *(const f32x2*)(SUMA + (size_t)(b * LRU_CPB + j) * DRNN + ch), Hh = *(const f32x2*)(SUMH + (size_t)(b * LRU_CPB + j) * DRNN + ch);
            carry = A * carry + Hh;
        }
    }
#pragma unroll 4
    for (int lr = 0; lr < LRU_CH; ++lr) {
        const size_t grow = (size_t)(ck * LRU_CH + lr);
        const f32x2 hl = *(const f32x2*)(HL + grow * DRNN + ch), pp = *(const f32x2*)(PP + grow * DRNN + ch), gg = *(const f32x2*)(GG + grow * DRNN + ch);
        const f32x2 h = hl + pp * carry;
        *(unsigned*)(CATB + grow * D + ch) = cvt_pk_bf16(h.x * gg.x, h.y * gg.y);
        if (prompt && (ck % LRU_CPB) == LRU_CPB - 1 && lr == LRU_CH - 1) *(f32x2*)(p.out + O_HP + (size_t)(ck / LRU_CPB) * DRNN + ch) = h;
    }
}


constexpr int IDX_SPLIT = 1;
constexpr int SCP_LD = 4096, SCS_LDL = 8200;
__device__ __forceinline__ unsigned fkey(float f) { const unsigned u = __float_as_uint(f); return (u & 0x80000000u) ? ~u : (u | 0x80000000u); }
__device__ __forceinline__ int mbcnt64(unsigned long long m) { return (int)__builtin_amdgcn_mbcnt_hi((unsigned)(m >> 32), __builtin_amdgcn_mbcnt_lo((unsigned)m, 0u)); }
template <int NB> __device__ __forceinline__ int wave_sum_small(unsigned c) {
    int t = 0;
#pragma unroll
    for (int b = 0; b < NB; ++b) t += __popcll(__ballot((c >> b) & 1u)) << b;
    return t;
}
__device__ __forceinline__ void split8(const f32x4 a, const f32x4 b, bf16x8& hi, bf16x8& lo) {
    u32x4 h; h.x = cvt_pk_bf16(a[0], a[1]); h.y = cvt_pk_bf16(a[2], a[3]); h.z = cvt_pk_bf16(b[0], b[1]); h.w = cvt_pk_bf16(b[2], b[3]);
    u32x4 l;
    l.x = cvt_pk_bf16(a[0] - __uint_as_float(h.x << 16), a[1] - __uint_as_float(h.x & 0xffff0000u));
    l.y = cvt_pk_bf16(a[2] - __uint_as_float(h.y << 16), a[3] - __uint_as_float(h.y & 0xffff0000u));
    l.z = cvt_pk_bf16(b[0] - __uint_as_float(h.z << 16), b[1] - __uint_as_float(h.z & 0xffff0000u));
    l.w = cvt_pk_bf16(b[2] - __uint_as_float(h.w << 16), b[3] - __uint_as_float(h.w & 0xffff0000u));
    hi = __builtin_bit_cast(bf16x8, h); lo = __builtin_bit_cast(bf16x8, l);
}
struct IdxQ { bf16x8 hi[4], lo[4]; float w[16]; };
struct IdxRaw { f32x4 v[8]; };
struct IdxKey { bf16x8 hi[4], lo[4]; };
__device__ __forceinline__ void idx_load_q(IdxQ& q, const float* QI, const float* WI, int grow0, int lane) {
    const int rho = lane & 31, kh = lane >> 5, ql = 2 * ((rho >> 2) & 1) + (rho >> 4), head = 4 * ((rho >> 3) & 1) + (rho & 3);
    const float* src = QI + (size_t)(grow0 + ql) * 512 + head * IDD + kh * 8;
#pragma unroll
    for (int ks = 0; ks < 4; ++ks) { const f32x4 a = *(const f32x4*)(src + ks * 16), b = *(const f32x4*)(src + ks * 16 + 4); split8(a, b, q.hi[ks], q.lo[ks]); }
#pragma unroll
    for (int e = 0; e < 2; ++e) {
        const float* wsrc = WI + (size_t)(grow0 + 2 * kh + e) * 8;
        const f32x4 a = *(const f32x4*)wsrc, b = *(const f32x4*)(wsrc + 4);
#pragma unroll
        for (int i = 0; i < 4; ++i) { q.w[e * 8 + i] = a[i] * IDX_W_SCALE; q.w[e * 8 + 4 + i] = b[i] * IDX_W_SCALE; }
    }
}
__device__ __forceinline__ void idx_load_raw(IdxRaw& raw, const float* kp) {
#pragma unroll
    for (int ks = 0; ks < 4; ++ks) { raw.v[2 * ks] = *(const f32x4*)(kp + ks * 16); raw.v[2 * ks + 1] = *(const f32x4*)(kp + ks * 16 + 4); }
}
__device__ __forceinline__ void idx_cvt_key(const IdxRaw& raw, IdxKey& k) {
#pragma unroll
    for (int ks = 0; ks < 4; ++ks) split8(raw.v[2 * ks], raw.v[2 * ks + 1], k.hi[ks], k.lo[ks]);
}
__device__ __forceinline__ void idx_load_keyb(IdxKey& k, const bf16_t* ph, const bf16_t* pl) {
#pragma unroll
    for (int ks = 0; ks < 4; ++ks) { k.hi[ks] = *(const bf16x8*)(ph + ks * 16); if (IDX_SPLIT == 3) k.lo[ks] = *(const bf16x8*)(pl + ks * 16); else k.lo[ks] = k.hi[ks]; }
}
__device__ __forceinline__ void idx_tile(const IdxQ& q, const IdxKey& k, float (&s)[2]) {
    f32x16 acc;
#pragma unroll
    for (int i = 0; i < 16; ++i) acc[i] = 0.f;
#pragma unroll
    for (int ks = 0; ks < 4; ++ks) {
        acc = __builtin_amdgcn_mfma_f32_32x32x16_bf16(q.hi[ks], k.hi[ks], acc, 0, 0, 0);
        if (IDX_SPLIT == 3) { acc = __builtin_amdgcn_mfma_f32_32x32x16_bf16(q.hi[ks], k.lo[ks], acc, 0, 0, 0); acc = __builtin_amdgcn_mfma_f32_32x32x16_bf16(q.lo[ks], k.hi[ks], acc, 0, 0, 0); }
    }
#pragma unroll
    for (int e = 0; e < 2; ++e) {
        float t = 0.f;
#pragma unroll
        for (int i = 0; i < 8; ++i) t += fmaxf(acc[e * 8 + i] * IDX_SCALE, 0.f) * q.w[e * 8 + i];
        s[e] = t;
    }
}

#define wlane2(vlo, vhi, m, j) asm volatile("s_nop 3\n\tv_writelane_b32 %0, %2, %4\n\tv_writelane_b32 %1, %3, %4" : "+v"(vlo), "+v"(vhi) : "s"((unsigned)(m)), "s"((unsigned)((m) >> 32)), "n"(j))
__device__ __forceinline__ int count8_ge(unsigned a0, unsigned a1, unsigned a2, unsigned a3, unsigned a4, unsigned a5, unsigned a6, unsigned a7, unsigned cand) {
    unsigned long long m0, m1, m2, m3, m4, m5, m6, m7;
    asm volatile("v_cmp_ge_u32_e64 %0, %8, %16\n\tv_cmp_ge_u32_e64 %1, %9, %16\n\tv_cmp_ge_u32_e64 %2, %10, %16\n\tv_cmp_ge_u32_e64 %3, %11, %16\n\t"
                 "v_cmp_ge_u32_e64 %4, %12, %16\n\tv_cmp_ge_u32_e64 %5, %13, %16\n\tv_cmp_ge_u32_e64 %6, %14, %16\n\tv_cmp_ge_u32_e64 %7, %15, %16\n\ts_nop 3"
                 : "=&s"(m0), "=&s"(m1), "=&s"(m2), "=&s"(m3), "=&s"(m4), "=&s"(m5), "=&s"(m6), "=&s"(m7)
                 : "v"(a0), "v"(a1), "v"(a2), "v"(a3), "v"(a4), "v"(a5), "v"(a6), "v"(a7), "v"(cand));
    return (__popcll(m0) + __popcll(m1)) + (__popcll(m2) + __popcll(m3)) + ((__popcll(m4) + __popcll(m5)) + (__popcll(m6) + __popcll(m7)));
}
template <int NJ, int BITLO = 0>
__device__ __forceinline__ void select_row(const PG8_LAS float* sc, int n, int lane, unsigned long long* bm_row) {
    constexpr int NG = (NJ + 7) / 8;
    unsigned v[NJ];
    const int nj = __builtin_amdgcn_readfirstlane((n + 63) >> 6), ng = (nj + 7) >> 3;
    const PG8_LAS float* pl = sc + lane;
#pragma unroll
    for (int j = 0; j < NJ; ++j) { const unsigned k = fkey(pl[j * 64]); v[j] = (lane < n - j * 64) ? k : 0u; }
    unsigned T = 1u; int need = 1 << 30;
    if (n > TOPK) {
        unsigned prefix = 0u; bool exact = false;
        for (int bit = 31; bit >= BITLO; --bit) {
            const unsigned cand = prefix | (1u << bit);
            int cnt = 0;
#pragma unroll
            for (int g = 0; g < NG; ++g) if (g < ng) cnt += count8_ge(v[g * 8], v[g * 8 + 1], v[g * 8 + 2], v[g * 8 + 3], v[g * 8 + 4], v[g * 8 + 5], v[g * 8 + 6], v[g * 8 + 7], cand);
            if (cnt >= TOPK) prefix = cand;
            if (cnt == TOPK) { exact = true; break; }
        }
        T = prefix;
        if (!exact) {
            int cgt = 0;
#pragma unroll
            for (int g = 0; g < NG; ++g) if (g < ng) {
#pragma unroll
                for (int jj = 0; jj < 8; ++jj) if (g * 8 + jj < NJ) cgt += __popcll(__ballot(v[g * 8 + jj] > T));
            }
            need = TOPK - cgt;
        }
    }
    unsigned mlo = 0u, mhi = 0u;
    if (need >= (1 << 29)) {
#pragma unroll
        for (int g = 0; g < NG; ++g) if (g < ng) {
#pragma unroll
            for (int jj = 0; jj < 8; ++jj) { const int j = g * 8 + jj; const unsigned long long sm = __ballot(v[j] >= T);
                wlane2(mlo, mhi, sm, j); }
        }
    } else {
        int base_eq = 0;
#pragma unroll
        for (int j = 0; j < NJ; ++j) if (j < nj) {
            const bool gt = v[j] > T, eq = v[j] == T;
            const unsigned long long eqm = __ballot(eq);
            const bool s = gt || (eq && (base_eq + mbcnt64(eqm)) < need);
            const unsigned long long sm = __ballot(s);
            base_eq += __popcll(eqm);
            wlane2(mlo, mhi, sm, j);
        }
    }
    const unsigned long long mymask = ((unsigned long long)mhi << 32) | mlo;
    bm_row[lane] = mymask;
}
__device__ __forceinline__ void select_row_wg(const PG8_LAS float* sc, int n, PG8_LAS int* sel, volatile PG8_LAS int* red) {
    constexpr int NC = 17;
    const int tid_ = fresh_tid(), lane = tid_ & 63, wave = __builtin_amdgcn_readfirstlane(tid_ >> 6);
    unsigned v[NC];
    const PG8_LAS float* pl = sc + wave * NC * 64 + lane;
    const int nrem = n - wave * NC * 64;
#pragma unroll
    for (int j = 0; j < NC; ++j) { const unsigned k = fkey(pl[j * 64]); v[j] = (lane < nrem - j * 64) ? k : 0u; }
    unsigned prefix = 0u; bool exact = false; int it = 0;
    for (int bit = 31; bit >= 0; --bit, ++it) {
        const unsigned cand = prefix | (1u << bit);
        int wc = 0;
#pragma unroll
        for (int j = 0; j < NC; ++j) wc += __popcll(__ballot(v[j] >= cand));
        if (lane == 0) red[(it & 1) * 8 + wave] = wc;
        __syncthreads();
        int cnt = 0;
#pragma unroll
        for (int w = 0; w < 8; ++w) cnt += red[(it & 1) * 8 + w];
        if (cnt >= TOPK) prefix = cand;
        if (cnt == TOPK) { exact = true; break; }
    }
    const unsigned T = prefix;
    unsigned cg = 0u, ce = 0u;
#pragma unroll
    for (int j = 0; j < NC; ++j) { cg += (v[j] > T) ? 1u : 0u; ce += (v[j] == T) ? 1u : 0u; }
    const int wg_ = wave_sum_small<5>(cg), we_ = wave_sum_small<5>(ce);
    __syncthreads();
    if (lane == 0) { red[16 + wave] = wg_; red[24 + wave] = we_; }
    __syncthreads();
    int tot_gt = 0, eq_before = 0, gt_before = 0;
#pragma unroll
    for (int w = 0; w < 8; ++w) { const int g = red[16 + w], e = red[24 + w]; tot_gt += g; if (w < wave) { gt_before += g; eq_before += e; } }
    const int need = exact ? (1 << 30) : TOPK - tot_gt;
    int base_sel = gt_before + (eq_before < need ? eq_before : need), base_eq = eq_before;
    int ln = lane; asm volatile("" : "+v"(ln));
#pragma unroll
    for (int j = 0; j < NC; ++j) {
        const bool gt = v[j] > T, eq = v[j] == T;
        const unsigned long long eqm = __ballot(eq);
        const bool s = gt || (eq && (base_eq + mbcnt64(eqm)) < need);
        const unsigned long long sm = __ballot(s);
        if (s) sel[base_sel + mbcnt64(sm)] = (wave * NC + j) * 64 + ln;
        base_eq += __popcll(eqm); base_sel += __popcll(sm);
    }
    __syncthreads();
}
__device__ __forceinline__ void idx_sample_score_unit(const Params& p, int bs, int pg8) {
    const int tid_ = fresh_tid(), lane = tid_ & 63, wave = __builtin_amdgcn_readfirstlane(tid_ >> 6), r = lane & 31, kh = lane >> 5;
    unsigned char* ws = p.ws;
    const float* QI = (const float*)(ws + WS_QI); const float* WI = (const float*)(ws + WS_WI); float* SCS = (float*)(ws + WS_SCS);
    const bf16_t* KIH = (const bf16_t*)(ws + WS_KIH); const bf16_t* KIL = (const bf16_t*)(ws + WS_KIL);
    const float* cache_ki = p.in[4]; const int* page_table = (const int*)p.in[7];
    IdxQ q; idx_load_q(q, QI, WI, MP + bs * DS, lane);
    const int pg = pg8 * 8 + wave, phys = page_table[bs * NPAGES + pg];
    const float* pbase = cache_ki + (size_t)phys * PAGE * IDD + (size_t)r * IDD + kh * 8;
    float* out0 = SCS + (size_t)(bs * DS + 2 * kh) * SCS_LD;
    IdxRaw raw; idx_load_raw(raw, pbase);
    IdxKey k;
#pragma unroll
    for (int tt = 0; tt < 4; ++tt) {
        idx_cvt_key(raw, k);
        if (tt < 3) idx_load_raw(raw, pbase + (size_t)(tt + 1) * 32 * IDD);
        float s[2]; idx_tile(q, k, s);
        const int col = pg * PAGE + tt * 32 + r;
        out0[col] = s[0]; out0[SCS_LD + col] = s[1];
    }
    if (pg8 == 0 && wave == 0) {
        const size_t kr = (size_t)(MP + bs * DS + (r & 3)) * IDD + kh * 8;
        idx_load_keyb(k, KIH + kr, KIL + kr);
        float s[2]; idx_tile(q, k, s);
        if (r < DS) { out0[NPAST + r] = s[0]; out0[SCS_LD + NPAST + r] = s[1]; }
    }
}
__device__ __forceinline__ void idx_prompt_unit(const Params& p, PG8_LAS unsigned char* lds, int s, int mode = 1) {
    const int tid_ = fresh_tid(), lane = tid_ & 63, wave = __builtin_amdgcn_readfirstlane(tid_ >> 6), r = lane & 31, kh = lane >> 5;
    unsigned char* ws = p.ws;
    const float* QI = (const float*)(ws + WS_QI); const float* WI = (const float*)(ws + WS_WI); unsigned long long* BM = (unsigned long long*)(ws + WS_BM);
    const bf16_t* KIH = (const bf16_t*)(ws + WS_KIH); const bf16_t* KIL = (const bf16_t*)(ws + WS_KIL);
    PG8_LAS float* sc = (PG8_LAS float*)lds;
    const int b = s & 1, q0 = (s >> 1) * 8, grow0 = b * SEQ + q0, ntile = (q0 + 8 + 31) >> 5;
    IdxQ qa, qb; idx_load_q(qa, QI, WI, grow0, lane); idx_load_q(qb, QI, WI, grow0 + 4, lane);
    const size_t kbase = (size_t)(b * SEQ + r) * IDD + kh * 8;
    IdxKey kn;
    if (wave < ntile) idx_load_keyb(kn, KIH + kbase + (size_t)wave * 32 * IDD, KIL + kbase + (size_t)wave * 32 * IDD);
    for (int t = wave; t < ntile; t += NWAVES) {
        const IdxKey k = kn;
        if (t + NWAVES < ntile) idx_load_keyb(kn, KIH + kbase + (size_t)(t + NWAVES) * 32 * IDD, KIL + kbase + (size_t)(t + NWAVES) * 32 * IDD);
        float sa[2], sb[2]; idx_tile(qa, k, sa); idx_tile(qb, k, sb);
        const int col = t * 32 + r;
        sc[(2 * kh) * SCP_LD + col] = sa[0]; sc[(2 * kh + 1) * SCP_LD + col] = sa[1];
        sc[(4 + 2 * kh) * SCP_LD + col] = sb[0]; sc[(5 + 2 * kh) * SCP_LD + col] = sb[1];
    }
    __syncthreads();
    if (mode == 1) select_row<64>(sc + wave * SCP_LD, q0 + wave + 1, lane, BM + (size_t)(grow0 + wave) * 64);
    if (mode == 2) select_row<64>(sc + wave * SCP_LD, q0 + wave + 1, lane, (unsigned long long*)(ws + WS_SEL) + (size_t)(grow0 + wave) * 64);
    if (mode == 3) select_row<64, 24>(sc + wave * SCP_LD, q0 + wave + 1, lane, (unsigned long long*)(ws + WS_SEL) + (size_t)(grow0 + wave) * 64);
}
__device__ __forceinline__ unsigned wq_next(unsigned* ctr, PG8_LAS unsigned char* lds) {
    volatile PG8_LAS unsigned* slot = (volatile PG8_LAS unsigned*)(lds + LDS_MISC + 64);
    __syncthreads();
    if (threadIdx.x == 0) *slot = atomicAdd(ctr, 1u);
    __syncthreads();
    return *slot;
}

constexpr int G_SC = 0, G_SEL = 32800, G_RED = 33824, G_QS = 34304, G_PS = 38400, G_KP = 46592, G_VP = 48640, G_OP = 50688;
__device__ __forceinline__ void sample_row_unit(const Params& p, PG8_LAS unsigned char* lds, int rs) {
    const int tid = fresh_tid(), lane = tid & 63, wave = tid >> 6;
    unsigned char* ws = p.ws;
    const bf16_t* QB = (const bf16_t*)(ws + WS_QB); const float* SCS = (const float*)(ws + WS_SCS);
    const float* cache_k = p.in[2]; const float* cache_v = p.in[3]; const int* page_table = (const int*)p.in[7];
    bf16_t* CATB = (bf16_t*)(ws + WS_CATB); float* PS = (float*)(ws + WS_PS);
    const int row = MP + rs, b = rs / DS, n = NPAST + (rs % DS) + 1;
    PG8_LAS float* sc = (PG8_LAS float*)(lds + G_SC);
    PG8_LAS int* sel = (PG8_LAS int*)(lds + G_SEL);
    PG8_LAS float* qs = (PG8_LAS float*)(lds + G_QS);
    PG8_LAS float* ps = (PG8_LAS float*)(lds + G_PS);
    PG8_LAS unsigned long long* kps = (PG8_LAS unsigned long long*)(lds + G_KP);
    PG8_LAS unsigned long long* vps = (PG8_LAS unsigned long long*)(lds + G_VP);
    PG8_LAS float* op = (PG8_LAS float*)(lds + G_OP);
    for (int e = tid; e < SCS_LDL; e += NTHREADS) sc[e] = SCS[(size_t)rs * SCS_LD + e];
    { const bf16_t* z = QB + (size_t)row * 1024; qs[tid] = __uint_as_float((unsigned)z[tid] << 16); qs[tid + 512] = __uint_as_float((unsigned)z[tid + 512] << 16); }
    __syncthreads();
    select_row_wg(sc, n, sel, (volatile PG8_LAS int*)(lds + G_RED));
    if (tid < TOPK) {
        const int idx = sel[tid];
        const float* kp; const float* vp;
        if (idx < NPAST) { const size_t prow = (size_t)page_table[b * NPAGES + idx / PAGE] * PAGE + (idx % PAGE); kp = cache_k + prow * 512; vp = cache_v + prow * 512; }
        else { const size_t zr = (size_t)(b * DS + idx - NPAST); kp = p.out + O_KS + zr * 512; vp = p.out + O_VS + zr * 512; }
        kps[tid] = (unsigned long long)kp; vps[tid] = (unsigned long long)vp;
    }
    __syncthreads();
    {
        const int j = tid & 255, hg = tid >> 8;
        const float* kp = (const float*)kps[j] + hg * 256;
#pragma unroll
        for (int n2 = 0; n2 < 2; ++n2) {
            float d0 = 0.f, d1 = 0.f;
            const PG8_LAS float* q0 = qs + (4 * hg + 2 * n2) * HD; const PG8_LAS float* q1 = q0 + HD;
#pragma unroll 8
            for (int d = 0; d < HD; d += 4) {
                const f32x4 k4 = *(const f32x4*)(kp + n2 * HD + d);
                d0 += q0[d] * k4[0] + q0[d + 1] * k4[1] + q0[d + 2] * k4[2] + q0[d + 3] * k4[3];
                d1 += q1[d] * k4[0] + q1[d + 1] * k4[1] + q1[d + 2] * k4[2] + q1[d + 3] * k4[3];
            }
            ps[(4 * hg + 2 * n2) * TOPK + j] = d0 * ATTN_SCALE; ps[(4 * hg + 2 * n2 + 1) * TOPK + j] = d1 * ATTN_SCALE;
        }
    }
    __syncthreads();
    {
        float v[4]; float m = -INFINITY;
#pragma unroll
        for (int i = 0; i < 4; ++i) { v[i] = ps[wave * TOPK + lane + 64 * i]; m = fmaxf(m, v[i]); }
#pragma unroll
        for (int o = 32; o >= 1; o >>= 1) m = fmaxf(m, __shfl_xor(m, o));
        float sum = 0.f;
#pragma unroll
        for (int i = 0; i < 4; ++i) { v[i] = expf(v[i] - m); sum += v[i]; }
#pragma unroll
        for (int o = 32; o >= 1; o >>= 1) sum += __shfl_xor(sum, o);
        const float inv = 1.0f / sum;
#pragma unroll
        for (int i = 0; i < 4; ++i) ps[wave * TOPK + lane + 64 * i] = v[i] * inv;
    }
    __syncthreads();
    {
        const int o4 = tid & 255, kq = tid >> 8, hq = o4 >> 5, d = (o4 & 31) * 4, nkv = hq >> 1;
        f32x4 acc = (f32x4){0.f, 0.f, 0.f, 0.f};
#pragma unroll 8
        for (int j = kq * 128; j < kq * 128 + 128; ++j) acc += *(const f32x4*)((const float*)vps[j] + nkv * HD + d) * ps[hq * TOPK + j];
        if (kq == 1) *(PG8_LAS f32x4*)(op + o4 * 4) = acc;
        __syncthreads();
        if (kq == 0) {
            acc += *(const PG8_LAS f32x4*)(op + o4 * 4);
            u32x2 w; w.x = cvt_pk_bf16(acc[0], acc[1]); w.y = cvt_pk_bf16(acc[2], acc[3]);
            *(u32x2*)(CATB + (size_t)row * D + 1024 + o4 * 4) = w;
        }
    }
    __syncthreads();
}

typedef short s16x4 __attribute__((ext_vector_type(4)));
constexpr int A_KP = 272, A_VP = 320, A_KBYTES = 64 * A_KP, A_VBYTES = 64 * A_VP, A_STAGE = A_KBYTES + A_VBYTES;
constexpr float A_SC = 0.08838834764831845f * 1.4426950408889634f;
__device__ __forceinline__ float xhalf_max(float x) { const auto sw = __builtin_amdgcn_permlane32_swap(__float_as_uint(x), __float_as_uint(x), false, false); return fmaxf(__uint_as_float(sw[0]), __uint_as_float(sw[1])); }
__device__ __forceinline__ float xhalf_sum(float x) { const auto sw = __builtin_amdgcn_permlane32_swap(__float_as_uint(x), __float_as_uint(x), false, false); return __uint_as_float(sw[0]) + __uint_as_float(sw[1]); }
__device__ __forceinline__ void attn_dense_unit(const Params& p, PG8_LAS unsigned char* lds, int b, int n, int qb) {
    const int tid = fresh_tid(), lane = tid & 63, wave = __builtin_amdgcn_readfirstlane(tid >> 6), r = lane & 31, kh = lane >> 5;
    unsigned char* ws = p.ws;
    const bf16_t* QB = (const bf16_t*)(ws + WS_QB); const bf16_t* KB = (const bf16_t*)(ws + WS_KB); const bf16_t* VB = (const bf16_t*)(ws + WS_VB);
    const unsigned long long* BM = (const unsigned long long*)(ws + WS_BM);
    bf16_t* CATB = (bf16_t*)(ws + WS_CATB); float* PS = (float*)(ws + WS_PS);
    const int q = qb * 128 + wave * 16 + (r & 15), head = 2 * n + (r >> 4);
    const size_t qrow = (size_t)b * SEQ + q;
    bf16x8 qf[8];
#pragma unroll
    for (int ks = 0; ks < 8; ++ks) qf[ks] = *(const bf16x8*)(QB + qrow * 1024 + head * HD + ks * 16 + kh * 8);
    f32x16 O[4];
#pragma unroll
    for (int dt = 0; dt < 4; ++dt)
#pragma unroll
        for (int i = 0; i < 16; ++i) O[dt][i] = 0.f;
    float m = -INFINITY, l = 0.f;
    const int ntile = 2 * qb + 2, qmax_w = qb * 128 + wave * 16 + 15;
    const int srow = tid >> 4, sch = tid & 15;
    const bf16_t* kg = KB + ((size_t)b * SEQ + srow) * 512 + n * HD + sch * 8;
    const bf16_t* vg = VB + ((size_t)b * SEQ + srow) * 512 + n * HD + sch * 8;
    u32x4 kst[2], vst[2];
#define A_GLOAD(t) do { _Pragma("unroll") for (int _i = 0; _i < 2; ++_i) { kst[_i] = *(const u32x4*)(kg + (size_t)((t) * 64 + _i * 32) * 512); vst[_i] = *(const u32x4*)(vg + (size_t)((t) * 64 + _i * 32) * 512); } } while (0)
#define A_LSTORE(buf) do { _Pragma("unroll") for (int _i = 0; _i < 2; ++_i) { *(PG8_LAS u32x4*)(lds + (buf) * A_STAGE + (srow + _i * 32) * A_KP + sch * 16) = kst[_i]; \
        *(PG8_LAS u32x4*)(lds + (buf) * A_STAGE + A_KBYTES + (srow + _i * 32) * A_VP + sch * 16) = vst[_i]; } } while (0)
    A_GLOAD(0); A_LSTORE(0);
    unsigned long long mw = BM[qrow * 64];
    __syncthreads();
    const int i16 = lane & 15, g2 = (lane >> 4) & 1;
    const int vlane_off = (4 * kh + (i16 >> 2)) * A_VP + (16 * g2 + 4 * (i16 & 3)) * 2;
    for (int t = 0; t < ntile; ++t) {
        const bool more = (t + 1 < ntile);
        if (more) A_GLOAD(t + 1);
        const unsigned long long mw_next = more ? BM[qrow * 64 + t + 1] : 0ull;
        const int buf = t & 1;
        if (t * 64 <= qmax_w) {
            PG8_LAS unsigned char* kb = lds + buf * A_STAGE; PG8_LAS unsigned char* vb = kb + A_KBYTES;
            f32x16 s0, s1;
#pragma unroll
            for (int i = 0; i < 16; ++i) { s0[i] = 0.f; s1[i] = 0.f; }
#pragma unroll
            for (int ks = 0; ks < 8; ++ks) {
                const bf16x8 k0 = *(const PG8_LAS bf16x8*)(kb + r * A_KP + (ks * 16 + kh * 8) * 2);
                const bf16x8 k1 = *(const PG8_LAS bf16x8*)(kb + (32 + r) * A_KP + (ks * 16 + kh * 8) * 2);
                s0 = __builtin_amdgcn_mfma_f32_32x32x16_bf16(k0, qf[ks], s0, 0, 0, 0);
                s1 = __builtin_amdgcn_mfma_f32_32x32x16_bf16(k1, qf[ks], s1, 0, 0, 0);
            }
            const unsigned lo = (unsigned)mw >> (4 * kh), hi = (unsigned)(mw >> 32) >> (4 * kh);
            float mx = -INFINITY;
#pragma unroll
            for (int i = 0; i < 16; ++i) {
                const unsigned bit = 1u << ((i & 3) + 8 * (i >> 2));
                s0[i] = (lo & bit) ? s0[i] * A_SC : -INFINITY; s1[i] = (hi & bit) ? s1[i] * A_SC : -INFINITY;
                mx = fmaxf(mx, fmaxf(s0[i], s1[i]));
            }
            mx = xhalf_max(mx);
            const float m_new = fmaxf(m, mx), m_safe = (m_new == -INFINITY) ? 0.f : m_new;
            const float alpha = __builtin_amdgcn_exp2f(m - m_safe);
            float lsum = 0.f;
#pragma unroll
            for (int i = 0; i < 16; ++i) { s0[i] = __builtin_amdgcn_exp2f(s0[i] - m_safe); s1[i] = __builtin_amdgcn_exp2f(s1[i] - m_safe); lsum += s0[i] + s1[i]; }
            l = l * alpha + lsum; m = m_new;
            if (__ballot(alpha != 1.0f) != 0ull) {
#pragma unroll
                for (int dt = 0; dt < 4; ++dt)
#pragma unroll
                    for (int i = 0; i < 16; ++i) O[dt][i] *= alpha;
            }
            bf16x8 pf[2][2];
#pragma unroll
            for (int sx = 0; sx < 2; ++sx) {
                u32x4 w0, w1;
                w0.x = cvt_pk_bf16(s0[8 * sx], s0[8 * sx + 1]); w0.y = cvt_pk_bf16(s0[8 * sx + 2], s0[8 * sx + 3]); w0.z = cvt_pk_bf16(s0[8 * sx + 4], s0[8 * sx + 5]); w0.w = cvt_pk_bf16(s0[8 * sx + 6], s0[8 * sx + 7]);
                w1.x = cvt_pk_bf16(s1[8 * sx], s1[8 * sx + 1]); w1.y = cvt_pk_bf16(s1[8 * sx + 2], s1[8 * sx + 3]); w1.z = cvt_pk_bf16(s1[8 * sx + 4], s1[8 * sx + 5]); w1.w = cvt_pk_bf16(s1[8 * sx + 6], s1[8 * sx + 7]);
                pf[0][sx] = __builtin_bit_cast(bf16x8, w0); pf[1][sx] = __builtin_bit_cast(bf16x8, w1);
            }
#pragma unroll
            for (int st = 0; st < 2; ++st)
#pragma unroll
                for (int sx = 0; sx < 2; ++sx)
#pragma unroll
                    for (int dt = 0; dt < 4; ++dt) {
                        PG8_LAS unsigned char* a = vb + vlane_off + (st * 32 + 16 * sx) * A_VP + dt * 64;
                        const s16x4 vlo = __builtin_amdgcn_ds_read_tr16_b64_v4i16((PG8_LAS s16x4*)a);
                        const s16x4 vhi = __builtin_amdgcn_ds_read_tr16_b64_v4i16((PG8_LAS s16x4*)(a + 8 * A_VP));
                        const bf16x8 vf = __builtin_shufflevector(vlo, vhi, 0, 1, 2, 3, 4, 5, 6, 7);
                        O[dt] = __builtin_amdgcn_mfma_f32_32x32x16_bf16(vf, pf[st][sx], O[dt], 0, 0, 0);
                    }
        }
        if (more) A_LSTORE(buf ^ 1);
        __syncthreads();
        mw = mw_next;
    }
#undef A_GLOAD
#undef A_LSTORE
    const float inv = 1.0f / xhalf_sum(l);
    bf16_t* orow = CATB + qrow * D + 1024 + head * HD;
#pragma unroll
    for (int dt = 0; dt < 4; ++dt)
#pragma unroll
        for (int a = 0; a < 4; ++a) {
            u32x2 w; w.x = cvt_pk_bf16(O[dt][4 * a] * inv, O[dt][4 * a + 1] * inv); w.y = cvt_pk_bf16(O[dt][4 * a + 2] * inv, O[dt][4 * a + 3] * inv);
            *(u32x2*)(orow + 32 * dt + 8 * a + 4 * kh) = w;
        }
}
__device__ __forceinline__ void attn_phase(const Params& p, PG8_LAS unsigned char* lds, int ctr_off = 0) {
    const int G = gridDim.x;
    for (int u = blockIdx.x; u < 256; u += G) { const int qb = 31 - (u >> 3), bn = u & 7; attn_dense_unit(p, lds, bn >> 2, bn & 3, qb); }
    unsigned* ctr = (unsigned*)(p.ws + WS_CTR) + ctr_off;
    for (;;) {
        const unsigned idx = wq_next(ctr, lds);
        if (idx >= (unsigned)(MS + LRU_NCHUNK)) break;
        if (idx < (unsigned)MS) sample_row_unit(p, lds, (int)idx); else lru_fixup_unit(p, (int)idx - MS);
    }
}
__device__ __forceinline__ void mid1_phase(const Params& p, PG8_LAS unsigned char* lds) {
    unsigned* ctr = (unsigned*)(p.ws + WS_CTR) + 64;
    constexpr unsigned NA = DB * 8, NB_ = MP / 8, NC_ = LRU_NCHUNK * 8;
    for (;;) {
        const unsigned idx = wq_next(ctr, lds);
        constexpr unsigned XA_ = (MID_DUP == 1) ? NA : 0u, XB_ = (MID_DUP >= 6) ? NB_ : 0u, XC_ = (MID_DUP == 3) ? NC_ : 0u;
        if (idx >= NA + XA_ + NB_ + XB_ + NC_ + XC_) break;
        if (idx < NA + XA_) { const unsigned u = idx % NA; idx_sample_score_unit(p, (int)(u >> 3), (int)(u & 7)); }
        else if (idx < NA + XA_ + NB_) idx_prompt_unit(p, lds, (int)(NB_ - 1 - (idx - NA - XA_)));
        else if (idx < NA + XA_ + NB_ + XB_) idx_prompt_unit(p, lds, (int)(NB_ - 1 - (idx - NA - XA_ - NB_)), MID_DUP == 6 ? 2 : (MID_DUP == 7 ? 3 : 0));
        else lru_local_unit(p, lds, (int)((idx - NA - XA_ - NB_ - XB_) % NC_));
    }
}

__device__ __forceinline__ void prep_phase(const Params& p, PG8_LAS unsigned char* lds) {
    unsigned char* ws = p.ws;
    bf16_t* Wgu1 = (bf16_t*)(ws + WS_WGU1); bf16_t* Wd1 = (bf16_t*)(ws + WS_WD1); bf16_t* Win = (bf16_t*)(ws + WS_WIN); bf16_t* Wout = (bf16_t*)(ws + WS_WOUT);
    bf16_t* Wgu2 = (bf16_t*)(ws + WS_WGU2); bf16_t* Wd2 = (bf16_t*)(ws + WS_WD2); bf16_t* XB = (bf16_t*)(ws + WS_XB);
    PG8_LAS float* tile = (PG8_LAS float*)lds;
    const int wid = blockIdx.x, nw = gridDim.x;
    transpose_cvt<1>(p.in[10], D, 2 * DFF, 2 * DFF, Wgu1, tile, wid, nw);
    cvt_x(p.in[0], p.in[1], XB);
    for (int n = 0; n < 8; ++n) { transpose_cvt<0>(p.in[15] + n * 16384, 128, 128, 128, (bf16_t*)(ws + WS_WAT) + n * 16384, tile, wid, nw); transpose_cvt<0>(p.in[17] + n * 16384, 128, 128, 128, (bf16_t*)(ws + WS_WIT) + n * 16384, tile, wid, nw); }
    (void)Wd1; (void)Win; (void)Wout; (void)Wgu2; (void)Wd2;
}
__device__ __forceinline__ void tail_cvt(const Params& p, PG8_LAS unsigned char* lds, int which, int nunits) {
    const int G = gridDim.x, c = blockIdx.x, full = nunits / G, rem = nunits - full * G;
    if (rem != 0 && c < rem) return;
    const int wid = (rem == 0) ? c : c - rem, nw = (rem == 0) ? G : G - rem;
    unsigned char* ws = p.ws; PG8_LAS float* tile = (PG8_LAS float*)lds;
    __syncthreads();
    if (which == 0) {
        transpose_cvt<0>(p.in[11], DFF, D, D, (bf16_t*)(ws + WS_WD1), tile, wid, nw);
        transpose_cvt<0>(p.in[12], D, DIN, DINP, (bf16_t*)(ws + WS_WIN), tile, wid, nw);
        transpose_cvt<0>(p.in[20], D, D, D, (bf16_t*)(ws + WS_WOUT), tile, wid, nw);
    } else if (which == 1) transpose_cvt<1>(p.in[23], D, 2 * DFF, 2 * DFF, (bf16_t*)(ws + WS_WGU2), tile, wid, nw);
    else transpose_cvt<0>(p.in[24], DFF, D, D, (bf16_t*)(ws + WS_WD2), tile, wid, nw);
}

__global__ void __launch_bounds__(NTHREADS, 2) mk_fwd(Params p) {
    extern __shared__ __attribute__((aligned(16))) unsigned char lds_raw[];
    PG8_LAS unsigned char* lds = (PG8_LAS unsigned char*)lds_raw;
    unsigned char* ws = p.ws;
    const int lo = p.ph_lo, hi = p.ph_hi;
    const int G = gridDim.x;
    if (threadIdx.x < 4) ((volatile PG8_LAS unsigned*)(lds + LDS_MISC))[threadIdx.x] = 0u;
    __syncthreads();
    XcdBarrier bar = xcd_barrier_post((unsigned*)(ws + WS_CTL) + (size_t)p.li * XCD_BAR_WORDS, (volatile LAS unsigned*)(lds + LDS_MISC));
#define SEAM(k) do { if (lo <= (k) && (k) + 1 < hi) xcd_barrier(bar); } while (0)
    bf16_t* Wgu1 = (bf16_t*)(ws + WS_WGU1); bf16_t* Wd1 = (bf16_t*)(ws + WS_WD1); bf16_t* Win = (bf16_t*)(ws + WS_WIN); bf16_t* Wout = (bf16_t*)(ws + WS_WOUT);
    bf16_t* Wgu2 = (bf16_t*)(ws + WS_WGU2); bf16_t* Wd2 = (bf16_t*)(ws + WS_WD2);
    bf16_t* XB = (bf16_t*)(ws + WS_XB); bf16_t* H = (bf16_t*)(ws + WS_H); float* T = (float*)(ws + WS_T); float* X1 = (float*)(ws + WS_X1); float* X2 = (float*)(ws + WS_X2);
    bf16_t* CATB = (bf16_t*)(ws + WS_CATB); float* PS = (float*)(ws + WS_PS); float* ST1 = (float*)(ws + WS_ST); float* ST2 = ST1 + 2 * MP;
#define IN(k) (lo <= (k) && (k) < hi)
    if (IN(0)) prep_phase(p, lds);
    SEAM(0);
    if (IN(1)) {
        pg8::Gemm g{XB, Wgu1, MPAD, 2 * DFF, D}; pg8::StaticOrder S; S.init(MPAD, 2 * DFF, G, (int)blockIdx.x, D);
        EpiSwiGLU E{H};
        pg8::gemm_phase<EpiSwiGLU, pg8::StaticOrder, true, true>(lds, g, S, E);
        tail_cvt(p, lds, 0, (MPAD / 256) * (2 * DFF / 256));
    }
    SEAM(1);
    if (IN(2)) {
        pg8::Gemm g{H, Wd1, MPAD, D, DFF}; SplitOrder S; S.init(D, DFF, G, (int)blockIdx.x);
        EpiResidSplit E{p.in[0], T, PS, 0.5f, nullptr, nullptr, nullptr};
        pg8::gemm_phase<EpiResidSplit, SplitOrder, true, true>(lds, g, S, E);
    }
    SEAM(2);
    if (IN(3)) ln_phase(T, p.in[8], p.in[9], X1, XB, PS, DFF / 256, p.in[1], 0.5f, ST1);
    SEAM(3);
    if (IN(4)) {
        pg8::Gemm g{XB, Win, MPAD, DINP, D}; pg8::StaticOrder S; S.init(MPAD, DINP, G, (int)blockIdx.x, D);
        EpiWin E{(float*)(ws + WS_XR), (float*)(ws + WS_GG), (bf16_t*)(ws + WS_QB), (bf16_t*)(ws + WS_KB), (bf16_t*)(ws + WS_VB), (float*)(ws + WS_QI), (bf16_t*)(ws + WS_KIH), (bf16_t*)(ws + WS_KIL), (float*)(ws + WS_WI), p.out};
        pg8::gemm_phase<EpiWin, pg8::StaticOrder, true, true>(lds, g, S, E);
        tail_cvt(p, lds, 1, (MPAD / 256) * (DINP / 256));
    }
    SEAM(4);
    if (IN(5)) mid1_phase(p, lds);
    SEAM(5);
    if (IN(6)) { attn_phase(p, lds); if (REP_6 > 1) { __syncthreads(); attn_phase(p, lds, 128); } }
    SEAM(6);
    if (IN(7)) {
        pg8::Gemm g{CATB, Wout, MPAD, D, D}; SplitOrder S; S.init(D, D, G, (int)blockIdx.x);
        EpiResidSplit E{nullptr, T, PS, 1.0f, ST1, p.in[8], p.in[9]};
        pg8::gemm_phase<EpiResidSplit, SplitOrder, true, true>(lds, g, S, E);
    }
    SEAM(7);
    if (IN(8)) ln_phase(T, p.in[21], p.in[22], X2, XB, PS, D / 256, X1 + (size_t)MP * D, 1.0f, ST2);
    SEAM(8);
    if (IN(9)) {
        pg8::Gemm g{XB, Wgu2, MPAD, 2 * DFF, D}; pg8::StaticOrder S; S.init(MPAD, 2 * DFF, G, (int)blockIdx.x, D);
        EpiSwiGLU E{H};
        pg8::gemm_phase<EpiSwiGLU, pg8::StaticOrder, true, true>(lds, g, S, E);
        tail_cvt(p, lds, 2, (MPAD / 256) * (2 * DFF / 256));
    }
    SEAM(9);
    if (IN(10)) {
        pg8::Gemm g{H, Wd2, MPAD, D, DFF}; SplitOrder S; S.init(D, DFF, G, (int)blockIdx.x);
        EpiResidSplit E{nullptr, T, PS, 0.5f, ST2, p.in[21], p.in[22]};
        pg8::gemm_phase<EpiResidSplit, SplitOrder, true, true>(lds, g, S, E);
    }
    SEAM(10);
    if (IN(11)) ln_phase(T, p.in[25], p.in[26], p.out + O_YP, nullptr, PS, DFF / 256, X2 + (size_t)MP * D, 0.5f, nullptr);
#undef IN
#undef SEAM
}

}

extern "C" void kernel_launch(void* const* d_in, const int* in_sizes, int n_in, void* d_out, int out_size, void* d_ws, size_t ws_size, hipStream_t stream) {
    static int grid = 0;
    if (grid == 0) {
        if (n_in != 27 || ws_size < WS_END3) { grid = -1; return; }
        int dev = 0, cus = 0;
        if (hipGetDevice(&dev) != hipSuccess || hipDeviceGetAttribute(&cus, hipDeviceAttributeMultiprocessorCount, dev) != hipSuccess) { grid = -1; return; }
        if (hipFuncSetAttribute((const void*)mk_fwd, hipFuncAttributeMaxDynamicSharedMemorySize, LDS_BYTES) != hipSuccess) { grid = -1; return; }
        (void)hipGetLastError();
        grid = cus;
    }
    if (grid < 0) return;
    float* out = (float*)d_out;
    unsigned char* ws = (unsigned char*)d_ws;

    (void)hipMemsetAsync(ws + WS_CTL, 0, CTL_BYTES, stream);
    Params p{};
    for (int i = 0; i < 27; ++i) p.in[i] = (const float*)d_in[i];
    p.out = out; p.ws = ws;
    int nli = 0;
    auto run = [&](int lo, int hi) { p.ph_lo = lo; p.ph_hi = hi; p.li = nli++; hipLaunchKernelGGL(mk_fwd, dim3(grid), dim3(NTHREADS), LDS_BYTES, stream, p); };
    run(0, 12);
}
```

```cpp
#include <hip/hip_runtime.h>
#include <stdint.h>

namespace pg8 {
#define PG8_LAS __attribute__((address_space(3)))
typedef unsigned short bf16_t;
typedef short bf16x8 __attribute__((ext_vector_type(8)));
typedef float f32x4 __attribute__((ext_vector_type(4)));
typedef unsigned u32x4 __attribute__((ext_vector_type(4)));
constexpr int BM = 256, BK = 64, HALF = 128, HTB = HALF * BK * 2  , STAGE_BYTES = 8 * HTB, NXCD = 8, WGM = 8;

__host__ __device__ __forceinline__ int lds_byte(int r, int c) { const int st = (r >> 4) * 2 + (c >> 5), rr = r & 15, cc = c & 31, ob = rr * 64 + cc * 2; return st * 1024 + (ob ^ (((ob >> 9) & 1) << 5)); }
__host__ __device__ __forceinline__ void stage_rc(int b, int& R, int& C) { const int st = b / 1024, sb = b % 1024, swz = sb ^ (((sb >> 9) & 1) << 5); R = (st >> 1) * 16 + swz / 64; C = (st & 1) * 32 + (swz % 64) / 2; }
__host__ __device__ __forceinline__ int perm32(int rho) { const int n = rho >> 4, i = rho & 15; return 8 * (i >> 2) + 4 * n + (i & 3); }

struct Unit { int pm, pn, k0, nt, aux; };
struct Gemm { const bf16_t* A; const bf16_t* Bt; int M, N, K; };

struct StaticOrder {
    int nM, nN, nwg, G, c, ntk;
    __host__ __device__ __forceinline__ void init(int M, int N, int G_, int c_, int K_ = 0) { nM = M / BM; nN = N / BM; nwg = nM * nN; G = G_; c = c_; ntk = K_ / BK; }
    __host__ __device__ __forceinline__ bool next(int i, Unit& u) const {
        const long L = (long)i * G + c; if (L >= nwg) return false;
        int wgid = (int)L; { const int q = nwg / NXCD, r = nwg % NXCD, xcd = wgid % NXCD, off = wgid / NXCD; wgid = (xcd < r ? xcd * (q + 1) : r * (q + 1) + (xcd - r) * q) + off; }
        const int nig = WGM * nN, gid = wgid / nig, fm = gid * WGM, gsz = (nM - fm) < WGM ? (nM - fm) : WGM;
        u.pm = fm + ((wgid % nig) % gsz); u.pn = (wgid % nig) / gsz; u.k0 = 0; u.nt = ntk; u.aux = -1; return true;
    }
    __device__ __forceinline__ void a_ready(const Unit&) const {}
    __device__ __forceinline__ void done(const Unit&) const {}
};

__device__ __forceinline__ unsigned cvt_pk_bf16(float lo, float hi) { unsigned r; asm volatile("v_cvt_pk_bf16_f32 %0, %1, %2" : "=v"(r) : "v"(lo), "v"(hi)); return r; }
typedef float f32x2 __attribute__((ext_vector_type(2)));

template <class Epi, class Sched, bool ALIGN_EPI = false, bool SP2 = false>
__device__ __forceinline__ void gemm_phase(PG8_LAS unsigned char* lds, const Gemm g, const Sched& S, const Epi& E) {
    int tid_v = threadIdx.x; asm volatile("" : "+v"(tid_v));
    const int tid = tid_v, wid = __builtin_amdgcn_readfirstlane(tid >> 6), lane = tid & 63, wr = wid >> 2, wc = wid & 3, fr = lane & 15, fq = lane >> 4;
    const int K = g.K;
    unsigned voffA[2], voffB[2];
#pragma unroll
    for (int i = 0; i < 2; ++i) { int R, C; stage_rc(tid * 16 + i * 8192, R, C); const int Rb = Epi::PERM ? ((R & ~31) + perm32(R & 31)) : R;
        voffA[i] = (unsigned)(R * K + C) * 2u; voffB[i] = (unsigned)(Rb * K + C) * 2u; }
    const size_t kstep = (size_t)(BK * 2);
    const size_t hstep = (size_t)HALF * K * 2;
    const size_t tstep = 2 * hstep;
    const unsigned ldsw = (unsigned)wid * 1024u;
    const int aoff = lds_byte(wr * 64 + fr, fq * 8), boff = lds_byte(wc * 32 + fr, fq * 8);
#define PG8_SA(b, h) (((b) * 2 + (h)) * HTB)
#define PG8_SB(b, h) ((4 + (b) * 2 + (h)) * HTB)
#define PG8_STAGE(bufoff, gbase, voff) do { _Pragma("unroll") for (int _i = 0; _i < 2; ++_i) \
        __builtin_amdgcn_global_load_lds((const unsigned*)((const char*)(gbase) + (voff)[_i]), (PG8_LAS unsigned*)(lds + (bufoff) + ldsw + _i * 8192), 16, 0, 0); } while (0)
#define PG8_LDA(dst, b, h) do { _Pragma("unroll") for (int m = 0; m < 4; ++m) _Pragma("unroll") for (int k = 0; k < 2; ++k) dst[m][k] = *(const PG8_LAS bf16x8*)(lds + PG8_SA(b, h) + aoff + m * 2048 + k * 1024); } while (0)
#define PG8_LDB(dst, b, h) do { _Pragma("unroll") for (int n = 0; n < 2; ++n) _Pragma("unroll") for (int k = 0; k < 2; ++k) dst[n][k] = *(const PG8_LAS bf16x8*)(lds + PG8_SB(b, h) + boff + n * 2048 + k * 1024); } while (0)
#define PG8_MMA(ai, bj, At, Bt) do { __builtin_amdgcn_s_setprio(1); _Pragma("unroll") for (int m = 0; m < 4; ++m) _Pragma("unroll") for (int n = 0; n < 2; ++n) _Pragma("unroll") for (int k = 0; k < 2; ++k) \
        acc[ai][bj][m][n] = __builtin_amdgcn_mfma_f32_16x16x32_bf16(Bt[n][k], At[m][k], acc[ai][bj][m][n], 0, 0, 0); __builtin_amdgcn_s_setprio(0); } while (0)
#define PG8_WAIT_V(n) asm volatile("s_waitcnt vmcnt(" #n ")" ::: "memory")
#define PG8_WAIT_L(n) asm volatile("s_waitcnt lgkmcnt(" #n ")" ::: "memory")
#define PG8_BAR __builtin_amdgcn_s_barrier()
#define PG8_SCHED __builtin_amdgcn_sched_barrier(0)
    Unit cur, nxt; int ui = 0;
    if (!S.next(0, cur)) return;
    f32x4 acc[2][2][4][2];
#pragma unroll
    for (int a = 0; a < 2; ++a)
#pragma unroll
        for (int b = 0; b < 2; ++b)
#pragma unroll
            for (int m = 0; m < 4; ++m)
#pragma unroll
                for (int n = 0; n < 2; ++n) acc[a][b][m][n] = (f32x4){0.f, 0.f, 0.f, 0.f};
    bf16x8 At[4][2], B0[2][2], B1[2][2];
    const char* cA = (const char*)g.A + (size_t)cur.pm * tstep + (size_t)cur.k0 * 2; const char* cB = (const char*)g.Bt + (size_t)cur.pn * tstep + (size_t)cur.k0 * 2;
    S.a_ready(cur);
    if constexpr (SP2) {
        PG8_STAGE(PG8_SB(0, 0), cB, voffB); PG8_STAGE(PG8_SB(0, 1), cB + hstep, voffB); PG8_STAGE(PG8_SA(0, 0), cA, voffA); PG8_STAGE(PG8_SA(0, 1), cA + hstep, voffA);
        if (wr == 1) PG8_BAR;
        PG8_WAIT_V(2); PG8_BAR;
        PG8_STAGE(PG8_SB(1, 0), cB + kstep, voffB); PG8_STAGE(PG8_SA(1, 0), cA + kstep, voffA); PG8_STAGE(PG8_SB(1, 1), cB + hstep + kstep, voffB);
        PG8_WAIT_V(6); PG8_BAR;
    } else {
        PG8_STAGE(PG8_SB(0, 0), cB, voffB); PG8_STAGE(PG8_SA(0, 0), cA, voffA); PG8_STAGE(PG8_SB(0, 1), cB + hstep, voffB); PG8_STAGE(PG8_SA(0, 1), cA + hstep, voffA);
        if (wr == 1) PG8_BAR;
        PG8_WAIT_V(4); PG8_BAR;
        PG8_STAGE(PG8_SB(1, 0), cB + kstep, voffB); PG8_STAGE(PG8_SA(1, 0), cA + kstep, voffA); PG8_STAGE(PG8_SB(1, 1), cB + hstep + kstep, voffB);
        PG8_WAIT_V(6); PG8_BAR;
    }
    for (;;) {
        const bool has_next = S.next(ui + 1, nxt);
        const char* nA = has_next ? (const char*)g.A + (size_t)nxt.pm * tstep + (size_t)nxt.k0 * 2 : cA; const char* nB = has_next ? (const char*)g.Bt + (size_t)nxt.pn * tstep + (size_t)nxt.k0 * 2 : cB;
        const int nt = cur.nt;
        for (int t = 0; t < nt; t += 2) {
            const bool last = (t == nt - 2);
            const char* a1 = cA + (size_t)(t + 1) * kstep;
            const char* a2 = last ? nA : cA + (size_t)(t + 2) * kstep; const char* b2 = last ? nB : cB + (size_t)(t + 2) * kstep;
            const char* a3 = a2 + kstep; const char* b3 = b2 + kstep;
            if (last && has_next) S.a_ready(nxt);
            if constexpr (SP2) {
            PG8_LDB(B0, 0, 0); PG8_LDB(B1, 0, 1); PG8_SCHED; PG8_LDA(At, 0, 0); PG8_STAGE(PG8_SA(1, 1), a1 + hstep, voffA);
            PG8_WAIT_V(8); PG8_WAIT_L(0); PG8_BAR; PG8_MMA(0, 0, At, B0); PG8_MMA(0, 1, At, B1); PG8_BAR; PG8_SCHED;
            PG8_LDA(At, 0, 1); PG8_STAGE(PG8_SB(0, 0), b2, voffB); PG8_STAGE(PG8_SB(0, 1), b2 + hstep, voffB); PG8_STAGE(PG8_SA(0, 0), a2, voffA);
            PG8_WAIT_V(8); PG8_WAIT_L(0); PG8_BAR; PG8_MMA(1, 0, At, B0); PG8_MMA(1, 1, At, B1); PG8_BAR; PG8_SCHED;
            PG8_LDB(B0, 1, 0); PG8_LDB(B1, 1, 1); PG8_SCHED; PG8_LDA(At, 1, 0); PG8_STAGE(PG8_SA(0, 1), a2 + hstep, voffA);
            PG8_WAIT_V(8); PG8_WAIT_L(0); PG8_BAR; PG8_MMA(0, 0, At, B0); PG8_MMA(0, 1, At, B1); PG8_BAR; PG8_SCHED;
            PG8_LDA(At, 1, 1); PG8_STAGE(PG8_SB(1, 0), b3, voffB); PG8_STAGE(PG8_SB(1, 1), b3 + hstep, voffB); PG8_STAGE(PG8_SA(1, 0), a3, voffA);
            PG8_WAIT_V(8); PG8_WAIT_L(0); PG8_BAR; PG8_MMA(1, 0, At, B0); PG8_MMA(1, 1, At, B1); PG8_BAR; PG8_SCHED;
            } else {
            PG8_LDB(B0, 0, 0); PG8_SCHED; PG8_LDA(At, 0, 0); PG8_STAGE(PG8_SA(1, 1), a1 + hstep, voffA);
            PG8_WAIT_L(8); PG8_BAR; PG8_WAIT_L(0); PG8_MMA(0, 0, At, B0); PG8_BAR; PG8_SCHED;
            PG8_LDB(B1, 0, 1); PG8_STAGE(PG8_SB(0, 0), b2, voffB);
            PG8_BAR; PG8_WAIT_L(0); PG8_MMA(0, 1, At, B1); PG8_BAR;
            PG8_LDA(At, 0, 1); PG8_STAGE(PG8_SA(0, 0), a2, voffA);
            PG8_BAR; PG8_WAIT_L(0); PG8_MMA(1, 0, At, B0); PG8_BAR; PG8_SCHED;
            PG8_STAGE(PG8_SB(0, 1), b2 + hstep, voffB);
            PG8_WAIT_V(6); PG8_BAR; PG8_MMA(1, 1, At, B1); PG8_BAR;
            PG8_LDB(B0, 1, 0); PG8_SCHED; PG8_LDA(At, 1, 0); PG8_STAGE(PG8_SA(0, 1), a2 + hstep, voffA);
            PG8_WAIT_L(8); PG8_BAR; PG8_WAIT_L(0); PG8_MMA(0, 0, At, B0); PG8_BAR; PG8_SCHED;
            PG8_LDB(B1, 1, 1); PG8_STAGE(PG8_SB(1, 0), b3, voffB);
            PG8_BAR; PG8_WAIT_L(0); PG8_MMA(0, 1, At, B1); PG8_BAR;
            PG8_LDA(At, 1, 1); PG8_STAGE(PG8_SA(1, 0), a3, voffA);
            PG8_BAR; PG8_WAIT_L(0); PG8_MMA(1, 0, At, B0); PG8_BAR; PG8_SCHED;
            PG8_STAGE(PG8_SB(1, 1), b3 + hstep, voffB);
            PG8_WAIT_V(6); PG8_BAR; PG8_MMA(1, 1, At, B1); PG8_BAR;
            }
        }
        if constexpr (ALIGN_EPI) { if (wr == 0) PG8_BAR; }
        if constexpr (!Epi::AFTER_DRAIN) { E(acc, cur, wr, wc, fr, fq); S.done(cur); }
        if (!has_next) break;
#pragma unroll
        for (int a = 0; a < 2; ++a)
#pragma unroll
            for (int b = 0; b < 2; ++b)
#pragma unroll
                for (int m = 0; m < 4; ++m)
#pragma unroll
                    for (int n = 0; n < 2; ++n) acc[a][b][m][n] = (f32x4){0.f, 0.f, 0.f, 0.f};
        cur = nxt; cA = nA; cB = nB; ++ui;
        if constexpr (ALIGN_EPI) { if (wr == 1) PG8_BAR; }
    }
    PG8_WAIT_V(0);
    if constexpr (!ALIGN_EPI) { if (wr == 0) PG8_BAR; }
    PG8_BAR;
    if constexpr (Epi::AFTER_DRAIN) { E.fused(acc, cur, wr, wc, fr, fq, lds, wid, lane); S.done(cur); }
#undef PG8_SA
#undef PG8_SB
#undef PG8_STAGE
#undef PG8_LDA
#undef PG8_LDB
#undef PG8_MMA
#undef PG8_WAIT_V
#undef PG8_WAIT_L
#undef PG8_BAR
#undef PG8_SCHED
}

}

#define XB_TMO      128
#define XB_XCNT(j)  (256  + 64 * (j))
#define XB_XSUB(j)  (1280 + 64 * (j))
#define XB_XGEN(j)  (2304 + 64 * (j))
#define XB_TOP      3328
#define XB_TOPGEN   3392
#define XCD_BAR_WORDS 3456
#define XB_SPIN_CAP (1u << 18)
#define LAS __attribute__((address_space(3)))

__device__ __forceinline__ unsigned xb_ld(unsigned* p)              { return __hip_atomic_load(p, __ATOMIC_RELAXED, __HIP_MEMORY_SCOPE_AGENT); }
__device__ __forceinline__ unsigned xb_add(unsigned* p, unsigned v) { return __hip_atomic_fetch_add(p, v, __ATOMIC_RELAXED, __HIP_MEMORY_SCOPE_AGENT); }
__device__ __forceinline__ unsigned xb_xcc_id() { return (unsigned)__builtin_amdgcn_s_getreg((3 << 11) | 20) & 0xFu; }
#define XB_SPIN(cond, bar) do { unsigned _sp = 0; while (cond) { __builtin_amdgcn_s_sleep(1); \
    if ((++_sp & 255u) == 0u) { if (xb_ld(&(bar)[XB_TMO])) break; if (_sp > XB_SPIN_CAP) { atomicAdd(&(bar)[XB_TMO], 1u); break; } } } } while (0)

struct XcdBarrier {
    unsigned* bar; unsigned x;
    volatile LAS unsigned* st;
};

__device__ __forceinline__ XcdBarrier xcd_barrier_post(unsigned* bar, volatile LAS unsigned* st) {
    XcdBarrier b; b.bar = bar; b.x = xb_xcc_id(); b.st = st;
    if (threadIdx.x == 0) (void)xb_add(&bar[XB_XCNT(b.x)], 1u);
    return b;
}
__device__ __forceinline__ void xcd_barrier_complete(unsigned* bar, unsigned x, unsigned& nloc, unsigned& nx) {
    const unsigned G = gridDim.x * gridDim.y * gridDim.z;
    unsigned sum, cnt, mine, sp = 0u;
    for (;;) {
        sum = 0u; cnt = 0u; mine = 0u;
#pragma unroll
        for (unsigned j = 0; j < 16; ++j) { const unsigned c = xb_ld(&bar[XB_XCNT(j)]); sum += c; cnt += (c > 0u) ? 1u : 0u; mine = (j == x) ? c : mine; }
        if (sum == G) break;
        __builtin_amdgcn_s_sleep(1);
        if ((++sp & 255u) == 0u) { if (xb_ld(&bar[XB_TMO])) break; if (sp > XB_SPIN_CAP) { atomicAdd(&bar[XB_TMO], 1u); break; } }
    }
    nloc = mine > 0u ? mine : 1u; nx = cnt > 0u ? cnt : 1u;
}

__device__ __forceinline__ void xcd_barrier(const XcdBarrier& b) {
    asm volatile("s_waitcnt vmcnt(0)" ::: "memory");
    __syncthreads();
    if (threadIdx.x == 0) {
        unsigned* bar = b.bar;
        __builtin_amdgcn_s_waitcnt(0);
        unsigned nloc = b.st[0], nx = b.st[1];
        if (nloc == 0u) { xcd_barrier_complete(bar, b.x, nloc, nx); b.st[0] = nloc; b.st[1] = nx; }
        const unsigned old = xb_add(&bar[XB_XSUB(b.x)], 1u);
        const unsigned gen = old / nloc;
        if (old + 1u == (gen + 1u) * nloc) {
            __builtin_amdgcn_fence(__ATOMIC_RELEASE, "agent");
            asm volatile("s_waitcnt vmcnt(0)" ::: "memory");
            const unsigned og = xb_add(&bar[XB_TOP], 1u);
            const unsigned tg = og / nx;
            if (og + 1u == (tg + 1u) * nx) xb_add(&bar[XB_TOPGEN], 1u);
            else XB_SPIN(xb_ld(&bar[XB_TOPGEN]) == tg, bar);
            __builtin_amdgcn_fence(__ATOMIC_ACQUIRE, "agent");
            xb_add(&bar[XB_XGEN(b.x)], 1u);
            asm volatile("s_waitcnt vmcnt(0)" ::: "memory");
        } else {
            XB_SPIN(xb_ld(&bar[XB_XGEN(b.x)]) == gen, bar);
            __builtin_amdgcn_fence(__ATOMIC_ACQUIRE, "agent");
            asm volatile("s_waitcnt vmcnt(0)" ::: "memory");
        }
    }
    __syncthreads();
}


namespace {
typedef unsigned short bf16_t;
typedef float f32x4 __attribute__((ext_vector_type(4)));
typedef unsigned u32x4 __attribute__((ext_vector_type(4)));
typedef unsigned u32x2 __attribute__((ext_vector_type(2)));

constexpr int D = 2048, SEQ = 4096, NB = 2, MP = NB * SEQ, DB = 32, DS = 4, MS = DB * DS, MT = MP + MS, MPAD = 8448;
constexpr int DFF = 5504, DRNN = 1024, HD = 128, NKV = 4, IDH = 8, IDD = 64, DIN = 4680, DINP = 4864;
constexpr int NPAGES = 64, PAGE = 128, NPAST = NPAGES * PAGE, LS = NPAST + DS, TOPK = 256;
constexpr int C_XR = 0, C_GR = 1024, C_Q = 2048, C_K = 3072, C_V = 3584, C_QI = 4096, C_KI = 4608, C_WI = 4672;
constexpr float ALPHA = 1.189207115002721f, LN_EPS = 1e-5f, ATTN_SCALE = 0.08838834764831845f, IDX_SCALE = 0.125f, IDX_W_SCALE = 0.35355339059327373f;
constexpr size_t O_YP = 0, O_YS = 16777216, O_KP = 17039360, O_VP = 21233664, O_KIP = 25427968, O_CP = 25952256, O_HP = 25958400,
                 O_KS = 25960448, O_VS = 26025984, O_KIS = 26091520, O_CS = 26099712, O_HS = 26198016;
constexpr int SCS_LD = 8256;
constexpr int ZLD = DINP;

constexpr size_t al256(size_t x) { return (x + 255) & ~(size_t)255; }
constexpr size_t WS_CTL = 0;
constexpr size_t CTL_BYTES = 65536;
constexpr size_t WS_WGU1 = WS_CTL + CTL_BYTES;
constexpr size_t WS_WD1 = WS_WGU1 + al256((size_t)2 * DFF * D * 2);
constexpr size_t WS_WIN = WS_WD1 + al256((size_t)D * DFF * 2);
constexpr size_t WS_WOUT = WS_WIN + al256((size_t)DINP * D * 2);
constexpr size_t WS_WGU2 = WS_WOUT + al256((size_t)D * D * 2);
constexpr size_t WS_WD2 = WS_WGU2 + al256((size_t)2 * DFF * D * 2);
constexpr size_t WS_XB = WS_WD2 + al256((size_t)D * DFF * 2);
constexpr size_t WS_H = WS_XB + al256((size_t)MPAD * D * 2);
constexpr size_t WS_T = WS_H + al256((size_t)MPAD * DFF * 2);
constexpr size_t WS_X1 = WS_T + al256((size_t)MPAD * D * 4);
constexpr size_t WS_X2 = WS_X1 + al256((size_t)MPAD * D * 4);
constexpr size_t WS_XR = WS_X2 + al256((size_t)MPAD * D * 4);
constexpr size_t WS_GG = WS_XR + al256((size_t)MPAD * DRNN * 4);
constexpr size_t WS_QI = WS_GG + al256((size_t)MPAD * DRNN * 4);
constexpr size_t WS_WI = WS_QI + al256((size_t)MPAD * 512 * 4);
constexpr size_t WS_KIH = WS_WI + al256((size_t)MPAD * 8 * 4);
constexpr size_t WS_KIL = WS_KIH + al256((size_t)MPAD * 64 * 2);
constexpr size_t WS_ZEND = WS_KIL + al256((size_t)MPAD * 64 * 2);
constexpr size_t WS_CATB = WS_ZEND;
constexpr size_t WS_HL = WS_CATB + al256((size_t)MPAD * D * 2);
constexpr size_t WS_PP = WS_HL + al256((size_t)MT * DRNN * 4);
constexpr size_t WS_GI = WS_PP + al256((size_t)MT * DRNN * 4);
constexpr size_t WS_SCP = WS_GI + al256((size_t)MT * DRNN * 4);
constexpr size_t WS_SCS = WS_SCP + al256((size_t)MP * SEQ * 4);
constexpr size_t WS_SEL = WS_SCS + al256((size_t)MS * SCS_LD * 4);
constexpr size_t WS_NSEL = WS_SEL + al256((size_t)MT * TOPK * 4);
constexpr size_t WS_SUMA = WS_NSEL + al256((size_t)MT * 4);
constexpr size_t WS_SUMH = WS_SUMA + al256((size_t)130 * DRNN * 4);
constexpr size_t WS_WAT = WS_SUMH + al256((size_t)130 * DRNN * 4);
constexpr size_t WS_WIT = WS_WAT + al256((size_t)8 * 128 * 128 * 2);
constexpr size_t WS_BM = WS_WIT + al256((size_t)8 * 128 * 128 * 2);
constexpr size_t WS_QB = WS_BM + al256((size_t)MP * 64 * 8);
constexpr size_t WS_KB = WS_QB + al256((size_t)MPAD * 1024 * 2);
constexpr size_t WS_VB = WS_KB + al256((size_t)MPAD * 512 * 2);
constexpr size_t WS_END = WS_VB + al256((size_t)MPAD * 512 * 2);
constexpr size_t WS_PS = WS_END;
constexpr size_t WS_END2 = WS_PS + al256((size_t)21 * MS * D * 4);
constexpr size_t WS_ST = WS_END2;
constexpr size_t WS_END3 = WS_ST + al256((size_t)2 * MP * 2 * 4);
constexpr size_t WS_CTR = WS_CTL + 32768;

constexpr int NWAVES = 8, NTHREADS = 512;
#ifndef REP_6
#define REP_6 1
#endif
#ifndef MID_DUP
#define MID_DUP 0
#endif
#ifndef REP_G
#define REP_G 1
#endif
#ifndef REP_T
#define REP_T 1
#endif
#ifndef REP_5
#define REP_5 2
#endif
constexpr int LDS_STAGE = 131072, LDS_MISC = 134144, LDS_BYTES = 135168;

struct Params {
    const float* in[27];
    float* out;
    unsigned char* ws;
    int ph_lo, ph_hi, li, pad_;
};

__device__ __forceinline__ unsigned cvt_pk_bf16(float lo, float hi) { unsigned r; asm volatile("v_cvt_pk_bf16_f32 %0, %1, %2" : "=v"(r) : "v"(lo), "v"(hi)); return r; }
__device__ __forceinline__ int fresh_tid() { int t = threadIdx.x; asm volatile("" : "+v"(t)); return t; }
__device__ __forceinline__ float sigmoidf_(float x) { return 1.0f / (1.0f + expf(-x)); }
__device__ __forceinline__ float gelu_tanh(float x) { const float a = -2.3022081985f * (x + 0.044715f * x * x * x); return x * __builtin_amdgcn_rcpf(1.0f + __builtin_amdgcn_exp2f(a)); }
__device__ __forceinline__ bf16_t f2bf(float f) { return (bf16_t)(cvt_pk_bf16(f, 0.f) & 0xffffu); }

struct EpiSwiGLU {
    static constexpr bool PERM = true, AFTER_DRAIN = false;
    bf16_t* H;
    __device__ __forceinline__ void operator()(const f32x4 (&acc)[2][2][4][2], const pg8::Unit& u, int wr, int wc, int fr, int fq) const {
        const int row0 = u.pm * 256 + wr * 64 + fr, col0 = u.pn * 128 + wc * 32 + 8 * fq;
#pragma unroll
        for (int ai = 0; ai < 2; ++ai)
#pragma unroll
            for (int m = 0; m < 4; ++m) {
                bf16_t* rowp = H + (size_t)(row0 + ai * 128 + m * 16) * DFF + col0;
                float h[8];
#pragma unroll
                for (int n = 0; n < 2; ++n)
#pragma unroll
                    for (int j = 0; j < 4; ++j) {
                        const float g = acc[ai][0][m][n][j], up = acc[ai][1][m][n][j];
                        const float sg = __builtin_amdgcn_rcpf(1.0f + __builtin_amdgcn_exp2f(-1.4426950408889634f * g));
                        h[n * 4 + j] = g * sg * up;
                    }
                u32x4 w; w.x = cvt_pk_bf16(h[0], h[1]); w.y = cvt_pk_bf16(h[2], h[3]); w.z = cvt_pk_bf16(h[4], h[5]); w.w = cvt_pk_bf16(h[6], h[7]);
                *(u32x4*)rowp = w;
            }
    }
};
struct EpiResid {
    static constexpr bool PERM = false, AFTER_DRAIN = false;
    const float* Xp; const float* Xs; float* T; float s;
    __device__ __forceinline__ void operator()(const f32x4 (&acc)[2][2][4][2], const pg8::Unit& u, int wr, int wc, int fr, int fq) const {
        const int row0 = u.pm * 256 + wr * 64 + fr, col0 = u.pn * 256 + wc * 32 + 4 * fq;
#pragma unroll
        for (int ai = 0; ai < 2; ++ai)
#pragma unroll
            for (int m = 0; m < 4; ++m) {
                const int row = row0 + ai * 128 + m * 16;
                if (row < MT) {
                    const float* xr = (row < MP) ? Xp + (size_t)row * D + col0 : Xs + (size_t)(row - MP) * D + col0;
                    float* tr = T + (size_t)row * D + col0;
#pragma unroll
                    for (int bj = 0; bj < 2; ++bj)
#pragma unroll
                        for (int n = 0; n < 2; ++n) { const f32x4 xv = *(const f32x4*)(xr + bj * 128 + n * 16); *(f32x4*)(tr + bj * 128 + n * 16) = xv * ALPHA + acc[ai][bj][m][n] * s; }
                }
            }
    }
};
struct EpiF32 {
    static constexpr bool PERM = false, AFTER_DRAIN = false;
    float* C; int ldc;
    __device__ __forceinline__ void operator()(const f32x4 (&acc)[2][2][4][2], const pg8::Unit& u, int wr, int wc, int fr, int fq) const {
        const int row0 = u.pm * 256 + wr * 64 + fr, col0 = u.pn * 256 + wc * 32 + 4 * fq;
#pragma unroll
        for (int ai = 0; ai < 2; ++ai)
#pragma unroll
            for (int m = 0; m < 4; ++m) {
                float* rowp = C + (size_t)(row0 + ai * 128 + m * 16) * ldc + col0;
#pragma unroll
                for (int bj = 0; bj < 2; ++bj)
#pragma unroll
                    for (int n = 0; n < 2; ++n) *(f32x4*)(rowp + bj * 128 + n * 16) = acc[ai][bj][m][n];
            }
    }
};


struct EpiWin {
    static constexpr bool PERM = false, AFTER_DRAIN = false;
    float* XR; float* GG; bf16_t* QB; bf16_t* KB; bf16_t* VB; float* QI; bf16_t* KIH; bf16_t* KIL; float* WI; float* out;
    template <class F> __device__ __forceinline__ void each(const f32x4 (&acc)[2][2][4][2], const pg8::Unit& u, int wr, int wc, int fr, int fq, F f) const {
        const int row0 = u.pm * 256 + wr * 64 + fr, cl = wc * 32 + 4 * fq;
#pragma unroll
        for (int ai = 0; ai < 2; ++ai)
#pragma unroll
            for (int m = 0; m < 4; ++m)
#pragma unroll
                for (int bj = 0; bj < 2; ++bj)
#pragma unroll
                    for (int n = 0; n < 2; ++n) f(row0 + ai * 128 + m * 16, cl + 128 * bj + 16 * n, acc[ai][bj][m][n]);
    }
    static __device__ __forceinline__ u32x2 pk4(const f32x4 v) { u32x2 w; w.x = cvt_pk_bf16(v[0], v[1]); w.y = cvt_pk_bf16(v[2], v[3]); return w; }
    __device__ __forceinline__ void operator()(const f32x4 (&acc)[2][2][4][2], const pg8::Unit& u, int wr, int wc, int fr, int fq) const {
        const int pn = u.pn;
        if (pn < 4) each(acc, u, wr, wc, fr, fq, [&](int row, int c, const f32x4 v) { *(f32x4*)(XR + (size_t)row * DRNN + pn * 256 + c) = v; });
        else if (pn < 8) each(acc, u, wr, wc, fr, fq, [&](int row, int c, const f32x4 v) { *(f32x4*)(GG + (size_t)row * DRNN + (pn - 4) * 256 + c) = (f32x4){gelu_tanh(v[0]), gelu_tanh(v[1]), gelu_tanh(v[2]), gelu_tanh(v[3])}; });
        else if (pn < 12) each(acc, u, wr, wc, fr, fq, [&](int row, int c, const f32x4 v) { *(u32x2*)(QB + (size_t)row * 1024 + (pn - 8) * 256 + c) = pk4(v); });
        else if (pn < 16) {
            bf16_t* B = (pn < 14) ? KB : VB; const size_t op = (pn < 14) ? O_KP : O_VP, os = (pn < 14) ? O_KS : O_VS; const int c0 = (pn & 1) * 256;
            each(acc, u, wr, wc, fr, fq, [&](int row, int c, const f32x4 v) {
                *(u32x2*)(B + (size_t)row * 512 + c0 + c) = pk4(v);
                if (row < MT) *(f32x4*)(out + (row < MP ? op + (size_t)row * 512 : os + (size_t)(row - MP) * 512) + c0 + c) = v; });
        }
        else if (pn < 18) each(acc, u, wr, wc, fr, fq, [&](int row, int c, const f32x4 v) { *(f32x4*)(QI + (size_t)row * 512 + (pn - 16) * 256 + c) = v; });
        else each(acc, u, wr, wc, fr, fq, [&](int row, int c, const f32x4 v) {
            if (c < 64) {
                const u32x2 h = pk4(v);
                u32x2 l; l.x = cvt_pk_bf16(v[0] - __uint_as_float(h.x << 16), v[1] - __uint_as_float(h.x & 0xffff0000u)); l.y = cvt_pk_bf16(v[2] - __uint_as_float(h.y << 16), v[3] - __uint_as_float(h.y & 0xffff0000u));
                *(u32x2*)(KIH + (size_t)row * 64 + c) = h; *(u32x2*)(KIL + (size_t)row * 64 + c) = l;
                if (row < MT) *(f32x4*)(out + (row < MP ? O_KIP + (size_t)row * 64 : O_KIS + (size_t)(row - MP) * 64) + c) = v;
            } else if (c < 72) *(f32x4*)(WI + (size_t)row * 8 + (c - 64)) = v; });
    }
};


struct SplitOrder {
    pg8::StaticOrder base; int G, c, nmine, npiece, ntk, nN;
    __device__ __forceinline__ void init(int N, int K, int G_, int c_) { base.init(MP, N, G_, c_, K); G = G_; c = c_; nN = N / 256; ntk = K / 64; npiece = ntk / 4; nmine = (c_ < base.nwg) ? (base.nwg - c_ + G_ - 1) / G_ : 0; }
    __device__ __forceinline__ bool next(int i, pg8::Unit& u) const {
        if (i < nmine) return base.next(i, u);
        const int mi = (i - nmine) * G + c; if (mi >= npiece * nN) return false;
        const int kp = mi / nN; u.pm = MP / 256; u.pn = mi % nN; u.k0 = kp * 256; u.nt = (kp == npiece - 1) ? ntk - 4 * (npiece - 1) : 4; u.aux = kp; return true;
    }
    __device__ __forceinline__ void a_ready(const pg8::Unit&) const {}
    __device__ __forceinline__ void done(const pg8::Unit&) const {}
};
struct EpiResidSplit {
    static constexpr bool PERM = false, AFTER_DRAIN = false;
    const float* X; float* T; float* PS; float s; const float* ST; const float* gn; const float* bn;
    __device__ __forceinline__ void operator()(const f32x4 (&acc)[2][2][4][2], const pg8::Unit& u, int wr, int wc, int fr, int fq) const {
        const int col0 = u.pn * 256 + wc * 32 + 4 * fq;
        if (u.aux < 0) {
            const int row0 = u.pm * 256 + wr * 64 + fr;
            if (ST == nullptr) {
#pragma unroll
                for (int ai = 0; ai < 2; ++ai)
#pragma unroll
                    for (int m = 0; m < 4; ++m) {
                        const size_t off = (size_t)(row0 + ai * 128 + m * 16) * D + col0;
#pragma unroll
                        for (int bj = 0; bj < 2; ++bj)
#pragma unroll
                            for (int n = 0; n < 2; ++n) { const f32x4 xv = *(const f32x4*)(X + off + bj * 128 + n * 16); *(f32x4*)(T + off + bj * 128 + n * 16) = xv * ALPHA + acc[ai][bj][m][n] * s; }
                    }
            } else {
                f32x4 gv[2][2], bv[2][2];
#pragma unroll
                for (int bj = 0; bj < 2; ++bj)
#pragma unroll
                    for (int n = 0; n < 2; ++n) { gv[bj][n] = *(const f32x4*)(gn + col0 + bj * 128 + n * 16); bv[bj][n] = *(const f32x4*)(bn + col0 + bj * 128 + n * 16); }
#pragma unroll
                for (int ai = 0; ai < 2; ++ai)
#pragma unroll
                    for (int m = 0; m < 4; ++m) {
                        const int row = row0 + ai * 128 + m * 16;
                        const size_t off = (size_t)row * D + col0;
                        const float mean = ST[2 * row], rstd = ST[2 * row + 1];
#pragma unroll
                        for (int bj = 0; bj < 2; ++bj)
#pragma unroll
                            for (int n = 0; n < 2; ++n) { const f32x4 tv = *(const f32x4*)(T + off + bj * 128 + n * 16); const f32x4 xv = (tv - mean) * rstd * gv[bj][n] + bv[bj][n];
                                *(f32x4*)(T + off + bj * 128 + n * 16) = xv * ALPHA + acc[ai][bj][m][n] * s; }
                    }
            }
        } else {
            float* slab = PS + (size_t)u.aux * MS * D;
#pragma unroll
            for (int m = 0; m < 4; ++m) {
                float* rp = slab + (size_t)(wr * 64 + m * 16 + fr) * D + col0;
#pragma unroll
                for (int bj = 0; bj < 2; ++bj)
#pragma unroll
                    for (int n = 0; n < 2; ++n) *(f32x4*)(rp + bj * 128 + n * 16) = acc[0][bj][m][n];
            }
        }
    }
};

template <int MODE>
__device__ __forceinline__ void transpose_cvt(const float* __restrict__ W, int K, int N, int Npad, bf16_t* __restrict__ Wt, PG8_LAS float* tile, int wid, int nw) {
    const int tid = fresh_tid(), ntn = Npad / 64, ntk = K / 128, ntiles = ntn * ntk;
    const int lk = tid >> 4, ln4 = (tid & 15) * 4;
    f32x4 v[4];
    auto src0 = [&](int t) { const int n0 = (t % ntn) * 64; if (MODE == 1) { const int t256 = n0 >> 8, j = n0 & 255; return (j < 128) ? t256 * 128 + j : DFF + t256 * 128 + (j - 128); } return n0; };
    auto gload = [&](int t) {
        const int k0 = (t / ntn) * 128, s0 = src0(t);
#pragma unroll
        for (int i = 0; i < 4; ++i) {
            const float* q = W + (size_t)(k0 + lk + 32 * i) * N + s0 + ln4;
            if (MODE == 1 || s0 + ln4 + 3 < N) v[i] = *(const f32x4*)q;
            else { v[i] = (f32x4){0.f, 0.f, 0.f, 0.f}; for (int e = 0; e < 4; ++e) if (s0 + ln4 + e < N) v[i][e] = q[e]; }
        }
    };
    int t = wid;
    if (t < ntiles) gload(t);
    for (; t < ntiles; t += nw) {
#pragma unroll
        for (int i = 0; i < 4; ++i)
#pragma unroll
            for (int e = 0; e < 4; ++e) tile[(lk + 32 * i) * 65 + ln4 + e] = v[i][e];
        const int tn = t + nw;
        if (tn < ntiles) gload(tn);
        __syncthreads();
        {
            const int n0 = (t % ntn) * 64, k0 = (t / ntn) * 128;
            const int n = tid >> 3, kq = (tid & 7) * 16;
#pragma unroll
            for (int h = 0; h < 2; ++h) {
                float x[8];
#pragma unroll
                for (int j = 0; j < 8; ++j) x[j] = tile[(kq + 8 * h + j) * 65 + n];
                u32x4 w; w.x = cvt_pk_bf16(x[0], x[1]); w.y = cvt_pk_bf16(x[2], x[3]); w.z = cvt_pk_bf16(x[4], x[5]); w.w = cvt_pk_bf16(x[6], x[7]);
                *(u32x4*)(Wt + (size_t)(n0 + n) * K + k0 + kq + 8 * h) = w;
            }
        }
        __syncthreads();
    }
}
__device__ __forceinline__ void cvt_x(const float* __restrict__ xp, const float* __restrict__ xs, bf16_t* __restrict__ XB) {
    const size_t n4 = (size_t)MPAD * D / 4;
    for (size_t i = (size_t)blockIdx.x * NTHREADS + threadIdx.x; i < n4; i += (size_t)gridDim.x * NTHREADS) {
        const size_t e = i * 4, row = e / D;
        f32x4 v = (f32x4){0.f, 0.f, 0.f, 0.f};
        if (row < (size_t)MP) v = *(const f32x4*)(xp + e); else if (row < (size_t)MT) v = *(const f32x4*)(xs + (e - (size_t)MP * D));
        u32x2 w; w.x = cvt_pk_bf16(v[0], v[1]); w.y = cvt_pk_bf16(v[2], v[3]);
        *(u32x2*)(XB + e) = w;
    }
}
__device__ __forceinline__ void ln_phase(const float* __restrict__ T, const float* __restrict__ g, const float* __restrict__ b, float* __restrict__ Xo, bf16_t* __restrict__ Xb,
                                         const float* __restrict__ PS, int npiece, const float* __restrict__ Xs, float sres, float* __restrict__ ST) {
    const int tid_ = fresh_tid(), lane = tid_ & 63, wave = tid_ >> 6;
    for (int row = blockIdx.x * NWAVES + wave; row < MT; row += gridDim.x * NWAVES) {
        f32x4 v[8]; float s = 0.f;
        if (row < MP) {
            const float* tr = T + (size_t)row * D + lane * 4;
#pragma unroll
            for (int i = 0; i < 8; ++i) v[i] = *(const f32x4*)(tr + 256 * i);
        } else {
            const size_t ro = (size_t)(row - MP) * D + lane * 4;
#pragma unroll
            for (int i = 0; i < 8; ++i) v[i] = (f32x4){0.f, 0.f, 0.f, 0.f};
#pragma unroll 1
            for (int pz = 0; pz < npiece; ++pz) {
                const float* sp = PS + (size_t)pz * MS * D + ro;
#pragma unroll
                for (int i = 0; i < 8; ++i) v[i] += *(const f32x4*)(sp + 256 * i);
            }
#pragma unroll
            for (int i = 0; i < 8; ++i) v[i] = *(const f32x4*)(Xs + ro + 256 * i) * ALPHA + v[i] * sres;
        }
#pragma unroll
        for (int i = 0; i < 8; ++i) s += (v[i][0] + v[i][1]) + (v[i][2] + v[i][3]);
#pragma unroll
        for (int o = 32; o >= 1; o >>= 1) s += __shfl_xor(s, o);
        const float mean = s * (1.0f / D);
        float q = 0.f;
#pragma unroll
        for (int i = 0; i < 8; ++i) { const f32x4 d = v[i] - mean; q += (d[0] * d[0] + d[1] * d[1]) + (d[2] * d[2] + d[3] * d[3]); }
#pragma unroll
        for (int o = 32; o >= 1; o >>= 1) q += __shfl_xor(q, o);
        const float rstd = rsqrtf(q * (1.0f / D) + LN_EPS);
        if (ST && row < MP && lane == 0) { ST[2 * row] = mean; ST[2 * row + 1] = rstd; }
        const float* gq = g; const float* bq = b; asm volatile("" : "+s"(gq), "+s"(bq));
#pragma unroll
        for (int i = 0; i < 8; ++i) {
            const f32x4 o = (v[i] - mean) * rstd * *(const f32x4*)(gq + lane * 4 + 256 * i) + *(const f32x4*)(bq + lane * 4 + 256 * i);
            if (Xo && (ST == nullptr || row >= MP)) *(f32x4*)(Xo + (size_t)row * D + lane * 4 + 256 * i) = o;
            if (Xb) { u32x2 w; w.x = cvt_pk_bf16(o[0], o[1]); w.y = cvt_pk_bf16(o[2], o[3]); *(u32x2*)(Xb + (size_t)row * D + lane * 4 + 256 * i) = w; }
        }
    }
}

typedef short bf16x8 __attribute__((ext_vector_type(8)));
typedef float f32x16 __attribute__((ext_vector_type(16)));
__device__ __forceinline__ int crow(int reg, int h) { return (reg & 3) + 8 * (reg >> 2) + 4 * h; }
constexpr int LRU_CH = 64, LRU_NCHUNK = MT / LRU_CH  , LRU_PCHUNK = MP / LRU_CH  , LRU_CPB = SEQ / LRU_CH  ;
constexpr int L_XCF = 0, L_XCB = 32768, L_AA = 50176, L_UU = 82944, XCB_PITCH = 272;
__device__ __forceinline__ void lru_local_unit(const Params& p, PG8_LAS unsigned char* lds, int u) {
    const int tid = fresh_tid(), lane = tid & 63, wave = tid >> 6;
    unsigned char* ws = p.ws;
    const float* XR = (const float*)(ws + WS_XR);
    const float* state_conv = p.in[5]; const float* state_rnn = p.in[6];
    const float* cw = p.in[13]; const float* cb = p.in[14];
    const float* ba = p.in[16]; const float* bi = p.in[18]; const float* lam = p.in[19];
    const bf16_t* WAt = (const bf16_t*)(ws + WS_WAT); const bf16_t* WIt = (const bf16_t*)(ws + WS_WIT);
    float* HL = (float*)(ws + WS_HL); float* PP = (float*)(ws + WS_PP); float* SUMA = (float*)(ws + WS_SUMA); float* SUMH = (float*)(ws + WS_SUMH);
    float* out = p.out;
    PG8_LAS float* XCF = (PG8_LAS float*)(lds + L_XCF); PG8_LAS float* AA = (PG8_LAS float*)(lds + L_AA); PG8_LAS float* UU = (PG8_LAS float*)(lds + L_UU);
    {
        const int ck = u >> 3, nb = u & 7;
        const int mt = wave >> 2, nt = wave & 3, r = lane & 31, kh = lane >> 5;
        bf16x8 bfa[8], bfi[8];
        {
            const bf16_t* wa = WAt + (size_t)nb * 16384 + (size_t)(nt * 32 + r) * 128 + kh * 8;
            const bf16_t* wi = WIt + (size_t)nb * 16384 + (size_t)(nt * 32 + r) * 128 + kh * 8;
#pragma unroll
            for (int ks = 0; ks < 8; ++ks) { bfa[ks] = *(const bf16x8*)(wa + ks * 16); bfi[ks] = *(const bf16x8*)(wi + ks * 16); }
        }
        const int col_e = nt * 32 + r, ch_e = nb * 128 + col_e;
        const float lam_e = lam[ch_e], bac = ba[ch_e], bic = bi[ch_e];
        {
            const int c = tid & 127, rg = tid >> 7, ch = nb * 128 + c;
            const float w0 = cw[ch], w1 = cw[DRNN + ch], w2 = cw[2 * DRNN + ch], w3 = cw[3 * DRNN + ch], cbv = cb[ch];
            if (ck < LRU_PCHUNK) {
                const int b = ck / LRU_CPB, t0 = (ck % LRU_CPB) * LRU_CH + rg * 16;
                const float* zc = XR + (size_t)(b * SEQ) * DRNN + ch;
                float x0 = (t0 - 3 >= 0) ? zc[(size_t)(t0 - 3) * DRNN] : 0.f, x1 = (t0 - 2 >= 0) ? zc[(size_t)(t0 - 2) * DRNN] : 0.f, x2 = (t0 - 1 >= 0) ? zc[(size_t)(t0 - 1) * DRNN] : 0.f;
#pragma unroll
                for (int i = 0; i < 16; ++i) {
                    const int t = t0 + i, lr = rg * 16 + i;
                    const float x3 = zc[(size_t)t * DRNN];
                    const float xc = cbv + w0 * x0 + w1 * x1 + w2 * x2 + w3 * x3;
                    XCF[lr * 128 + c] = xc;
                    *(PG8_LAS bf16_t*)(lds + L_XCB + lr * XCB_PITCH + c * 2) = f2bf(xc);
                    if (t >= SEQ - 3) out[O_CP + (size_t)(b * 3 + (t - (SEQ - 3))) * DRNN + ch] = x3;
                    x0 = x1; x1 = x2; x2 = x3;
                }
            } else {
#pragma unroll
                for (int i = 0; i < 16; ++i) {
                    const int lr = rg * 16 + i, rs = (ck - LRU_PCHUNK) * LRU_CH + lr, bs = rs >> 2, tt = rs & 3;
                    float xv[4];
#pragma unroll
                    for (int j = 0; j < 4; ++j) { const int pp = tt + j; xv[j] = (pp < 3) ? state_conv[(size_t)(bs * 3 + pp) * DRNN + ch] : XR[(size_t)(MP + bs * DS + pp - 3) * DRNN + ch]; }
                    const float xc = cbv + w0 * xv[0] + w1 * xv[1] + w2 * xv[2] + w3 * xv[3];
                    XCF[lr * 128 + c] = xc;
                    *(PG8_LAS bf16_t*)(lds + L_XCB + lr * XCB_PITCH + c * 2) = f2bf(xc);
                    if (tt >= 1) out[O_CS + (size_t)(bs * 3 + (tt - 1)) * DRNN + ch] = xv[3];
                }
            }
        }
        __syncthreads();
        {
            f32x16 acc_a, acc_i;
#pragma unroll
            for (int i = 0; i < 16; ++i) { acc_a[i] = 0.f; acc_i[i] = 0.f; }
#pragma unroll
            for (int ks = 0; ks < 8; ++ks) {
                const bf16x8 af = *(const PG8_LAS bf16x8*)(lds + L_XCB + (mt * 32 + r) * XCB_PITCH + (ks * 16 + kh * 8) * 2);
                acc_a = __builtin_amdgcn_mfma_f32_32x32x16_bf16(af, bfa[ks], acc_a, 0, 0, 0);
                acc_i = __builtin_amdgcn_mfma_f32_32x32x16_bf16(af, bfi[ks], acc_i, 0, 0, 0);
            }
            const int col = col_e, hh = lane >> 5;
            const float l = lam_e, sp = (-l > 20.f) ? -l : log1pf(expf(-l));
#pragma unroll
            for (int i = 0; i < 16; ++i) {
                const int lr = mt * 32 + crow(i, hh);
                const float xc = XCF[lr * 128 + col];
                const float rg = __builtin_amdgcn_rcpf(1.0f + __builtin_amdgcn_exp2f(-1.4426950408889634f * (acc_a[i] + bac)));
                const float ig = __builtin_amdgcn_rcpf(1.0f + __builtin_amdgcn_exp2f(-1.4426950408889634f * (acc_i[i] + bic)));
                const float log_a = -8.0f * rg * sp, x = 2.0f * log_a;
                float om;
                if (x > -0.25f) { float q = 1.0f / 720.0f; q = q * x + 1.0f / 120.0f; q = q * x + 1.0f / 24.0f; q = q * x + 1.0f / 6.0f; q = q * x + 0.5f; q = q * x + 1.0f; om = -x * q; }
                else om = -expm1f(x);
                AA[lr * 128 + col] = __builtin_amdgcn_exp2f(1.4426950408889634f * log_a);
                UU[lr * 128 + col] = __builtin_amdgcn_sqrtf(om) * ig * xc;
            }
        }
        __syncthreads();
        {
            const int c = tid & 127, sg = tid >> 7, ch = nb * 128 + c;
            PG8_LAS float* SEG = (PG8_LAS float*)(lds + L_XCF);
            float hv[16], pv[16];
            float h = 0.f, P = 1.f;
            const bool prompt = ck < LRU_PCHUNK;
#pragma unroll
            for (int i = 0; i < 16; ++i) {
                const int lr = sg * 16 + i;
                const float a = AA[lr * 128 + c], uu = UU[lr * 128 + c];
                if (!prompt && (i & 3) == 0) { h = state_rnn[(size_t)(((ck - LRU_PCHUNK) * LRU_CH + lr) >> 2) * DRNN + ch]; P = 0.f; }
                h = a * h + uu; P *= a;
                hv[i] = h; pv[i] = P;
            }
            SEG[(sg * 128 + c) * 2] = P; SEG[(sg * 128 + c) * 2 + 1] = h;
            __syncthreads();
            float cin = 0.f, pin = 1.f;
            if (prompt) {
#pragma unroll
                for (int s2 = 0; s2 < 3; ++s2) if (s2 < sg) { const float ps = SEG[(s2 * 128 + c) * 2], hs = SEG[(s2 * 128 + c) * 2 + 1]; cin = ps * cin + hs; pin *= ps; }
            }
#pragma unroll
            for (int i = 0; i < 16; ++i) {
                const int lr = sg * 16 + i;
                const size_t g = (size_t)(ck * LRU_CH + lr) * DRNN + ch;
                const float hf = prompt ? hv[i] + pv[i] * cin : hv[i];
                HL[g] = hf; PP[g] = prompt ? pv[i] * pin : 0.f;
                if (!prompt && (i & 3) == 3) out[O_HS + (size_t)(((ck - LRU_PCHUNK) * LRU_CH + lr) >> 2) * DRNN + ch] = hf;
            }
            if (sg == 3) { SUMA[(size_t)ck * DRNN + ch] = prompt ? pv[15] * pin : 0.f; SUMH[(size_t)ck * DRNN + ch] = prompt ? hv[15] + pv[15] * cin : 0.f; }
        }
        __syncthreads();
    }
}
__device__ __forceinline__ void lru_fixup_unit(const Params& p, int ck) {
    const int tid = fresh_tid(), ch = tid * 2;
    unsigned char* ws = p.ws;
    const float* GG = (const float*)(ws + WS_GG);
    const float* HL = (const float*)(ws + WS_HL); const float* PP = (const float*)(ws + WS_PP); const float* SUMA = (const float*)(ws + WS_SUMA); const float* SUMH = (const float*)(ws + WS_SUMH);
    bf16_t* CATB = (bf16_t*)(ws + WS_CATB); float* PS = (float*)(ws + WS_PS);
    typedef float f32x2 __attribute__((ext_vector_type(2)));
    f32x2 carry = (f32x2){0.f, 0.f};
    const bool prompt = ck < LRU_PCHUNK;
    if (prompt) {
        const int b = ck / LRU_CPB, kk = ck % LRU_CPB;
#pragma unroll 4
        for (int j = 0; j < kk; ++j) {
            const f32x2 A = *(const f32x2*)(SUMA + (size_t)(b * LRU_CPB + j) * DRNN + ch), Hh = *(const f32x2*)(SUMH + (size_t)(b * LRU_CPB + j) * DRNN + ch);
            carry = A * carry + Hh;
        }
    }
#pragma unroll 4
    for (int lr = 0; lr < LRU_CH; ++lr) {
        const size_t grow = (size_t)(ck * LRU_CH + lr);
        const f32x2 hl = *(const f32x2*)(HL + grow * DRNN + ch), pp = *(const f32x2*)(PP + grow * DRNN + ch), gg = *(const f32x2*)(GG + grow * DRNN + ch);
        const f32x2 h = hl + pp * carry;
        *(unsigned*)(CATB + grow * D + ch) = cvt_pk_bf16(h.x * gg.x, h.y * gg.y);
        if (prompt && (ck % LRU_CPB) == LRU_CPB - 1 && lr == LRU_CH - 1) *(f32x2*)(p.out + O_HP + (size_t)(ck / LRU_CPB) * DRNN + ch) = h;
    }
}


constexpr int IDX_SPLIT = 1;
constexpr int SCP_LD = 4096, SCS_LDL = 8200;
__device__ __forceinline__ unsigned fkey(float f) { const unsigned u = __float_as_uint(f); return (u & 0x80000000u) ? ~u : (u | 0x80000000u); }
__device__ __forceinline__ int mbcnt64(unsigned long long m) { return (int)__builtin_amdgcn_mbcnt_hi((unsigned)(m >> 32), __builtin_amdgcn_mbcnt_lo((unsigned)m, 0u)); }
template <int NB> __device__ __forceinline__ int wave_sum_small(unsigned c) {
    int t = 0;
#pragma unroll
    for (int b = 0; b < NB; ++b) t += __popcll(__ballot((c >> b) & 1u)) << b;
    return t;
}
__device__ __forceinline__ void split8(const f32x4 a, const f32x4 b, bf16x8& hi, bf16x8& lo) {
    u32x4 h; h.x = cvt_pk_bf16(a[0], a[1]); h.y = cvt_pk_bf16(a[2], a[3]); h.z = cvt_pk_bf16(b[0], b[1]); h.w = cvt_pk_bf16(b[2], b[3]);
    u32x4 l;
    l.x = cvt_pk_bf16(a[0] - __uint_as_float(h.x << 16), a[1] - __uint_as_float(h.x & 0xffff0000u));
    l.y = cvt_pk_bf16(a[2] - __uint_as_float(h.y << 16), a[3] - __uint_as_float(h.y & 0xffff0000u));
    l.z = cvt_pk_bf16(b[0] - __uint_as_float(h.z << 16), b[1] - __uint_as_float(h.z & 0xffff0000u));
    l.w = cvt_pk_bf16(b[2] - __uint_as_float(h.w << 16), b[3] - __uint_as_float(h.w & 0xffff0000u));
    hi = __builtin_bit_cast(bf16x8, h); lo = __builtin_bit_cast(bf16x8, l);
}
struct IdxQ { bf16x8 hi[4], lo[4]; float w[16]; };
struct IdxRaw { f32x4 v[8]; };
struct IdxKey { bf16x8 hi[4], lo[4]; };
__device__ __forceinline__ void idx_load_q(IdxQ& q, const float* QI, const float* WI, int grow0, int lane) {
    const int rho = lane & 31, kh = lane >> 5, ql = 2 * ((rho >> 2) & 1) + (rho >> 4), head = 4 * ((rho >> 3) & 1) + (rho & 3);
    const float* src = QI + (size_t)(grow0 + ql) * 512 + head * IDD + kh * 8;
#pragma unroll
    for (int ks = 0; ks < 4; ++ks) { const f32x4 a = *(const f32x4*)(src + ks * 16), b = *(const f32x4*)(src + ks * 16 + 4); split8(a, b, q.hi[ks], q.lo[ks]); }
#pragma unroll
    for (int e = 0; e < 2; ++e) {
        const float* wsrc = WI + (size_t)(grow0 + 2 * kh + e) * 8;
        const f32x4 a = *(const f32x4*)wsrc, b = *(const f32x4*)(wsrc + 4);
#pragma unroll
        for (int i = 0; i < 4; ++i) { q.w[e * 8 + i] = a[i] * IDX_W_SCALE; q.w[e * 8 + 4 + i] = b[i] * IDX_W_SCALE; }
    }
}
__device__ __forceinline__ void idx_load_raw(IdxRaw& raw, const float* kp) {
#pragma unroll
    for (int ks = 0; ks < 4; ++ks) { raw.v[2 * ks] = *(const f32x4*)(kp + ks * 16); raw.v[2 * ks + 1] = *(const f32x4*)(kp + ks * 16 + 4); }
}
__device__ __forceinline__ void idx_cvt_key(const IdxRaw& raw, IdxKey& k) {
#pragma unroll
    for (int ks = 0; ks < 4; ++ks) split8(raw.v[2 * ks], raw.v[2 * ks + 1], k.hi[ks], k.lo[ks]);
}
__device__ __forceinline__ void idx_load_keyb(IdxKey& k, const bf16_t* ph, const bf16_t* pl) {
#pragma unroll
    for (int ks = 0; ks < 4; ++ks) { k.hi[ks] = *(const bf16x8*)(ph + ks * 16); if (IDX_SPLIT == 3) k.lo[ks] = *(const bf16x8*)(pl + ks * 16); else k.lo[ks] = k.hi[ks]; }
}
__device__ __forceinline__ void idx_tile(const IdxQ& q, const IdxKey& k, float (&s)[2]) {
    f32x16 acc;
#pragma unroll
    for (int i = 0; i < 16; ++i) acc[i] = 0.f;
#pragma unroll
    for (int ks = 0; ks < 4; ++ks) {
        acc = __builtin_amdgcn_mfma_f32_32x32x16_bf16(q.hi[ks], k.hi[ks], acc, 0, 0, 0);
        if (IDX_SPLIT == 3) { acc = __builtin_amdgcn_mfma_f32_32x32x16_bf16(q.hi[ks], k.lo[ks], acc, 0, 0, 0); acc = __builtin_amdgcn_mfma_f32_32x32x16_bf16(q.lo[ks], k.hi[ks], acc, 0, 0, 0); }
    }
#pragma unroll
    for (int e = 0; e < 2; ++e) {
        float t = 0.f;
#pragma unroll
        for (int i = 0; i < 8; ++i) t += fmaxf(acc[e * 8 + i] * IDX_SCALE, 0.f) * q.w[e * 8 + i];
        s[e] = t;
    }
}

#define wlane2(vlo, vhi, m, j) asm volatile("s_nop 3\n\tv_writelane_b32 %0, %2, %4\n\tv_writelane_b32 %1, %3, %4" : "+v"(vlo), "+v"(vhi) : "s"((unsigned)(m)), "s"((unsigned)((m) >> 32)), "n"(j))
__device__ __forceinline__ int count8_ge(unsigned a0, unsigned a1, unsigned a2, unsigned a3, unsigned a4, unsigned a5, unsigned a6, unsigned a7, unsigned cand) {
    unsigned long long m0, m1, m2, m3, m4, m5, m6, m7;
    asm volatile("v_cmp_ge_u32_e64 %0, %8, %16\n\tv_cmp_ge_u32_e64 %1, %9, %16\n\tv_cmp_ge_u32_e64 %2, %10, %16\n\tv_cmp_ge_u32_e64 %3, %11, %16\n\t"
                 "v_cmp_ge_u32_e64 %4, %12, %16\n\tv_cmp_ge_u32_e64 %5, %13, %16\n\tv_cmp_ge_u32_e64 %6, %14, %16\n\tv_cmp_ge_u32_e64 %7, %15, %16\n\ts_nop 3"
                 : "=&s"(m0), "=&s"(m1), "=&s"(m2), "=&s"(m3), "=&s"(m4), "=&s"(m5), "=&s"(m6), "=&s"(m7)
                 : "v"(a0), "v"(a1), "v"(a2), "v"(a3), "v"(a4), "v"(a5), "v"(a6), "v"(a7), "v"(cand));
    return (__popcll(m0) + __popcll(m1)) + (__popcll(m2) + __popcll(m3)) + ((__popcll(m4) + __popcll(m5)) + (__popcll(m6) + __popcll(m7)));
}
template <int NJ, int BITLO = 0>
__device__ __forceinline__ void select_row(const PG8_LAS float* sc, int n, int lane, unsigned long long* bm_row) {
    constexpr int NG = (NJ + 7) / 8;
    unsigned v[NJ];
    const int nj = __builtin_amdgcn_readfirstlane((n + 63) >> 6), ng = (nj + 7) >> 3;
    const PG8_LAS float* pl = sc + lane;
#pragma unroll
    for (int j = 0; j < NJ; ++j) { const unsigned k = fkey(pl[j * 64]); v[j] = (lane < n - j * 64) ? k : 0u; }
    unsigned T = 1u; int need = 1 << 30;
    if (n > TOPK) {
        unsigned prefix = 0u; bool exact = false;
        for (int bit = 31; bit >= BITLO; --bit) {
            const unsigned cand = prefix | (1u << bit);
            int cnt = 0;
#pragma unroll
            for (int g = 0; g < NG; ++g) if (g < ng) cnt += count8_ge(v[g * 8], v[g * 8 + 1], v[g * 8 + 2], v[g * 8 + 3], v[g * 8 + 4], v[g * 8 + 5], v[g * 8 + 6], v[g * 8 + 7], cand);
            if (cnt >= TOPK) prefix = cand;
            if (cnt == TOPK) { exact = true; break; }
        }
        T = prefix;
        if (!exact) {
            int cgt = 0;
#pragma unroll
            for (int g = 0; g < NG; ++g) if (g < ng) {
#pragma unroll
                for (int jj = 0; jj < 8; ++jj) if (g * 8 + jj < NJ) cgt += __popcll(__ballot(v[g * 8 + jj] > T));
            }
            need = TOPK - cgt;
        }
    }
    unsigned mlo = 0u, mhi = 0u;
    if (need >= (1 << 29)) {
#pragma unroll
        for (int g = 0; g < NG; ++g) if (g < ng) {
#pragma unroll
            for (int jj = 0; jj < 8; ++jj) { const int j = g * 8 + jj; const unsigned long long sm = __ballot(v[j] >= T);
                wlane2(mlo, mhi, sm, j); }
        }
    } else {
        int base_eq = 0;
#pragma unroll
        for (int j = 0; j < NJ; ++j) if (j < nj) {
            const bool gt = v[j] > T, eq = v[j] == T;
            const unsigned long long eqm = __ballot(eq);
            const bool s = gt || (eq && (base_eq + mbcnt64(eqm)) < need);
            const unsigned long long sm = __ballot(s);
            base_eq += __popcll(eqm);
            wlane2(mlo, mhi, sm, j);
        }
    }
    const unsigned long long mymask = ((unsigned long long)mhi << 32) | mlo;
    bm_row[lane] = mymask;
}
__device__ __forceinline__ void select_row_wg(const PG8_LAS float* sc, int n, PG8_LAS int* sel, volatile PG8_LAS int* red) {
    constexpr int NC = 17;
    const int tid_ = fresh_tid(), lane = tid_ & 63, wave = __builtin_amdgcn_readfirstlane(tid_ >> 6);
    unsigned v[NC];
    const PG8_LAS float* pl = sc + wave * NC * 64 + lane;
    const int nrem = n - wave * NC * 64;
#pragma unroll
    for (int j = 0; j < NC; ++j) { const unsigned k = fkey(pl[j * 64]); v[j] = (lane < nrem - j * 64) ? k : 0u; }
    unsigned prefix = 0u; bool exact = false; int it = 0;
    for (int bit = 31; bit >= 0; --bit, ++it) {
        const unsigned cand = prefix | (1u << bit);
        int wc = 0;
#pragma unroll
        for (int j = 0; j < NC; ++j) wc += __popcll(__ballot(v[j] >= cand));
        if (lane == 0) red[(it & 1) * 8 + wave] = wc;
        __syncthreads();
        int cnt = 0;
#pragma unroll
        for (int w = 0; w < 8; ++w) cnt += red[(it & 1) * 8 + w];
        if (cnt >= TOPK) prefix = cand;
        if (cnt == TOPK) { exact = true; break; }
    }
    const unsigned T = prefix;
    unsigned cg = 0u, ce = 0u;
#pragma unroll
    for (int j = 0; j < NC; ++j) { cg += (v[j] > T) ? 1u : 0u; ce += (v[j] == T) ? 1u : 0u; }
    const int wg_ = wave_sum_small<5>(cg), we_ = wave_sum_small<5>(ce);
    __syncthreads();
    if (lane == 0) { red[16 + wave] = wg_; red[24 + wave] = we_; }
    __syncthreads();
    int tot_gt = 0, eq_before = 0, gt_before = 0;
#pragma unroll
    for (int w = 0; w < 8; ++w) { const int g = red[16 + w], e = red[24 + w]; tot_gt += g; if (w < wave) { gt_before += g; eq_before += e; } }
    const int need = exact ? (1 << 30) : TOPK - tot_gt;
    int base_sel = gt_before + (eq_before < need ? eq_before : need), base_eq = eq_before;
    int ln = lane; asm volatile("" : "+v"(ln));
#pragma unroll
    for (int j = 0; j < NC; ++j) {
        const bool gt = v[j] > T, eq = v[j] == T;
        const unsigned long long eqm = __ballot(eq);
        const bool s = gt || (eq && (base_eq + mbcnt64(eqm)) < need);
        const unsigned long long sm = __ballot(s);
        if (s) sel[base_sel + mbcnt64(sm)] = (wave * NC + j) * 64 + ln;
        base_eq += __popcll(eqm); base_sel += __popcll(sm);
    }
    __syncthreads();
}
__device__ __forceinline__ void idx_sample_score_unit(const Params& p, int bs, int pg8) {
    const int tid_ = fresh_tid(), lane = tid_ & 63, wave = __builtin_amdgcn_readfirstlane(tid_ >> 6), r = lane & 31, kh = lane >> 5;
    unsigned char* ws = p.ws;
    const float* QI = (const float*)(ws + WS_QI); const float* WI = (const float*)(ws + WS_WI); float* SCS = (float*)(ws + WS_SCS);
    const bf16_t* KIH = (const bf16_t*)(ws + WS_KIH); const bf16_t* KIL = (const bf16_t*)(ws + WS_KIL);
    const float* cache_ki = p.in[4]; const int* page_table = (const int*)p.in[7];
    IdxQ q; idx_load_q(q, QI, WI, MP + bs * DS, lane);
    const int pg = pg8 * 8 + wave, phys = page_table[bs * NPAGES + pg];
    const float* pbase = cache_ki + (size_t)phys * PAGE * IDD + (size_t)r * IDD + kh * 8;
    float* out0 = SCS + (size_t)(bs * DS + 2 * kh) * SCS_LD;
    IdxRaw raw; idx_load_raw(raw, pbase);
    IdxKey k;
#pragma unroll
    for (int tt = 0; tt < 4; ++tt) {
        idx_cvt_key(raw, k);
        if (tt < 3) idx_load_raw(raw, pbase + (size_t)(tt + 1) * 32 * IDD);
        float s[2]; idx_tile(q, k, s);
        const int col = pg * PAGE + tt * 32 + r;
        out0[col] = s[0]; out0[SCS_LD + col] = s[1];
    }
    if (pg8 == 0 && wave == 0) {
        const size_t kr = (size_t)(MP + bs * DS + (r & 3)) * IDD + kh * 8;
        idx_load_keyb(k, KIH + kr, KIL + kr);
        float s[2]; idx_tile(q, k, s);
        if (r < DS) { out0[NPAST + r] = s[0]; out0[SCS_LD + NPAST + r] = s[1]; }
    }
}

__device__ __forceinline__ void select_row_list(const PG8_LAS float* sc, int n, int lane, int* sel) {
    constexpr int NJ = 136, NG = 17;
    unsigned v[NJ];
    const int nj = __builtin_amdgcn_readfirstlane((n + 63) >> 6), ng = (nj + 7) >> 3;
    const PG8_LAS float* pl = sc + lane;
#pragma unroll
    for (int j = 0; j < NJ; ++j) { const unsigned k = fkey(pl[j * 64]); v[j] = (lane < n - j * 64) ? k : 0u; }
    unsigned prefix = 0u; bool exact = false;
    for (int bit = 31; bit >= 0; --bit) {
        const unsigned cand = prefix | (1u << bit);
        int cnt = 0;
#pragma unroll
        for (int g = 0; g < NG; ++g) if (g < ng) cnt += count8_ge(v[g * 8], v[g * 8 + 1], v[g * 8 + 2], v[g * 8 + 3], v[g * 8 + 4], v[g * 8 + 5], v[g * 8 + 6], v[g * 8 + 7], cand);
        if (cnt >= TOPK) prefix = cand;
        if (cnt == TOPK) { exact = true; break; }
    }
    const unsigned T = prefix; int need = 1 << 30;
    if (!exact) {
        int cgt = 0;
#pragma unroll
        for (int j = 0; j < NJ; ++j) if (j < nj) cgt += __popcll(__ballot(v[j] > T));
        need = TOPK - cgt;
    }
    int base_eq = 0, base_sel = 0;
    int ln = lane; asm volatile("" : "+v"(ln));
#pragma unroll
    for (int j = 0; j < NJ; ++j) if (j < nj) {
        const bool gt = v[j] > T, eq = v[j] == T;
        const unsigned long long eqm = __ballot(eq);
        const bool s = gt || (eq && (base_eq + mbcnt64(eqm)) < need);
        const unsigned long long sm = __ballot(s);
        if (s) sel[base_sel + mbcnt64(sm)] = j * 64 + ln;
        base_eq += __popcll(eqm); base_sel += __popcll(sm);
    }
}
__device__ __forceinline__ void idx_sample_batch_unit(const Params& p, PG8_LAS unsigned char* lds, int bs) {
    const int tid_ = fresh_tid(), lane = tid_ & 63, wave = __builtin_amdgcn_readfirstlane(tid_ >> 6), r = lane & 31, kh = lane >> 5;
    unsigned char* ws = p.ws;
    const float* QI = (const float*)(ws + WS_QI); const float* WI = (const float*)(ws + WS_WI); int* SEL = (int*)(ws + WS_SEL);
    const bf16_t* KIH = (const bf16_t*)(ws + WS_KIH); const bf16_t* KIL = (const bf16_t*)(ws + WS_KIL);
    const float* cache_ki = p.in[4]; const int* page_table = (const int*)p.in[7];
    PG8_LAS float* sc = (PG8_LAS float*)lds;
    IdxQ q; idx_load_q(q, QI, WI, MP + bs * DS, lane);
    IdxRaw raw; IdxKey k;
    for (int pg = wave; pg < NPAGES; pg += NWAVES) {
        const int phys = page_table[bs * NPAGES + pg];
        const float* pbase = cache_ki + (size_t)phys * PAGE * IDD + (size_t)r * IDD + kh * 8;
        idx_load_raw(raw, pbase);
#pragma unroll
        for (int tt = 0; tt < 4; ++tt) {
            idx_cvt_key(raw, k);
            if (tt < 3) idx_load_raw(raw, pbase + (size_t)(tt + 1) * 32 * IDD);
            float s2[2]; idx_tile(q, k, s2);
            const int col = pg * PAGE + tt * 32 + r;
            sc[(2 * kh) * SCS_LDL + col] = s2[0]; sc[(2 * kh + 1) * SCS_LDL + col] = s2[1];
        }
    }
    if (wave == 0) {
        const size_t kr = (size_t)(MP + bs * DS + (r & 3)) * IDD + kh * 8;
        idx_load_keyb(k, KIH + kr, KIL + kr);
        float s2[2]; idx_tile(q, k, s2);
        if (r < DS) { sc[(2 * kh) * SCS_LDL + NPAST + r] = s2[0]; sc[(2 * kh + 1) * SCS_LDL + NPAST + r] = s2[1]; }
    }
    __syncthreads();
    if (wave < DS) select_row_list(sc + wave * SCS_LDL, NPAST + wave + 1, lane, SEL + (size_t)(bs * DS + wave) * TOPK);
    __syncthreads();
}
__device__ __forceinline__ void idx_prompt_unit(const Params& p, PG8_LAS unsigned char* lds, int s, int mode = 1) {
    const int tid_ = fresh_tid(), lane = tid_ & 63, wave = __builtin_amdgcn_readfirstlane(tid_ >> 6), r = lane & 31, kh = lane >> 5;
    unsigned char* ws = p.ws;
    const float* QI = (const float*)(ws + WS_QI); const float* WI = (const float*)(ws + WS_WI); unsigned long long* BM = (unsigned long long*)(ws + WS_BM);
    const bf16_t* KIH = (const bf16_t*)(ws + WS_KIH); const bf16_t* KIL = (const bf16_t*)(ws + WS_KIL);
    PG8_LAS float* sc = (PG8_LAS float*)lds;
    const int b = s & 1, q0 = (s >> 1) * 8, grow0 = b * SEQ + q0, ntile = (q0 + 8 + 31) >> 5;
    IdxQ qa, qb; idx_load_q(qa, QI, WI, grow0, lane); idx_load_q(qb, QI, WI, grow0 + 4, lane);
    const size_t kbase = (size_t)(b * SEQ + r) * IDD + kh * 8;
    IdxKey kn;
    if (wave < ntile) idx_load_keyb(kn, KIH + kbase + (size_t)wave * 32 * IDD, KIL + kbase + (size_t)wave * 32 * IDD);
    for (int t = wave; t < ntile; t += NWAVES) {
        const IdxKey k = kn;
        if (t + NWAVES < ntile) idx_load_keyb(kn, KIH + kbase + (size_t)(t + NWAVES) * 32 * IDD, KIL + kbase + (size_t)(t + NWAVES) * 32 * IDD);
        float sa[2], sb[2]; idx_tile(qa, k, sa); idx_tile(qb, k, sb);
        const int col = t * 32 + r;
        sc[(2 * kh) * SCP_LD + col] = sa[0]; sc[(2 * kh + 1) * SCP_LD + col] = sa[1];
        sc[(4 + 2 * kh) * SCP_LD + col] = sb[0]; sc[(5 + 2 * kh) * SCP_LD + col] = sb[1];
    }
    __syncthreads();
    if (mode == 1) select_row<64>(sc + wave * SCP_LD, q0 + wave + 1, lane, BM + (size_t)(grow0 + wave) * 64);
    if (mode == 2) select_row<64>(sc + wave * SCP_LD, q0 + wave + 1, lane, (unsigned long long*)(ws + WS_SEL) + (size_t)(grow0 + wave) * 64);
    if (mode == 3) select_row<64, 24>(sc + wave * SCP_LD, q0 + wave + 1, lane, (unsigned long long*)(ws + WS_SEL) + (size_t)(grow0 + wave) * 64);
}
__device__ __forceinline__ unsigned wq_next(unsigned* ctr, PG8_LAS unsigned char* lds) {
    volatile PG8_LAS unsigned* slot = (volatile PG8_LAS unsigned*)(lds + LDS_MISC + 64);
    __syncthreads();
    if (threadIdx.x == 0) *slot = atomicAdd(ctr, 1u);
    __syncthreads();
    return *slot;
}

constexpr int G_SC = 0, G_SEL = 32800, G_RED = 33824, G_QS = 34304, G_PS = 38400, G_KP = 46592, G_VP = 48640, G_OP = 50688;
__device__ __forceinline__ void sample_row_unit(const Params& p, PG8_LAS unsigned char* lds, int rs) {
    const int tid = fresh_tid(), lane = tid & 63, wave = tid >> 6;
    unsigned char* ws = p.ws;
    const bf16_t* QB = (const bf16_t*)(ws + WS_QB); const float* SCS = (const float*)(ws + WS_SCS);
    const float* cache_k = p.in[2]; const float* cache_v = p.in[3]; const int* page_table = (const int*)p.in[7];
    bf16_t* CATB = (bf16_t*)(ws + WS_CATB); float* PS = (float*)(ws + WS_PS);
    const int row = MP + rs, b = rs / DS, n = NPAST + (rs % DS) + 1;
    PG8_LAS float* sc = (PG8_LAS float*)(lds + G_SC);
    PG8_LAS int* sel = (PG8_LAS int*)(lds + G_SEL);
    PG8_LAS float* qs = (PG8_LAS float*)(lds + G_QS);
    PG8_LAS float* ps = (PG8_LAS float*)(lds + G_PS);
    PG8_LAS unsigned long long* kps = (PG8_LAS unsigned long long*)(lds + G_KP);
    PG8_LAS unsigned long long* vps = (PG8_LAS unsigned long long*)(lds + G_VP);
    PG8_LAS float* op = (PG8_LAS float*)(lds + G_OP);
    { const bf16_t* z = QB + (size_t)row * 1024; qs[tid] = __uint_as_float((unsigned)z[tid] << 16); qs[tid + 512] = __uint_as_float((unsigned)z[tid + 512] << 16); }
    __syncthreads();
    (void)sc; (void)SCS; (void)n; (void)sel;
    if (tid < TOPK) {
        const int idx = ((const int*)(ws + WS_SEL))[(size_t)rs * TOPK + tid];
        const float* kp; const float* vp;
        if (idx < NPAST) { const size_t prow = (size_t)page_table[b * NPAGES + idx / PAGE] * PAGE + (idx % PAGE); kp = cache_k + prow * 512; vp = cache_v + prow * 512; }
        else { const size_t zr = (size_t)(b * DS + idx - NPAST); kp = p.out + O_KS + zr * 512; vp = p.out + O_VS + zr * 512; }
        kps[tid] = (unsigned long long)kp; vps[tid] = (unsigned long long)vp;
    }
    __syncthreads();
    {
        const int j = tid & 255, hg = tid >> 8;
        const float* kp = (const float*)kps[j] + hg * 256;
#pragma unroll
        for (int n2 = 0; n2 < 2; ++n2) {
            float d0 = 0.f, d1 = 0.f;
            const PG8_LAS float* q0 = qs + (4 * hg + 2 * n2) * HD; const PG8_LAS float* q1 = q0 + HD;
#pragma unroll 8
            for (int d = 0; d < HD; d += 4) {
                const f32x4 k4 = *(const f32x4*)(kp + n2 * HD + d);
                d0 += q0[d] * k4[0] + q0[d + 1] * k4[1] + q0[d + 2] * k4[2] + q0[d + 3] * k4[3];
                d1 += q1[d] * k4[0] + q1[d + 1] * k4[1] + q1[d + 2] * k4[2] + q1[d + 3] * k4[3];
            }
            ps[(4 * hg + 2 * n2) * TOPK + j] = d0 * ATTN_SCALE; ps[(4 * hg + 2 * n2 + 1) * TOPK + j] = d1 * ATTN_SCALE;
        }
    }
    __syncthreads();
    {
        float v[4]; float m = -INFINITY;
#pragma unroll
        for (int i = 0; i < 4; ++i) { v[i] = ps[wave * TOPK + lane + 64 * i]; m = fmaxf(m, v[i]); }
#pragma unroll
        for (int o = 32; o >= 1; o >>= 1) m = fmaxf(m, __shfl_xor(m, o));
        float sum = 0.f;
#pragma unroll
        for (int i = 0; i < 4; ++i) { v[i] = expf(v[i] - m); sum += v[i]; }
#pragma unroll
        for (int o = 32; o >= 1; o >>= 1) sum += __shfl_xor(sum, o);
        const float inv = 1.0f / sum;
#pragma unroll
        for (int i = 0; i < 4; ++i) ps[wave * TOPK + lane + 64 * i] = v[i] * inv;
    }
    __syncthreads();
    {
        const int o4 = tid & 255, kq = tid >> 8, hq = o4 >> 5, d = (o4 & 31) * 4, nkv = hq >> 1;
        f32x4 acc = (f32x4){0.f, 0.f, 0.f, 0.f};
#pragma unroll 8
        for (int j = kq * 128; j < kq * 128 + 128; ++j) acc += *(const f32x4*)((const float*)vps[j] + nkv * HD + d) * ps[hq * TOPK + j];
        if (kq == 1) *(PG8_LAS f32x4*)(op + o4 * 4) = acc;
        __syncthreads();
        if (kq == 0) {
            acc += *(const PG8_LAS f32x4*)(op + o4 * 4);
            u32x2 w; w.x = cvt_pk_bf16(acc[0], acc[1]); w.y = cvt_pk_bf16(acc[2], acc[3]);
            *(u32x2*)(CATB + (size_t)row * D + 1024 + o4 * 4) = w;
        }
    }
    __syncthreads();
}

typedef short s16x4 __attribute__((ext_vector_type(4)));
constexpr int A_KP = 272, A_VP = 320, A_KBYTES = 64 * A_KP, A_VBYTES = 64 * A_VP, A_STAGE = A_KBYTES + A_VBYTES;
constexpr float A_SC = 0.08838834764831845f * 1.4426950408889634f;
__device__ __forceinline__ float xhalf_max(float x) { const auto sw = __builtin_amdgcn_permlane32_swap(__float_as_uint(x), __float_as_uint(x), false, false); return fmaxf(__uint_as_float(sw[0]), __uint_as_float(sw[1])); }
__device__ __forceinline__ float xhalf_sum(float x) { const auto sw = __builtin_amdgcn_permlane32_swap(__float_as_uint(x), __float_as_uint(x), false, false); return __uint_as_float(sw[0]) + __uint_as_float(sw[1]); }
__device__ __forceinline__ void attn_dense_unit(const Params& p, PG8_LAS unsigned char* lds, int b, int n, int qb) {
    const int tid = fresh_tid(), lane = tid & 63, wave = __builtin_amdgcn_readfirstlane(tid >> 6), r = lane & 31, kh = lane >> 5;
    unsigned char* ws = p.ws;
    const bf16_t* QB = (const bf16_t*)(ws + WS_QB); const bf16_t* KB = (const bf16_t*)(ws + WS_KB); const bf16_t* VB = (const bf16_t*)(ws + WS_VB);
    const unsigned long long* BM = (const unsigned long long*)(ws + WS_BM);
    bf16_t* CATB = (bf16_t*)(ws + WS_CATB); float* PS = (float*)(ws + WS_PS);
    const int q = qb * 128 + wave * 16 + (r & 15), head = 2 * n + (r >> 4);
    const size_t qrow = (size_t)b * SEQ + q;
    bf16x8 qf[8];
#pragma unroll
    for (int ks = 0; ks < 8; ++ks) qf[ks] = *(const bf16x8*)(QB + qrow * 1024 + head * HD + ks * 16 + kh * 8);
    f32x16 O[4];
#pragma unroll
    for (int dt = 0; dt < 4; ++dt)
#pragma unroll
        for (int i = 0; i < 16; ++i) O[dt][i] = 0.f;
    float m = -INFINITY, l = 0.f;
    const int ntile = 2 * qb + 2, qmax_w = qb * 128 + wave * 16 + 15;
    const int srow = tid >> 4, sch = tid & 15;
    const bf16_t* kg = KB + ((size_t)b * SEQ + srow) * 512 + n * HD + sch * 8;
    const bf16_t* vg = VB + ((size_t)b * SEQ + srow) * 512 + n * HD + sch * 8;
    u32x4 kst[2], vst[2];
#define A_GLOAD(t) do { _Pragma("unroll") for (int _i = 0; _i < 2; ++_i) { kst[_i] = *(const u32x4*)(kg + (size_t)((t) * 64 + _i * 32) * 512); vst[_i] = *(const u32x4*)(vg + (size_t)((t) * 64 + _i * 32) * 512); } } while (0)
#define A_LSTORE(buf) do { _Pragma("unroll") for (int _i = 0; _i < 2; ++_i) { *(PG8_LAS u32x4*)(lds + (buf) * A_STAGE + (srow + _i * 32) * A_KP + sch * 16) = kst[_i]; \
        *(PG8_LAS u32x4*)(lds + (buf) * A_STAGE + A_KBYTES + (srow + _i * 32) * A_VP + sch * 16) = vst[_i]; } } while (0)
    A_GLOAD(0); A_LSTORE(0);
    unsigned long long mw = BM[qrow * 64];
    __syncthreads();
    const int i16 = lane & 15, g2 = (lane >> 4) & 1;
    const int vlane_off = (4 * kh + (i16 >> 2)) * A_VP + (16 * g2 + 4 * (i16 & 3)) * 2;
    for (int t = 0; t < ntile; ++t) {
        const bool more = (t + 1 < ntile);
        if (more) A_GLOAD(t + 1);
        const unsigned long long mw_next = more ? BM[qrow * 64 + t + 1] : 0ull;
        const int buf = t & 1;
        if (t * 64 <= qmax_w) {
            PG8_LAS unsigned char* kb = lds + buf * A_STAGE; PG8_LAS unsigned char* vb = kb + A_KBYTES;
            f32x16 s0, s1;
#pragma unroll
            for (int i = 0; i < 16; ++i) { s0[i] = 0.f; s1[i] = 0.f; }
#pragma unroll
            for (int ks = 0; ks < 8; ++ks) {
                const bf16x8 k0 = *(const PG8_LAS bf16x8*)(kb + r * A_KP + (ks * 16 + kh * 8) * 2);
                const bf16x8 k1 = *(const PG8_LAS bf16x8*)(kb + (32 + r) * A_KP + (ks * 16 + kh * 8) * 2);
                s0 = __builtin_amdgcn_mfma_f32_32x32x16_bf16(k0, qf[ks], s0, 0, 0, 0);
                s1 = __builtin_amdgcn_mfma_f32_32x32x16_bf16(k1, qf[ks], s1, 0, 0, 0);
            }
            const unsigned lo = (unsigned)mw >> (4 * kh), hi = (unsigned)(mw >> 32) >> (4 * kh);
            float mx = -INFINITY;
#pragma unroll
            for (int i = 0; i < 16; ++i) {
                const unsigned bit = 1u << ((i & 3) + 8 * (i >> 2));
                s0[i] = (lo & bit) ? s0[i] * A_SC : -INFINITY; s1[i] = (hi & bit) ? s1[i] * A_SC : -INFINITY;
                mx = fmaxf(mx, fmaxf(s0[i], s1[i]));
            }
            mx = xhalf_max(mx);
            const float m_new = fmaxf(m, mx), m_safe = (m_new == -INFINITY) ? 0.f : m_new;
            const float alpha = __builtin_amdgcn_exp2f(m - m_safe);
            float lsum = 0.f;
#pragma unroll
            for (int i = 0; i < 16; ++i) { s0[i] = __builtin_amdgcn_exp2f(s0[i] - m_safe); s1[i] = __builtin_amdgcn_exp2f(s1[i] - m_safe); lsum += s0[i] + s1[i]; }
            l = l * alpha + lsum; m = m_new;
            if (__ballot(alpha != 1.0f) != 0ull) {
#pragma unroll
                for (int dt = 0; dt < 4; ++dt)
#pragma unroll
                    for (int i = 0; i < 16; ++i) O[dt][i] *= alpha;
            }
            bf16x8 pf[2][2];
#pragma unroll
            for (int sx = 0; sx < 2; ++sx) {
                u32x4 w0, w1;
                w0.x = cvt_pk_bf16(s0[8 * sx], s0[8 * sx + 1]); w0.y = cvt_pk_bf16(s0[8 * sx + 2], s0[8 * sx + 3]); w0.z = cvt_pk_bf16(s0[8 * sx + 4], s0[8 * sx + 5]); w0.w = cvt_pk_bf16(s0[8 * sx + 6], s0[8 * sx + 7]);
                w1.x = cvt_pk_bf16(s1[8 * sx], s1[8 * sx + 1]); w1.y = cvt_pk_bf16(s1[8 * sx + 2], s1[8 * sx + 3]); w1.z = cvt_pk_bf16(s1[8 * sx + 4], s1[8 * sx + 5]); w1.w = cvt_pk_bf16(s1[8 * sx + 6], s1[8 * sx + 7]);
                pf[0][sx] = __builtin_bit_cast(bf16x8, w0); pf[1][sx] = __builtin_bit_cast(bf16x8, w1);
            }
#pragma unroll
            for (int st = 0; st < 2; ++st)
#pragma unroll
                for (int sx = 0; sx < 2; ++sx)
#pragma unroll
                    for (int dt = 0; dt < 4; ++dt) {
                        PG8_LAS unsigned char* a = vb + vlane_off + (st * 32 + 16 * sx) * A_VP + dt * 64;
                        const s16x4 vlo = __builtin_amdgcn_ds_read_tr16_b64_v4i16((PG8_LAS s16x4*)a);
                        const s16x4 vhi = __builtin_amdgcn_ds_read_tr16_b64_v4i16((PG8_LAS s16x4*)(a + 8 * A_VP));
                        const bf16x8 vf = __builtin_shufflevector(vlo, vhi, 0, 1, 2, 3, 4, 5, 6, 7);
                        O[dt] = __builtin_amdgcn_mfma_f32_32x32x16_bf16(vf, pf[st][sx], O[dt], 0, 0, 0);
                    }
        }
        if (more) A_LSTORE(buf ^ 1);
        __syncthreads();
        mw = mw_next;
    }
#undef A_GLOAD
#undef A_LSTORE
    const float inv = 1.0f / xhalf_sum(l);
    bf16_t* orow = CATB + qrow * D + 1024 + head * HD;
#pragma unroll
    for (int dt = 0; dt < 4; ++dt)
#pragma unroll
        for (int a = 0; a < 4; ++a) {
            u32x2 w; w.x = cvt_pk_bf16(O[dt][4 * a] * inv, O[dt][4 * a + 1] * inv); w.y = cvt_pk_bf16(O[dt][4 * a + 2] * inv, O[dt][4 * a + 3] * inv);
            *(u32x2*)(orow + 32 * dt + 8 * a + 4 * kh) = w;
        }
}
__device__ __forceinline__ void attn_phase(const Params& p, PG8_LAS unsigned char* lds, int ctr_off = 0) {
    const int G = gridDim.x;
    for (int u = blockIdx.x; u < 256; u += G) { const int qb = 31 - (u >> 3), bn = u & 7; attn_dense_unit(p, lds, bn >> 2, bn & 3, qb); }
    unsigned* ctr = (unsigned*)(p.ws + WS_CTR) + ctr_off;
    for (;;) {
        const unsigned idx = wq_next(ctr, lds);
        if (idx >= (unsigned)(MS + LRU_NCHUNK)) break;
        if (idx < (unsigned)MS) sample_row_unit(p, lds, (int)idx); else lru_fixup_unit(p, (int)idx - MS);
    }
}
__device__ __forceinline__ void mid1_phase(const Params& p, PG8_LAS unsigned char* lds) {
    unsigned* ctr = (unsigned*)(p.ws + WS_CTR) + 64;
    constexpr unsigned NA = DB, NB_ = MP / 8, NC_ = LRU_NCHUNK * 8;
    for (;;) {
        const unsigned idx = wq_next(ctr, lds);
        constexpr unsigned XA_ = (MID_DUP == 1) ? NA : 0u, XB_ = (MID_DUP >= 6) ? NB_ : 0u, XC_ = (MID_DUP == 3) ? NC_ : 0u;
        if (idx >= NA + XA_ + NB_ + XB_ + NC_ + XC_) break;
        if (idx < NA + XA_) { const unsigned u = idx % NA; idx_sample_batch_unit(p, lds, (int)u); }
        else if (idx < NA + XA_ + NB_) idx_prompt_unit(p, lds, (int)(NB_ - 1 - (idx - NA - XA_)));
        else if (idx < NA + XA_ + NB_ + XB_) idx_prompt_unit(p, lds, (int)(NB_ - 1 - (idx - NA - XA_ - NB_)), MID_DUP == 6 ? 2 : (MID_DUP == 7 ? 3 : 0));
        else lru_local_unit(p, lds, (int)((idx - NA - XA_ - NB_ - XB_) % NC_));
    }
}

__device__ __forceinline__ void prep_phase(const Params& p, PG8_LAS unsigned char* lds) {
    unsigned char* ws = p.ws;
    bf16_t* Wgu1 = (bf16_t*)(ws + WS_WGU1); bf16_t* Wd1 = (bf16_t*)(ws + WS_WD1); bf16_t* Win = (bf16_t*)(ws + WS_WIN); bf16_t* Wout = (bf16_t*)(ws + WS_WOUT);
    bf16_t* Wgu2 = (bf16_t*)(ws + WS_WGU2); bf16_t* Wd2 = (bf16_t*)(ws + WS_WD2); bf16_t* XB = (bf16_t*)(ws + WS_XB);
    PG8_LAS float* tile = (PG8_LAS float*)lds;
    const int wid = blockIdx.x, nw = gridDim.x;
    transpose_cvt<1>(p.in[10], D, 2 * DFF, 2 * DFF, Wgu1, tile, wid, nw);
    cvt_x(p.in[0], p.in[1], XB);
    for (int n = 0; n < 8; ++n) { transpose_cvt<0>(p.in[15] + n * 16384, 128, 128, 128, (bf16_t*)(ws + WS_WAT) + n * 16384, tile, wid, nw); transpose_cvt<0>(p.in[17] + n * 16384, 128, 128, 128, (bf16_t*)(ws + WS_WIT) + n * 16384, tile, wid, nw); }
    (void)Wd1; (void)Win; (void)Wout; (void)Wgu2; (void)Wd2;
}
__device__ __forceinline__ void tail_cvt(const Params& p, PG8_LAS unsigned char* lds, int which, int nunits) {
    const int G = gridDim.x, c = blockIdx.x, full = nunits / G, rem = nunits - full * G;
    if (rem != 0 && c < rem) return;
    const int wid = (rem == 0) ? c : c - rem, nw = (rem == 0) ? G : G - rem;
    unsigned char* ws = p.ws; PG8_LAS float* tile = (PG8_LAS float*)lds;
    __syncthreads();
    if (which == 0) {
        transpose_cvt<0>(p.in[11], DFF, D, D, (bf16_t*)(ws + WS_WD1), tile, wid, nw);
        transpose_cvt<0>(p.in[12], D, DIN, DINP, (bf16_t*)(ws + WS_WIN), tile, wid, nw);
        transpose_cvt<0>(p.in[20], D, D, D, (bf16_t*)(ws + WS_WOUT), tile, wid, nw);
    } else if (which == 1) transpose_cvt<1>(p.in[23], D, 2 * DFF, 2 * DFF, (bf16_t*)(ws + WS_WGU2), tile, wid, nw);
    else transpose_cvt<0>(p.in[24], DFF, D, D, (bf16_t*)(ws + WS_WD2), tile, wid, nw);
}

__global__ void __launch_bounds__(NTHREADS, 2) mk_fwd(Params p) {
    extern __shared__ __attribute__((aligned(16))) unsigned char lds_raw[];
    PG8_LAS unsigned char* lds = (PG8_LAS unsigned char*)lds_raw;
    unsigned char* ws = p.ws;
    const int lo = p.ph_lo, hi = p.ph_hi;
    const int G = gridDim.x;
    if (threadIdx.x < 4) ((volatile PG8_LAS unsigned*)(lds + LDS_MISC))[threadIdx.x] = 0u;
    __syncthreads();
    XcdBarrier bar = xcd_barrier_post((unsigned*)(ws + WS_CTL) + (size_t)p.li * XCD_BAR_WORDS, (volatile LAS unsigned*)(lds + LDS_MISC));
#define SEAM(k) do { if (lo <= (k) && (k) + 1 < hi) xcd_barrier(bar); } while (0)
    bf16_t* Wgu1 = (bf16_t*)(ws + WS_WGU1); bf16_t* Wd1 = (bf16_t*)(ws + WS_WD1); bf16_t* Win = (bf16_t*)(ws + WS_WIN); bf16_t* Wout = (bf16_t*)(ws + WS_WOUT);
    bf16_t* Wgu2 = (bf16_t*)(ws + WS_WGU2); bf16_t* Wd2 = (bf16_t*)(ws + WS_WD2);
    bf16_t* XB = (bf16_t*)(ws + WS_XB); bf16_t* H = (bf16_t*)(ws + WS_H); float* T = (float*)(ws + WS_T); float* X1 = (float*)(ws + WS_X1); float* X2 = (float*)(ws + WS_X2);
    bf16_t* CATB = (bf16_t*)(ws + WS_CATB); float* PS = (float*)(ws + WS_PS); float* ST1 = (float*)(ws + WS_ST); float* ST2 = ST1 + 2 * MP;
#define IN(k) (lo <= (k) && (k) < hi)
    if (IN(0)) prep_phase(p, lds);
    SEAM(0);
    if (IN(1)) {
        pg8::Gemm g{XB, Wgu1, MPAD, 2 * DFF, D}; pg8::StaticOrder S; S.init(MPAD, 2 * DFF, G, (int)blockIdx.x, D);
        EpiSwiGLU E{H};
        pg8::gemm_phase<EpiSwiGLU, pg8::StaticOrder, true, true>(lds, g, S, E);
        tail_cvt(p, lds, 0, (MPAD / 256) * (2 * DFF / 256));
    }
    SEAM(1);
    if (IN(2)) {
        pg8::Gemm g{H, Wd1, MPAD, D, DFF}; SplitOrder S; S.init(D, DFF, G, (int)blockIdx.x);
        EpiResidSplit E{p.in[0], T, PS, 0.5f, nullptr, nullptr, nullptr};
        pg8::gemm_phase<EpiResidSplit, SplitOrder, true, true>(lds, g, S, E);
    }
    SEAM(2);
    if (IN(3)) ln_phase(T, p.in[8], p.in[9], X1, XB, PS, DFF / 256, p.in[1], 0.5f, ST1);
    SEAM(3);
    if (IN(4)) {
        pg8::Gemm g{XB, Win, MPAD, DINP, D}; pg8::StaticOrder S; S.init(MPAD, DINP, G, (int)blockIdx.x, D);
        EpiWin E{(float*)(ws + WS_XR), (float*)(ws + WS_GG), (bf16_t*)(ws + WS_QB), (bf16_t*)(ws + WS_KB), (bf16_t*)(ws + WS_VB), (float*)(ws + WS_QI), (bf16_t*)(ws + WS_KIH), (bf16_t*)(ws + WS_KIL), (float*)(ws + WS_WI), p.out};
        pg8::gemm_phase<EpiWin, pg8::StaticOrder, true, true>(lds, g, S, E);
        tail_cvt(p, lds, 1, (MPAD / 256) * (DINP / 256));
    }
    SEAM(4);
    if (IN(5)) mid1_phase(p, lds);
    SEAM(5);
    if (IN(6)) { attn_phase(p, lds); if (REP_6 > 1) { __syncthreads(); attn_phase(p, lds, 128); } }
    SEAM(6);
    if (IN(7)) {
        pg8::Gemm g{CATB, Wout, MPAD, D, D}; SplitOrder S; S.init(D, D, G, (int)blockIdx.x);
        EpiResidSplit E{nullptr, T, PS, 1.0f, ST1, p.in[8], p.in[9]};
        pg8::gemm_phase<EpiResidSplit, SplitOrder, true, true>(lds, g, S, E);
    }
    SEAM(7);
    if (IN(8)) ln_phase(T, p.in[21], p.in[22], X2, XB, PS, D / 256, X1 + (size_t)MP * D, 1.0f, ST2);
    SEAM(8);
    if (IN(9)) {
        pg8::Gemm g{XB, Wgu2, MPAD, 2 * DFF, D}; pg8::StaticOrder S; S.init(MPAD, 2 * DFF, G, (int)blockIdx.x, D);
        EpiSwiGLU E{H};
        pg8::gemm_phase<EpiSwiGLU, pg8::StaticOrder, true, true>(lds, g, S, E);
        tail_cvt(p, lds, 2, (MPAD / 256) * (2 * DFF / 256));
    }
    SEAM(9);
    if (IN(10)) {
        pg8::Gemm g{H, Wd2, MPAD, D, DFF}; SplitOrder S; S.init(D, DFF, G, (int)blockIdx.x);
        EpiResidSplit E{nullptr, T, PS, 0.5f, ST2, p.in[21], p.in[22]};
        pg8::gemm_phase<EpiResidSplit, SplitOrder, true, true>(lds, g, S, E);
    }
    SEAM(10);
    if (IN(11)) ln_phase(T, p.in[25], p.in[26], p.out + O_YP, nullptr, PS, DFF / 256, X2 + (size_t)MP * D, 0.5f, nullptr);
#undef IN
#undef SEAM
}

}

extern "C" void kernel_launch(void* const* d_in, const int* in_sizes, int n_in, void* d_out, int out_size, void* d_ws, size_t ws_size, hipStream_t stream) {
    static int grid = 0;
    if (grid == 0) {
        if (n_in != 27 || ws_size < WS_END3) { grid = -1; return; }
        int dev = 0, cus = 0;
        if (hipGetDevice(&dev) != hipSuccess || hipDeviceGetAttribute(&cus, hipDeviceAttributeMultiprocessorCount, dev) != hipSuccess) { grid = -1; return; }
        if (hipFuncSetAttribute((const void*)mk_fwd, hipFuncAttributeMaxDynamicSharedMemorySize, LDS_BYTES) != hipSuccess) { grid = -1; return; }
        (void)hipGetLastError();
        grid = cus;
    }
    if (grid < 0) return;
    float* out = (float*)d_out;
    unsigned char* ws = (unsigned char*)d_ws;

    (void)hipMemsetAsync(ws + WS_CTL, 0, CTL_BYTES, stream);
    Params p{};
    for (int i = 0; i < 27; ++i) p.in[i] = (const float*)d_in[i];
    p.out = out; p.ws = ws;
    int nli = 0;
    auto run = [&](int lo, int hi) { p.ph_lo = lo; p.ph_hi = hi; p.li = nli++; hipLaunchKernelGGL(mk_fwd, dim3(grid), dim3(NTHREADS), LDS_BYTES, stream, p); };
    run(0, 12);
}
```

```cpp
#include <hip/hip_runtime.h>
#include <stdint.h>

namespace pg8 {
#define PG8_LAS __attribute__((address_space(3)))
typedef unsigned short bf16_t;
typedef short bf16x8 __attribute__((ext_vector_type(8)));
typedef float f32x4 __attribute__((ext_vector_type(4)));
typedef unsigned u32x4 __attribute__((ext_vector_type(4)));
constexpr int BM = 256, BK = 64, HALF = 128, HTB = HALF * BK * 2  , STAGE_BYTES = 8 * HTB, NXCD = 8, WGM = 8;

__host__ __device__ __forceinline__ int lds_byte(int r, int c) { const int st = (r >> 4) * 2 + (c >> 5), rr = r & 15, cc = c & 31, ob = rr * 64 + cc * 2; return st * 1024 + (ob ^ (((ob >> 9) & 1) << 5)); }
__host__ __device__ __forceinline__ void stage_rc(int b, int& R, int& C) { const int st = b / 1024, sb = b % 1024, swz = sb ^ (((sb >> 9) & 1) << 5); R = (st >> 1) * 16 + swz / 64; C = (st & 1) * 32 + (swz % 64) / 2; }
__host__ __device__ __forceinline__ int perm32(int rho) { const int n = rho >> 4, i = rho & 15; return 8 * (i >> 2) + 4 * n + (i & 3); }

struct Unit { int pm, pn, k0, nt, aux; };
struct Gemm { const bf16_t* A; const bf16_t* Bt; int M, N, K; };

struct StaticOrder {
    int nM, nN, nwg, G, c, ntk;
    __host__ __device__ __forceinline__ void init(int M, int N, int G_, int c_, int K_ = 0) { nM = M / BM; nN = N / BM; nwg = nM * nN; G = G_; c = c_; ntk = K_ / BK; }
    __host__ __device__ __forceinline__ bool next(int i, Unit& u) const {
        const long L = (long)i * G + c; if (L >= nwg) return false;
        int wgid = (int)L; { const int q = nwg / NXCD, r = nwg % NXCD, xcd = wgid % NXCD, off = wgid / NXCD; wgid = (xcd < r ? xcd * (q + 1) : r * (q + 1) + (xcd - r) * q) + off; }
        const int nig = WGM * nN, gid = wgid / nig, fm = gid * WGM, gsz = (nM - fm) < WGM ? (nM - fm) : WGM;
        u.pm = fm + ((wgid % nig) % gsz); u.pn = (wgid % nig) / gsz; u.k0 = 0; u.nt = ntk; u.aux = -1; return true;
    }
    __device__ __forceinline__ void a_ready(const Unit&) const {}
    __device__ __forceinline__ void done(const Unit&) const {}
};

__device__ __forceinline__ unsigned cvt_pk_bf16(float lo, float hi) { unsigned r; asm volatile("v_cvt_pk_bf16_f32 %0, %1, %2" : "=v"(r) : "v"(lo), "v"(hi)); return r; }
typedef float f32x2 __attribute__((ext_vector_type(2)));

template <class Epi, class Sched, bool ALIGN_EPI = false, bool SP2 = false>
__device__ __forceinline__ void gemm_phase(PG8_LAS unsigned char* lds, const Gemm g, const Sched& S, const Epi& E) {
    int tid_v = threadIdx.x; asm volatile("" : "+v"(tid_v));
    const int tid = tid_v, wid = __builtin_amdgcn_readfirstlane(tid >> 6), lane = tid & 63, wr = wid >> 2, wc = wid & 3, fr = lane & 15, fq = lane >> 4;
    const int K = g.K;
    unsigned voffA[2], voffB[2];
#pragma unroll
    for (int i = 0; i < 2; ++i) { int R, C; stage_rc(tid * 16 + i * 8192, R, C); const int Rb = Epi::PERM ? ((R & ~31) + perm32(R & 31)) : R;
        voffA[i] = (unsigned)(R * K + C) * 2u; voffB[i] = (unsigned)(Rb * K + C) * 2u; }
    const size_t kstep = (size_t)(BK * 2);
    const size_t hstep = (size_t)HALF * K * 2;
    const size_t tstep = 2 * hstep;
    const unsigned ldsw = (unsigned)wid * 1024u;
    const int aoff = lds_byte(wr * 64 + fr, fq * 8), boff = lds_byte(wc * 32 + fr, fq * 8);
#define PG8_SA(b, h) (((b) * 2 + (h)) * HTB)
#define PG8_SB(b, h) ((4 + (b) * 2 + (h)) * HTB)
#define PG8_STAGE(bufoff, gbase, voff) do { _Pragma("unroll") for (int _i = 0; _i < 2; ++_i) \
        __builtin_amdgcn_global_load_lds((const unsigned*)((const char*)(gbase) + (voff)[_i]), (PG8_LAS unsigned*)(lds + (bufoff) + ldsw + _i * 8192), 16, 0, 0); } while (0)
#define PG8_LDA(dst, b, h) do { _Pragma("unroll") for (int m = 0; m < 4; ++m) _Pragma("unroll") for (int k = 0; k < 2; ++k) dst[m][k] = *(const PG8_LAS bf16x8*)(lds + PG8_SA(b, h) + aoff + m * 2048 + k * 1024); } while (0)
#define PG8_LDB(dst, b, h) do { _Pragma("unroll") for (int n = 0; n < 2; ++n) _Pragma("unroll") for (int k = 0; k < 2; ++k) dst[n][k] = *(const PG8_LAS bf16x8*)(lds + PG8_SB(b, h) + boff + n * 2048 + k * 1024); } while (0)
#define PG8_MMA(ai, bj, At, Bt) do { __builtin_amdgcn_s_setprio(1); _Pragma("unroll") for (int m = 0; m < 4; ++m) _Pragma("unroll") for (int n = 0; n < 2; ++n) _Pragma("unroll") for (int k = 0; k < 2; ++k) \
        acc[ai][bj][m][n] = __builtin_amdgcn_mfma_f32_16x16x32_bf16(Bt[n][k], At[m][k], acc[ai][bj][m][n], 0, 0, 0); __builtin_amdgcn_s_setprio(0); } while (0)
#define PG8_WAIT_V(n) asm volatile("s_waitcnt vmcnt(" #n ")" ::: "memory")
#define PG8_WAIT_L(n) asm volatile("s_waitcnt lgkmcnt(" #n ")" ::: "memory")
#define PG8_BAR __builtin_amdgcn_s_barrier()
#define PG8_SCHED __builtin_amdgcn_sched_barrier(0)
    Unit cur, nxt; int ui = 0;
    if (!S.next(0, cur)) return;
    f32x4 acc[2][2][4][2];
#pragma unroll
    for (int a = 0; a < 2; ++a)
#pragma unroll
        for (int b = 0; b < 2; ++b)
#pragma unroll
            for (int m = 0; m < 4; ++m)
#pragma unroll
                for (int n = 0; n < 2; ++n) acc[a][b][m][n] = (f32x4){0.f, 0.f, 0.f, 0.f};
    bf16x8 At[4][2], B0[2][2], B1[2][2];
    const char* cA = (const char*)g.A + (size_t)cur.pm * tstep + (size_t)cur.k0 * 2; const char* cB = (const char*)g.Bt + (size_t)cur.pn * tstep + (size_t)cur.k0 * 2;
    S.a_ready(cur);
    if constexpr (SP2) {
        PG8_STAGE(PG8_SB(0, 0), cB, voffB); PG8_STAGE(PG8_SB(0, 1), cB + hstep, voffB); PG8_STAGE(PG8_SA(0, 0), cA, voffA); PG8_STAGE(PG8_SA(0, 1), cA + hstep, voffA);
        if (wr == 1) PG8_BAR;
        PG8_WAIT_V(2); PG8_BAR;
        PG8_STAGE(PG8_SB(1, 0), cB + kstep, voffB); PG8_STAGE(PG8_SA(1, 0), cA + kstep, voffA); PG8_STAGE(PG8_SB(1, 1), cB + hstep + kstep, voffB);
        PG8_WAIT_V(6); PG8_BAR;
    } else {
        PG8_STAGE(PG8_SB(0, 0), cB, voffB); PG8_STAGE(PG8_SA(0, 0), cA, voffA); PG8_STAGE(PG8_SB(0, 1), cB + hstep, voffB); PG8_STAGE(PG8_SA(0, 1), cA + hstep, voffA);
        if (wr == 1) PG8_BAR;
        PG8_WAIT_V(4); PG8_BAR;
        PG8_STAGE(PG8_SB(1, 0), cB + kstep, voffB); PG8_STAGE(PG8_SA(1, 0), cA + kstep, voffA); PG8_STAGE(PG8_SB(1, 1), cB + hstep + kstep, voffB);
        PG8_WAIT_V(6); PG8_BAR;
    }
    for (;;) {
        const bool has_next = S.next(ui + 1, nxt);
        const char* nA = has_next ? (const char*)g.A + (size_t)nxt.pm * tstep + (size_t)nxt.k0 * 2 : cA; const char* nB = has_next ? (const char*)g.Bt + (size_t)nxt.pn * tstep + (size_t)nxt.k0 * 2 : cB;
        const int nt = cur.nt;
        for (int t = 0; t < nt; t += 2) {
            const bool last = (t == nt - 2);
            const char* a1 = cA + (size_t)(t + 1) * kstep;
            const char* a2 = last ? nA : cA + (size_t)(t + 2) * kstep; const char* b2 = last ? nB : cB + (size_t)(t + 2) * kstep;
            const char* a3 = a2 + kstep; const char* b3 = b2 + kstep;
            if (last && has_next) S.a_ready(nxt);
            if constexpr (SP2) {
            PG8_LDB(B0, 0, 0); PG8_LDB(B1, 0, 1); PG8_SCHED; PG8_LDA(At, 0, 0); PG8_STAGE(PG8_SA(1, 1), a1 + hstep, voffA);
            PG8_WAIT_V(8); PG8_WAIT_L(0); PG8_BAR; PG8_MMA(0, 0, At, B0); PG8_MMA(0, 1, At, B1); PG8_BAR; PG8_SCHED;
            PG8_LDA(At, 0, 1); PG8_STAGE(PG8_SB(0, 0), b2, voffB); PG8_STAGE(PG8_SB(0, 1), b2 + hstep, voffB); PG8_STAGE(PG8_SA(0, 0), a2, voffA);
            PG8_WAIT_V(8); PG8_WAIT_L(0); PG8_BAR; PG8_MMA(1, 0, At, B0); PG8_MMA(1, 1, At, B1); PG8_BAR; PG8_SCHED;
            PG8_LDB(B0, 1, 0); PG8_LDB(B1, 1, 1); PG8_SCHED; PG8_LDA(At, 1, 0); PG8_STAGE(PG8_SA(0, 1), a2 + hstep, voffA);
            PG8_WAIT_V(8); PG8_WAIT_L(0); PG8_BAR; PG8_MMA(0, 0, At, B0); PG8_MMA(0, 1, At, B1); PG8_BAR; PG8_SCHED;
            PG8_LDA(At, 1, 1); PG8_STAGE(PG8_SB(1, 0), b3, voffB); PG8_STAGE(PG8_SB(1, 1), b3 + hstep, voffB); PG8_STAGE(PG8_SA(1, 0), a3, voffA);
            PG8_WAIT_V(8); PG8_WAIT_L(0); PG8_BAR; PG8_MMA(1, 0, At, B0); PG8_MMA(1, 1, At, B1); PG8_BAR; PG8_SCHED;
            } else {
            PG8_LDB(B0, 0, 0); PG8_SCHED; PG8_LDA(At, 0, 0); PG8_STAGE(PG8_SA(1, 1), a1 + hstep, voffA);
            PG8_WAIT_L(8); PG8_BAR; PG8_WAIT_L(0); PG8_MMA(0, 0, At, B0); PG8_BAR; PG8_SCHED;
            PG8_LDB(B1, 0, 1); PG8_STAGE(PG8_SB(0, 0), b2, voffB);
            PG8_BAR; PG8_WAIT_L(0); PG8_MMA(0, 1, At, B1); PG8_BAR;
            PG8_LDA(At, 0, 1); PG8_STAGE(PG8_SA(0, 0), a2, voffA);
            PG8_BAR; PG8_WAIT_L(0); PG8_MMA(1, 0, At, B0); PG8_BAR; PG8_SCHED;
            PG8_STAGE(PG8_SB(0, 1), b2 + hstep, voffB);
            PG8_WAIT_V(6); PG8_BAR; PG8_MMA(1, 1, At, B1); PG8_BAR;
            PG8_LDB(B0, 1, 0); PG8_SCHED; PG8_LDA(At, 1, 0); PG8_STAGE(PG8_SA(0, 1), a2 + hstep, voffA);
            PG8_WAIT_L(8); PG8_BAR; PG8_WAIT_L(0); PG8_MMA(0, 0, At, B0); PG8_BAR; PG8_SCHED;
            PG8_LDB(B1, 1, 1); PG8_STAGE(PG8_SB(1, 0), b3, voffB);
            PG8_BAR; PG8_WAIT_L(0); PG8_MMA(0, 1, At, B1); PG8_BAR;
            PG8_LDA(At, 1, 1); PG8_STAGE(PG8_SA(1, 0), a3, voffA);
            PG8_BAR; PG8_WAIT_L(0); PG8_MMA(1, 0, At, B0); PG8_BAR; PG8_SCHED;
            PG8_STAGE(PG8_SB(1, 1), b3 + hstep, voffB);
            PG8_WAIT_V(6); PG8_BAR; PG8_MMA(1, 1, At, B1); PG8_BAR;
            }
        }
        if constexpr (ALIGN_EPI) { if (wr == 0) PG8_BAR; }
        if constexpr (!Epi::AFTER_DRAIN) { E(acc, cur, wr, wc, fr, fq); S.done(cur); }
        if (!has_next) break;
#pragma unroll
        for (int a = 0; a < 2; ++a)
#pragma unroll
            for (int b = 0; b < 2; ++b)
#pragma unroll
                for (int m = 0; m < 4; ++m)
#pragma unroll
                    for (int n = 0; n < 2; ++n) acc[a][b][m][n] = (f32x4){0.f, 0.f, 0.f, 0.f};
        cur = nxt; cA = nA; cB = nB; ++ui;
        if constexpr (ALIGN_EPI) { if (wr == 1) PG8_BAR; }
    }
    PG8_WAIT_V(0);
    if constexpr (!ALIGN_EPI) { if (wr == 0) PG8_BAR; }
    PG8_BAR;
    if constexpr (Epi::AFTER_DRAIN) { E.fused(acc, cur, wr, wc, fr, fq, lds, wid, lane); S.done(cur); }
#undef PG8_SA
#undef PG8_SB
#undef PG8_STAGE
#undef PG8_LDA
#undef PG8_LDB
#undef PG8_MMA
#undef PG8_WAIT_V
#undef PG8_WAIT_L
#undef PG8_BAR
#undef PG8_SCHED
}

}

#define XB_TMO      128
#define XB_XCNT(j)  (256  + 64 * (j))
#define XB_XSUB(j)  (1280 + 64 * (j))
#define XB_XGEN(j)  (2304 + 64 * (j))
#define XB_TOP      3328
#define XB_TOPGEN   3392
#define XCD_BAR_WORDS 3456
#define XB_SPIN_CAP (1u << 18)
#define LAS __attribute__((address_space(3)))

__device__ __forceinline__ unsigned xb_ld(unsigned* p)              { return __hip_atomic_load(p, __ATOMIC_RELAXED, __HIP_MEMORY_SCOPE_AGENT); }
__device__ __forceinline__ unsigned xb_add(unsigned* p, unsigned v) { return __hip_atomic_fetch_add(p, v, __ATOMIC_RELAXED, __HIP_MEMORY_SCOPE_AGENT); }
__device__ __forceinline__ unsigned xb_xcc_id() { return (unsigned)__builtin_amdgcn_s_getreg((3 << 11) | 20) & 0xFu; }
#define XB_SPIN(cond, bar) do { unsigned _sp = 0; while (cond) { __builtin_amdgcn_s_sleep(1); \
    if ((++_sp & 255u) == 0u) { if (xb_ld(&(bar)[XB_TMO])) break; if (_sp > XB_SPIN_CAP) { atomicAdd(&(bar)[XB_TMO], 1u); break; } } } } while (0)

struct XcdBarrier {
    unsigned* bar; unsigned x;
    volatile LAS unsigned* st;
};

__device__ __forceinline__ XcdBarrier xcd_barrier_post(unsigned* bar, volatile LAS unsigned* st) {
    XcdBarrier b; b.bar = bar; b.x = xb_xcc_id(); b.st = st;
    if (threadIdx.x == 0) (void)xb_add(&bar[XB_XCNT(b.x)], 1u);
    return b;
}
__device__ __forceinline__ void xcd_barrier_complete(unsigned* bar, unsigned x, unsigned& nloc, unsigned& nx) {
    const unsigned G = gridDim.x * gridDim.y * gridDim.z;
    unsigned sum, cnt, mine, sp = 0u;
    for (;;) {
        sum = 0u; cnt = 0u; mine = 0u;
#pragma unroll
        for (unsigned j = 0; j < 16; ++j) { const unsigned c = xb_ld(&bar[XB_XCNT(j)]); sum += c; cnt += (c > 0u) ? 1u : 0u; mine = (j == x) ? c : mine; }
        if (sum == G) break;
        __builtin_amdgcn_s_sleep(1);
        if ((++sp & 255u) == 0u) { if (xb_ld(&bar[XB_TMO])) break; if (sp > XB_SPIN_CAP) { atomicAdd(&bar[XB_TMO], 1u); break; } }
    }
    nloc = mine > 0u ? mine : 1u; nx = cnt > 0u ? cnt : 1u;
}

__device__ __forceinline__ void xcd_barrier(const XcdBarrier& b) {
    asm volatile("s_waitcnt vmcnt(0)" ::: "memory");
    __syncthreads();
    if (threadIdx.x == 0) {
        unsigned* bar = b.bar;
        __builtin_amdgcn_s_waitcnt(0);
        unsigned nloc = b.st[0], nx = b.st[1];
        if (nloc == 0u) { xcd_barrier_complete(bar, b.x, nloc, nx); b.st[0] = nloc; b.st[1] = nx; }
        const unsigned old = xb_add(&bar[XB_XSUB(b.x)], 1u);
        const unsigned gen = old / nloc;
        if (old + 1u == (gen + 1u) * nloc) {
            __builtin_amdgcn_fence(__ATOMIC_RELEASE, "agent");
            asm volatile("s_waitcnt vmcnt(0)" ::: "memory");
            const unsigned og = xb_add(&bar[XB_TOP], 1u);
            const unsigned tg = og / nx;
            if (og + 1u == (tg + 1u) * nx) xb_add(&bar[XB_TOPGEN], 1u);
            else XB_SPIN(xb_ld(&bar[XB_TOPGEN]) == tg, bar);
            __builtin_amdgcn_fence(__ATOMIC_ACQUIRE, "agent");
            xb_add(&bar[XB_XGEN(b.x)], 1u);
            asm volatile("s_waitcnt vmcnt(0)" ::: "memory");
        } else {
            XB_SPIN(xb_ld(&bar[XB_XGEN(b.x)]) == gen, bar);
            __builtin_amdgcn_fence(__ATOMIC_ACQUIRE, "agent");
            asm volatile("s_waitcnt vmcnt(0)" ::: "memory");
        }
    }
    __syncthreads();
}


namespace {
typedef unsigned short bf16_t;
typedef float f32x4 __attribute__((ext_vector_type(4)));
typedef unsigned u32x4 __attribute__((ext_vector_type(4)));
typedef unsigned u32x2 __attribute__((ext_vector_type(2)));

constexpr int D = 2048, SEQ = 4096, NB = 2, MP = NB * SEQ, DB = 32, DS = 4, MS = DB * DS, MT = MP + MS, MPAD = 8448;
constexpr int DFF = 5504, DRNN = 1024, HD = 128, NKV = 4, IDH = 8, IDD = 64, DIN = 4680, DINP = 4864;
constexpr int NPAGES = 64, PAGE = 128, NPAST = NPAGES * PAGE, LS = NPAST + DS, TOPK = 256;
constexpr int C_XR = 0, C_GR = 1024, C_Q = 2048, C_K = 3072, C_V = 3584, C_QI = 4096, C_KI = 4608, C_WI = 4672;
constexpr float ALPHA = 1.189207115002721f, LN_EPS = 1e-5f, ATTN_SCALE = 0.08838834764831845f, IDX_SCALE = 0.125f, IDX_W_SCALE = 0.35355339059327373f;
constexpr size_t O_YP = 0, O_YS = 16777216, O_KP = 17039360, O_VP = 21233664, O_KIP = 25427968, O_CP = 25952256, O_HP = 25958400,
                 O_KS = 25960448, O_VS = 26025984, O_KIS = 26091520, O_CS = 26099712, O_HS = 26198016;
constexpr int SCS_LD = 8256;
constexpr int ZLD = DINP;

constexpr size_t al256(size_t x) { return (x + 255) & ~(size_t)255; }
constexpr size_t WS_CTL = 0;
constexpr size_t CTL_BYTES = 65536;
constexpr size_t WS_WGU1 = WS_CTL + CTL_BYTES;
constexpr size_t WS_WD1 = WS_WGU1 + al256((size_t)2 * DFF * D * 2);
constexpr size_t WS_WIN = WS_WD1 + al256((size_t)D * DFF * 2);
constexpr size_t WS_WOUT = WS_WIN + al256((size_t)DINP * D * 2);
constexpr size_t WS_WGU2 = WS_WOUT + al256((size_t)D * D * 2);
constexpr size_t WS_WD2 = WS_WGU2 + al256((size_t)2 * DFF * D * 2);
constexpr size_t WS_XB = WS_WD2 + al256((size_t)D * DFF * 2);
constexpr size_t WS_H = WS_XB + al256((size_t)MPAD * D * 2);
constexpr size_t WS_T = WS_H + al256((size_t)MPAD * DFF * 2);
constexpr size_t WS_X1 = WS_T + al256((size_t)MPAD * D * 4);
constexpr size_t WS_X2 = WS_X1 + al256((size_t)MPAD * D * 4);
constexpr size_t WS_XR = WS_X2 + al256((size_t)MPAD * D * 4);
constexpr size_t WS_GG = WS_XR + al256((size_t)MPAD * DRNN * 4);
constexpr size_t WS_QI = WS_GG + al256((size_t)MPAD * DRNN * 4);
constexpr size_t WS_WI = WS_QI + al256((size_t)MPAD * 512 * 4);
constexpr size_t WS_KIH = WS_WI + al256((size_t)MPAD * 8 * 4);
constexpr size_t WS_KIL = WS_KIH + al256((size_t)MPAD * 64 * 2);
constexpr size_t WS_ZEND = WS_KIL + al256((size_t)MPAD * 64 * 2);
constexpr size_t WS_CATB = WS_ZEND;
constexpr size_t WS_HL = WS_CATB + al256((size_t)MPAD * D * 2);
constexpr size_t WS_PP = WS_HL + al256((size_t)MT * DRNN * 4);
constexpr size_t WS_GI = WS_PP + al256((size_t)MT * DRNN * 4);
constexpr size_t WS_SCP = WS_GI + al256((size_t)MT * DRNN * 4);
constexpr size_t WS_SCS = WS_SCP + al256((size_t)MP * SEQ * 4);
constexpr size_t WS_SEL = WS_SCS + al256((size_t)MS * SCS_LD * 4);
constexpr size_t WS_NSEL = WS_SEL + al256((size_t)MT * TOPK * 4);
constexpr size_t WS_SUMA = WS_NSEL + al256((size_t)MT * 4);
constexpr size_t WS_SUMH = WS_SUMA + al256((size_t)130 * DRNN * 4);
constexpr size_t WS_WAT = WS_SUMH + al256((size_t)130 * DRNN * 4);
constexpr size_t WS_WIT = WS_WAT + al256((size_t)8 * 128 * 128 * 2);
constexpr size_t WS_BM = WS_WIT + al256((size_t)8 * 128 * 128 * 2);
constexpr size_t WS_QB = WS_BM + al256((size_t)MP * 64 * 8);
constexpr size_t WS_KB = WS_QB + al256((size_t)MPAD * 1024 * 2);
constexpr size_t WS_VB = WS_KB + al256((size_t)MPAD * 512 * 2);
constexpr size_t WS_END = WS_VB + al256((size_t)MPAD * 512 * 2);
constexpr size_t WS_PS = WS_END;
constexpr size_t WS_END2 = WS_PS + al256((size_t)21 * MS * D * 4);
constexpr size_t WS_ST = WS_END2;
constexpr size_t WS_END3 = WS_ST + al256((size_t)2 * MP * 2 * 4);
constexpr size_t WS_CTR = WS_CTL + 32768;

constexpr int NWAVES = 8, NTHREADS = 512;
#ifndef REP_6
#define REP_6 1
#endif
#ifndef MID_DUP
#define MID_DUP 0
#endif
#ifndef REP_G
#define REP_G 1
#endif
#ifndef REP_T
#define REP_T 1
#endif
#ifndef REP_5
#define REP_5 2
#endif
constexpr int LDS_STAGE = 131072, LDS_MISC = 134144, LDS_BYTES = 135168;

struct Params {
    const float* in[27];
    float* out;
    unsigned char* ws;
    int ph_lo, ph_hi, li, pad_;
};

__device__ __forceinline__ unsigned cvt_pk_bf16(float lo, float hi) { unsigned r; asm volatile("v_cvt_pk_bf16_f32 %0, %1, %2" : "=v"(r) : "v"(lo), "v"(hi)); return r; }
__device__ __forceinline__ int fresh_tid() { int t = threadIdx.x; asm volatile("" : "+v"(t)); return t; }
__device__ __forceinline__ float sigmoidf_(float x) { return 1.0f / (1.0f + expf(-x)); }
__device__ __forceinline__ float gelu_tanh(float x) { const float a = -2.3022081985f * (x + 0.044715f * x * x * x); return x * __builtin_amdgcn_rcpf(1.0f + __builtin_amdgcn_exp2f(a)); }
__device__ __forceinline__ bf16_t f2bf(float f) { return (bf16_t)(cvt_pk_bf16(f, 0.f) & 0xffffu); }

struct EpiSwiGLU {
    static constexpr bool PERM = true, AFTER_DRAIN = false;
    bf16_t* H;
    __device__ __forceinline__ void operator()(const f32x4 (&acc)[2][2][4][2], const pg8::Unit& u, int wr, int wc, int fr, int fq) const {
        const int row0 = u.pm * 256 + wr * 64 + fr, col0 = u.pn * 128 + wc * 32 + 8 * fq;
#pragma unroll
        for (int ai = 0; ai < 2; ++ai)
#pragma unroll
            for (int m = 0; m < 4; ++m) {
                bf16_t* rowp = H + (size_t)(row0 + ai * 128 + m * 16) * DFF + col0;
                float h[8];
#pragma unroll
                for (int n = 0; n < 2; ++n)
#pragma unroll
                    for (int j = 0; j < 4; ++j) {
                        const float g = acc[ai][0][m][n][j], up = acc[ai][1][m][n][j];
                        const float sg = __builtin_amdgcn_rcpf(1.0f + __builtin_amdgcn_exp2f(-1.4426950408889634f * g));
                        h[n * 4 + j] = g * sg * up;
                    }
                u32x4 w; w.x = cvt_pk_bf16(h[0], h[1]); w.y = cvt_pk_bf16(h[2], h[3]); w.z = cvt_pk_bf16(h[4], h[5]); w.w = cvt_pk_bf16(h[6], h[7]);
                *(u32x4*)rowp = w;
            }
    }
};
struct EpiResid {
    static constexpr bool PERM = false, AFTER_DRAIN = false;
    const float* Xp; const float* Xs; float* T; float s;
    __device__ __forceinline__ void operator()(const f32x4 (&acc)[2][2][4][2], const pg8::Unit& u, int wr, int wc, int fr, int fq) const {
        const int row0 = u.pm * 256 + wr * 64 + fr, col0 = u.pn * 256 + wc * 32 + 4 * fq;
#pragma unroll
        for (int ai = 0; ai < 2; ++ai)
#pragma unroll
            for (int m = 0; m < 4; ++m) {
                const int row = row0 + ai * 128 + m * 16;
                if (row < MT) {
                    const float* xr = (row < MP) ? Xp + (size_t)row * D + col0 : Xs + (size_t)(row - MP) * D + col0;
                    float* tr = T + (size_t)row * D + col0;
#pragma unroll
                    for (int bj = 0; bj < 2; ++bj)
#pragma unroll
                        for (int n = 0; n < 2; ++n) { const f32x4 xv = *(const f32x4*)(xr + bj * 128 + n * 16); *(f32x4*)(tr + bj * 128 + n * 16) = xv * ALPHA + acc[ai][bj][m][n] * s; }
                }
            }
    }
};
struct EpiF32 {
    static constexpr bool PERM = false, AFTER_DRAIN = false;
    float* C; int ldc;
    __device__ __forceinline__ void operator()(const f32x4 (&acc)[2][2][4][2], const pg8::Unit& u, int wr, int wc, int fr, int fq) const {
        const int row0 = u.pm * 256 + wr * 64 + fr, col0 = u.pn * 256 + wc * 32 + 4 * fq;
#pragma unroll
        for (int ai = 0; ai < 2; ++ai)
#pragma unroll
            for (int m = 0; m < 4; ++m) {
                float* rowp = C + (size_t)(row0 + ai * 128 + m * 16) * ldc + col0;
#pragma unroll
                for (int bj = 0; bj < 2; ++bj)
#pragma unroll
                    for (int n = 0; n < 2; ++n) *(f32x4*)(rowp + bj * 128 + n * 16) = acc[ai][bj][m][n];
            }
    }
};


struct EpiWin {
    static constexpr bool PERM = false, AFTER_DRAIN = false;
    float* XR; float* GG; bf16_t* QB; bf16_t* KB; bf16_t* VB; float* QI; bf16_t* KIH; bf16_t* KIL; float* WI; float* out;
    template <class F> __device__ __forceinline__ void each(const f32x4 (&acc)[2][2][4][2], const pg8::Unit& u, int wr, int wc, int fr, int fq, F f) const {
        const int row0 = u.pm * 256 + wr * 64 + fr, cl = wc * 32 + 4 * fq;
#pragma unroll
        for (int ai = 0; ai < 2; ++ai)
#pragma unroll
            for (int m = 0; m < 4; ++m)
#pragma unroll
                for (int bj = 0; bj < 2; ++bj)
#pragma unroll
                    for (int n = 0; n < 2; ++n) f(row0 + ai * 128 + m * 16, cl + 128 * bj + 16 * n, acc[ai][bj][m][n]);
    }
    static __device__ __forceinline__ u32x2 pk4(const f32x4 v) { u32x2 w; w.x = cvt_pk_bf16(v[0], v[1]); w.y = cvt_pk_bf16(v[2], v[3]); return w; }
    __device__ __forceinline__ void operator()(const f32x4 (&acc)[2][2][4][2], const pg8::Unit& u, int wr, int wc, int fr, int fq) const {
        const int pn = u.pn;
        if (pn < 4) each(acc, u, wr, wc, fr, fq, [&](int row, int c, const f32x4 v) { *(f32x4*)(XR + (size_t)row * DRNN + pn * 256 + c) = v; });
        else if (pn < 8) each(acc, u, wr, wc, fr, fq, [&](int row, int c, const f32x4 v) { *(f32x4*)(GG + (size_t)row * DRNN + (pn - 4) * 256 + c) = (f32x4){gelu_tanh(v[0]), gelu_tanh(v[1]), gelu_tanh(v[2]), gelu_tanh(v[3])}; });
        else if (pn < 12) each(acc, u, wr, wc, fr, fq, [&](int row, int c, const f32x4 v) { *(u32x2*)(QB + (size_t)row * 1024 + (pn - 8) * 256 + c) = pk4(v); });
        else if (pn < 16) {
            bf16_t* B = (pn < 14) ? KB : VB; const size_t op = (pn < 14) ? O_KP : O_VP, os = (pn < 14) ? O_KS : O_VS; const int c0 = (pn & 1) * 256;
            each(acc, u, wr, wc, fr, fq, [&](int row, int c, const f32x4 v) {
                *(u32x2*)(B + (size_t)row * 512 + c0 + c) = pk4(v);
                if (row < MT) *(f32x4*)(out + (row < MP ? op + (size_t)row * 512 : os + (size_t)(row - MP) * 512) + c0 + c) = v; });
        }
        else if (pn < 18) each(acc, u, wr, wc, fr, fq, [&](int row, int c, const f32x4 v) { *(f32x4*)(QI + (size_t)row * 512 + (pn - 16) * 256 + c) = v; });
        else each(acc, u, wr, wc, fr, fq, [&](int row, int c, const f32x4 v) {
            if (c < 64) {
                const u32x2 h = pk4(v);
                u32x2 l; l.x = cvt_pk_bf16(v[0] - __uint_as_float(h.x << 16), v[1] - __uint_as_float(h.x & 0xffff0000u)); l.y = cvt_pk_bf16(v[2] - __uint_as_float(h.y << 16), v[3] - __uint_as_float(h.y & 0xffff0000u));
                *(u32x2*)(KIH + (size_t)row * 64 + c) = h; *(u32x2*)(KIL + (size_t)row * 64 + c) = l;
                if (row < MT) *(f32x4*)(out + (row < MP ? O_KIP + (size_t)row * 64 : O_KIS + (size_t)(row - MP) * 64) + c) = v;
            } else if (c < 72) *(f32x4*)(WI + (size_t)row * 8 + (c - 64)) = v; });
    }
};


struct SplitOrder {
    pg8::StaticOrder base; int G, c, nmine, npiece, ntk, nN;
    __device__ __forceinline__ void init(int N, int K, int G_, int c_) { base.init(MP, N, G_, c_, K); G = G_; c = c_; nN = N / 256; ntk = K / 64; npiece = ntk / 4; nmine = (c_ < base.nwg) ? (base.nwg - c_ + G_ - 1) / G_ : 0; }
    __device__ __forceinline__ bool next(int i, pg8::Unit& u) const {
        if (i < nmine) return base.next(i, u);
        const int mi = (i - nmine) * G + c; if (mi >= npiece * nN) return false;
        const int kp = mi / nN; u.pm = MP / 256; u.pn = mi % nN; u.k0 = kp * 256; u.nt = (kp == npiece - 1) ? ntk - 4 * (npiece - 1) : 4; u.aux = kp; return true;
    }
    __device__ __forceinline__ void a_ready(const pg8::Unit&) const {}
    __device__ __forceinline__ void done(const pg8::Unit&) const {}
};
struct EpiResidSplit {
    static constexpr bool PERM = false, AFTER_DRAIN = false;
    const float* X; float* T; float* PS; float s; const float* ST; const float* gn; const float* bn;
    __device__ __forceinline__ void operator()(const f32x4 (&acc)[2][2][4][2], const pg8::Unit& u, int wr, int wc, int fr, int fq) const {
        const int col0 = u.pn * 256 + wc * 32 + 4 * fq;
        if (u.aux < 0) {
            const int row0 = u.pm * 256 + wr * 64 + fr;
            if (ST == nullptr) {
#pragma unroll
                for (int ai = 0; ai < 2; ++ai)
#pragma unroll
                    for (int m = 0; m < 4; ++m) {
                        const size_t off = (size_t)(row0 + ai * 128 + m * 16) * D + col0;
#pragma unroll
                        for (int bj = 0; bj < 2; ++bj)
#pragma unroll
                            for (int n = 0; n < 2; ++n) { const f32x4 xv = *(const f32x4*)(X + off + bj * 128 + n * 16); *(f32x4*)(T + off + bj * 128 + n * 16) = xv * ALPHA + acc[ai][bj][m][n] * s; }
                    }
            } else {
                f32x4 gv[2][2], bv[2][2];
#pragma unroll
                for (int bj = 0; bj < 2; ++bj)
#pragma unroll
                    for (int n = 0; n < 2; ++n) { gv[bj][n] = *(const f32x4*)(gn + col0 + bj * 128 + n * 16); bv[bj][n] = *(const f32x4*)(bn + col0 + bj * 128 + n * 16); }
#pragma unroll
                for (int ai = 0; ai < 2; ++ai)
#pragma unroll
                    for (int m = 0; m < 4; ++m) {
                        const int row = row0 + ai * 128 + m * 16;
                        const size_t off = (size_t)row * D + col0;
                        const float mean = ST[2 * row], rstd = ST[2 * row + 1];
#pragma unroll
                        for (int bj = 0; bj < 2; ++bj)
#pragma unroll
                            for (int n = 0; n < 2; ++n) { const f32x4 tv = *(const f32x4*)(T + off + bj * 128 + n * 16); const f32x4 xv = (tv - mean) * rstd * gv[bj][n] + bv[bj][n];
                                *(f32x4*)(T + off + bj * 128 + n * 16) = xv * ALPHA + acc[ai][bj][m][n] * s; }
                    }
            }
        } else {
            float* slab = PS + (size_t)u.aux * MS * D;
#pragma unroll
            for (int m = 0; m < 4; ++m) {
                float* rp = slab + (size_t)(wr * 64 + m * 16 + fr) * D + col0;
#pragma unroll
                for (int bj = 0; bj < 2; ++bj)
#pragma unroll
                    for (int n = 0; n < 2; ++n) *(f32x4*)(rp + bj * 128 + n * 16) = acc[0][bj][m][n];
            }
        }
    }
};

template <int MODE>
__device__ __forceinline__ void transpose_cvt(const float* __restrict__ W, int K, int N, int Npad, bf16_t* __restrict__ Wt, PG8_LAS float* tile, int wid, int nw) {
    const int tid = fresh_tid(), ntn = Npad / 64, ntk = K / 128, ntiles = ntn * ntk;
    const int lk = tid >> 4, ln4 = (tid & 15) * 4;
    f32x4 v[4];
    auto src0 = [&](int t) { const int n0 = (t % ntn) * 64; if (MODE == 1) { const int t256 = n0 >> 8, j = n0 & 255; return (j < 128) ? t256 * 128 + j : DFF + t256 * 128 + (j - 128); } return n0; };
    auto gload = [&](int t) {
        const int k0 = (t / ntn) * 128, s0 = src0(t);
#pragma unroll
        for (int i = 0; i < 4; ++i) {
            const float* q = W + (size_t)(k0 + lk + 32 * i) * N + s0 + ln4;
            if (MODE == 1 || s0 + ln4 + 3 < N) v[i] = *(const f32x4*)q;
            else { v[i] = (f32x4){0.f, 0.f, 0.f, 0.f}; for (int e = 0; e < 4; ++e) if (s0 + ln4 + e < N) v[i][e] = q[e]; }
        }
    };
    int t = wid;
    if (t < ntiles) gload(t);
    for (; t < ntiles; t += nw) {
#pragma unroll
        for (int i = 0; i < 4; ++i)
#pragma unroll
            for (int e = 0; e < 4; ++e) tile[(lk + 32 * i) * 65 + ln4 + e] = v[i][e];
        const int tn = t + nw;
        if (tn < ntiles) gload(tn);
        __syncthreads();
        {
            const int n0 = (t % ntn) * 64, k0 = (t / ntn) * 128;
            const int n = tid >> 3, kq = (tid & 7) * 16;
#pragma unroll
            for (int h = 0; h < 2; ++h) {
                float x[8];
#pragma unroll
                for (int j = 0; j < 8; ++j) x[j] = tile[(kq + 8 * h + j) * 65 + n];
                u32x4 w; w.x = cvt_pk_bf16(x[0], x[1]); w.y = cvt_pk_bf16(x[2], x[3]); w.z = cvt_pk_bf16(x[4], x[5]); w.w = cvt_pk_bf16(x[6], x[7]);
                *(u32x4*)(Wt + (size_t)(n0 + n) * K + k0 + kq + 8 * h) = w;
            }
        }
        __syncthreads();
    }
}
__device__ __forceinline__ void cvt_x(const float* __restrict__ xp, const float* __restrict__ xs, bf16_t* __restrict__ XB) {
    const size_t n4 = (size_t)MPAD * D / 4;
    for (size_t i = (size_t)blockIdx.x * NTHREADS + threadIdx.x; i < n4; i += (size_t)gridDim.x * NTHREADS) {
        const size_t e = i * 4, row = e / D;
        f32x4 v = (f32x4){0.f, 0.f, 0.f, 0.f};
        if (row < (size_t)MP) v = *(const f32x4*)(xp + e); else if (row < (size_t)MT) v = *(const f32x4*)(xs + (e - (size_t)MP * D));
        u32x2 w; w.x = cvt_pk_bf16(v[0], v[1]); w.y = cvt_pk_bf16(v[2], v[3]);
        *(u32x2*)(XB + e) = w;
    }
}
__device__ __forceinline__ void ln_phase(const float* __restrict__ T, const float* __restrict__ g, const float* __restrict__ b, float* __restrict__ Xo, bf16_t* __restrict__ Xb,
                                         const float* __restrict__ PS, int npiece, const float* __restrict__ Xs, float sres, float* __restrict__ ST) {
    const int tid_ = fresh_tid(), lane = tid_ & 63, wave = tid_ >> 6;
    for (int row = blockIdx.x * NWAVES + wave; row < MT; row += gridDim.x * NWAVES) {
        f32x4 v[8]; float s = 0.f;
        if (row < MP) {
            const float* tr = T + (size_t)row * D + lane * 4;
#pragma unroll
            for (int i = 0; i < 8; ++i) v[i] = *(const f32x4*)(tr + 256 * i);
        } else {
            const size_t ro = (size_t)(row - MP) * D + lane * 4;
#pragma unroll
            for (int i = 0; i < 8; ++i) v[i] = (f32x4){0.f, 0.f, 0.f, 0.f};
#pragma unroll 1
            for (int pz = 0; pz < npiece; ++pz) {
                const float* sp = PS + (size_t)pz * MS * D + ro;
#pragma unroll
                for (int i = 0; i < 8; ++i) v[i] += *(const f32x4*)(sp + 256 * i);
            }
#pragma unroll
            for (int i = 0; i < 8; ++i) v[i] = *(const f32x4*)(Xs + ro + 256 * i) * ALPHA + v[i] * sres;
        }
#pragma unroll
        for (int i = 0; i < 8; ++i) s += (v[i][0] + v[i][1]) + (v[i][2] + v[i][3]);
#pragma unroll
        for (int o = 32; o >= 1; o >>= 1) s += __shfl_xor(s, o);
        const float mean = s * (1.0f / D);
        float q = 0.f;
#pragma unroll
        for (int i = 0; i < 8; ++i) { const f32x4 d = v[i] - mean; q += (d[0] * d[0] + d[1] * d[1]) + (d[2] * d[2] + d[3] * d[3]); }
#pragma unroll
        for (int o = 32; o >= 1; o >>= 1) q += __shfl_xor(q, o);
        const float rstd = rsqrtf(q * (1.0f / D) + LN_EPS);
        if (ST && row < MP && lane == 0) { ST[2 * row] = mean; ST[2 * row + 1] = rstd; }
        const float* gq = g; const float* bq = b; asm volatile("" : "+s"(gq), "+s"(bq));
#pragma unroll
        for (int i = 0; i < 8; ++i) {
            const f32x4 o = (v[i] - mean) * rstd * *(const f32x4*)(gq + lane * 4 + 256 * i) + *(const f32x4*)(bq + lane * 4 + 256 * i);
            if (Xo && (ST == nullptr || row >= MP)) *(f32x4*)(Xo + (size_t)row * D + lane * 4 + 256 * i) = o;
            if (Xb) { u32x2 w; w.x = cvt_pk_bf16(o[0], o[1]); w.y = cvt_pk_bf16(o[2], o[3]); *(u32x2*)(Xb + (size_t)row * D + lane * 4 + 256 * i) = w; }
        }
    }
}

typedef short bf16x8 __attribute__((ext_vector_type(8)));
typedef float f32x16 __attribute__((ext_vector_type(16)));
__device__ __forceinline__ int crow(int reg, int h) { return (reg & 3) + 8 * (reg >> 2) + 4 * h; }
constexpr int LRU_CH = 64, LRU_NCHUNK = MT / LRU_CH  , LRU_PCHUNK = MP / LRU_CH  , LRU_CPB = SEQ / LRU_CH  ;
constexpr int L_XCF = 0, L_XCB = 32768, L_AA = 50176, L_UU = 82944, XCB_PITCH = 272;
__device__ __forceinline__ void lru_local_unit(const Params& p, PG8_LAS unsigned char* lds, int u) {
    const int tid = fresh_tid(), lane = tid & 63, wave = tid >> 6;
    unsigned char* ws = p.ws;
    const float* XR = (const float*)(ws + WS_XR);
    const float* state_conv = p.in[5]; const float* state_rnn = p.in[6];
    const float* cw = p.in[13]; const float* cb = p.in[14];
    const float* ba = p.in[16]; const float* bi = p.in[18]; const float* lam = p.in[19];
    const bf16_t* WAt = (const bf16_t*)(ws + WS_WAT); const bf16_t* WIt = (const bf16_t*)(ws + WS_WIT);
    float* HL = (float*)(ws + WS_HL); float* PP = (float*)(ws + WS_PP); float* SUMA = (float*)(ws + WS_SUMA); float* SUMH = (float*)(ws + WS_SUMH);
    float* out = p.out;
    PG8_LAS float* XCF = (PG8_LAS float*)(lds + L_XCF); PG8_LAS float* AA = (PG8_LAS float*)(lds + L_AA); PG8_LAS float* UU = (PG8_LAS float*)(lds + L_UU);
    {
        const int ck = u >> 3, nb = u & 7;
        const int mt = wave >> 2, nt = wave & 3, r = lane & 31, kh = lane >> 5;
        bf16x8 bfa[8], bfi[8];
        {
            const bf16_t* wa = WAt + (size_t)nb * 16384 + (size_t)(nt * 32 + r) * 128 + kh * 8;
            const bf16_t* wi = WIt + (size_t)nb * 16384 + (size_t)(nt * 32 + r) * 128 + kh * 8;
#pragma unroll
            for (int ks = 0; ks < 8; ++ks) { bfa[ks] = *(const bf16x8*)(wa + ks * 16); bfi[ks] = *(const bf16x8*)(wi + ks * 16); }
        }
        const int col_e = nt * 32 + r, ch_e = nb * 128 + col_e;
        const float lam_e = lam[ch_e], bac = ba[ch_e], bic = bi[ch_e];
        {
            const int c = tid & 127, rg = tid >> 7, ch = nb * 128 + c;
            const float w0 = cw[ch], w1 = cw[DRNN + ch], w2 = cw[2 * DRNN + ch], w3 = cw[3 * DRNN + ch], cbv = cb[ch];
            if (ck < LRU_PCHUNK) {
                const int b = ck / LRU_CPB, t0 = (ck % LRU_CPB) * LRU_CH + rg * 16;
                const float* zc = XR + (size_t)(b * SEQ) * DRNN + ch;
                float x0 = (t0 - 3 >= 0) ? zc[(size_t)(t0 - 3) * DRNN] : 0.f, x1 = (t0 - 2 >= 0) ? zc[(size_t)(t0 - 2) * DRNN] : 0.f, x2 = (t0 - 1 >= 0) ? zc[(size_t)(t0 - 1) * DRNN] : 0.f;
#pragma unroll
                for (int i = 0; i < 16; ++i) {
                    const int t = t0 + i, lr = rg * 16 + i;
                    const float x3 = zc[(size_t)t * DRNN];
                    const float xc = cbv + w0 * x0 + w1 * x1 + w2 * x2 + w3 * x3;
                    XCF[lr * 128 + c] = xc;
                    *(PG8_LAS bf16_t*)(lds + L_XCB + lr * XCB_PITCH + c * 2) = f2bf(xc);
                    if (t >= SEQ - 3) out[O_CP + (size_t)(b * 3 + (t - (SEQ - 3))) * DRNN + ch] = x3;
                    x0 = x1; x1 = x2; x2 = x3;
                }
            } else {
#pragma unroll
                for (int i = 0; i < 16; ++i) {
                    const int lr = rg * 16 + i, rs = (ck - LRU_PCHUNK) * LRU_CH + lr, bs = rs >> 2, tt = rs & 3;
                    float xv[4];
#pragma unroll
                    for (int j = 0; j < 4; ++j) { const int pp = tt + j; xv[j] = (pp < 3) ? state_conv[(size_t)(bs * 3 + pp) * DRNN + ch] : XR[(size_t)(MP + bs * DS + pp - 3) * DRNN + ch]; }
                    const float xc = cbv + w0 * xv[0] + w1 * xv[1] + w2 * xv[2] + w3 * xv[3];
                    XCF[lr * 128 + c] = xc;
                    *(PG8_LAS bf16_t*)(lds + L_XCB + lr * XCB_PITCH + c * 2) = f2bf(xc);
                    if (tt >= 1) out[O_CS + (size_t)(bs * 3 + (tt - 1)) * DRNN + ch] = xv[3];
                }
            }
        }
        __syncthreads();
        {
            f32x16 acc_a, acc_i;
#pragma unroll
            for (int i = 0; i < 16; ++i) { acc_a[i] = 0.f; acc_i[i] = 0.f; }
#pragma unroll
            for (int ks = 0; ks < 8; ++ks) {
                const bf16x8 af = *(const PG8_LAS bf16x8*)(lds + L_XCB + (mt * 32 + r) * XCB_PITCH + (ks * 16 + kh * 8) * 2);
                acc_a = __builtin_amdgcn_mfma_f32_32x32x16_bf16(af, bfa[ks], acc_a, 0, 0, 0);
                acc_i = __builtin_amdgcn_mfma_f32_32x32x16_bf16(af, bfi[ks], acc_i, 0, 0, 0);
            }
            const int col = col_e, hh = lane >> 5;
            const float l = lam_e, sp = (-l > 20.f) ? -l : log1pf(expf(-l));
#pragma unroll
            for (int i = 0; i < 16; ++i) {
                const int lr = mt * 32 + crow(i, hh);
                const float xc = XCF[lr * 128 + col];
                const float rg = __builtin_amdgcn_rcpf(1.0f + __builtin_amdgcn_exp2f(-1.4426950408889634f * (acc_a[i] + bac)));
                const float ig = __builtin_amdgcn_rcpf(1.0f + __builtin_amdgcn_exp2f(-1.4426950408889634f * (acc_i[i] + bic)));
                const float log_a = -8.0f * rg * sp, x = 2.0f * log_a;
                float om;
                if (x > -0.25f) { float q = 1.0f / 720.0f; q = q * x + 1.0f / 120.0f; q = q * x + 1.0f / 24.0f; q = q * x + 1.0f / 6.0f; q = q * x + 0.5f; q = q * x + 1.0f; om = -x * q; }
                else om = -expm1f(x);
                AA[lr * 128 + col] = __builtin_amdgcn_exp2f(1.4426950408889634f * log_a);
                UU[lr * 128 + col] = __builtin_amdgcn_sqrtf(om) * ig * xc;
            }
        }
        __syncthreads();
        {
            const int c = tid & 127, sg = tid >> 7, ch = nb * 128 + c;
            PG8_LAS float* SEG = (PG8_LAS float*)(lds + L_XCF);
            float hv[16], pv[16];
            float h = 0.f, P = 1.f;
            const bool prompt = ck < LRU_PCHUNK;
#pragma unroll
            for (int i = 0; i < 16; ++i) {
                const int lr = sg * 16 + i;
                const float a = AA[lr * 128 + c], uu = UU[lr * 128 + c];
                if (!prompt && (i & 3) == 0) { h = state_rnn[(size_t)(((ck - LRU_PCHUNK) * LRU_CH + lr) >> 2) * DRNN + ch]; P = 0.f; }
                h = a * h + uu; P *= a;
                hv[i] = h; pv[i] = P;
            }
            SEG[(sg * 128 + c) * 2] = P; SEG[(sg * 128 + c) * 2 + 1] = h;
            __syncthreads();
            float cin = 0.f, pin = 1.f;
            if (prompt) {
#pragma unroll
                for (int s2 = 0; s2 < 3; ++s2) if (s2 < sg) { const float ps = SEG[(s2 * 128 + c) * 2], hs = SEG[(s2 * 128 + c) * 2 + 1]; cin = ps * cin + hs; pin *= ps; }
            }
#pragma unroll
            for (int i = 0; i < 16; ++i) {
                const int lr = sg * 16 + i;
                const size_t g = (size_t)(ck * LRU_CH + lr) * DRNN + ch;
                const float hf = prompt ? hv[i] + pv[i] * cin : hv[i];
                HL[g] = hf; PP[g] = prompt ? pv[i] * pin : 0.f;
                if (!prompt && (i & 3) == 3) out[O_HS + (size_t)(((ck - LRU_PCHUNK) * LRU_CH + lr) >> 2) * DRNN + ch] = hf;
            }
            if (sg == 3) { SUMA[(size_t)ck * DRNN + ch] = prompt ? pv[15] * pin : 0.f; SUMH[(size_t)ck * DRNN + ch] = prompt ? hv[15] + pv[15] * cin : 0.f; }
        }
        __syncthreads();
    }
}
__device__ __forceinline__ void lru_fixup_unit(const Params& p, int ck) {
    const int tid = fresh_tid(), ch = tid * 2;
    unsigned char* ws = p.ws;
    const float* GG = (const float*)(ws + WS_GG);
    const float* HL = (const float*)(ws + WS_HL); const float* PP = (const float*)(ws + WS_PP); const float* SUMA = (const float*)(ws + WS_SUMA); const float* SUMH = (const float*)(ws + WS_SUMH);
    bf16_t* CATB = (bf16_t*)(ws + WS_CATB); float* PS = (float*)(ws + WS_PS);
    typedef float f32x2 __attribute__((ext_vector_type(2)));
    f32x2 carry = (f32x2){0.f, 0.f};
    const bool prompt = ck < LRU_PCHUNK;
    if (prompt) {
        const int b = ck / LRU_CPB, kk = ck % LRU_CPB;
#pragma unroll 4
        for (int j = 0; j < kk; ++j) {
            const f32x2 A = *(const f32x2*)(SUMA + (size_t)(b * LRU_CPB + j) * DRNN + ch), Hh = *(const f32x2*)(SUMH + (size_t)(b * LRU_CPB + j) * DRNN + ch);
            carry = A * carry + Hh;
        }
    }
#pragma unroll 4
    for (int lr = 0; lr < LRU_CH; ++lr) {
        const size_t grow = (size_t)(ck * LRU_CH + lr);
        const f32x2 hl = *(const f32x2*)(HL + grow * DRNN + ch), pp = *(const f32x2*)(PP + grow * DRNN + ch), gg = *(const f32x2*)(GG + grow * DRNN + ch);
        const f32x2 h = hl + pp * carry;
        *(unsigned*)(CATB + grow * D + ch) = cvt_pk_bf16(h.x * gg.x, h.y * gg.y);
        if (prompt && (ck % LRU_CPB) == LRU_CPB - 1 && lr == LRU_CH - 1) *(f32x2*)(p.out + O_HP + (size_t)(ck / LRU_CPB) * DRNN + ch) = h;
    }
}


constexpr int IDX_SPLIT = 1;
constexpr int SCP_LD = 4096, SCS_LDL = 8200;
__device__ __forceinline__ unsigned fkey(float f) { const unsigned u = __float_as_uint(f); return (u & 0x80000000u) ? ~u : (u | 0x80000000u); }
__device__ __forceinline__ int mbcnt64(unsigned long long m) { return (int)__builtin_amdgcn_mbcnt_hi((unsigned)(m >> 32), __builtin_amdgcn_mbcnt_lo((unsigned)m, 0u)); }
template <int NB> __device__ __forceinline__ int wave_sum_small(unsigned c) {
    int t = 0;
#pragma unroll
    for (int b = 0; b < NB; ++b) t += __popcll(__ballot((c >> b) & 1u)) << b;
    return t;
}
__device__ __forceinline__ void split8(const f32x4 a, const f32x4 b, bf16x8& hi, bf16x8& lo) {
    u32x4 h; h.x = cvt_pk_bf16(a[0], a[1]); h.y = cvt_pk_bf16(a[2], a[3]); h.z = cvt_pk_bf16(b[0], b[1]); h.w = cvt_pk_bf16(b[2], b[3]);
    u32x4 l;
    l.x = cvt_pk_bf16(a[0] - __uint_as_float(h.x << 16), a[1] - __uint_as_float(h.x & 0xffff0000u));
    l.y = cvt_pk_bf16(a[2] - __uint_as_float(h.y << 16), a[3] - __uint_as_float(h.y & 0xffff0000u));
    l.z = cvt_pk_bf16(b[0] - __uint_as_float(h.z << 16), b[1] - __uint_as_float(h.z & 0xffff0000u));
    l.w = cvt_pk_bf16(b[2] - __uint_as_float(h.w << 16), b[3] - __uint_as_float(h.w & 0xffff0000u));
    hi = __builtin_bit_cast(bf16x8, h); lo = __builtin_bit_cast(bf16x8, l);
}
struct IdxQ { bf16x8 hi[4], lo[4]; float w[16]; };
struct IdxRaw { f32x4 v[8]; };
struct IdxKey { bf16x8 hi[4], lo[4]; };
__device__ __forceinline__ void idx_load_q(IdxQ& q, const float* QI, const float* WI, int grow0, int lane) {
    const int rho = lane & 31, kh = lane >> 5, ql = 2 * ((rho >> 2) & 1) + (rho >> 4), head = 4 * ((rho >> 3) & 1) + (rho & 3);
    const float* src = QI + (size_t)(grow0 + ql) * 512 + head * IDD + kh * 8;
#pragma unroll
    for (int ks = 0; ks < 4; ++ks) { const f32x4 a = *(const f32x4*)(src + ks * 16), b = *(const f32x4*)(src + ks * 16 + 4); split8(a, b, q.hi[ks], q.lo[ks]); }
#pragma unroll
    for (int e = 0; e < 2; ++e) {
        const float* wsrc = WI + (size_t)(grow0 + 2 * kh + e) * 8;
        const f32x4 a = *(const f32x4*)wsrc, b = *(const f32x4*)(wsrc + 4);
#pragma unroll
        for (int i = 0; i < 4; ++i) { q.w[e * 8 + i] = a[i] * IDX_W_SCALE; q.w[e * 8 + 4 + i] = b[i] * IDX_W_SCALE; }
    }
}
__device__ __forceinline__ void idx_load_raw(IdxRaw& raw, const float* kp) {
#pragma unroll
    for (int ks = 0; ks < 4; ++ks) { raw.v[2 * ks] = *(const f32x4*)(kp + ks * 16); raw.v[2 * ks + 1] = *(const f32x4*)(kp + ks * 16 + 4); }
}
__device__ __forceinline__ void idx_cvt_key(const IdxRaw& raw, IdxKey& k) {
#pragma unroll
    for (int ks = 0; ks < 4; ++ks) split8(raw.v[2 * ks], raw.v[2 * ks + 1], k.hi[ks], k.lo[ks]);
}
__device__ __forceinline__ void idx_load_keyb(IdxKey& k, const bf16_t* ph, const bf16_t* pl) {
#pragma unroll
    for (int ks = 0; ks < 4; ++ks) { k.hi[ks] = *(const bf16x8*)(ph + ks * 16); if (IDX_SPLIT == 3) k.lo[ks] = *(const bf16x8*)(pl + ks * 16); else k.lo[ks] = k.hi[ks]; }
}
__device__ __forceinline__ void idx_tile(const IdxQ& q, const IdxKey& k, float (&s)[2]) {
    f32x16 acc;
#pragma unroll
    for (int i = 0; i < 16; ++i) acc[i] = 0.f;
#pragma unroll
    for (int ks = 0; ks < 4; ++ks) {
        acc = __builtin_amdgcn_mfma_f32_32x32x16_bf16(q.hi[ks], k.hi[ks], acc, 0, 0, 0);
        if (IDX_SPLIT == 3) { acc = __builtin_amdgcn_mfma_f32_32x32x16_bf16(q.hi[ks], k.lo[ks], acc, 0, 0, 0); acc = __builtin_amdgcn_mfma_f32_32x32x16_bf16(q.lo[ks], k.hi[ks], acc, 0, 0, 0); }
    }
#pragma unroll
    for (int e = 0; e < 2; ++e) {
        float t = 0.f;
#pragma unroll
        for (int i = 0; i < 8; ++i) t += fmaxf(acc[e * 8 + i] * IDX_SCALE, 0.f) * q.w[e * 8 + i];
        s[e] = t;
    }
}

#define wlane2(vlo, vhi, m, j) asm volatile("s_nop 3\n\tv_writelane_b32 %0, %2, %4\n\tv_writelane_b32 %1, %3, %4" : "+v"(vlo), "+v"(vhi) : "s"((unsigned)(m)), "s"((unsigned)((m) >> 32)), "n"(j))
__device__ __forceinline__ int count8_ge(unsigned a0, unsigned a1, unsigned a2, unsigned a3, unsigned a4, unsigned a5, unsigned a6, unsigned a7, unsigned cand) {
    unsigned long long m0, m1, m2, m3, m4, m5, m6, m7;
    asm volatile("v_cmp_ge_u32_e64 %0, %8, %16\n\tv_cmp_ge_u32_e64 %1, %9, %16\n\tv_cmp_ge_u32_e64 %2, %10, %16\n\tv_cmp_ge_u32_e64 %3, %11, %16\n\t"
                 "v_cmp_ge_u32_e64 %4, %12, %16\n\tv_cmp_ge_u32_e64 %5, %13, %16\n\tv_cmp_ge_u32_e64 %6, %14, %16\n\tv_cmp_ge_u32_e64 %7, %15, %16\n\ts_nop 3"
                 : "=&s"(m0), "=&s"(m1), "=&s"(m2), "=&s"(m3), "=&s"(m4), "=&s"(m5), "=&s"(m6), "=&s"(m7)
                 : "v"(a0), "v"(a1), "v"(a2), "v"(a3), "v"(a4), "v"(a5), "v"(a6), "v"(a7), "v"(cand));
    return (__popcll(m0) + __popcll(m1)) + (__popcll(m2) + __popcll(m3)) + ((__popcll(m4) + __popcll(m5)) + (__popcll(m6) + __popcll(m7)));
}

template <int NGA, int NJ, int BITLO>
__device__ __forceinline__ bool bit_search(const unsigned (&v)[NJ], unsigned& prefix) {
    for (int bit = 31; bit >= BITLO; --bit) {
        const unsigned cand = prefix | (1u << bit);
        int cnt = 0;
#pragma unroll
        for (int g = 0; g < NGA; ++g) cnt += count8_ge(v[g * 8], v[g * 8 + 1], v[g * 8 + 2], v[g * 8 + 3], v[g * 8 + 4], v[g * 8 + 5], v[g * 8 + 6], v[g * 8 + 7], cand);
        if (cnt >= TOPK) prefix = cand;
        if (cnt == TOPK) return true;
    }
    return false;
}
template <int NJ, int BITLO = 0>
__device__ __forceinline__ void select_row(const PG8_LAS float* sc, int n, int lane, unsigned long long* bm_row) {
    constexpr int NG = (NJ + 7) / 8;
    unsigned v[NJ];
    const int nj = __builtin_amdgcn_readfirstlane((n + 63) >> 6), ng = (nj + 7) >> 3;
    const PG8_LAS float* pl = sc + lane;
#pragma unroll
    for (int j = 0; j < NJ; ++j) { const unsigned k = fkey(pl[j * 64]); v[j] = (lane < n - j * 64) ? k : 0u; }
    unsigned T = 1u; int need = 1 << 30;
    if (n > TOPK) {
        unsigned prefix = 0u; bool exact;
        if (NG >= 8 && ng > 7) exact = bit_search<(NG >= 8 ? 8 : NG), NJ, BITLO>(v, prefix);
        else if (NG >= 7 && ng > 6) exact = bit_search<(NG >= 7 ? 7 : NG), NJ, BITLO>(v, prefix);
        else if (NG >= 6 && ng > 5) exact = bit_search<(NG >= 6 ? 6 : NG), NJ, BITLO>(v, prefix);
        else if (NG >= 5 && ng > 4) exact = bit_search<(NG >= 5 ? 5 : NG), NJ, BITLO>(v, prefix);
        else if (NG >= 4 && ng > 3) exact = bit_search<(NG >= 4 ? 4 : NG), NJ, BITLO>(v, prefix);
        else if (NG >= 3 && ng > 2) exact = bit_search<(NG >= 3 ? 3 : NG), NJ, BITLO>(v, prefix);
        else if (NG >= 2 && ng > 1) exact = bit_search<(NG >= 2 ? 2 : NG), NJ, BITLO>(v, prefix);
        else exact = bit_search<1, NJ, BITLO>(v, prefix);
        T = prefix;
        if (!exact) {
            int cgt = 0;
#pragma unroll
            for (int g = 0; g < NG; ++g) if (g < ng) {
#pragma unroll
                for (int jj = 0; jj < 8; ++jj) if (g * 8 + jj < NJ) cgt += __popcll(__ballot(v[g * 8 + jj] > T));
            }
            need = TOPK - cgt;
        }
    }
    unsigned mlo = 0u, mhi = 0u;
    if (need >= (1 << 29)) {
#pragma unroll
        for (int g = 0; g < NG; ++g) if (g < ng) {
#pragma unroll
            for (int jj = 0; jj < 8; ++jj) { const int j = g * 8 + jj; const unsigned long long sm = __ballot(v[j] >= T);
                wlane2(mlo, mhi, sm, j); }
        }
    } else {
        int base_eq = 0;
#pragma unroll
        for (int j = 0; j < NJ; ++j) if (j < nj) {
            const bool gt = v[j] > T, eq = v[j] == T;
            const unsigned long long eqm = __ballot(eq);
            const bool s = gt || (eq && (base_eq + mbcnt64(eqm)) < need);
            const unsigned long long sm = __ballot(s);
            base_eq += __popcll(eqm);
            wlane2(mlo, mhi, sm, j);
        }
    }
    const unsigned long long mymask = ((unsigned long long)mhi << 32) | mlo;
    bm_row[lane] = mymask;
}
__device__ __forceinline__ void select_row_wg(const PG8_LAS float* sc, int n, PG8_LAS int* sel, volatile PG8_LAS int* red) {
    constexpr int NC = 17;
    const int tid_ = fresh_tid(), lane = tid_ & 63, wave = __builtin_amdgcn_readfirstlane(tid_ >> 6);
    unsigned v[NC];
    const PG8_LAS float* pl = sc + wave * NC * 64 + lane;
    const int nrem = n - wave * NC * 64;
#pragma unroll
    for (int j = 0; j < NC; ++j) { const unsigned k = fkey(pl[j * 64]); v[j] = (lane < nrem - j * 64) ? k : 0u; }
    unsigned prefix = 0u; bool exact = false; int it = 0;
    for (int bit = 31; bit >= 0; --bit, ++it) {
        const unsigned cand = prefix | (1u << bit);
        int wc = 0;
#pragma unroll
        for (int j = 0; j < NC; ++j) wc += __popcll(__ballot(v[j] >= cand));
        if (lane == 0) red[(it & 1) * 8 + wave] = wc;
        __syncthreads();
        int cnt = 0;
#pragma unroll
        for (int w = 0; w < 8; ++w) cnt += red[(it & 1) * 8 + w];
        if (cnt >= TOPK) prefix = cand;
        if (cnt == TOPK) { exact = true; break; }
    }
    const unsigned T = prefix;
    unsigned cg = 0u, ce = 0u;
#pragma unroll
    for (int j = 0; j < NC; ++j) { cg += (v[j] > T) ? 1u : 0u; ce += (v[j] == T) ? 1u : 0u; }
    const int wg_ = wave_sum_small<5>(cg), we_ = wave_sum_small<5>(ce);
    __syncthreads();
    if (lane == 0) { red[16 + wave] = wg_; red[24 + wave] = we_; }
    __syncthreads();
    int tot_gt = 0, eq_before = 0, gt_before = 0;
#pragma unroll
    for (int w = 0; w < 8; ++w) { const int g = red[16 + w], e = red[24 + w]; tot_gt += g; if (w < wave) { gt_before += g; eq_before += e; } }
    const int need = exact ? (1 << 30) : TOPK - tot_gt;
    int base_sel = gt_before + (eq_before < need ? eq_before : need), base_eq = eq_before;
    int ln = lane; asm volatile("" : "+v"(ln));
#pragma unroll
    for (int j = 0; j < NC; ++j) {
        const bool gt = v[j] > T, eq = v[j] == T;
        const unsigned long long eqm = __ballot(eq);
        const bool s = gt || (eq && (base_eq + mbcnt64(eqm)) < need);
        const unsigned long long sm = __ballot(s);
        if (s) sel[base_sel + mbcnt64(sm)] = (wave * NC + j) * 64 + ln;
        base_eq += __popcll(eqm); base_sel += __popcll(sm);
    }
    __syncthreads();
}
__device__ __forceinline__ void idx_sample_score_unit(const Params& p, int bs, int pg8) {
    const int tid_ = fresh_tid(), lane = tid_ & 63, wave = __builtin_amdgcn_readfirstlane(tid_ >> 6), r = lane & 31, kh = lane >> 5;
    unsigned char* ws = p.ws;
    const float* QI = (const float*)(ws + WS_QI); const float* WI = (const float*)(ws + WS_WI); float* SCS = (float*)(ws + WS_SCS);
    const bf16_t* KIH = (const bf16_t*)(ws + WS_KIH); const bf16_t* KIL = (const bf16_t*)(ws + WS_KIL);
    const float* cache_ki = p.in[4]; const int* page_table = (const int*)p.in[7];
    IdxQ q; idx_load_q(q, QI, WI, MP + bs * DS, lane);
    const int pg = pg8 * 8 + wave, phys = page_table[bs * NPAGES + pg];
    const float* pbase = cache_ki + (size_t)phys * PAGE * IDD + (size_t)r * IDD + kh * 8;
    float* out0 = SCS + (size_t)(bs * DS + 2 * kh) * SCS_LD;
    IdxRaw raw; idx_load_raw(raw, pbase);
    IdxKey k;
#pragma unroll
    for (int tt = 0; tt < 4; ++tt) {
        idx_cvt_key(raw, k);
        if (tt < 3) idx_load_raw(raw, pbase + (size_t)(tt + 1) * 32 * IDD);
        float s[2]; idx_tile(q, k, s);
        const int col = pg * PAGE + tt * 32 + r;
        out0[col] = s[0]; out0[SCS_LD + col] = s[1];
    }
    if (pg8 == 0 && wave == 0) {
        const size_t kr = (size_t)(MP + bs * DS + (r & 3)) * IDD + kh * 8;
        idx_load_keyb(k, KIH + kr, KIL + kr);
        float s[2]; idx_tile(q, k, s);
        if (r < DS) { out0[NPAST + r] = s[0]; out0[SCS_LD + NPAST + r] = s[1]; }
    }
}

__device__ __forceinline__ void select_row_list(const PG8_LAS float* sc, int n, int lane, int* sel) {
    constexpr int NJ = 136, NG = 17;
    unsigned v[NJ];
    const int nj = __builtin_amdgcn_readfirstlane((n + 63) >> 6), ng = (nj + 7) >> 3;
    const PG8_LAS float* pl = sc + lane;
#pragma unroll
    for (int j = 0; j < NJ; ++j) { const unsigned k = fkey(pl[j * 64]); v[j] = (lane < n - j * 64) ? k : 0u; }
    unsigned prefix = 0u; bool exact = false;
    for (int bit = 31; bit >= 0; --bit) {
        const unsigned cand = prefix | (1u << bit);
        int cnt = 0;
#pragma unroll
        for (int g = 0; g < NG; ++g) if (g < ng) cnt += count8_ge(v[g * 8], v[g * 8 + 1], v[g * 8 + 2], v[g * 8 + 3], v[g * 8 + 4], v[g * 8 + 5], v[g * 8 + 6], v[g * 8 + 7], cand);
        if (cnt >= TOPK) prefix = cand;
        if (cnt == TOPK) { exact = true; break; }
    }
    const unsigned T = prefix; int need = 1 << 30;
    if (!exact) {
        int cgt = 0;
#pragma unroll
        for (int j = 0; j < NJ; ++j) if (j < nj) cgt += __popcll(__ballot(v[j] > T));
        need = TOPK - cgt;
    }
    int base_eq = 0, base_sel = 0;
    int ln = lane; asm volatile("" : "+v"(ln));
#pragma unroll
    for (int j = 0; j < NJ; ++j) if (j < nj) {
        const bool gt = v[j] > T, eq = v[j] == T;
        const unsigned long long eqm = __ballot(eq);
        const bool s = gt || (eq && (base_eq + mbcnt64(eqm)) < need);
        const unsigned long long sm = __ballot(s);
        if (s) sel[base_sel + mbcnt64(sm)] = j * 64 + ln;
        base_eq += __popcll(eqm); base_sel += __popcll(sm);
    }
}
__device__ __forceinline__ void idx_sample_batch_unit(const Params& p, PG8_LAS unsigned char* lds, int bs) {
    const int tid_ = fresh_tid(), lane = tid_ & 63, wave = __builtin_amdgcn_readfirstlane(tid_ >> 6), r = lane & 31, kh = lane >> 5;
    unsigned char* ws = p.ws;
    const float* QI = (const float*)(ws + WS_QI); const float* WI = (const float*)(ws + WS_WI); int* SEL = (int*)(ws + WS_SEL);
    const bf16_t* KIH = (const bf16_t*)(ws + WS_KIH); const bf16_t* KIL = (const bf16_t*)(ws + WS_KIL);
    const float* cache_ki = p.in[4]; const int* page_table = (const int*)p.in[7];
    PG8_LAS float* sc = (PG8_LAS float*)lds;
    IdxQ q; idx_load_q(q, QI, WI, MP + bs * DS, lane);
    IdxRaw raw; IdxKey k;
    for (int pg = wave; pg < NPAGES; pg += NWAVES) {
        const int phys = page_table[bs * NPAGES + pg];
        const float* pbase = cache_ki + (size_t)phys * PAGE * IDD + (size_t)r * IDD + kh * 8;
        idx_load_raw(raw, pbase);
#pragma unroll
        for (int tt = 0; tt < 4; ++tt) {
            idx_cvt_key(raw, k);
            if (tt < 3) idx_load_raw(raw, pbase + (size_t)(tt + 1) * 32 * IDD);
            float s2[2]; idx_tile(q, k, s2);
            const int col = pg * PAGE + tt * 32 + r;
            sc[(2 * kh) * SCS_LDL + col] = s2[0]; sc[(2 * kh + 1) * SCS_LDL + col] = s2[1];
        }
    }
    if (wave == 0) {
        const size_t kr = (size_t)(MP + bs * DS + (r & 3)) * IDD + kh * 8;
        idx_load_keyb(k, KIH + kr, KIL + kr);
        float s2[2]; idx_tile(q, k, s2);
        if (r < DS) { sc[(2 * kh) * SCS_LDL + NPAST + r] = s2[0]; sc[(2 * kh + 1) * SCS_LDL + NPAST + r] = s2[1]; }
    }
    __syncthreads();
    if (wave < DS) select_row_list(sc + wave * SCS_LDL, NPAST + wave + 1, lane, SEL + (size_t)(bs * DS + wave) * TOPK);
    __syncthreads();
}
__device__ __forceinline__ void idx_prompt_unit(const Params& p, PG8_LAS unsigned char* lds, int s, int mode = 1) {
    const int tid_ = fresh_tid(), lane = tid_ & 63, wave = __builtin_amdgcn_readfirstlane(tid_ >> 6), r = lane & 31, kh = lane >> 5;
    unsigned char* ws = p.ws;
    const float* QI = (const float*)(ws + WS_QI); const float* WI = (const float*)(ws + WS_WI); unsigned long long* BM = (unsigned long long*)(ws + WS_BM);
    const bf16_t* KIH = (const bf16_t*)(ws + WS_KIH); const bf16_t* KIL = (const bf16_t*)(ws + WS_KIL);
    PG8_LAS float* sc = (PG8_LAS float*)lds;
    const int b = s & 1, q0 = (s >> 1) * 8, grow0 = b * SEQ + q0, ntile = (q0 + 8 + 31) >> 5;
    IdxQ qa, qb; idx_load_q(qa, QI, WI, grow0, lane); idx_load_q(qb, QI, WI, grow0 + 4, lane);
    const size_t kbase = (size_t)(b * SEQ + r) * IDD + kh * 8;
    IdxKey kn;
    if (wave < ntile) idx_load_keyb(kn, KIH + kbase + (size_t)wave * 32 * IDD, KIL + kbase + (size_t)wave * 32 * IDD);
    for (int t = wave; t < ntile; t += NWAVES) {
        const IdxKey k = kn;
        if (t + NWAVES < ntile) idx_load_keyb(kn, KIH + kbase + (size_t)(t + NWAVES) * 32 * IDD, KIL + kbase + (size_t)(t + NWAVES) * 32 * IDD);
        float sa[2], sb[2]; idx_tile(qa, k, sa); idx_tile(qb, k, sb);
        const int col = t * 32 + r;
        sc[(2 * kh) * SCP_LD + col] = sa[0]; sc[(2 * kh + 1) * SCP_LD + col] = sa[1];
        sc[(4 + 2 * kh) * SCP_LD + col] = sb[0]; sc[(5 + 2 * kh) * SCP_LD + col] = sb[1];
    }
    __syncthreads();
    if (mode == 1) select_row<64>(sc + wave * SCP_LD, q0 + wave + 1, lane, BM + (size_t)(grow0 + wave) * 64);
    if (mode == 2) select_row<64>(sc + wave * SCP_LD, q0 + wave + 1, lane, (unsigned long long*)(ws + WS_SEL) + (size_t)(grow0 + wave) * 64);
    if (mode == 3) select_row<64, 24>(sc + wave * SCP_LD, q0 + wave + 1, lane, (unsigned long long*)(ws + WS_SEL) + (size_t)(grow0 + wave) * 64);
}
__device__ __forceinline__ unsigned wq_next(unsigned* ctr, PG8_LAS unsigned char* lds) {
    volatile PG8_LAS unsigned* slot = (volatile PG8_LAS unsigned*)(lds + LDS_MISC + 64);
    __syncthreads();
    if (threadIdx.x == 0) *slot = atomicAdd(ctr, 1u);
    __syncthreads();
    return *slot;
}

constexpr int G_SC = 0, G_SEL = 32800, G_RED = 33824, G_QS = 34304, G_PS = 38400, G_KP = 46592, G_VP = 48640, G_OP = 50688;
__device__ __forceinline__ void sample_row_unit(const Params& p, PG8_LAS unsigned char* lds, int rs) {
    const int tid = fresh_tid(), lane = tid & 63, wave = tid >> 6;
    unsigned char* ws = p.ws;
    const bf16_t* QB = (const bf16_t*)(ws + WS_QB); const float* SCS = (const float*)(ws + WS_SCS);
    const float* cache_k = p.in[2]; const float* cache_v = p.in[3]; const int* page_table = (const int*)p.in[7];
    bf16_t* CATB = (bf16_t*)(ws + WS_CATB); float* PS = (float*)(ws + WS_PS);
    const int row = MP + rs, b = rs / DS, n = NPAST + (rs % DS) + 1;
    PG8_LAS float* sc = (PG8_LAS float*)(lds + G_SC);
    PG8_LAS int* sel = (PG8_LAS int*)(lds + G_SEL);
    PG8_LAS float* qs = (PG8_LAS float*)(lds + G_QS);
    PG8_LAS float* ps = (PG8_LAS float*)(lds + G_PS);
    PG8_LAS unsigned long long* kps = (PG8_LAS unsigned long long*)(lds + G_KP);
    PG8_LAS unsigned long long* vps = (PG8_LAS unsigned long long*)(lds + G_VP);
    PG8_LAS float* op = (PG8_LAS float*)(lds + G_OP);
    { const bf16_t* z = QB + (size_t)row * 1024; qs[tid] = __uint_as_float((unsigned)z[tid] << 16); qs[tid + 512] = __uint_as_float((unsigned)z[tid + 512] << 16); }
    __syncthreads();
    (void)sc; (void)SCS; (void)n; (void)sel;
    if (tid < TOPK) {
        const int idx = ((const int*)(ws + WS_SEL))[(size_t)rs * TOPK + tid];
        const float* kp; const float* vp;
        if (idx < NPAST) { const size_t prow = (size_t)page_table[b * NPAGES + idx / PAGE] * PAGE + (idx % PAGE); kp = cache_k + prow * 512; vp = cache_v + prow * 512; }
        else { const size_t zr = (size_t)(b * DS + idx - NPAST); kp = p.out + O_KS + zr * 512; vp = p.out + O_VS + zr * 512; }
        kps[tid] = (unsigned long long)kp; vps[tid] = (unsigned long long)vp;
    }
    __syncthreads();
    {
        const int j = tid & 255, hg = tid >> 8;
        const float* kp = (const float*)kps[j] + hg * 256;
#pragma unroll
        for (int n2 = 0; n2 < 2; ++n2) {
            float d0 = 0.f, d1 = 0.f;
            const PG8_LAS float* q0 = qs + (4 * hg + 2 * n2) * HD; const PG8_LAS float* q1 = q0 + HD;
#pragma unroll 8
            for (int d = 0; d < HD; d += 4) {
                const f32x4 k4 = *(const f32x4*)(kp + n2 * HD + d);
                d0 += q0[d] * k4[0] + q0[d + 1] * k4[1] + q0[d + 2] * k4[2] + q0[d + 3] * k4[3];
                d1 += q1[d] * k4[0] + q1[d + 1] * k4[1] + q1[d + 2] * k4[2] + q1[d + 3] * k4[3];
            }
            ps[(4 * hg + 2 * n2) * TOPK + j] = d0 * ATTN_SCALE; ps[(4 * hg + 2 * n2 + 1) * TOPK + j] = d1 * ATTN_SCALE;
        }
    }
    __syncthreads();
    {
        float v[4]; float m = -INFINITY;
#pragma unroll
        for (int i = 0; i < 4; ++i) { v[i] = ps[wave * TOPK + lane + 64 * i]; m = fmaxf(m, v[i]); }
#pragma unroll
        for (int o = 32; o >= 1; o >>= 1) m = fmaxf(m, __shfl_xor(m, o));
        float sum = 0.f;
#pragma unroll
        for (int i = 0; i < 4; ++i) { v[i] = expf(v[i] - m); sum += v[i]; }
#pragma unroll
        for (int o = 32; o >= 1; o >>= 1) sum += __shfl_xor(sum, o);
        const float inv = 1.0f / sum;
#pragma unroll
        for (int i = 0; i < 4; ++i) ps[wave * TOPK + lane + 64 * i] = v[i] * inv;
    }
    __syncthreads();
    {
        const int o4 = tid & 255, kq = tid >> 8, hq = o4 >> 5, d = (o4 & 31) * 4, nkv = hq >> 1;
        f32x4 acc = (f32x4){0.f, 0.f, 0.f, 0.f};
#pragma unroll 8
        for (int j = kq * 128; j < kq * 128 + 128; ++j) acc += *(const f32x4*)((const float*)vps[j] + nkv * HD + d) * ps[hq * TOPK + j];
        if (kq == 1) *(PG8_LAS f32x4*)(op + o4 * 4) = acc;
        __syncthreads();
        if (kq == 0) {
            acc += *(const PG8_LAS f32x4*)(op + o4 * 4);
            u32x2 w; w.x = cvt_pk_bf16(acc[0], acc[1]); w.y = cvt_pk_bf16(acc[2], acc[3]);
            *(u32x2*)(CATB + (size_t)row * D + 1024 + o4 * 4) = w;
        }
    }
    __syncthreads();
}

typedef short s16x4 __attribute__((ext_vector_type(4)));
constexpr int A_KP = 272, A_VP = 320, A_KBYTES = 64 * A_KP, A_VBYTES = 64 * A_VP, A_STAGE = A_KBYTES + A_VBYTES;
constexpr float A_SC = 0.08838834764831845f * 1.4426950408889634f;
__device__ __forceinline__ float xhalf_max(float x) { const auto sw = __builtin_amdgcn_permlane32_swap(__float_as_uint(x), __float_as_uint(x), false, false); return fmaxf(__uint_as_float(sw[0]), __uint_as_float(sw[1])); }
__device__ __forceinline__ float xhalf_sum(float x) { const auto sw = __builtin_amdgcn_permlane32_swap(__float_as_uint(x), __float_as_uint(x), false, false); return __uint_as_float(sw[0]) + __uint_as_float(sw[1]); }
__device__ __forceinline__ void attn_dense_unit(const Params& p, PG8_LAS unsigned char* lds, int b, int n, int qb) {
    const int tid = fresh_tid(), lane = tid & 63, wave = __builtin_amdgcn_readfirstlane(tid >> 6), r = lane & 31, kh = lane >> 5;
    unsigned char* ws = p.ws;
    const bf16_t* QB = (const bf16_t*)(ws + WS_QB); const bf16_t* KB = (const bf16_t*)(ws + WS_KB); const bf16_t* VB = (const bf16_t*)(ws + WS_VB);
    const unsigned long long* BM = (const unsigned long long*)(ws + WS_BM);
    bf16_t* CATB = (bf16_t*)(ws + WS_CATB); float* PS = (float*)(ws + WS_PS);
    const int q = qb * 128 + wave * 16 + (r & 15), head = 2 * n + (r >> 4);
    const size_t qrow = (size_t)b * SEQ + q;
    bf16x8 qf[8];
#pragma unroll
    for (int ks = 0; ks < 8; ++ks) qf[ks] = *(const bf16x8*)(QB + qrow * 1024 + head * HD + ks * 16 + kh * 8);
    f32x16 O[4];
#pragma unroll
    for (int dt = 0; dt < 4; ++dt)
#pragma unroll
        for (int i = 0; i < 16; ++i) O[dt][i] = 0.f;
    float m = -INFINITY, l = 0.f;
    const int ntile = 2 * qb + 2, qmax_w = qb * 128 + wave * 16 + 15;
    const int srow = tid >> 4, sch = tid & 15;
    const bf16_t* kg = KB + ((size_t)b * SEQ + srow) * 512 + n * HD + sch * 8;
    const bf16_t* vg = VB + ((size_t)b * SEQ + srow) * 512 + n * HD + sch * 8;
    u32x4 kst[2], vst[2];
#define A_GLOAD(t) do { _Pragma("unroll") for (int _i = 0; _i < 2; ++_i) { kst[_i] = *(const u32x4*)(kg + (size_t)((t) * 64 + _i * 32) * 512); vst[_i] = *(const u32x4*)(vg + (size_t)((t) * 64 + _i * 32) * 512); } } while (0)
#define A_LSTORE(buf) do { _Pragma("unroll") for (int _i = 0; _i < 2; ++_i) { *(PG8_LAS u32x4*)(lds + (buf) * A_STAGE + (srow + _i * 32) * A_KP + sch * 16) = kst[_i]; \
        *(PG8_LAS u32x4*)(lds + (buf) * A_STAGE + A_KBYTES + (srow + _i * 32) * A_VP + sch * 16) = vst[_i]; } } while (0)
    A_GLOAD(0); A_LSTORE(0);
    unsigned long long mw = BM[qrow * 64];
    __syncthreads();
    const int i16 = lane & 15, g2 = (lane >> 4) & 1;
    const int vlane_off = (4 * kh + (i16 >> 2)) * A_VP + (16 * g2 + 4 * (i16 & 3)) * 2;
    for (int t = 0; t < ntile; ++t) {
        const bool more = (t + 1 < ntile);
        if (more) A_GLOAD(t + 1);
        const unsigned long long mw_next = more ? BM[qrow * 64 + t + 1] : 0ull;
        const int buf = t & 1;
        if (t * 64 <= qmax_w) {
            PG8_LAS unsigned char* kb = lds + buf * A_STAGE; PG8_LAS unsigned char* vb = kb + A_KBYTES;
            f32x16 s0, s1;
#pragma unroll
            for (int i = 0; i < 16; ++i) { s0[i] = 0.f; s1[i] = 0.f; }
#pragma unroll
            for (int ks = 0; ks < 8; ++ks) {
                const bf16x8 k0 = *(const PG8_LAS bf16x8*)(kb + r * A_KP + (ks * 16 + kh * 8) * 2);
                const bf16x8 k1 = *(const PG8_LAS bf16x8*)(kb + (32 + r) * A_KP + (ks * 16 + kh * 8) * 2);
                s0 = __builtin_amdgcn_mfma_f32_32x32x16_bf16(k0, qf[ks], s0, 0, 0, 0);
                s1 = __builtin_amdgcn_mfma_f32_32x32x16_bf16(k1, qf[ks], s1, 0, 0, 0);
            }
            const unsigned lo = (unsigned)mw >> (4 * kh), hi = (unsigned)(mw >> 32) >> (4 * kh);
            float mx = -INFINITY;
#pragma unroll
            for (int i = 0; i < 16; ++i) {
                const unsigned bit = 1u << ((i & 3) + 8 * (i >> 2));
                s0[i] = (lo & bit) ? s0[i] * A_SC : -INFINITY; s1[i] = (hi & bit) ? s1[i] * A_SC : -INFINITY;
                mx = fmaxf(mx, fmaxf(s0[i], s1[i]));
            }
            mx = xhalf_max(mx);
            const float m_new = fmaxf(m, mx), m_safe = (m_new == -INFINITY) ? 0.f : m_new;
            const float alpha = __builtin_amdgcn_exp2f(m - m_safe);
            float lsum = 0.f;
#pragma unroll
            for (int i = 0; i < 16; ++i) { s0[i] = __builtin_amdgcn_exp2f(s0[i] - m_safe); s1[i] = __builtin_amdgcn_exp2f(s1[i] - m_safe); lsum += s0[i] + s1[i]; }
            l = l * alpha + lsum; m = m_new;
            if (__ballot(alpha != 1.0f) != 0ull) {
#pragma unroll
                for (int dt = 0; dt < 4; ++dt)
#pragma unroll
                    for (int i = 0; i < 16; ++i) O[dt][i] *= alpha;
            }
            bf16x8 pf[2][2];
#pragma unroll
            for (int sx = 0; sx < 2; ++sx) {
                u32x4 w0, w1;
                w0.x = cvt_pk_bf16(s0[8 * sx], s0[8 * sx + 1]); w0.y = cvt_pk_bf16(s0[8 * sx + 2], s0[8 * sx + 3]); w0.z = cvt_pk_bf16(s0[8 * sx + 4], s0[8 * sx + 5]); w0.w = cvt_pk_bf16(s0[8 * sx + 6], s0[8 * sx + 7]);
                w1.x = cvt_pk_bf16(s1[8 * sx], s1[8 * sx + 1]); w1.y = cvt_pk_bf16(s1[8 * sx + 2], s1[8 * sx + 3]); w1.z = cvt_pk_bf16(s1[8 * sx + 4], s1[8 * sx + 5]); w1.w = cvt_pk_bf16(s1[8 * sx + 6], s1[8 * sx + 7]);
                pf[0][sx] = __builtin_bit_cast(bf16x8, w0); pf[1][sx] = __builtin_bit_cast(bf16x8, w1);
            }
#pragma unroll
            for (int st = 0; st < 2; ++st)
#pragma unroll
                for (int sx = 0; sx < 2; ++sx)
#pragma unroll
                    for (int dt = 0; dt < 4; ++dt) {
                        PG8_LAS unsigned char* a = vb + vlane_off + (st * 32 + 16 * sx) * A_VP + dt * 64;
                        const s16x4 vlo = __builtin_amdgcn_ds_read_tr16_b64_v4i16((PG8_LAS s16x4*)a);
                        const s16x4 vhi = __builtin_amdgcn_ds_read_tr16_b64_v4i16((PG8_LAS s16x4*)(a + 8 * A_VP));
                        const bf16x8 vf = __builtin_shufflevector(vlo, vhi, 0, 1, 2, 3, 4, 5, 6, 7);
                        O[dt] = __builtin_amdgcn_mfma_f32_32x32x16_bf16(vf, pf[st][sx], O[dt], 0, 0, 0);
                    }
        }
        if (more) A_LSTORE(buf ^ 1);
        __syncthreads();
        mw = mw_next;
    }
#undef A_GLOAD
#undef A_LSTORE
    const float inv = 1.0f / xhalf_sum(l);
    bf16_t* orow = CATB + qrow * D + 1024 + head * HD;
#pragma unroll
    for (int dt = 0; dt < 4; ++dt)
#pragma unroll
        for (int a = 0; a < 4; ++a) {
            u32x2 w; w.x = cvt_pk_bf16(O[dt][4 * a] * inv, O[dt][4 * a + 1] * inv); w.y = cvt_pk_bf16(O[dt][4 * a + 2] * inv, O[dt][4 * a + 3] * inv);
            *(u32x2*)(orow + 32 * dt + 8 * a + 4 * kh) = w;
        }
}
__device__ __forceinline__ void attn_phase(const Params& p, PG8_LAS unsigned char* lds, int ctr_off = 0) {
    const int G = gridDim.x;
    for (int u = blockIdx.x; u < 256; u += G) { const int qb = 31 - (u >> 3), bn = u & 7; attn_dense_unit(p, lds, bn >> 2, bn & 3, qb); }
    unsigned* ctr = (unsigned*)(p.ws + WS_CTR) + ctr_off;
    for (;;) {
        const unsigned idx = wq_next(ctr, lds);
        if (idx >= (unsigned)(MS + LRU_NCHUNK)) break;
        if (idx < (unsigned)MS) sample_row_unit(p, lds, (int)idx); else lru_fixup_unit(p, (int)idx - MS);
    }
}
__device__ __forceinline__ void mid1_phase(const Params& p, PG8_LAS unsigned char* lds) {
    unsigned* ctr = (unsigned*)(p.ws + WS_CTR) + 64;
    constexpr unsigned NA = DB, NB_ = MP / 8, NC_ = LRU_NCHUNK * 8;
    for (;;) {
        const unsigned idx = wq_next(ctr, lds);
        constexpr unsigned XA_ = (MID_DUP == 1) ? NA : 0u, XB_ = (MID_DUP >= 6) ? NB_ : 0u, XC_ = (MID_DUP == 3) ? NC_ : 0u;
        if (idx >= NA + XA_ + NB_ + XB_ + NC_ + XC_) break;
        if (idx < NA + XA_) { const unsigned u = idx % NA; idx_sample_batch_unit(p, lds, (int)u); }
        else if (idx < NA + XA_ + NB_) idx_prompt_unit(p, lds, (int)(NB_ - 1 - (idx - NA - XA_)));
        else if (idx < NA + XA_ + NB_ + XB_) idx_prompt_unit(p, lds, (int)(NB_ - 1 - (idx - NA - XA_ - NB_)), MID_DUP == 6 ? 2 : (MID_DUP == 7 ? 3 : 0));
        else lru_local_unit(p, lds, (int)((idx - NA - XA_ - NB_ - XB_) % NC_));
    }
}

__device__ __forceinline__ void prep_phase(const Params& p, PG8_LAS unsigned char* lds) {
    unsigned char* ws = p.ws;
    bf16_t* Wgu1 = (bf16_t*)(ws + WS_WGU1); bf16_t* Wd1 = (bf16_t*)(ws + WS_WD1); bf16_t* Win = (bf16_t*)(ws + WS_WIN); bf16_t* Wout = (bf16_t*)(ws + WS_WOUT);
    bf16_t* Wgu2 = (bf16_t*)(ws + WS_WGU2); bf16_t* Wd2 = (bf16_t*)(ws + WS_WD2); bf16_t* XB = (bf16_t*)(ws + WS_XB);
    PG8_LAS float* tile = (PG8_LAS float*)lds;
    const int wid = blockIdx.x, nw = gridDim.x;
    transpose_cvt<1>(p.in[10], D, 2 * DFF, 2 * DFF, Wgu1, tile, wid, nw);
    cvt_x(p.in[0], p.in[1], XB);
    for (int n = 0; n < 8; ++n) { transpose_cvt<0>(p.in[15] + n * 16384, 128, 128, 128, (bf16_t*)(ws + WS_WAT) + n * 16384, tile, wid, nw); transpose_cvt<0>(p.in[17] + n * 16384, 128, 128, 128, (bf16_t*)(ws + WS_WIT) + n * 16384, tile, wid, nw); }
    (void)Wd1; (void)Win; (void)Wout; (void)Wgu2; (void)Wd2;
}
__device__ __forceinline__ void tail_cvt(const Params& p, PG8_LAS unsigned char* lds, int which, int nunits) {
    const int G = gridDim.x, c = blockIdx.x, full = nunits / G, rem = nunits - full * G;
    if (rem != 0 && c < rem) return;
    const int wid = (rem == 0) ? c : c - rem, nw = (rem == 0) ? G : G - rem;
    unsigned char* ws = p.ws; PG8_LAS float* tile = (PG8_LAS float*)lds;
    __syncthreads();
    if (which == 0) {
        transpose_cvt<0>(p.in[11], DFF, D, D, (bf16_t*)(ws + WS_WD1), tile, wid, nw);
        transpose_cvt<0>(p.in[12], D, DIN, DINP, (bf16_t*)(ws + WS_WIN), tile, wid, nw);
        transpose_cvt<0>(p.in[20], D, D, D, (bf16_t*)(ws + WS_WOUT), tile, wid, nw);
    } else if (which == 1) transpose_cvt<1>(p.in[23], D, 2 * DFF, 2 * DFF, (bf16_t*)(ws + WS_WGU2), tile, wid, nw);
    else transpose_cvt<0>(p.in[24], DFF, D, D, (bf16_t*)(ws + WS_WD2), tile, wid, nw);
}

__global__ void __launch_bounds__(NTHREADS, 2) mk_fwd(Params p) {
    extern __shared__ __attribute__((aligned(16))) unsigned char lds_raw[];
    PG8_LAS unsigned char* lds = (PG8_LAS unsigned char*)lds_raw;
    unsigned char* ws = p.ws;
    const int lo = p.ph_lo, hi = p.ph_hi;
    const int G = gridDim.x;
    if (threadIdx.x < 4) ((volatile PG8_LAS unsigned*)(lds + LDS_MISC))[threadIdx.x] = 0u;
    __syncthreads();
    XcdBarrier bar = xcd_barrier_post((unsigned*)(ws + WS_CTL) + (size_t)p.li * XCD_BAR_WORDS, (volatile LAS unsigned*)(lds + LDS_MISC));
#define SEAM(k) do { if (lo <= (k) && (k) + 1 < hi) xcd_barrier(bar); } while (0)
    bf16_t* Wgu1 = (bf16_t*)(ws + WS_WGU1); bf16_t* Wd1 = (bf16_t*)(ws + WS_WD1); bf16_t* Win = (bf16_t*)(ws + WS_WIN); bf16_t* Wout = (bf16_t*)(ws + WS_WOUT);
    bf16_t* Wgu2 = (bf16_t*)(ws + WS_WGU2); bf16_t* Wd2 = (bf16_t*)(ws + WS_WD2);
    bf16_t* XB = (bf16_t*)(ws + WS_XB); bf16_t* H = (bf16_t*)(ws + WS_H); float* T = (float*)(ws + WS_T); float* X1 = (float*)(ws + WS_X1); float* X2 = (float*)(ws + WS_X2);
    bf16_t* CATB = (bf16_t*)(ws + WS_CATB); float* PS = (float*)(ws + WS_PS); float* ST1 = (float*)(ws + WS_ST); float* ST2 = ST1 + 2 * MP;
#define IN(k) (lo <= (k) && (k) < hi)
    if (IN(0)) prep_phase(p, lds);
    SEAM(0);
    if (IN(1)) {
        pg8::Gemm g{XB, Wgu1, MPAD, 2 * DFF, D}; pg8::StaticOrder S; S.init(MPAD, 2 * DFF, G, (int)blockIdx.x, D);
        EpiSwiGLU E{H};
        pg8::gemm_phase<EpiSwiGLU, pg8::StaticOrder, true, true>(lds, g, S, E);
        tail_cvt(p, lds, 0, (MPAD / 256) * (2 * DFF / 256));
    }
    SEAM(1);
    if (IN(2)) {
        pg8::Gemm g{H, Wd1, MPAD, D, DFF}; SplitOrder S; S.init(D, DFF, G, (int)blockIdx.x);
        EpiResidSplit E{p.in[0], T, PS, 0.5f, nullptr, nullptr, nullptr};
        pg8::gemm_phase<EpiResidSplit, SplitOrder, true, true>(lds, g, S, E);
    }
    SEAM(2);
    if (IN(3)) ln_phase(T, p.in[8], p.in[9], X1, XB, PS, DFF / 256, p.in[1], 0.5f, ST1);
    SEAM(3);
    if (IN(4)) {
        pg8::Gemm g{XB, Win, MPAD, DINP, D}; pg8::StaticOrder S; S.init(MPAD, DINP, G, (int)blockIdx.x, D);
        EpiWin E{(float*)(ws + WS_XR), (float*)(ws + WS_GG), (bf16_t*)(ws + WS_QB), (bf16_t*)(ws + WS_KB), (bf16_t*)(ws + WS_VB), (float*)(ws + WS_QI), (bf16_t*)(ws + WS_KIH), (bf16_t*)(ws + WS_KIL), (float*)(ws + WS_WI), p.out};
        pg8::gemm_phase<EpiWin, pg8::StaticOrder, true, true>(lds, g, S, E);
        tail_cvt(p, lds, 1, (MPAD / 256) * (DINP / 256));
    }
    SEAM(4);
    if (IN(5)) mid1_phase(p, lds);
    SEAM(5);
    if (IN(6)) { attn_phase(p, lds); if (REP_6 > 1) { __syncthreads(); attn_phase(p, lds, 128); } }
    SEAM(6);
    if (IN(7)) {
        pg8::Gemm g{CATB, Wout, MPAD, D, D}; SplitOrder S; S.init(D, D, G, (int)blockIdx.x);
        EpiResidSplit E{nullptr, T, PS, 1.0f, ST1, p.in[8], p.in[9]};
        pg8::gemm_phase<EpiResidSplit, SplitOrder, true, true>(lds, g, S, E);
    }
    SEAM(7);
    if (IN(8)) ln_phase(T, p.in[21], p.in[22], X2, XB, PS, D / 256, X1 + (size_t)MP * D, 1.0f, ST2);
    SEAM(8);
    if (IN(9)) {
        pg8::Gemm g{XB, Wgu2, MPAD, 2 * DFF, D}; pg8::StaticOrder S; S.init(MPAD, 2 * DFF, G, (int)blockIdx.x, D);
        EpiSwiGLU E{H};
        pg8::gemm_phase<EpiSwiGLU, pg8::StaticOrder, true, true>(lds, g, S, E);
        tail_cvt(p, lds, 2, (MPAD / 256) * (2 * DFF / 256));
    }
    SEAM(9);
    if (IN(10)) {
        pg8::Gemm g{H, Wd2, MPAD, D, DFF}; SplitOrder S; S.init(D, DFF, G, (int)blockIdx.x);
        EpiResidSplit E{nullptr, T, PS, 0.5f, ST2, p.in[21], p.in[22]};
        pg8::gemm_phase<EpiResidSplit, SplitOrder, true, true>(lds, g, S, E);
    }
    SEAM(10);
    if (IN(11)) ln_phase(T, p.in[25], p.in[26], p.out + O_YP, nullptr, PS, DFF / 256, X2 + (size_t)MP * D, 0.5f, nullptr);
#undef IN
#undef SEAM
}

}

extern "C" void kernel_launch(void* const* d_in, const int* in_sizes, int n_in, void* d_out, int out_size, void* d_ws, size_t ws_size, hipStream_t stream) {
    static int grid = 0;
    if (grid == 0) {
        if (n_in != 27 || ws_size < WS_END3) { grid = -1; return; }
        int dev = 0, cus = 0;
        if (hipGetDevice(&dev) != hipSuccess || hipDeviceGetAttribute(&cus, hipDeviceAttributeMultiprocessorCount, dev) != hipSuccess) { grid = -1; return; }
        if (hipFuncSetAttribute((const void*)mk_fwd, hipFuncAttributeMaxDynamicSharedMemorySize, LDS_BYTES) != hipSuccess) { grid = -1; return; }
        (void)hipGetLastError();
        grid = cus;
    }
    if (grid < 0) return;
    float* out = (float*)d_out;
    unsigned char* ws = (unsigned char*)d_ws;

    (void)hipMemsetAsync(ws + WS_CTL, 0, CTL_BYTES, stream);
    Params p{};
    for (int i = 0; i < 27; ++i) p.in[i] = (const float*)d_in[i];
    p.out = out; p.ws = ws;
    int nli = 0;
    auto run = [&](int lo, int hi) { p.ph_lo = lo; p.ph_hi = hi; p.li = nli++; hipLaunchKernelGGL(mk_fwd, dim3(grid), dim3(NTHREADS), LDS_BYTES, stream, p); };
    run(0, 12);
}
```

```cpp
#include <hip/hip_runtime.h>
#include <stdint.h>

namespace pg8 {
#define PG8_LAS __attribute__((address_space(3)))
typedef unsigned short bf16_t;
typedef short bf16x8 __attribute__((ext_vector_type(8)));
typedef float f32x4 __attribute__((ext_vector_type(4)));
typedef unsigned u32x4 __attribute__((ext_vector_type(4)));
constexpr int BM = 256, BK = 64, HALF = 128, HTB = HALF * BK * 2  , STAGE_BYTES = 8 * HTB, NXCD = 8, WGM = 8;

__host__ __device__ __forceinline__ int lds_byte(int r, int c) { const int st = (r >> 4) * 2 + (c >> 5), rr = r & 15, cc = c & 31, ob = rr * 64 + cc * 2; return st * 1024 + (ob ^ (((ob >> 9) & 1) << 5)); }
__host__ __device__ __forceinline__ void stage_rc(int b, int& R, int& C) { const int st = b / 1024, sb = b % 1024, swz = sb ^ (((sb >> 9) & 1) << 5); R = (st >> 1) * 16 + swz / 64; C = (st & 1) * 32 + (swz % 64) / 2; }
__host__ __device__ __forceinline__ int perm32(int rho) { const int n = rho >> 4, i = rho & 15; return 8 * (i >> 2) + 4 * n + (i & 3); }

struct Unit { int pm, pn, k0, nt, aux; };
struct Gemm { const bf16_t* A; const bf16_t* Bt; int M, N, K; };

struct StaticOrder {
    int nM, nN, nwg, G, c, ntk;
    __host__ __device__ __forceinline__ void init(int M, int N, int G_, int c_, int K_ = 0) { nM = M / BM; nN = N / BM; nwg = nM * nN; G = G_; c = c_; ntk = K_ / BK; }
    __host__ __device__ __forceinline__ bool next(int i, Unit& u) const {
        const long L = (long)i * G + c; if (L >= nwg) return false;
        int wgid = (int)L; { const int q = nwg / NXCD, r = nwg % NXCD, xcd = wgid % NXCD, off = wgid / NXCD; wgid = (xcd < r ? xcd * (q + 1) : r * (q + 1) + (xcd - r) * q) + off; }
        const int nig = WGM * nN, gid = wgid / nig, fm = gid * WGM, gsz = (nM - fm) < WGM ? (nM - fm) : WGM;
        u.pm = fm + ((wgid % nig) % gsz); u.pn = (wgid % nig) / gsz; u.k0 = 0; u.nt = ntk; u.aux = -1; return true;
    }
    __device__ __forceinline__ void a_ready(const Unit&) const {}
    __device__ __forceinline__ void done(const Unit&) const {}
};

__device__ __forceinline__ unsigned cvt_pk_bf16(float lo, float hi) { unsigned r; asm volatile("v_cvt_pk_bf16_f32 %0, %1, %2" : "=v"(r) : "v"(lo), "v"(hi)); return r; }
typedef float f32x2 __attribute__((ext_vector_type(2)));

template <class Epi, class Sched, bool ALIGN_EPI = false, bool SP2 = false>
__device__ __forceinline__ void gemm_phase(PG8_LAS unsigned char* lds, const Gemm g, const Sched& S, const Epi& E) {
    int tid_v = threadIdx.x; asm volatile("" : "+v"(tid_v));
    const int tid = tid_v, wid = __builtin_amdgcn_readfirstlane(tid >> 6), lane = tid & 63, wr = wid >> 2, wc = wid & 3, fr = lane & 15, fq = lane >> 4;
    const int K = g.K;
    unsigned voffA[2], voffB[2];
#pragma unroll
    for (int i = 0; i < 2; ++i) { int R, C; stage_rc(tid * 16 + i * 8192, R, C); const int Rb = Epi::PERM ? ((R & ~31) + perm32(R & 31)) : R;
        voffA[i] = (unsigned)(R * K + C) * 2u; voffB[i] = (unsigned)(Rb * K + C) * 2u; }
    const size_t kstep = (size_t)(BK * 2);
    const size_t hstep = (size_t)HALF * K * 2;
    const size_t tstep = 2 * hstep;
    const unsigned ldsw = (unsigned)wid * 1024u;
    const int aoff = lds_byte(wr * 64 + fr, fq * 8), boff = lds_byte(wc * 32 + fr, fq * 8);
#define PG8_SA(b, h) (((b) * 2 + (h)) * HTB)
#define PG8_SB(b, h) ((4 + (b) * 2 + (h)) * HTB)
#define PG8_STAGE(bufoff, gbase, voff) do { _Pragma("unroll") for (int _i = 0; _i < 2; ++_i) \
        __builtin_amdgcn_global_load_lds((const unsigned*)((const char*)(gbase) + (voff)[_i]), (PG8_LAS unsigned*)(lds + (bufoff) + ldsw + _i * 8192), 16, 0, 0); } while (0)
#define PG8_LDA(dst, b, h) do { _Pragma("unroll") for (int m = 0; m < 4; ++m) _Pragma("unroll") for (int k = 0; k < 2; ++k) dst[m][k] = *(const PG8_LAS bf16x8*)(lds + PG8_SA(b, h) + aoff + m * 2048 + k * 1024); } while (0)
#define PG8_LDB(dst, b, h) do { _Pragma("unroll") for (int n = 0; n < 2; ++n) _Pragma("unroll") for (int k = 0; k < 2; ++k) dst[n][k] = *(const PG8_LAS bf16x8*)(lds + PG8_SB(b, h) + boff + n * 2048 + k * 1024); } while (0)
#define PG8_MMA(ai, bj, At, Bt) do { __builtin_amdgcn_s_setprio(1); _Pragma("unroll") for (int m = 0; m < 4; ++m) _Pragma("unroll") for (int n = 0; n < 2; ++n) _Pragma("unroll") for (int k = 0; k < 2; ++k) \
        acc[ai][bj][m][n] = __builtin_amdgcn_mfma_f32_16x16x32_bf16(Bt[n][k], At[m][k], acc[ai][bj][m][n], 0, 0, 0); __builtin_amdgcn_s_setprio(0); } while (0)
#define PG8_WAIT_V(n) asm volatile("s_waitcnt vmcnt(" #n ")" ::: "memory")
#define PG8_WAIT_L(n) asm volatile("s_waitcnt lgkmcnt(" #n ")" ::: "memory")
#define PG8_BAR __builtin_amdgcn_s_barrier()
#define PG8_SCHED __builtin_amdgcn_sched_barrier(0)
    Unit cur, nxt; int ui = 0;
    if (!S.next(0, cur)) return;
    f32x4 acc[2][2][4][2];
#pragma unroll
    for (int a = 0; a < 2; ++a)
#pragma unroll
        for (int b = 0; b < 2; ++b)
#pragma unroll
            for (int m = 0; m < 4; ++m)
#pragma unroll
                for (int n = 0; n < 2; ++n) acc[a][b][m][n] = (f32x4){0.f, 0.f, 0.f, 0.f};
    bf16x8 At[4][2], B0[2][2], B1[2][2];
    const char* cA = (const char*)g.A + (size_t)cur.pm * tstep + (size_t)cur.k0 * 2; const char* cB = (const char*)g.Bt + (size_t)cur.pn * tstep + (size_t)cur.k0 * 2;
    S.a_ready(cur);
    if constexpr (SP2) {
        PG8_STAGE(PG8_SB(0, 0), cB, voffB); PG8_STAGE(PG8_SB(0, 1), cB + hstep, voffB); PG8_STAGE(PG8_SA(0, 0), cA, voffA); PG8_STAGE(PG8_SA(0, 1), cA + hstep, voffA);
        if (wr == 1) PG8_BAR;
        PG8_WAIT_V(2); PG8_BAR;
        PG8_STAGE(PG8_SB(1, 0), cB + kstep, voffB); PG8_STAGE(PG8_SA(1, 0), cA + kstep, voffA); PG8_STAGE(PG8_SB(1, 1), cB + hstep + kstep, voffB);
        PG8_WAIT_V(6); PG8_BAR;
    } else {
        PG8_STAGE(PG8_SB(0, 0), cB, voffB); PG8_STAGE(PG8_SA(0, 0), cA, voffA); PG8_STAGE(PG8_SB(0, 1), cB + hstep, voffB); PG8_STAGE(PG8_SA(0, 1), cA + hstep, voffA);
        if (wr == 1) PG8_BAR;
        PG8_WAIT_V(4); PG8_BAR;
        PG8_STAGE(PG8_SB(1, 0), cB + kstep, voffB); PG8_STAGE(PG8_SA(1, 0), cA + kstep, voffA); PG8_STAGE(PG8_SB(1, 1), cB + hstep + kstep, voffB);
        PG8_WAIT_V(6); PG8_BAR;
    }
    for (;;) {
        const bool has_next = S.next(ui + 1, nxt);
        const char* nA = has_next ? (const char*)g.A + (size_t)nxt.pm * tstep + (size_t)nxt.k0 * 2 : cA; const char* nB = has_next ? (const char*)g.Bt + (size_t)nxt.pn * tstep + (size_t)nxt.k0 * 2 : cB;
        const int nt = cur.nt;
        for (int t = 0; t < nt; t += 2) {
            const bool last = (t == nt - 2);
            const char* a1 = cA + (size_t)(t + 1) * kstep;
            const char* a2 = last ? nA : cA + (size_t)(t + 2) * kstep; const char* b2 = last ? nB : cB + (size_t)(t + 2) * kstep;
            const char* a3 = a2 + kstep; const char* b3 = b2 + kstep;
            if (last && has_next) S.a_ready(nxt);
            if constexpr (SP2) {
            PG8_LDB(B0, 0, 0); PG8_LDB(B1, 0, 1); PG8_SCHED; PG8_LDA(At, 0, 0); PG8_STAGE(PG8_SA(1, 1), a1 + hstep, voffA);
            PG8_WAIT_V(8); PG8_WAIT_L(0); PG8_BAR; PG8_MMA(0, 0, At, B0); PG8_MMA(0, 1, At, B1); PG8_BAR; PG8_SCHED;
            PG8_LDA(At, 0, 1); PG8_STAGE(PG8_SB(0, 0), b2, voffB); PG8_STAGE(PG8_SB(0, 1), b2 + hstep, voffB); PG8_STAGE(PG8_SA(0, 0), a2, voffA);
            PG8_WAIT_V(8); PG8_WAIT_L(0); PG8_BAR; PG8_MMA(1, 0, At, B0); PG8_MMA(1, 1, At, B1); PG8_BAR; PG8_SCHED;
            PG8_LDB(B0, 1, 0); PG8_LDB(B1, 1, 1); PG8_SCHED; PG8_LDA(At, 1, 0); PG8_STAGE(PG8_SA(0, 1), a2 + hstep, voffA);
            PG8_WAIT_V(8); PG8_WAIT_L(0); PG8_BAR; PG8_MMA(0, 0, At, B0); PG8_MMA(0, 1, At, B1); PG8_BAR; PG8_SCHED;
            PG8_LDA(At, 1, 1); PG8_STAGE(PG8_SB(1, 0), b3, voffB); PG8_STAGE(PG8_SB(1, 1), b3 + hstep, voffB); PG8_STAGE(PG8_SA(1, 0), a3, voffA);
            PG8_WAIT_V(8); PG8_WAIT_L(0); PG8_BAR; PG8_MMA(1, 0, At, B0); PG8_MMA(1, 1, At, B1); PG8_BAR; PG8_SCHED;
            } else {
            PG8_LDB(B0, 0, 0); PG8_SCHED; PG8_LDA(At, 0, 0); PG8_STAGE(PG8_SA(1, 1), a1 + hstep, voffA);
            PG8_WAIT_L(8); PG8_BAR; PG8_WAIT_L(0); PG8_MMA(0, 0, At, B0); PG8_BAR; PG8_SCHED;
            PG8_LDB(B1, 0, 1); PG8_STAGE(PG8_SB(0, 0), b2, voffB);
            PG8_BAR; PG8_WAIT_L(0); PG8_MMA(0, 1, At, B1); PG8_BAR;
            PG8_LDA(At, 0, 1); PG8_STAGE(PG8_SA(0, 0), a2, voffA);
            PG8_BAR; PG8_WAIT_L(0); PG8_MMA(1, 0, At, B0); PG8_BAR; PG8_SCHED;
            PG8_STAGE(PG8_SB(0, 1), b2 + hstep, voffB);
            PG8_WAIT_V(6); PG8_BAR; PG8_MMA(1, 1, At, B1); PG8_BAR;
            PG8_LDB(B0, 1, 0); PG8_SCHED; PG8_LDA(At, 1, 0); PG8_STAGE(PG8_SA(0, 1), a2 + hstep, voffA);
            PG8_WAIT_L(8); PG8_BAR; PG8_WAIT_L(0); PG8_MMA(0, 0, At, B0); PG8_BAR; PG8_SCHED;
            PG8_LDB(B1, 1, 1); PG8_STAGE(PG8_SB(1, 0), b3, voffB);
            PG8_BAR; PG8_WAIT_L(0); PG8_MMA(0, 1, At, B1); PG8_BAR;
            PG8_LDA(At, 1, 1); PG8_STAGE(PG8_SA(1, 0), a3, voffA);
            PG8_BAR; PG8_WAIT_L(0); PG8_MMA(1, 0, At, B0); PG8_BAR; PG8_SCHED;
            PG8_STAGE(PG8_SB(1, 1), b3 + hstep, voffB);
            PG8_WAIT_V(6); PG8_BAR; PG8_MMA(1, 1, At, B1); PG8_BAR;
            }
        }
        if constexpr (ALIGN_EPI) { if (wr == 0) PG8_BAR; }
        if constexpr (!Epi::AFTER_DRAIN) { E(acc, cur, wr, wc, fr, fq); S.done(cur); }
        if (!has_next) break;
#pragma unroll
        for (int a = 0; a < 2; ++a)
#pragma unroll
            for (int b = 0; b < 2; ++b)
#pragma unroll
                for (int m = 0; m < 4; ++m)
#pragma unroll
                    for (int n = 0; n < 2; ++n) acc[a][b][m][n] = (f32x4){0.f, 0.f, 0.f, 0.f};
        cur = nxt; cA = nA; cB = nB; ++ui;
        if constexpr (ALIGN_EPI) { if (wr == 1) PG8_BAR; }
    }
    PG8_WAIT_V(0);
    if constexpr (!ALIGN_EPI) { if (wr == 0) PG8_BAR; }
    PG8_BAR;
    if constexpr (Epi::AFTER_DRAIN) { E.fused(acc, cur, wr, wc, fr, fq, lds, wid, lane); S.done(cur); }
#undef PG8_SA
#undef PG8_SB
#undef PG8_STAGE
#undef PG8_LDA
#undef PG8_LDB
#undef PG8_MMA
#undef PG8_WAIT_V
#undef PG8_WAIT_L
#undef PG8_BAR
#undef PG8_SCHED
}

}

#define XB_TMO      128
#define XB_XCNT(j)  (256  + 64 * (j))
#define XB_XSUB(j)  (1280 + 64 * (j))
#define XB_XGEN(j)  (2304 + 64 * (j))
#define XB_TOP      3328
#define XB_TOPGEN   3392
#define XCD_BAR_WORDS 3456
#define XB_SPIN_CAP (1u << 18)
#define LAS __attribute__((address_space(3)))

__device__ __forceinline__ unsigned xb_ld(unsigned* p)              { return __hip_atomic_load(p, __ATOMIC_RELAXED, __HIP_MEMORY_SCOPE_AGENT); }
__device__ __forceinline__ unsigned xb_add(unsigned* p, unsigned v) { return __hip_atomic_fetch_add(p, v, __ATOMIC_RELAXED, __HIP_MEMORY_SCOPE_AGENT); }
__device__ __forceinline__ unsigned xb_xcc_id() { return (unsigned)__builtin_amdgcn_s_getreg((3 << 11) | 20) & 0xFu; }
#define XB_SPIN(cond, bar) do { unsigned _sp = 0; while (cond) { __builtin_amdgcn_s_sleep(1); \
    if ((++_sp & 255u) == 0u) { if (xb_ld(&(bar)[XB_TMO])) break; if (_sp > XB_SPIN_CAP) { atomicAdd(&(bar)[XB_TMO], 1u); break; } } } } while (0)

struct XcdBarrier {
    unsigned* bar; unsigned x;
    volatile LAS unsigned* st;
};

__device__ __forceinline__ XcdBarrier xcd_barrier_post(unsigned* bar, volatile LAS unsigned* st) {
    XcdBarrier b; b.bar = bar; b.x = xb_xcc_id(); b.st = st;
    if (threadIdx.x == 0) (void)xb_add(&bar[XB_XCNT(b.x)], 1u);
    return b;
}
__device__ __forceinline__ void xcd_barrier_complete(unsigned* bar, unsigned x, unsigned& nloc, unsigned& nx) {
    const unsigned G = gridDim.x * gridDim.y * gridDim.z;
    unsigned sum, cnt, mine, sp = 0u;
    for (;;) {
        sum = 0u; cnt = 0u; mine = 0u;
#pragma unroll
        for (unsigned j = 0; j < 16; ++j) { const unsigned c = xb_ld(&bar[XB_XCNT(j)]); sum += c; cnt += (c > 0u) ? 1u : 0u; mine = (j == x) ? c : mine; }
        if (sum == G) break;
        __builtin_amdgcn_s_sleep(1);
        if ((++sp & 255u) == 0u) { if (xb_ld(&bar[XB_TMO])) break; if (sp > XB_SPIN_CAP) { atomicAdd(&bar[XB_TMO], 1u); break; } }
    }
    nloc = mine > 0u ? mine : 1u; nx = cnt > 0u ? cnt : 1u;
}

__device__ __forceinline__ void xcd_barrier(const XcdBarrier& b) {
    asm volatile("s_waitcnt vmcnt(0)" ::: "memory");
    __syncthreads();
    if (threadIdx.x == 0) {
        unsigned* bar = b.bar;
        __builtin_amdgcn_s_waitcnt(0);
        unsigned nloc = b.st[0], nx = b.st[1];
        if (nloc == 0u) { xcd_barrier_complete(bar, b.x, nloc, nx); b.st[0] = nloc; b.st[1] = nx; }
        const unsigned old = xb_add(&bar[XB_XSUB(b.x)], 1u);
        const unsigned gen = old / nloc;
        if (old + 1u == (gen + 1u) * nloc) {
            __builtin_amdgcn_fence(__ATOMIC_RELEASE, "agent");
            asm volatile("s_waitcnt vmcnt(0)" ::: "memory");
            const unsigned og = xb_add(&bar[XB_TOP], 1u);
            const unsigned tg = og / nx;
            if (og + 1u == (tg + 1u) * nx) xb_add(&bar[XB_TOPGEN], 1u);
            else XB_SPIN(xb_ld(&bar[XB_TOPGEN]) == tg, bar);
            __builtin_amdgcn_fence(__ATOMIC_ACQUIRE, "agent");
            xb_add(&bar[XB_XGEN(b.x)], 1u);
            asm volatile("s_waitcnt vmcnt(0)" ::: "memory");
        } else {
            XB_SPIN(xb_ld(&bar[XB_XGEN(b.x)]) == gen, bar);
            __builtin_amdgcn_fence(__ATOMIC_ACQUIRE, "agent");
            asm volatile("s_waitcnt vmcnt(0)" ::: "memory");
        }
    }
    __syncthreads();
}


namespace {
typedef unsigned short bf16_t;
typedef float f32x4 __attribute__((ext_vector_type(4)));
typedef unsigned u32x4 __attribute__((ext_vector_type(4)));
typedef unsigned u32x2 __attribute__((ext_vector_type(2)));

constexpr int D = 2048, SEQ = 4096, NB = 2, MP = NB * SEQ, DB = 32, DS = 4, MS = DB * DS, MT = MP + MS, MPAD = 8448;
constexpr int DFF = 5504, DRNN = 1024, HD = 128, NKV = 4, IDH = 8, IDD = 64, DIN = 4680, DINP = 4864;
constexpr int NPAGES = 64, PAGE = 128, NPAST = NPAGES * PAGE, LS = NPAST + DS, TOPK = 256;
constexpr int C_XR = 0, C_GR = 1024, C_Q = 2048, C_K = 3072, C_V = 3584, C_QI = 4096, C_KI = 4608, C_WI = 4672;
constexpr float ALPHA = 1.189207115002721f, LN_EPS = 1e-5f, ATTN_SCALE = 0.08838834764831845f, IDX_SCALE = 0.125f, IDX_W_SCALE = 0.35355339059327373f;
constexpr size_t O_YP = 0, O_YS = 16777216, O_KP = 17039360, O_VP = 21233664, O_KIP = 25427968, O_CP = 25952256, O_HP = 25958400,
                 O_KS = 25960448, O_VS = 26025984, O_KIS = 26091520, O_CS = 26099712, O_HS = 26198016;
constexpr int SCS_LD = 8256;
constexpr int ZLD = DINP;

constexpr size_t al256(size_t x) { return (x + 255) & ~(size_t)255; }
constexpr size_t WS_CTL = 0;
constexpr size_t CTL_BYTES = 65536;
constexpr size_t WS_WGU1 = WS_CTL + CTL_BYTES;
constexpr size_t WS_WD1 = WS_WGU1 + al256((size_t)2 * DFF * D * 2);
constexpr size_t WS_WIN = WS_WD1 + al256((size_t)D * DFF * 2);
constexpr size_t WS_WOUT = WS_WIN + al256((size_t)DINP * D * 2);
constexpr size_t WS_WGU2 = WS_WOUT + al256((size_t)D * D * 2);
constexpr size_t WS_WD2 = WS_WGU2 + al256((size_t)2 * DFF * D * 2);
constexpr size_t WS_XB = WS_WD2 + al256((size_t)D * DFF * 2);
constexpr size_t WS_H = WS_XB + al256((size_t)MPAD * D * 2);
constexpr size_t WS_T = WS_H + al256((size_t)MPAD * DFF * 2);
constexpr size_t WS_X1 = WS_T + al256((size_t)MPAD * D * 4);
constexpr size_t WS_X2 = WS_X1 + al256((size_t)MPAD * D * 4);
constexpr size_t WS_XR = WS_X2 + al256((size_t)MPAD * D * 4);
constexpr size_t WS_GG = WS_XR + al256((size_t)MPAD * DRNN * 4);
constexpr size_t WS_QI = WS_GG + al256((size_t)MPAD * DRNN * 4);
constexpr size_t WS_WI = WS_QI + al256((size_t)MPAD * 512 * 4);
constexpr size_t WS_KIH = WS_WI + al256((size_t)MPAD * 8 * 4);
constexpr size_t WS_KIL = WS_KIH + al256((size_t)MPAD * 64 * 2);
constexpr size_t WS_ZEND = WS_KIL + al256((size_t)MPAD * 64 * 2);
constexpr size_t WS_CATB = WS_ZEND;
constexpr size_t WS_HL = WS_CATB + al256((size_t)MPAD * D * 2);
constexpr size_t WS_PP = WS_HL + al256((size_t)MT * DRNN * 4);
constexpr size_t WS_GI = WS_PP + al256((size_t)MT * DRNN * 4);
constexpr size_t WS_SCP = WS_GI + al256((size_t)MT * DRNN * 4);
constexpr size_t WS_SCS = WS_SCP + al256((size_t)MP * SEQ * 4);
constexpr size_t WS_SEL = WS_SCS + al256((size_t)MS * SCS_LD * 4);
constexpr size_t WS_NSEL = WS_SEL + al256((size_t)MT * TOPK * 4);
constexpr size_t WS_SUMA = WS_NSEL + al256((size_t)MT * 4);
constexpr size_t WS_SUMH = WS_SUMA + al256((size_t)130 * DRNN * 4);
constexpr size_t WS_WAT = WS_SUMH + al256((size_t)130 * DRNN * 4);
constexpr size_t WS_WIT = WS_WAT + al256((size_t)8 * 128 * 128 * 2);
constexpr size_t WS_BM = WS_WIT + al256((size_t)8 * 128 * 128 * 2);
constexpr size_t WS_QB = WS_BM + al256((size_t)MP * 64 * 8);
constexpr size_t WS_KB = WS_QB + al256((size_t)MPAD * 1024 * 2);
constexpr size_t WS_VB = WS_KB + al256((size_t)MPAD * 512 * 2);
constexpr size_t WS_END = WS_VB + al256((size_t)MPAD * 512 * 2);
constexpr size_t WS_PS = WS_END;
constexpr size_t WS_END2 = WS_PS + al256((size_t)21 * MS * D * 4);
constexpr size_t WS_ST = WS_END2;
constexpr size_t WS_END3 = WS_ST + al256((size_t)2 * MP * 2 * 4);
constexpr size_t WS_CTR = WS_CTL + 32768;

constexpr int NWAVES = 8, NTHREADS = 512;
#ifndef REP_6
#define REP_6 1
#endif
#ifndef MID_DUP
#define MID_DUP 0
#endif
#ifndef REP_G
#define REP_G 1
#endif
#ifndef REP_T
#define REP_T 1
#endif
#ifndef REP_5
#define REP_5 2
#endif
constexpr int LDS_STAGE = 131072, LDS_MISC = 134144, LDS_BYTES = 135168;

struct Params {
    const float* in[27];
    float* out;
    unsigned char* ws;
    int ph_lo, ph_hi, li, pad_;
};

__device__ __forceinline__ unsigned cvt_pk_bf16(float lo, float hi) { unsigned r; asm volatile("v_cvt_pk_bf16_f32 %0, %1, %2" : "=v"(r) : "v"(lo), "v"(hi)); return r; }
__device__ __forceinline__ int fresh_tid() { int t = threadIdx.x; asm volatile("" : "+v"(t)); return t; }
__device__ __forceinline__ float sigmoidf_(float x) { return 1.0f / (1.0f + expf(-x)); }
__device__ __forceinline__ float gelu_tanh(float x) { const float a = -2.3022081985f * (x + 0.044715f * x * x * x); return x * __builtin_amdgcn_rcpf(1.0f + __builtin_amdgcn_exp2f(a)); }
__device__ __forceinline__ bf16_t f2bf(float f) { return (bf16_t)(cvt_pk_bf16(f, 0.f) & 0xffffu); }

struct EpiSwiGLU {
    static constexpr bool PERM = true, AFTER_DRAIN = false;
    bf16_t* H;
    __device__ __forceinline__ void operator()(const f32x4 (&acc)[2][2][4][2], const pg8::Unit& u, int wr, int wc, int fr, int fq) const {
        const int row0 = u.pm * 256 + wr * 64 + fr, col0 = u.pn * 128 + wc * 32 + 8 * fq;
#pragma unroll
        for (int ai = 0; ai < 2; ++ai)
#pragma unroll
            for (int m = 0; m < 4; ++m) {
                bf16_t* rowp = H + (size_t)(row0 + ai * 128 + m * 16) * DFF + col0;
                float h[8];
#pragma unroll
                for (int n = 0; n < 2; ++n)
#pragma unroll
                    for (int j = 0; j < 4; ++j) {
                        const float g = acc[ai][0][m][n][j], up = acc[ai][1][m][n][j];
                        const float sg = __builtin_amdgcn_rcpf(1.0f + __builtin_amdgcn_exp2f(-1.4426950408889634f * g));
                        h[n * 4 + j] = g * sg * up;
                    }
                u32x4 w; w.x = cvt_pk_bf16(h[0], h[1]); w.y = cvt_pk_bf16(h[2], h[3]); w.z = cvt_pk_bf16(h[4], h[5]); w.w = cvt_pk_bf16(h[6], h[7]);
                *(u32x4*)rowp = w;
            }
    }
};
struct EpiResid {
    static constexpr bool PERM = false, AFTER_DRAIN = false;
    const float* Xp; const float* Xs; float* T; float s;
    __device__ __forceinline__ void operator()(const f32x4 (&acc)[2][2][4][2], const pg8::Unit& u, int wr, int wc, int fr, int fq) const {
        const int row0 = u.pm * 256 + wr * 64 + fr, col0 = u.pn * 256 + wc * 32 + 4 * fq;
#pragma unroll
        for (int ai = 0; ai < 2; ++ai)
#pragma unroll
            for (int m = 0; m < 4; ++m) {
                const int row = row0 + ai * 128 + m * 16;
                if (row < MT) {
                    const float* xr = (row < MP) ? Xp + (size_t)row * D + col0 : Xs + (size_t)(row - MP) * D + col0;
                    float* tr = T + (size_t)row * D + col0;
#pragma unroll
                    for (int bj = 0; bj < 2; ++bj)
#pragma unroll
                        for (int n = 0; n < 2; ++n) { const f32x4 xv = *(const f32x4*)(xr + bj * 128 + n * 16); *(f32x4*)(tr + bj * 128 + n * 16) = xv * ALPHA + acc[ai][bj][m][n] * s; }
                }
            }
    }
};
struct EpiF32 {
    static constexpr bool PERM = false, AFTER_DRAIN = false;
    float* C; int ldc;
    __device__ __forceinline__ void operator()(const f32x4 (&acc)[2][2][4][2], const pg8::Unit& u, int wr, int wc, int fr, int fq) const {
        const int row0 = u.pm * 256 + wr * 64 + fr, col0 = u.pn * 256 + wc * 32 + 4 * fq;
#pragma unroll
        for (int ai = 0; ai < 2; ++ai)
#pragma unroll
            for (int m = 0; m < 4; ++m) {
                float* rowp = C + (size_t)(row0 + ai * 128 + m * 16) * ldc + col0;
#pragma unroll
                for (int bj = 0; bj < 2; ++bj)
#pragma unroll
                    for (int n = 0; n < 2; ++n) *(f32x4*)(rowp + bj * 128 + n * 16) = acc[ai][bj][m][n];
            }
    }
};


struct EpiWin {
    static constexpr bool PERM = false, AFTER_DRAIN = false;
    float* XR; float* GG; bf16_t* QB; bf16_t* KB; bf16_t* VB; float* QI; bf16_t* KIH; bf16_t* KIL; float* WI; float* out;
    template <class F> __device__ __forceinline__ void each(const f32x4 (&acc)[2][2][4][2], const pg8::Unit& u, int wr, int wc, int fr, int fq, F f) const {
        const int row0 = u.pm * 256 + wr * 64 + fr, cl = wc * 32 + 4 * fq;
#pragma unroll
        for (int ai = 0; ai < 2; ++ai)
#pragma unroll
            for (int m = 0; m < 4; ++m)
#pragma unroll
                for (int bj = 0; bj < 2; ++bj)
#pragma unroll
                    for (int n = 0; n < 2; ++n) f(row0 + ai * 128 + m * 16, cl + 128 * bj + 16 * n, acc[ai][bj][m][n]);
    }
    static __device__ __forceinline__ u32x2 pk4(const f32x4 v) { u32x2 w; w.x = cvt_pk_bf16(v[0], v[1]); w.y = cvt_pk_bf16(v[2], v[3]); return w; }
    __device__ __forceinline__ void operator()(const f32x4 (&acc)[2][2][4][2], const pg8::Unit& u, int wr, int wc, int fr, int fq) const {
        const int pn = u.pn;
        if (pn < 4) each(acc, u, wr, wc, fr, fq, [&](int row, int c, const f32x4 v) { *(f32x4*)(XR + (size_t)row * DRNN + pn * 256 + c) = v; });
        else if (pn < 8) each(acc, u, wr, wc, fr, fq, [&](int row, int c, const f32x4 v) { *(f32x4*)(GG + (size_t)row * DRNN + (pn - 4) * 256 + c) = (f32x4){gelu_tanh(v[0]), gelu_tanh(v[1]), gelu_tanh(v[2]), gelu_tanh(v[3])}; });
        else if (pn < 12) each(acc, u, wr, wc, fr, fq, [&](int row, int c, const f32x4 v) { *(u32x2*)(QB + (size_t)row * 1024 + (pn - 8) * 256 + c) = pk4(v); });
        else if (pn < 16) {
            bf16_t* B = (pn < 14) ? KB : VB; const size_t op = (pn < 14) ? O_KP : O_VP, os = (pn < 14) ? O_KS : O_VS; const int c0 = (pn & 1) * 256;
            each(acc, u, wr, wc, fr, fq, [&](int row, int c, const f32x4 v) {
                *(u32x2*)(B + (size_t)row * 512 + c0 + c) = pk4(v);
                if (row < MT) *(f32x4*)(out + (row < MP ? op + (size_t)row * 512 : os + (size_t)(row - MP) * 512) + c0 + c) = v; });
        }
        else if (pn < 18) each(acc, u, wr, wc, fr, fq, [&](int row, int c, const f32x4 v) { *(f32x4*)(QI + (size_t)row * 512 + (pn - 16) * 256 + c) = v; });
        else each(acc, u, wr, wc, fr, fq, [&](int row, int c, const f32x4 v) {
            if (c < 64) {
                const u32x2 h = pk4(v);
                u32x2 l; l.x = cvt_pk_bf16(v[0] - __uint_as_float(h.x << 16), v[1] - __uint_as_float(h.x & 0xffff0000u)); l.y = cvt_pk_bf16(v[2] - __uint_as_float(h.y << 16), v[3] - __uint_as_float(h.y & 0xffff0000u));
                *(u32x2*)(KIH + (size_t)row * 64 + c) = h; *(u32x2*)(KIL + (size_t)row * 64 + c) = l;
                if (row < MT) *(f32x4*)(out + (row < MP ? O_KIP + (size_t)row * 64 : O_KIS + (size_t)(row - MP) * 64) + c) = v;
            } else if (c < 72) *(f32x4*)(WI + (size_t)row * 8 + (c - 64)) = v; });
    }
};


struct SplitOrder {
    pg8::StaticOrder base; int G, c, nmine, npiece, ntk, nN;
    __device__ __forceinline__ void init(int N, int K, int G_, int c_) { base.init(MP, N, G_, c_, K); G = G_; c = c_; nN = N / 256; ntk = K / 64; npiece = ntk / 4; nmine = (c_ < base.nwg) ? (base.nwg - c_ + G_ - 1) / G_ : 0; }
    __device__ __forceinline__ bool next(int i, pg8::Unit& u) const {
        if (i < nmine) return base.next(i, u);
        const int mi = (i - nmine) * G + c; if (mi >= npiece * nN) return false;
        const int kp = mi / nN; u.pm = MP / 256; u.pn = mi % nN; u.k0 = kp * 256; u.nt = (kp == npiece - 1) ? ntk - 4 * (npiece - 1) : 4; u.aux = kp; return true;
    }
    __device__ __forceinline__ void a_ready(const pg8::Unit&) const {}
    __device__ __forceinline__ void done(const pg8::Unit&) const {}
};
struct EpiResidSplit {
    static constexpr bool PERM = false, AFTER_DRAIN = false;
    const float* X; float* T; float* PS; float s; const float* ST; const float* gn; const float* bn;
    __device__ __forceinline__ void operator()(const f32x4 (&acc)[2][2][4][2], const pg8::Unit& u, int wr, int wc, int fr, int fq) const {
        const int col0 = u.pn * 256 + wc * 32 + 4 * fq;
        if (u.aux < 0) {
            const int row0 = u.pm * 256 + wr * 64 + fr;
            if (ST == nullptr) {
#pragma unroll
                for (int ai = 0; ai < 2; ++ai)
#pragma unroll
                    for (int m = 0; m < 4; ++m) {
                        const size_t off = (size_t)(row0 + ai * 128 + m * 16) * D + col0;
#pragma unroll
                        for (int bj = 0; bj < 2; ++bj)
#pragma unroll
                            for (int n = 0; n < 2; ++n) { const f32x4 xv = *(const f32x4*)(X + off + bj * 128 + n * 16); *(f32x4*)(T + off + bj * 128 + n * 16) = xv * ALPHA + acc[ai][bj][m][n] * s; }
                    }
            } else {
                f32x4 gv[2][2], bv[2][2];
#pragma unroll
                for (int bj = 0; bj < 2; ++bj)
#pragma unroll
                    for (int n = 0; n < 2; ++n) { gv[bj][n] = *(const f32x4*)(gn + col0 + bj * 128 + n * 16); bv[bj][n] = *(const f32x4*)(bn + col0 + bj * 128 + n * 16); }
#pragma unroll
                for (int ai = 0; ai < 2; ++ai)
#pragma unroll
                    for (int m = 0; m < 4; ++m) {
                        const int row = row0 + ai * 128 + m * 16;
                        const size_t off = (size_t)row * D + col0;
                        const float mean = ST[2 * row], rstd = ST[2 * row + 1];
#pragma unroll
                        for (int bj = 0; bj < 2; ++bj)
#pragma unroll
                            for (int n = 0; n < 2; ++n) { const f32x4 tv = *(const f32x4*)(T + off + bj * 128 + n * 16); const f32x4 xv = (tv - mean) * rstd * gv[bj][n] + bv[bj][n];
                                *(f32x4*)(T + off + bj * 128 + n * 16) = xv * ALPHA + acc[ai][bj][m][n] * s; }
                    }
            }
        } else {
            float* slab = PS + (size_t)u.aux * MS * D;
#pragma unroll
            for (int m = 0; m < 4; ++m) {
                float* rp = slab + (size_t)(wr * 64 + m * 16 + fr) * D + col0;
#pragma unroll
                for (int bj = 0; bj < 2; ++bj)
#pragma unroll
                    for (int n = 0; n < 2; ++n) *(f32x4*)(rp + bj * 128 + n * 16) = acc[0][bj][m][n];
            }
        }
    }
};

template <int MODE>
__device__ __forceinline__ void transpose_cvt(const float* __restrict__ W, int K, int N, int Npad, bf16_t* __restrict__ Wt, PG8_LAS float* tile, int wid, int nw) {
    const int tid = fresh_tid(), ntn = Npad / 64, ntk = K / 128, ntiles = ntn * ntk;
    const int lk = tid >> 4, ln4 = (tid & 15) * 4;
    f32x4 v[4];
    auto src0 = [&](int t) { const int n0 = (t % ntn) * 64; if (MODE == 1) { const int t256 = n0 >> 8, j = n0 & 255; return (j < 128) ? t256 * 128 + j : DFF + t256 * 128 + (j - 128); } return n0; };
    auto gload = [&](int t) {
        const int k0 = (t / ntn) * 128, s0 = src0(t);
#pragma unroll
        for (int i = 0; i < 4; ++i) {
            const float* q = W + (size_t)(k0 + lk + 32 * i) * N + s0 + ln4;
            if (MODE == 1 || s0 + ln4 + 3 < N) v[i] = *(const f32x4*)q;
            else { v[i] = (f32x4){0.f, 0.f, 0.f, 0.f}; for (int e = 0; e < 4; ++e) if (s0 + ln4 + e < N) v[i][e] = q[e]; }
        }
    };
    int t = wid;
    if (t < ntiles) gload(t);
    for (; t < ntiles; t += nw) {
#pragma unroll
        for (int i = 0; i < 4; ++i)
#pragma unroll
            for (int e = 0; e < 4; ++e) tile[(lk + 32 * i) * 65 + ln4 + e] = v[i][e];
        const int tn = t + nw;
        if (tn < ntiles) gload(tn);
        __syncthreads();
        {
            const int n0 = (t % ntn) * 64, k0 = (t / ntn) * 128;
            const int n = tid >> 3, kq = (tid & 7) * 16;
#pragma unroll
            for (int h = 0; h < 2; ++h) {
                float x[8];
#pragma unroll
                for (int j = 0; j < 8; ++j) x[j] = tile[(kq + 8 * h + j) * 65 + n];
                u32x4 w; w.x = cvt_pk_bf16(x[0], x[1]); w.y = cvt_pk_bf16(x[2], x[3]); w.z = cvt_pk_bf16(x[4], x[5]); w.w = cvt_pk_bf16(x[6], x[7]);
                *(u32x4*)(Wt + (size_t)(n0 + n) * K + k0 + kq + 8 * h) = w;
            }
        }
        __syncthreads();
    }
}
__device__ __forceinline__ void cvt_x(const float* __restrict__ xp, const float* __restrict__ xs, bf16_t* __restrict__ XB) {
    const size_t n4 = (size_t)MPAD * D / 4;
    for (size_t i = (size_t)blockIdx.x * NTHREADS + threadIdx.x; i < n4; i += (size_t)gridDim.x * NTHREADS) {
        const size_t e = i * 4, row = e / D;
        f32x4 v = (f32x4){0.f, 0.f, 0.f, 0.f};
        if (row < (size_t)MP) v = *(const f32x4*)(xp + e); else if (row < (size_t)MT) v = *(const f32x4*)(xs + (e - (size_t)MP * D));
        u32x2 w; w.x = cvt_pk_bf16(v[0], v[1]); w.y = cvt_pk_bf16(v[2], v[3]);
        *(u32x2*)(XB + e) = w;
    }
}
__device__ __forceinline__ void ln_phase(const float* __restrict__ T, const float* __restrict__ g, const float* __restrict__ b, float* __restrict__ Xo, bf16_t* __restrict__ Xb,
                                         const float* __restrict__ PS, int npiece, const float* __restrict__ Xs, float sres, float* __restrict__ ST) {
    const int tid_ = fresh_tid(), lane = tid_ & 63, wave = tid_ >> 6;
    for (int row = blockIdx.x * NWAVES + wave; row < MT; row += gridDim.x * NWAVES) {
        f32x4 v[8]; float s = 0.f;
        if (row < MP) {
            const float* tr = T + (size_t)row * D + lane * 4;
#pragma unroll
            for (int i = 0; i < 8; ++i) v[i] = *(const f32x4*)(tr + 256 * i);
        } else {
            const size_t ro = (size_t)(row - MP) * D + lane * 4;
#pragma unroll
            for (int i = 0; i < 8; ++i) v[i] = (f32x4){0.f, 0.f, 0.f, 0.f};
#pragma unroll 1
            for (int pz = 0; pz < npiece; ++pz) {
                const float* sp = PS + (size_t)pz * MS * D + ro;
#pragma unroll
                for (int i = 0; i < 8; ++i) v[i] += *(const f32x4*)(sp + 256 * i);
            }
#pragma unroll
            for (int i = 0; i < 8; ++i) v[i] = *(const f32x4*)(Xs + ro + 256 * i) * ALPHA + v[i] * sres;
        }
#pragma unroll
        for (int i = 0; i < 8; ++i) s += (v[i][0] + v[i][1]) + (v[i][2] + v[i][3]);
#pragma unroll
        for (int o = 32; o >= 1; o >>= 1) s += __shfl_xor(s, o);
        const float mean = s * (1.0f / D);
        float q = 0.f;
#pragma unroll
        for (int i = 0; i < 8; ++i) { const f32x4 d = v[i] - mean; q += (d[0] * d[0] + d[1] * d[1]) + (d[2] * d[2] + d[3] * d[3]); }
#pragma unroll
        for (int o = 32; o >= 1; o >>= 1) q += __shfl_xor(q, o);
        const float rstd = rsqrtf(q * (1.0f / D) + LN_EPS);
        if (ST && row < MP && lane == 0) { ST[2 * row] = mean; ST[2 * row + 1] = rstd; }
        const float* gq = g; const float* bq = b; asm volatile("" : "+s"(gq), "+s"(bq));
#pragma unroll
        for (int i = 0; i < 8; ++i) {
            const f32x4 o = (v[i] - mean) * rstd * *(const f32x4*)(gq + lane * 4 + 256 * i) + *(const f32x4*)(bq + lane * 4 + 256 * i);
            if (Xo && (ST == nullptr || row >= MP)) *(f32x4*)(Xo + (size_t)row * D + lane * 4 + 256 * i) = o;
            if (Xb) { u32x2 w; w.x = cvt_pk_bf16(o[0], o[1]); w.y = cvt_pk_bf16(o[2], o[3]); *(u32x2*)(Xb + (size_t)row * D + lane * 4 + 256 * i) = w; }
        }
    }
}

typedef short bf16x8 __attribute__((ext_vector_type(8)));
typedef float f32x16 __attribute__((ext_vector_type(16)));
__device__ __forceinline__ int crow(int reg, int h) { return (reg & 3) + 8 * (reg >> 2) + 4 * h; }
constexpr int LRU_CH = 64, LRU_NCHUNK = MT / LRU_CH  , LRU_PCHUNK = MP / LRU_CH  , LRU_CPB = SEQ / LRU_CH  ;
constexpr int L_XCF = 0, L_XCB = 32768, L_AA = 50176, L_UU = 82944, XCB_PITCH = 272;
__device__ __forceinline__ void lru_local_unit(const Params& p, PG8_LAS unsigned char* lds, int u) {
    const int tid = fresh_tid(), lane = tid & 63, wave = tid >> 6;
    unsigned char* ws = p.ws;
    const float* XR = (const float*)(ws + WS_XR);
    const float* state_conv = p.in[5]; const float* state_rnn = p.in[6];
    const float* cw = p.in[13]; const float* cb = p.in[14];
    const float* ba = p.in[16]; const float* bi = p.in[18]; const float* lam = p.in[19];
    const bf16_t* WAt = (const bf16_t*)(ws + WS_WAT); const bf16_t* WIt = (const bf16_t*)(ws + WS_WIT);
    float* HL = (float*)(ws + WS_HL); float* PP = (float*)(ws + WS_PP); float* SUMA = (float*)(ws + WS_SUMA); float* SUMH = (float*)(ws + WS_SUMH);
    float* out = p.out;
    PG8_LAS float* XCF = (PG8_LAS float*)(lds + L_XCF); PG8_LAS float* AA = (PG8_LAS float*)(lds + L_AA); PG8_LAS float* UU = (PG8_LAS float*)(lds + L_UU);
    {
        const int ck = u >> 3, nb = u & 7;
        const int mt = wave >> 2, nt = wave & 3, r = lane & 31, kh = lane >> 5;
        bf16x8 bfa[8], bfi[8];
        {
            const bf16_t* wa = WAt + (size_t)nb * 16384 + (size_t)(nt * 32 + r) * 128 + kh * 8;
            const bf16_t* wi = WIt + (size_t)nb * 16384 + (size_t)(nt * 32 + r) * 128 + kh * 8;
#pragma unroll
            for (int ks = 0; ks < 8; ++ks) { bfa[ks] = *(const bf16x8*)(wa + ks * 16); bfi[ks] = *(const bf16x8*)(wi + ks * 16); }
        }
        const int col_e = nt * 32 + r, ch_e = nb * 128 + col_e;
        const float lam_e = lam[ch_e], bac = ba[ch_e], bic = bi[ch_e];
        {
            const int c = tid & 127, rg = tid >> 7, ch = nb * 128 + c;
            const float w0 = cw[ch], w1 = cw[DRNN + ch], w2 = cw[2 * DRNN + ch], w3 = cw[3 * DRNN + ch], cbv = cb[ch];
            if (ck < LRU_PCHUNK) {
                const int b = ck / LRU_CPB, t0 = (ck % LRU_CPB) * LRU_CH + rg * 16;
                const float* zc = XR + (size_t)(b * SEQ) * DRNN + ch;
                float x0 = (t0 - 3 >= 0) ? zc[(size_t)(t0 - 3) * DRNN] : 0.f, x1 = (t0 - 2 >= 0) ? zc[(size_t)(t0 - 2) * DRNN] : 0.f, x2 = (t0 - 1 >= 0) ? zc[(size_t)(t0 - 1) * DRNN] : 0.f;
#pragma unroll
                for (int i = 0; i < 16; ++i) {
                    const int t = t0 + i, lr = rg * 16 + i;
                    const float x3 = zc[(size_t)t * DRNN];
                    const float xc = cbv + w0 * x0 + w1 * x1 + w2 * x2 + w3 * x3;
                    XCF[lr * 128 + c] = xc;
                    *(PG8_LAS bf16_t*)(lds + L_XCB + lr * XCB_PITCH + c * 2) = f2bf(xc);
                    if (t >= SEQ - 3) out[O_CP + (size_t)(b * 3 + (t - (SEQ - 3))) * DRNN + ch] = x3;
                    x0 = x1; x1 = x2; x2 = x3;
                }
            } else {
#pragma unroll
                for (int i = 0; i < 16; ++i) {
                    const int lr = rg * 16 + i, rs = (ck - LRU_PCHUNK) * LRU_CH + lr, bs = rs >> 2, tt = rs & 3;
                    float xv[4];
#pragma unroll
                    for (int j = 0; j < 4; ++j) { const int pp = tt + j; xv[j] = (pp < 3) ? state_conv[(size_t)(bs * 3 + pp) * DRNN + ch] : XR[(size_t)(MP + bs * DS + pp - 3) * DRNN + ch]; }
                    const float xc = cbv + w0 * xv[0] + w1 * xv[1] + w2 * xv[2] + w3 * xv[3];
                    XCF[lr * 128 + c] = xc;
                    *(PG8_LAS bf16_t*)(lds + L_XCB + lr * XCB_PITCH + c * 2) = f2bf(xc);
                    if (tt >= 1) out[O_CS + (size_t)(bs * 3 + (tt - 1)) * DRNN + ch] = xv[3];
                }
            }
        }
        __syncthreads();
        {
            f32x16 acc_a, acc_i;
#pragma unroll
            for (int i = 0; i < 16; ++i) { acc_a[i] = 0.f; acc_i[i] = 0.f; }
#pragma unroll
            for (int ks = 0; ks < 8; ++ks) {
                const bf16x8 af = *(const PG8_LAS bf16x8*)(lds + L_XCB + (mt * 32 + r) * XCB_PITCH + (ks * 16 + kh * 8) * 2);
                acc_a = __builtin_amdgcn_mfma_f32_32x32x16_bf16(af, bfa[ks], acc_a, 0, 0, 0);
                acc_i = __builtin_amdgcn_mfma_f32_32x32x16_bf16(af, bfi[ks], acc_i, 0, 0, 0);
            }
            const int col = col_e, hh = lane >> 5;
            const float l = lam_e, sp = (-l > 20.f) ? -l : log1pf(expf(-l));
#pragma unroll
            for (int i = 0; i < 16; ++i) {
                const int lr = mt * 32 + crow(i, hh);
                const float xc = XCF[lr * 128 + col];
                const float rg = __builtin_amdgcn_rcpf(1.0f + __builtin_amdgcn_exp2f(-1.4426950408889634f * (acc_a[i] + bac)));
                const float ig = __builtin_amdgcn_rcpf(1.0f + __builtin_amdgcn_exp2f(-1.4426950408889634f * (acc_i[i] + bic)));
                const float log_a = -8.0f * rg * sp, x = 2.0f * log_a;
                float om;
                if (x > -0.25f) { float q = 1.0f / 720.0f; q = q * x + 1.0f / 120.0f; q = q * x + 1.0f / 24.0f; q = q * x + 1.0f / 6.0f; q = q * x + 0.5f; q = q * x + 1.0f; om = -x * q; }
                else om = -expm1f(x);
                AA[lr * 128 + col] = __builtin_amdgcn_exp2f(1.4426950408889634f * log_a);
                UU[lr * 128 + col] = __builtin_amdgcn_sqrtf(om) * ig * xc;
            }
        }
        __syncthreads();
        {
            const int c = tid & 127, sg = tid >> 7, ch = nb * 128 + c;
            PG8_LAS float* SEG = (PG8_LAS float*)(lds + L_XCF);
            float hv[16], pv[16];
            float h = 0.f, P = 1.f;
            const bool prompt = ck < LRU_PCHUNK;
#pragma unroll
            for (int i = 0; i < 16; ++i) {
                const int lr = sg * 16 + i;
                const float a = AA[lr * 128 + c], uu = UU[lr * 128 + c];
                if (!prompt && (i & 3) == 0) { h = state_rnn[(size_t)(((ck - LRU_PCHUNK) * LRU_CH + lr) >> 2) * DRNN + ch]; P = 0.f; }
                h = a * h + uu; P *= a;
                hv[i] = h; pv[i] = P;
            }
            SEG[(sg * 128 + c) * 2] = P; SEG[(sg * 128 + c) * 2 + 1] = h;
            __syncthreads();
            float cin = 0.f, pin = 1.f;
            if (prompt) {
#pragma unroll
                for (int s2 = 0; s2 < 3; ++s2) if (s2 < sg) { const float ps = SEG[(s2 * 128 + c) * 2], hs = SEG[(s2 * 128 + c) * 2 + 1]; cin = ps * cin + hs; pin *= ps; }
            }
#pragma unroll
            for (int i = 0; i < 16; ++i) {
                const int lr = sg * 16 + i;
                const size_t g = (size_t)(ck * LRU_CH + lr) * DRNN + ch;
                const float hf = prompt ? hv[i] + pv[i] * cin : hv[i];
                HL[g] = hf; PP[g] = prompt ? pv[i] * pin : 0.f;
                if (!prompt && (i & 3) == 3) out[O_HS + (size_t)(((ck - LRU_PCHUNK) * LRU_CH + lr) >> 2) * DRNN + ch] = hf;
            }
            if (sg == 3) { SUMA[(size_t)ck * DRNN + ch] = prompt ? pv[15] * pin : 0.f; SUMH[(size_t)ck * DRNN + ch] = prompt ? hv[15] + pv[15] * cin : 0.f; }
        }
        __syncthreads();
    }
}
__device__ __forceinline__ void lru_fixup_unit(const Params& p, int ck) {
    const int tid = fresh_tid(), ch = tid * 2;
    unsigned char* ws = p.ws;
    const float* GG = (const float*)(ws + WS_GG);
    const float* HL = (const float*)(ws + WS_HL); const float* PP = (const float*)(ws + WS_PP); const float* SUMA = (const float*)(ws + WS_SUMA); const float* SUMH = (const float*)(ws + WS_SUMH);
    bf16_t* CATB = (bf16_t*)(ws + WS_CATB); float* PS = (float*)(ws + WS_PS);
    typedef float f32x2 __attribute__((ext_vector_type(2)));
    f32x2 carry = (f32x2){0.f, 0.f};
    const bool prompt = ck < LRU_PCHUNK;
    if (prompt) {
        const int b = ck / LRU_CPB, kk = ck % LRU_CPB;
#pragma unroll 4
        for (int j = 0; j < kk; ++j) {
            const f32x2 A = *(const f32x2*)(SUMA + (size_t)(b * LRU_CPB + j) * DRNN + ch), Hh = *(const f32x2*)(SUMH + (size_t)(b * LRU_CPB + j) * DRNN + ch);
            carry = A * carry + Hh;
        }
    }
#pragma unroll 4
    for (int lr = 0; lr < LRU_CH; ++lr) {
        const size_t grow = (size_t)(ck * LRU_CH + lr);
        const f32x2 hl = *(const f32x2*)(HL + grow * DRNN + ch), pp = *(const f32x2*)(PP + grow * DRNN + ch), gg = *(const f32x2*)(GG + grow * DRNN + ch);
        const f32x2 h = hl + pp * carry;
        *(unsigned*)(CATB + grow * D + ch) = cvt_pk_bf16(h.x * gg.x, h.y * gg.y);
        if (prompt && (ck % LRU_CPB) == LRU_CPB - 1 && lr == LRU_CH - 1) *(f32x2*)(p.out + O_HP + (size_t)(ck / LRU_CPB) * DRNN + ch) = h;
    }
}


constexpr int IDX_SPLIT = 1;
constexpr int SCP_LD = 4096, SCS_LDL = 8200;
__device__ __forceinline__ unsigned fkey(float f) { const unsigned u = __float_as_uint(f); return (u & 0x80000000u) ? ~u : (u | 0x80000000u); }
__device__ __forceinline__ int mbcnt64(unsigned long long m) { return (int)__builtin_amdgcn_mbcnt_hi((unsigned)(m >> 32), __builtin_amdgcn_mbcnt_lo((unsigned)m, 0u)); }
template <int NB> __device__ __forceinline__ int wave_sum_small(unsigned c) {
    int t = 0;
#pragma unroll
    for (int b = 0; b < NB; ++b) t += __popcll(__ballot((c >> b) & 1u)) << b;
    return t;
}
__device__ __forceinline__ void split8(const f32x4 a, const f32x4 b, bf16x8& hi, bf16x8& lo) {
    u32x4 h; h.x = cvt_pk_bf16(a[0], a[1]); h.y = cvt_pk_bf16(a[2], a[3]); h.z = cvt_pk_bf16(b[0], b[1]); h.w = cvt_pk_bf16(b[2], b[3]);
    u32x4 l;
    l.x = cvt_pk_bf16(a[0] - __uint_as_float(h.x << 16), a[1] - __uint_as_float(h.x & 0xffff0000u));
    l.y = cvt_pk_bf16(a[2] - __uint_as_float(h.y << 16), a[3] - __uint_as_float(h.y & 0xffff0000u));
    l.z = cvt_pk_bf16(b[0] - __uint_as_float(h.z << 16), b[1] - __uint_as_float(h.z & 0xffff0000u));
    l.w = cvt_pk_bf16(b[2] - __uint_as_float(h.w << 16), b[3] - __uint_as_float(h.w & 0xffff0000u));
    hi = __builtin_bit_cast(bf16x8, h); lo = __builtin_bit_cast(bf16x8, l);
}
struct IdxQ { bf16x8 hi[4], lo[4]; float w[16]; };
struct IdxRaw { f32x4 v[8]; };
struct IdxKey { bf16x8 hi[4], lo[4]; };
__device__ __forceinline__ void idx_load_q(IdxQ& q, const float* QI, const float* WI, int grow0, int lane) {
    const int rho = lane & 31, kh = lane >> 5, ql = 2 * ((rho >> 2) & 1) + (rho >> 4), head = 4 * ((rho >> 3) & 1) + (rho & 3);
    const float* src = QI + (size_t)(grow0 + ql) * 512 + head * IDD + kh * 8;
#pragma unroll
    for (int ks = 0; ks < 4; ++ks) { const f32x4 a = *(const f32x4*)(src + ks * 16), b = *(const f32x4*)(src + ks * 16 + 4); split8(a, b, q.hi[ks], q.lo[ks]); }
#pragma unroll
    for (int e = 0; e < 2; ++e) {
        const float* wsrc = WI + (size_t)(grow0 + 2 * kh + e) * 8;
        const f32x4 a = *(const f32x4*)wsrc, b = *(const f32x4*)(wsrc + 4);
#pragma unroll
        for (int i = 0; i < 4; ++i) { q.w[e * 8 + i] = a[i] * IDX_W_SCALE; q.w[e * 8 + 4 + i] = b[i] * IDX_W_SCALE; }
    }
}
__device__ __forceinline__ void idx_load_raw(IdxRaw& raw, const float* kp) {
#pragma unroll
    for (int ks = 0; ks < 4; ++ks) { raw.v[2 * ks] = *(const f32x4*)(kp + ks * 16); raw.v[2 * ks + 1] = *(const f32x4*)(kp + ks * 16 + 4); }
}
__device__ __forceinline__ void idx_cvt_key(const IdxRaw& raw, IdxKey& k) {
#pragma unroll
    for (int ks = 0; ks < 4; ++ks) split8(raw.v[2 * ks], raw.v[2 * ks + 1], k.hi[ks], k.lo[ks]);
}
__device__ __forceinline__ void idx_load_keyb(IdxKey& k, const bf16_t* ph, const bf16_t* pl) {
#pragma unroll
    for (int ks = 0; ks < 4; ++ks) { k.hi[ks] = *(const bf16x8*)(ph + ks * 16); if (IDX_SPLIT == 3) k.lo[ks] = *(const bf16x8*)(pl + ks * 16); else k.lo[ks] = k.hi[ks]; }
}
__device__ __forceinline__ void idx_tile(const IdxQ& q, const IdxKey& k, float (&s)[2]) {
    f32x16 acc;
#pragma unroll
    for (int i = 0; i < 16; ++i) acc[i] = 0.f;
#pragma unroll
    for (int ks = 0; ks < 4; ++ks) {
        acc = __builtin_amdgcn_mfma_f32_32x32x16_bf16(q.hi[ks], k.hi[ks], acc, 0, 0, 0);
        if (IDX_SPLIT == 3) { acc = __builtin_amdgcn_mfma_f32_32x32x16_bf16(q.hi[ks], k.lo[ks], acc, 0, 0, 0); acc = __builtin_amdgcn_mfma_f32_32x32x16_bf16(q.lo[ks], k.hi[ks], acc, 0, 0, 0); }
    }
#pragma unroll
    for (int e = 0; e < 2; ++e) {
        float t = 0.f;
#pragma unroll
        for (int i = 0; i < 8; ++i) t += fmaxf(acc[e * 8 + i] * IDX_SCALE, 0.f) * q.w[e * 8 + i];
        s[e] = t;
    }
}

#define wlane2(vlo, vhi, m, j) asm volatile("s_nop 3\n\tv_writelane_b32 %0, %2, %4\n\tv_writelane_b32 %1, %3, %4" : "+v"(vlo), "+v"(vhi) : "s"((unsigned)(m)), "s"((unsigned)((m) >> 32)), "n"(j))
__device__ __forceinline__ int count8_ge(unsigned a0, unsigned a1, unsigned a2, unsigned a3, unsigned a4, unsigned a5, unsigned a6, unsigned a7, unsigned cand) {
    unsigned long long m0, m1, m2, m3, m4, m5, m6, m7;
    asm volatile("v_cmp_ge_u32_e64 %0, %8, %16\n\tv_cmp_ge_u32_e64 %1, %9, %16\n\tv_cmp_ge_u32_e64 %2, %10, %16\n\tv_cmp_ge_u32_e64 %3, %11, %16\n\t"
                 "v_cmp_ge_u32_e64 %4, %12, %16\n\tv_cmp_ge_u32_e64 %5, %13, %16\n\tv_cmp_ge_u32_e64 %6, %14, %16\n\tv_cmp_ge_u32_e64 %7, %15, %16\n\ts_nop 3"
                 : "=&s"(m0), "=&s"(m1), "=&s"(m2), "=&s"(m3), "=&s"(m4), "=&s"(m5), "=&s"(m6), "=&s"(m7)
                 : "v"(a0), "v"(a1), "v"(a2), "v"(a3), "v"(a4), "v"(a5), "v"(a6), "v"(a7), "v"(cand));
    return (__popcll(m0) + __popcll(m1)) + (__popcll(m2) + __popcll(m3)) + ((__popcll(m4) + __popcll(m5)) + (__popcll(m6) + __popcll(m7)));
}


__device__ __forceinline__ void count8_acc(unsigned& cnt, unsigned a0, unsigned a1, unsigned a2, unsigned a3, unsigned a4, unsigned a5, unsigned a6, unsigned a7, unsigned cand) {
    unsigned long long m0, m1, m2, m3, m4, m5, m6, m7;
    asm volatile("v_cmp_ge_u32_e64 %1, %9, %17\n\tv_cmp_ge_u32_e64 %2, %10, %17\n\tv_cmp_ge_u32_e64 %3, %11, %17\n\tv_cmp_ge_u32_e64 %4, %12, %17\n\t"
                 "v_cmp_ge_u32_e64 %5, %13, %17\n\tv_cmp_ge_u32_e64 %6, %14, %17\n\tv_cmp_ge_u32_e64 %7, %15, %17\n\tv_cmp_ge_u32_e64 %8, %16, %17\n\ts_nop 1\n\t"
                 "v_addc_co_u32_e64 %0, vcc, 0, %0, %1\n\tv_addc_co_u32_e64 %0, vcc, 0, %0, %2\n\tv_addc_co_u32_e64 %0, vcc, 0, %0, %3\n\tv_addc_co_u32_e64 %0, vcc, 0, %0, %4\n\t"
                 "v_addc_co_u32_e64 %0, vcc, 0, %0, %5\n\tv_addc_co_u32_e64 %0, vcc, 0, %0, %6\n\tv_addc_co_u32_e64 %0, vcc, 0, %0, %7\n\tv_addc_co_u32_e64 %0, vcc, 0, %0, %8"
                 : "+v"(cnt), "=&s"(m0), "=&s"(m1), "=&s"(m2), "=&s"(m3), "=&s"(m4), "=&s"(m5), "=&s"(m6), "=&s"(m7)
                 : "v"(a0), "v"(a1), "v"(a2), "v"(a3), "v"(a4), "v"(a5), "v"(a6), "v"(a7), "v"(cand) : "vcc");
}
__device__ __forceinline__ int wave_sum_dpp(int x) {
    x += __builtin_amdgcn_update_dpp(0, x, 0x111, 0xf, 0xf, true);
    x += __builtin_amdgcn_update_dpp(0, x, 0x112, 0xf, 0xf, true);
    x += __builtin_amdgcn_update_dpp(0, x, 0x114, 0xf, 0xf, true);
    x += __builtin_amdgcn_update_dpp(0, x, 0x118, 0xf, 0xf, true);
    x += __builtin_amdgcn_update_dpp(0, x, 0x142, 0xa, 0xf, true);
    x += __builtin_amdgcn_update_dpp(0, x, 0x143, 0xc, 0xf, true);
    return __builtin_amdgcn_readlane(x, 63);
}
template <int NGA, int NJ, int BITLO>
__device__ __forceinline__ bool bit_search(const unsigned (&v)[NJ], unsigned& prefix) {
    for (int bit = 31; bit >= BITLO; --bit) {
        const unsigned cand = prefix | (1u << bit);
        int cnt;
        if (NGA >= 2) {
            unsigned c = 0u;
#pragma unroll
            for (int g = 0; g < NGA; ++g) count8_acc(c, v[g * 8], v[g * 8 + 1], v[g * 8 + 2], v[g * 8 + 3], v[g * 8 + 4], v[g * 8 + 5], v[g * 8 + 6], v[g * 8 + 7], cand);
            cnt = wave_sum_dpp((int)c);
        } else cnt = count8_ge(v[0], v[1], v[2], v[3], v[4], v[5], v[6], v[7], cand);
        if (cnt >= TOPK) prefix = cand;
        if (cnt == TOPK) return true;
    }
    return false;
}
template <int NJ, int BITLO = 0>
__device__ __forceinline__ void select_row(const PG8_LAS float* sc, int n, int lane, unsigned long long* bm_row) {
    constexpr int NG = (NJ + 7) / 8;
    unsigned v[NJ];
    const int nj = __builtin_amdgcn_readfirstlane((n + 63) >> 6), ng = (nj + 7) >> 3;
    const PG8_LAS float* pl = sc + lane;
#pragma unroll
    for (int j = 0; j < NJ; ++j) { const unsigned k = fkey(pl[j * 64]); v[j] = (lane < n - j * 64) ? k : 0u; }
    unsigned T = 1u; int need = 1 << 30;
    if (n > TOPK) {
        unsigned prefix = 0u; bool exact;
        if (NG >= 8 && ng > 7) exact = bit_search<(NG >= 8 ? 8 : NG), NJ, BITLO>(v, prefix);
        else if (NG >= 7 && ng > 6) exact = bit_search<(NG >= 7 ? 7 : NG), NJ, BITLO>(v, prefix);
        else if (NG >= 6 && ng > 5) exact = bit_search<(NG >= 6 ? 6 : NG), NJ, BITLO>(v, prefix);
        else if (NG >= 5 && ng > 4) exact = bit_search<(NG >= 5 ? 5 : NG), NJ, BITLO>(v, prefix);
        else if (NG >= 4 && ng > 3) exact = bit_search<(NG >= 4 ? 4 : NG), NJ, BITLO>(v, prefix);
        else if (NG >= 3 && ng > 2) exact = bit_search<(NG >= 3 ? 3 : NG), NJ, BITLO>(v, prefix);
        else if (NG >= 2 && ng > 1) exact = bit_search<(NG >= 2 ? 2 : NG), NJ, BITLO>(v, prefix);
        else exact = bit_search<1, NJ, BITLO>(v, prefix);
        T = prefix;
        if (!exact) {
            int cgt = 0;
#pragma unroll
            for (int g = 0; g < NG; ++g) if (g < ng) {
#pragma unroll
                for (int jj = 0; jj < 8; ++jj) if (g * 8 + jj < NJ) cgt += __popcll(__ballot(v[g * 8 + jj] > T));
            }
            need = TOPK - cgt;
        }
    }
    unsigned mlo = 0u, mhi = 0u;
    if (need >= (1 << 29)) {
#pragma unroll
        for (int g = 0; g < NG; ++g) if (g < ng) {
#pragma unroll
            for (int jj = 0; jj < 8; ++jj) { const int j = g * 8 + jj; const unsigned long long sm = __ballot(v[j] >= T);
                wlane2(mlo, mhi, sm, j); }
        }
    } else {
        int base_eq = 0;
#pragma unroll
        for (int j = 0; j < NJ; ++j) if (j < nj) {
            const bool gt = v[j] > T, eq = v[j] == T;
            const unsigned long long eqm = __ballot(eq);
            const bool s = gt || (eq && (base_eq + mbcnt64(eqm)) < need);
            const unsigned long long sm = __ballot(s);
            base_eq += __popcll(eqm);
            wlane2(mlo, mhi, sm, j);
        }
    }
    const unsigned long long mymask = ((unsigned long long)mhi << 32) | mlo;
    bm_row[lane] = mymask;
}
__device__ __forceinline__ void select_row_wg(const PG8_LAS float* sc, int n, PG8_LAS int* sel, volatile PG8_LAS int* red) {
    constexpr int NC = 17;
    const int tid_ = fresh_tid(), lane = tid_ & 63, wave = __builtin_amdgcn_readfirstlane(tid_ >> 6);
    unsigned v[NC];
    const PG8_LAS float* pl = sc + wave * NC * 64 + lane;
    const int nrem = n - wave * NC * 64;
#pragma unroll
    for (int j = 0; j < NC; ++j) { const unsigned k = fkey(pl[j * 64]); v[j] = (lane < nrem - j * 64) ? k : 0u; }
    unsigned prefix = 0u; bool exact = false; int it = 0;
    for (int bit = 31; bit >= 0; --bit, ++it) {
        const unsigned cand = prefix | (1u << bit);
        int wc = 0;
#pragma unroll
        for (int j = 0; j < NC; ++j) wc += __popcll(__ballot(v[j] >= cand));
        if (lane == 0) red[(it & 1) * 8 + wave] = wc;
        __syncthreads();
        int cnt = 0;
#pragma unroll
        for (int w = 0; w < 8; ++w) cnt += red[(it & 1) * 8 + w];
        if (cnt >= TOPK) prefix = cand;
        if (cnt == TOPK) { exact = true; break; }
    }
    const unsigned T = prefix;
    unsigned cg = 0u, ce = 0u;
#pragma unroll
    for (int j = 0; j < NC; ++j) { cg += (v[j] > T) ? 1u : 0u; ce += (v[j] == T) ? 1u : 0u; }
    const int wg_ = wave_sum_small<5>(cg), we_ = wave_sum_small<5>(ce);
    __syncthreads();
    if (lane == 0) { red[16 + wave] = wg_; red[24 + wave] = we_; }
    __syncthreads();
    int tot_gt = 0, eq_before = 0, gt_before = 0;
#pragma unroll
    for (int w = 0; w < 8; ++w) { const int g = red[16 + w], e = red[24 + w]; tot_gt += g; if (w < wave) { gt_before += g; eq_before += e; } }
    const int need = exact ? (1 << 30) : TOPK - tot_gt;
    int base_sel = gt_before + (eq_before < need ? eq_before : need), base_eq = eq_before;
    int ln = lane; asm volatile("" : "+v"(ln));
#pragma unroll
    for (int j = 0; j < NC; ++j) {
        const bool gt = v[j] > T, eq = v[j] == T;
        const unsigned long long eqm = __ballot(eq);
        const bool s = gt || (eq && (base_eq + mbcnt64(eqm)) < need);
        const unsigned long long sm = __ballot(s);
        if (s) sel[base_sel + mbcnt64(sm)] = (wave * NC + j) * 64 + ln;
        base_eq += __popcll(eqm); base_sel += __popcll(sm);
    }
    __syncthreads();
}
__device__ __forceinline__ void idx_sample_score_unit(const Params& p, int bs, int pg8) {
    const int tid_ = fresh_tid(), lane = tid_ & 63, wave = __builtin_amdgcn_readfirstlane(tid_ >> 6), r = lane & 31, kh = lane >> 5;
    unsigned char* ws = p.ws;
    const float* QI = (const float*)(ws + WS_QI); const float* WI = (const float*)(ws + WS_WI); float* SCS = (float*)(ws + WS_SCS);
    const bf16_t* KIH = (const bf16_t*)(ws + WS_KIH); const bf16_t* KIL = (const bf16_t*)(ws + WS_KIL);
    const float* cache_ki = p.in[4]; const int* page_table = (const int*)p.in[7];
    IdxQ q; idx_load_q(q, QI, WI, MP + bs * DS, lane);
    const int pg = pg8 * 8 + wave, phys = page_table[bs * NPAGES + pg];
    const float* pbase = cache_ki + (size_t)phys * PAGE * IDD + (size_t)r * IDD + kh * 8;
    float* out0 = SCS + (size_t)(bs * DS + 2 * kh) * SCS_LD;
    IdxRaw raw; idx_load_raw(raw, pbase);
    IdxKey k;
#pragma unroll
    for (int tt = 0; tt < 4; ++tt) {
        idx_cvt_key(raw, k);
        if (tt < 3) idx_load_raw(raw, pbase + (size_t)(tt + 1) * 32 * IDD);
        float s[2]; idx_tile(q, k, s);
        const int col = pg * PAGE + tt * 32 + r;
        out0[col] = s[0]; out0[SCS_LD + col] = s[1];
    }
    if (pg8 == 0 && wave == 0) {
        const size_t kr = (size_t)(MP + bs * DS + (r & 3)) * IDD + kh * 8;
        idx_load_keyb(k, KIH + kr, KIL + kr);
        float s[2]; idx_tile(q, k, s);
        if (r < DS) { out0[NPAST + r] = s[0]; out0[SCS_LD + NPAST + r] = s[1]; }
    }
}

__device__ __forceinline__ void select_row_list(const PG8_LAS float* sc, int n, int lane, int* sel) {
    constexpr int NJ = 136, NG = 17;
    unsigned v[NJ];
    const int nj = __builtin_amdgcn_readfirstlane((n + 63) >> 6), ng = (nj + 7) >> 3;
    const PG8_LAS float* pl = sc + lane;
#pragma unroll
    for (int j = 0; j < NJ; ++j) { const unsigned k = fkey(pl[j * 64]); v[j] = (lane < n - j * 64) ? k : 0u; }
    unsigned prefix = 0u; bool exact = false;
    for (int bit = 31; bit >= 0; --bit) {
        const unsigned cand = prefix | (1u << bit);
        int cnt = 0;
#pragma unroll
        for (int g = 0; g < NG; ++g) if (g < ng) cnt += count8_ge(v[g * 8], v[g * 8 + 1], v[g * 8 + 2], v[g * 8 + 3], v[g * 8 + 4], v[g * 8 + 5], v[g * 8 + 6], v[g * 8 + 7], cand);
        if (cnt >= TOPK) prefix = cand;
        if (cnt == TOPK) { exact = true; break; }
    }
    const unsigned T = prefix; int need = 1 << 30;
    if (!exact) {
        int cgt = 0;
#pragma unroll
        for (int j = 0; j < NJ; ++j) if (j < nj) cgt += __popcll(__ballot(v[j] > T));
        need = TOPK - cgt;
    }
    int base_eq = 0, base_sel = 0;
    int ln = lane; asm volatile("" : "+v"(ln));
#pragma unroll
    for (int j = 0; j < NJ; ++j) if (j < nj) {
        const bool gt = v[j] > T, eq = v[j] == T;
        const unsigned long long eqm = __ballot(eq);
        const bool s = gt || (eq && (base_eq + mbcnt64(eqm)) < need);
        const unsigned long long sm = __ballot(s);
        if (s) sel[base_sel + mbcnt64(sm)] = j * 64 + ln;
        base_eq += __popcll(eqm); base_sel += __popcll(sm);
    }
}
__device__ __forceinline__ void idx_sample_batch_unit(const Params& p, PG8_LAS unsigned char* lds, int bs) {
    const int tid_ = fresh_tid(), lane = tid_ & 63, wave = __builtin_amdgcn_readfirstlane(tid_ >> 6), r = lane & 31, kh = lane >> 5;
    unsigned char* ws = p.ws;
    const float* QI = (const float*)(ws + WS_QI); const float* WI = (const float*)(ws + WS_WI); int* SEL = (int*)(ws + WS_SEL);
    const bf16_t* KIH = (const bf16_t*)(ws + WS_KIH); const bf16_t* KIL = (const bf16_t*)(ws + WS_KIL);
    const float* cache_ki = p.in[4]; const int* page_table = (const int*)p.in[7];
    PG8_LAS float* sc = (PG8_LAS float*)lds;
    IdxQ q; idx_load_q(q, QI, WI, MP + bs * DS, lane);
    IdxRaw raw; IdxKey k;
    for (int pg = wave; pg < NPAGES; pg += NWAVES) {
        const int phys = page_table[bs * NPAGES + pg];
        const float* pbase = cache_ki + (size_t)phys * PAGE * IDD + (size_t)r * IDD + kh * 8;
        idx_load_raw(raw, pbase);
#pragma unroll
        for (int tt = 0; tt < 4; ++tt) {
            idx_cvt_key(raw, k);
            if (tt < 3) idx_load_raw(raw, pbase + (size_t)(tt + 1) * 32 * IDD);
            float s2[2]; idx_tile(q, k, s2);
            const int col = pg * PAGE + tt * 32 + r;
            sc[(2 * kh) * SCS_LDL + col] = s2[0]; sc[(2 * kh + 1) * SCS_LDL + col] = s2[1];
        }
    }
    if (wave == 0) {
        const size_t kr = (size_t)(MP + bs * DS + (r & 3)) * IDD + kh * 8;
        idx_load_keyb(k, KIH + kr, KIL + kr);
        float s2[2]; idx_tile(q, k, s2);
        if (r < DS) { sc[(2 * kh) * SCS_LDL + NPAST + r] = s2[0]; sc[(2 * kh + 1) * SCS_LDL + NPAST + r] = s2[1]; }
    }
    __syncthreads();
    if (wave < DS) select_row_list(sc + wave * SCS_LDL, NPAST + wave + 1, lane, SEL + (size_t)(bs * DS + wave) * TOPK);
    __syncthreads();
}
__device__ __forceinline__ void idx_prompt_unit(const Params& p, PG8_LAS unsigned char* lds, int s, int mode = 1) {
    const int tid_ = fresh_tid(), lane = tid_ & 63, wave = __builtin_amdgcn_readfirstlane(tid_ >> 6), r = lane & 31, kh = lane >> 5;
    unsigned char* ws = p.ws;
    const float* QI = (const float*)(ws + WS_QI); const float* WI = (const float*)(ws + WS_WI); unsigned long long* BM = (unsigned long long*)(ws + WS_BM);
    const bf16_t* KIH = (const bf16_t*)(ws + WS_KIH); const bf16_t* KIL = (const bf16_t*)(ws + WS_KIL);
    PG8_LAS float* sc = (PG8_LAS float*)lds;
    const int b = s & 1, q0 = (s >> 1) * 8, grow0 = b * SEQ + q0, ntile = (q0 + 8 + 31) >> 5;
    IdxQ qa, qb; idx_load_q(qa, QI, WI, grow0, lane); idx_load_q(qb, QI, WI, grow0 + 4, lane);
    const size_t kbase = (size_t)(b * SEQ + r) * IDD + kh * 8;
    IdxKey kn;
    if (wave < ntile) idx_load_keyb(kn, KIH + kbase + (size_t)wave * 32 * IDD, KIL + kbase + (size_t)wave * 32 * IDD);
    for (int t = wave; t < ntile; t += NWAVES) {
        const IdxKey k = kn;
        if (t + NWAVES < ntile) idx_load_keyb(kn, KIH + kbase + (size_t)(t + NWAVES) * 32 * IDD, KIL + kbase + (size_t)(t + NWAVES) * 32 * IDD);
        float sa[2], sb[2]; idx_tile(qa, k, sa); idx_tile(qb, k, sb);
        const int col = t * 32 + r;
        sc[(2 * kh) * SCP_LD + col] = sa[0]; sc[(2 * kh + 1) * SCP_LD + col] = sa[1];
        sc[(4 + 2 * kh) * SCP_LD + col] = sb[0]; sc[(5 + 2 * kh) * SCP_LD + col] = sb[1];
    }
    __syncthreads();
    if (mode == 1) select_row<64>(sc + wave * SCP_LD, q0 + wave + 1, lane, BM + (size_t)(grow0 + wave) * 64);
    if (mode == 2) select_row<64>(sc + wave * SCP_LD, q0 + wave + 1, lane, (unsigned long long*)(ws + WS_SEL) + (size_t)(grow0 + wave) * 64);
    if (mode == 3) select_row<64, 24>(sc + wave * SCP_LD, q0 + wave + 1, lane, (unsigned long long*)(ws + WS_SEL) + (size_t)(grow0 + wave) * 64);
}
__device__ __forceinline__ unsigned wq_next(unsigned* ctr, PG8_LAS unsigned char* lds) {
    volatile PG8_LAS unsigned* slot = (volatile PG8_LAS unsigned*)(lds + LDS_MISC + 64);
    __syncthreads();
    if (threadIdx.x == 0) *slot = atomicAdd(ctr, 1u);
    __syncthreads();
    return *slot;
}

constexpr int G_SC = 0, G_SEL = 32800, G_RED = 33824, G_QS = 34304, G_PS = 38400, G_KP = 46592, G_VP = 48640, G_OP = 50688;
__device__ __forceinline__ void sample_row_unit(const Params& p, PG8_LAS unsigned char* lds, int rs) {
    const int tid = fresh_tid(), lane = tid & 63, wave = tid >> 6;
    unsigned char* ws = p.ws;
    const bf16_t* QB = (const bf16_t*)(ws + WS_QB); const float* SCS = (const float*)(ws + WS_SCS);
    const float* cache_k = p.in[2]; const float* cache_v = p.in[3]; const int* page_table = (const int*)p.in[7];
    bf16_t* CATB = (bf16_t*)(ws + WS_CATB); float* PS = (float*)(ws + WS_PS);
    const int row = MP + rs, b = rs / DS, n = NPAST + (rs % DS) + 1;
    PG8_LAS float* sc = (PG8_LAS float*)(lds + G_SC);
    PG8_LAS int* sel = (PG8_LAS int*)(lds + G_SEL);
    PG8_LAS float* qs = (PG8_LAS float*)(lds + G_QS);
    PG8_LAS float* ps = (PG8_LAS float*)(lds + G_PS);
    PG8_LAS unsigned long long* kps = (PG8_LAS unsigned long long*)(lds + G_KP);
    PG8_LAS unsigned long long* vps = (PG8_LAS unsigned long long*)(lds + G_VP);
    PG8_LAS float* op = (PG8_LAS float*)(lds + G_OP);
    { const bf16_t* z = QB + (size_t)row * 1024; qs[tid] = __uint_as_float((unsigned)z[tid] << 16); qs[tid + 512] = __uint_as_float((unsigned)z[tid + 512] << 16); }
    __syncthreads();
    (void)sc; (void)SCS; (void)n; (void)sel;
    if (tid < TOPK) {
        const int idx = ((const int*)(ws + WS_SEL))[(size_t)rs * TOPK + tid];
        const float* kp; const float* vp;
        if (idx < NPAST) { const size_t prow = (size_t)page_table[b * NPAGES + idx / PAGE] * PAGE + (idx % PAGE); kp = cache_k + prow * 512; vp = cache_v + prow * 512; }
        else { const size_t zr = (size_t)(b * DS + idx - NPAST); kp = p.out + O_KS + zr * 512; vp = p.out + O_VS + zr * 512; }
        kps[tid] = (unsigned long long)kp; vps[tid] = (unsigned long long)vp;
    }
    __syncthreads();
    {
        const int j = tid & 255, hg = tid >> 8;
        const float* kp = (const float*)kps[j] + hg * 256;
#pragma unroll
        for (int n2 = 0; n2 < 2; ++n2) {
            float d0 = 0.f, d1 = 0.f;
            const PG8_LAS float* q0 = qs + (4 * hg + 2 * n2) * HD; const PG8_LAS float* q1 = q0 + HD;
#pragma unroll 8
            for (int d = 0; d < HD; d += 4) {
                const f32x4 k4 = *(const f32x4*)(kp + n2 * HD + d);
                d0 += q0[d] * k4[0] + q0[d + 1] * k4[1] + q0[d + 2] * k4[2] + q0[d + 3] * k4[3];
                d1 += q1[d] * k4[0] + q1[d + 1] * k4[1] + q1[d + 2] * k4[2] + q1[d + 3] * k4[3];
            }
            ps[(4 * hg + 2 * n2) * TOPK + j] = d0 * ATTN_SCALE; ps[(4 * hg + 2 * n2 + 1) * TOPK + j] = d1 * ATTN_SCALE;
        }
    }
    __syncthreads();
    {
        float v[4]; float m = -INFINITY;
#pragma unroll
        for (int i = 0; i < 4; ++i) { v[i] = ps[wave * TOPK + lane + 64 * i]; m = fmaxf(m, v[i]); }
#pragma unroll
        for (int o = 32; o >= 1; o >>= 1) m = fmaxf(m, __shfl_xor(m, o));
        float sum = 0.f;
#pragma unroll
        for (int i = 0; i < 4; ++i) { v[i] = expf(v[i] - m); sum += v[i]; }
#pragma unroll
        for (int o = 32; o >= 1; o >>= 1) sum += __shfl_xor(sum, o);
        const float inv = 1.0f / sum;
#pragma unroll
        for (int i = 0; i < 4; ++i) ps[wave * TOPK + lane + 64 * i] = v[i] * inv;
    }
    __syncthreads();
    {
        const int o4 = tid & 255, kq = tid >> 8, hq = o4 >> 5, d = (o4 & 31) * 4, nkv = hq >> 1;
        f32x4 acc = (f32x4){0.f, 0.f, 0.f, 0.f};
#pragma unroll 8
        for (int j = kq * 128; j < kq * 128 + 128; ++j) acc += *(const f32x4*)((const float*)vps[j] + nkv * HD + d) * ps[hq * TOPK + j];
        if (kq == 1) *(PG8_LAS f32x4*)(op + o4 * 4) = acc;
        __syncthreads();
        if (kq == 0) {
            acc += *(const PG8_LAS f32x4*)(op + o4 * 4);
            u32x2 w; w.x = cvt_pk_bf16(acc[0], acc[1]); w.y = cvt_pk_bf16(acc[2], acc[3]);
            *(u32x2*)(CATB + (size_t)row * D + 1024 + o4 * 4) = w;
        }
    }
    __syncthreads();
}

typedef short s16x4 __attribute__((ext_vector_type(4)));
constexpr int A_KP = 272, A_VP = 320, A_KBYTES = 64 * A_KP, A_VBYTES = 64 * A_VP, A_STAGE = A_KBYTES + A_VBYTES;
constexpr float A_SC = 0.08838834764831845f * 1.4426950408889634f;
__device__ __forceinline__ float xhalf_max(float x) { const auto sw = __builtin_amdgcn_permlane32_swap(__float_as_uint(x), __float_as_uint(x), false, false); return fmaxf(__uint_as_float(sw[0]), __uint_as_float(sw[1])); }
__device__ __forceinline__ float xhalf_sum(float x) { const auto sw = __builtin_amdgcn_permlane32_swap(__float_as_uint(x), __float_as_uint(x), false, false); return __uint_as_float(sw[0]) + __uint_as_float(sw[1]); }
__device__ __forceinline__ void attn_dense_unit(const Params& p, PG8_LAS unsigned char* lds, int b, int n, int qb) {
    const int tid = fresh_tid(), lane = tid & 63, wave = __builtin_amdgcn_readfirstlane(tid >> 6), r = lane & 31, kh = lane >> 5;
    unsigned char* ws = p.ws;
    const bf16_t* QB = (const bf16_t*)(ws + WS_QB); const bf16_t* KB = (const bf16_t*)(ws + WS_KB); const bf16_t* VB = (const bf16_t*)(ws + WS_VB);
    const unsigned long long* BM = (const unsigned long long*)(ws + WS_BM);
    bf16_t* CATB = (bf16_t*)(ws + WS_CATB); float* PS = (float*)(ws + WS_PS);
    const int q = qb * 128 + wave * 16 + (r & 15), head = 2 * n + (r >> 4);
    const size_t qrow = (size_t)b * SEQ + q;
    bf16x8 qf[8];
#pragma unroll
    for (int ks = 0; ks < 8; ++ks) qf[ks] = *(const bf16x8*)(QB + qrow * 1024 + head * HD + ks * 16 + kh * 8);
    f32x16 O[4];
#pragma unroll
    for (int dt = 0; dt < 4; ++dt)
#pragma unroll
        for (int i = 0; i < 16; ++i) O[dt][i] = 0.f;
    float m = -INFINITY, l = 0.f;
    const int ntile = 2 * qb + 2, qmax_w = qb * 128 + wave * 16 + 15;
    const int srow = tid >> 4, sch = tid & 15;
    const bf16_t* kg = KB + ((size_t)b * SEQ + srow) * 512 + n * HD + sch * 8;
    const bf16_t* vg = VB + ((size_t)b * SEQ + srow) * 512 + n * HD + sch * 8;
    u32x4 kst[2], vst[2];
#define A_GLOAD(t) do { _Pragma("unroll") for (int _i = 0; _i < 2; ++_i) { kst[_i] = *(const u32x4*)(kg + (size_t)((t) * 64 + _i * 32) * 512); vst[_i] = *(const u32x4*)(vg + (size_t)((t) * 64 + _i * 32) * 512); } } while (0)
#define A_LSTORE(buf) do { _Pragma("unroll") for (int _i = 0; _i < 2; ++_i) { *(PG8_LAS u32x4*)(lds + (buf) * A_STAGE + (srow + _i * 32) * A_KP + sch * 16) = kst[_i]; \
        *(PG8_LAS u32x4*)(lds + (buf) * A_STAGE + A_KBYTES + (srow + _i * 32) * A_VP + sch * 16) = vst[_i]; } } while (0)
    A_GLOAD(0); A_LSTORE(0);
    unsigned long long mw = BM[qrow * 64];
    __syncthreads();
    const int i16 = lane & 15, g2 = (lane >> 4) & 1;
    const int vlane_off = (4 * kh + (i16 >> 2)) * A_VP + (16 * g2 + 4 * (i16 & 3)) * 2;
    for (int t = 0; t < ntile; ++t) {
        const bool more = (t + 1 < ntile);
        if (more) A_GLOAD(t + 1);
        const unsigned long long mw_next = more ? BM[qrow * 64 + t + 1] : 0ull;
        const int buf = t & 1;
        if (t * 64 <= qmax_w) {
            PG8_LAS unsigned char* kb = lds + buf * A_STAGE; PG8_LAS unsigned char* vb = kb + A_KBYTES;
            f32x16 s0, s1;
#pragma unroll
            for (int i = 0; i < 16; ++i) { s0[i] = 0.f; s1[i] = 0.f; }
#pragma unroll
            for (int ks = 0; ks < 8; ++ks) {
                const bf16x8 k0 = *(const PG8_LAS bf16x8*)(kb + r * A_KP + (ks * 16 + kh * 8) * 2);
                const bf16x8 k1 = *(const PG8_LAS bf16x8*)(kb + (32 + r) * A_KP + (ks * 16 + kh * 8) * 2);
                s0 = __builtin_amdgcn_mfma_f32_32x32x16_bf16(k0, qf[ks], s0, 0, 0, 0);
                s1 = __builtin_amdgcn_mfma_f32_32x32x16_bf16(k1, qf[ks], s1, 0, 0, 0);
            }
            const unsigned lo = (unsigned)mw >> (4 * kh), hi = (unsigned)(mw >> 32) >> (4 * kh);
            float mx = -INFINITY;
#pragma unroll
            for (int i = 0; i < 16; ++i) {
                const unsigned bit = 1u << ((i & 3) + 8 * (i >> 2));
                s0[i] = (lo & bit) ? s0[i] * A_SC : -INFINITY; s1[i] = (hi & bit) ? s1[i] * A_SC : -INFINITY;
                mx = fmaxf(mx, fmaxf(s0[i], s1[i]));
            }
            mx = xhalf_max(mx);
            const float m_new = fmaxf(m, mx), m_safe = (m_new == -INFINITY) ? 0.f : m_new;
            const float alpha = __builtin_amdgcn_exp2f(m - m_safe);
            float lsum = 0.f;
#pragma unroll
            for (int i = 0; i < 16; ++i) { s0[i] = __builtin_amdgcn_exp2f(s0[i] - m_safe); s1[i] = __builtin_amdgcn_exp2f(s1[i] - m_safe); lsum += s0[i] + s1[i]; }
            l = l * alpha + lsum; m = m_new;
            if (__ballot(alpha != 1.0f) != 0ull) {
#pragma unroll
                for (int dt = 0; dt < 4; ++dt)
#pragma unroll
                    for (int i = 0; i < 16; ++i) O[dt][i] *= alpha;
            }
            bf16x8 pf[2][2];
#pragma unroll
            for (int sx = 0; sx < 2; ++sx) {
                u32x4 w0, w1;
                w0.x = cvt_pk_bf16(s0[8 * sx], s0[8 * sx + 1]); w0.y = cvt_pk_bf16(s0[8 * sx + 2], s0[8 * sx + 3]); w0.z = cvt_pk_bf16(s0[8 * sx + 4], s0[8 * sx + 5]); w0.w = cvt_pk_bf16(s0[8 * sx + 6], s0[8 * sx + 7]);
                w1.x = cvt_pk_bf16(s1[8 * sx], s1[8 * sx + 1]); w1.y = cvt_pk_bf16(s1[8 * sx + 2], s1[8 * sx + 3]); w1.z = cvt_pk_bf16(s1[8 * sx + 4], s1[8 * sx + 5]); w1.w = cvt_pk_bf16(s1[8 * sx + 6], s1[8 * sx + 7]);
                pf[0][sx] = __builtin_bit_cast(bf16x8, w0); pf[1][sx] = __builtin_bit_cast(bf16x8, w1);
            }
#pragma unroll
            for (int st = 0; st < 2; ++st)
#pragma unroll
                for (int sx = 0; sx < 2; ++sx)
#pragma unroll
                    for (int dt = 0; dt < 4; ++dt) {
                        PG8_LAS unsigned char* a = vb + vlane_off + (st * 32 + 16 * sx) * A_VP + dt * 64;
                        const s16x4 vlo = __builtin_amdgcn_ds_read_tr16_b64_v4i16((PG8_LAS s16x4*)a);
                        const s16x4 vhi = __builtin_amdgcn_ds_read_tr16_b64_v4i16((PG8_LAS s16x4*)(a + 8 * A_VP));
                        const bf16x8 vf = __builtin_shufflevector(vlo, vhi, 0, 1, 2, 3, 4, 5, 6, 7);
                        O[dt] = __builtin_amdgcn_mfma_f32_32x32x16_bf16(vf, pf[st][sx], O[dt], 0, 0, 0);
                    }
        }
        if (more) A_LSTORE(buf ^ 1);
        __syncthreads();
        mw = mw_next;
    }
#undef A_GLOAD
#undef A_LSTORE
    const float inv = 1.0f / xhalf_sum(l);
    bf16_t* orow = CATB + qrow * D + 1024 + head * HD;
#pragma unroll
    for (int dt = 0; dt < 4; ++dt)
#pragma unroll
        for (int a = 0; a < 4; ++a) {
            u32x2 w; w.x = cvt_pk_bf16(O[dt][4 * a] * inv, O[dt][4 * a + 1] * inv); w.y = cvt_pk_bf16(O[dt][4 * a + 2] * inv, O[dt][4 * a + 3] * inv);
            *(u32x2*)(orow + 32 * dt + 8 * a + 4 * kh) = w;
        }
}
__device__ __forceinline__ void attn_phase(const Params& p, PG8_LAS unsigned char* lds, int ctr_off = 0) {
    const int G = gridDim.x;
    for (int u = blockIdx.x; u < 256; u += G) { const int qb = 31 - (u >> 3), bn = u & 7; attn_dense_unit(p, lds, bn >> 2, bn & 3, qb); }
    unsigned* ctr = (unsigned*)(p.ws + WS_CTR) + ctr_off;
    for (;;) {
        const unsigned idx = wq_next(ctr, lds);
        if (idx >= (unsigned)(MS + LRU_NCHUNK)) break;
        if (idx < (unsigned)MS) sample_row_unit(p, lds, (int)idx); else lru_fixup_unit(p, (int)idx - MS);
    }
}
__device__ __forceinline__ void mid1_phase(const Params& p, PG8_LAS unsigned char* lds) {
    unsigned* ctr = (unsigned*)(p.ws + WS_CTR) + 64;
    constexpr unsigned NA = DB, NB_ = MP / 8, NC_ = LRU_NCHUNK * 8;
    for (;;) {
        const unsigned idx = wq_next(ctr, lds);
        constexpr unsigned XA_ = (MID_DUP == 1) ? NA : 0u, XB_ = (MID_DUP >= 6) ? NB_ : 0u, XC_ = (MID_DUP == 3) ? NC_ : 0u;
        if (idx >= NA + XA_ + NB_ + XB_ + NC_ + XC_) break;
        if (idx < NA + XA_) { const unsigned u = idx % NA; idx_sample_batch_unit(p, lds, (int)u); }
        else if (idx < NA + XA_ + NB_) idx_prompt_unit(p, lds, (int)(NB_ - 1 - (idx - NA - XA_)));
        else if (idx < NA + XA_ + NB_ + XB_) idx_prompt_unit(p, lds, (int)(NB_ - 1 - (idx - NA - XA_ - NB_)), MID_DUP == 6 ? 2 : (MID_DUP == 7 ? 3 : 0));
        else lru_local_unit(p, lds, (int)((idx - NA - XA_ - NB_ - XB_) % NC_));
    }
}

__device__ __forceinline__ void prep_phase(const Params& p, PG8_LAS unsigned char* lds) {
    unsigned char* ws = p.ws;
    bf16_t* Wgu1 = (bf16_t*)(ws + WS_WGU1); bf16_t* Wd1 = (bf16_t*)(ws + WS_WD1); bf16_t* Win = (bf16_t*)(ws + WS_WIN); bf16_t* Wout = (bf16_t*)(ws + WS_WOUT);
    bf16_t* Wgu2 = (bf16_t*)(ws + WS_WGU2); bf16_t* Wd2 = (bf16_t*)(ws + WS_WD2); bf16_t* XB = (bf16_t*)(ws + WS_XB);
    PG8_LAS float* tile = (PG8_LAS float*)lds;
    const int wid = blockIdx.x, nw = gridDim.x;
    transpose_cvt<1>(p.in[10], D, 2 * DFF, 2 * DFF, Wgu1, tile, wid, nw);
    cvt_x(p.in[0], p.in[1], XB);
    for (int n = 0; n < 8; ++n) { transpose_cvt<0>(p.in[15] + n * 16384, 128, 128, 128, (bf16_t*)(ws + WS_WAT) + n * 16384, tile, wid, nw); transpose_cvt<0>(p.in[17] + n * 16384, 128, 128, 128, (bf16_t*)(ws + WS_WIT) + n * 16384, tile, wid, nw); }
    (void)Wd1; (void)Win; (void)Wout; (void)Wgu2; (void)Wd2;
}
__device__ __forceinline__ void tail_cvt(const Params& p, PG8_LAS unsigned char* lds, int which, int nunits) {
    const int G = gridDim.x, c = blockIdx.x, full = nunits / G, rem = nunits - full * G;
    if (rem != 0 && c < rem) return;
    const int wid = (rem == 0) ? c : c - rem, nw = (rem == 0) ? G : G - rem;
    unsigned char* ws = p.ws; PG8_LAS float* tile = (PG8_LAS float*)lds;
    __syncthreads();
    if (which == 0) {
        transpose_cvt<0>(p.in[11], DFF, D, D, (bf16_t*)(ws + WS_WD1), tile, wid, nw);
        transpose_cvt<0>(p.in[12], D, DIN, DINP, (bf16_t*)(ws + WS_WIN), tile, wid, nw);
        transpose_cvt<0>(p.in[20], D, D, D, (bf16_t*)(ws + WS_WOUT), tile, wid, nw);
    } else if (which == 1) transpose_cvt<1>(p.in[23], D, 2 * DFF, 2 * DFF, (bf16_t*)(ws + WS_WGU2), tile, wid, nw);
    else transpose_cvt<0>(p.in[24], DFF, D, D, (bf16_t*)(ws + WS_WD2), tile, wid, nw);
}

__global__ void __launch_bounds__(NTHREADS, 2) mk_fwd(Params p) {
    extern __shared__ __attribute__((aligned(16))) unsigned char lds_raw[];
    PG8_LAS unsigned char* lds = (PG8_LAS unsigned char*)lds_raw;
    unsigned char* ws = p.ws;
    const int lo = p.ph_lo, hi = p.ph_hi;
    const int G = gridDim.x;
    if (threadIdx.x < 4) ((volatile PG8_LAS unsigned*)(lds + LDS_MISC))[threadIdx.x] = 0u;
    __syncthreads();
    XcdBarrier bar = xcd_barrier_post((unsigned*)(ws + WS_CTL) + (size_t)p.li * XCD_BAR_WORDS, (volatile LAS unsigned*)(lds + LDS_MISC));
#define SEAM(k) do { if (lo <= (k) && (k) + 1 < hi) xcd_barrier(bar); } while (0)
    bf16_t* Wgu1 = (bf16_t*)(ws + WS_WGU1); bf16_t* Wd1 = (bf16_t*)(ws + WS_WD1); bf16_t* Win = (bf16_t*)(ws + WS_WIN); bf16_t* Wout = (bf16_t*)(ws + WS_WOUT);
    bf16_t* Wgu2 = (bf16_t*)(ws + WS_WGU2); bf16_t* Wd2 = (bf16_t*)(ws + WS_WD2);
    bf16_t* XB = (bf16_t*)(ws + WS_XB); bf16_t* H = (bf16_t*)(ws + WS_H); float* T = (float*)(ws + WS_T); float* X1 = (float*)(ws + WS_X1); float* X2 = (float*)(ws + WS_X2);
    bf16_t* CATB = (bf16_t*)(ws + WS_CATB); float* PS = (float*)(ws + WS_PS); float* ST1 = (float*)(ws + WS_ST); float* ST2 = ST1 + 2 * MP;
#define IN(k) (lo <= (k) && (k) < hi)
    if (IN(0)) prep_phase(p, lds);
    SEAM(0);
    if (IN(1)) {
        pg8::Gemm g{XB, Wgu1, MPAD, 2 * DFF, D}; pg8::StaticOrder S; S.init(MPAD, 2 * DFF, G, (int)blockIdx.x, D);
        EpiSwiGLU E{H};
        pg8::gemm_phase<EpiSwiGLU, pg8::StaticOrder, true, true>(lds, g, S, E);
        tail_cvt(p, lds, 0, (MPAD / 256) * (2 * DFF / 256));
    }
    SEAM(1);
    if (IN(2)) {
        pg8::Gemm g{H, Wd1, MPAD, D, DFF}; SplitOrder S; S.init(D, DFF, G, (int)blockIdx.x);
        EpiResidSplit E{p.in[0], T, PS, 0.5f, nullptr, nullptr, nullptr};
        pg8::gemm_phase<EpiResidSplit, SplitOrder, true, true>(lds, g, S, E);
    }
    SEAM(2);
    if (IN(3)) ln_phase(T, p.in[8], p.in[9], X1, XB, PS, DFF / 256, p.in[1], 0.5f, ST1);
    SEAM(3);
    if (IN(4)) {
        pg8::Gemm g{XB, Win, MPAD, DINP, D}; pg8::StaticOrder S; S.init(MPAD, DINP, G, (int)blockIdx.x, D);
        EpiWin E{(float*)(ws + WS_XR), (float*)(ws + WS_GG), (bf16_t*)(ws + WS_QB), (bf16_t*)(ws + WS_KB), (bf16_t*)(ws + WS_VB), (float*)(ws + WS_QI), (bf16_t*)(ws + WS_KIH), (bf16_t*)(ws + WS_KIL), (float*)(ws + WS_WI), p.out};
        pg8::gemm_phase<EpiWin, pg8::StaticOrder, true, true>(lds, g, S, E);
        tail_cvt(p, lds, 1, (MPAD / 256) * (DINP / 256));
    }
    SEAM(4);
    if (IN(5)) mid1_phase(p, lds);
    SEAM(5);
    if (IN(6)) { attn_phase(p, lds); if (REP_6 > 1) { __syncthreads(); attn_phase(p, lds, 128); } }
    SEAM(6);
    if (IN(7)) {
        pg8::Gemm g{CATB, Wout, MPAD, D, D}; SplitOrder S; S.init(D, D, G, (int)blockIdx.x);
        EpiResidSplit E{nullptr, T, PS, 1.0f, ST1, p.in[8], p.in[9]};
        pg8::gemm_phase<EpiResidSplit, SplitOrder, true, true>(lds, g, S, E);
    }
    SEAM(7);
    if (IN(8)) ln_phase(T, p.in[21], p.in[22], X2, XB, PS, D / 256, X1 + (size_t)MP * D, 1.0f, ST2);
    SEAM(8);
    if (IN(9)) {
        pg8::Gemm g{XB, Wgu2, MPAD, 2 * DFF, D}; pg8::StaticOrder S; S.init(MPAD, 2 * DFF, G, (int)blockIdx.x, D);
        EpiSwiGLU E{H};
        pg8::gemm_phase<EpiSwiGLU, pg8::StaticOrder, true, true>(lds, g, S, E);
        tail_cvt(p, lds, 2, (MPAD / 256) * (2 * DFF / 256));
    }
    SEAM(9);
    if (IN(10)) {
        pg8::Gemm g{H, Wd2, MPAD, D, DFF}; SplitOrder S; S.init(D, DFF, G, (int)blockIdx.x);
        EpiResidSplit E{nullptr, T, PS, 0.5f, ST2, p.in[21], p.in[22]};
        pg8::gemm_phase<EpiResidSplit, SplitOrder, true, true>(lds, g, S, E);
    }
    SEAM(10);
    if (IN(11)) ln_phase(T, p.in[25], p.in[26], p.out + O_YP, nullptr, PS, DFF / 256, X2 + (size_t)MP * D, 0.5f, nullptr);
#undef IN
#undef SEAM
}

}

extern "C" void kernel_launch(void* const* d_in, const int* in_sizes, int n_in, void* d_out, int out_size, void* d_ws, size_t ws_size, hipStream_t stream) {
    static int grid = 0;
    if (grid == 0) {
        if (n_in != 27 || ws_size < WS_END3) { grid = -1; return; }
        int dev = 0, cus = 0;
        if (hipGetDevice(&dev) != hipSuccess || hipDeviceGetAttribute(&cus, hipDeviceAttributeMultiprocessorCount, dev) != hipSuccess) { grid = -1; return; }
        if (hipFuncSetAttribute((const void*)mk_fwd, hipFuncAttributeMaxDynamicSharedMemorySize, LDS_BYTES) != hipSuccess) { grid = -1; return; }
        (void)hipGetLastError();
        grid = cus;
    }
    if (grid < 0) return;
    float* out = (float*)d_out;
    unsigned char* ws = (unsigned char*)d_ws;

    (void)hipMemsetAsync(ws + WS_CTL, 0, CTL_BYTES, stream);
    Params p{};
    for (int i = 0; i < 27; ++i) p.in[i] = (const float*)d_in[i];
    p.out = out; p.ws = ws;
    int nli = 0;
    auto run = [&](int lo, int hi) { p.ph_lo = lo; p.ph_hi = hi; p.li = nli++; hipLaunchKernelGGL(mk_fwd, dim3(grid), dim3(NTHREADS), LDS_BYTES, stream, p); };
    run(0, 12);
}
```

```cpp
#include <hip/hip_runtime.h>
#include <stdint.h>

namespace pg8 {
#define PG8_LAS __attribute__((address_space(3)))
typedef unsigned short bf16_t;
typedef short bf16x8 __attribute__((ext_vector_type(8)));
typedef float f32x4 __attribute__((ext_vector_type(4)));
typedef unsigned u32x4 __attribute__((ext_vector_type(4)));
constexpr int BM = 256, BK = 64, HALF = 128, HTB = HALF * BK * 2  , STAGE_BYTES = 8 * HTB, NXCD = 8, WGM = 8;

__host__ __device__ __forceinline__ int lds_byte(int r, int c) { const int st = (r >> 4) * 2 + (c >> 5), rr = r & 15, cc = c & 31, ob = rr * 64 + cc * 2; return st * 1024 + (ob ^ (((ob >> 9) & 1) << 5)); }
__host__ __device__ __forceinline__ void stage_rc(int b, int& R, int& C) { const int st = b / 1024, sb = b % 1024, swz = sb ^ (((sb >> 9) & 1) << 5); R = (st >> 1) * 16 + swz / 64; C = (st & 1) * 32 + (swz % 64) / 2; }
__host__ __device__ __forceinline__ int perm32(int rho) { const int n = rho >> 4, i = rho & 15; return 8 * (i >> 2) + 4 * n + (i & 3); }

struct Unit { int pm, pn, k0, nt, aux; };
struct Gemm { const bf16_t* A; const bf16_t* Bt; int M, N, K; };

struct StaticOrder {
    int nM, nN, nwg, G, c, ntk;
    __host__ __device__ __forceinline__ void init(int M, int N, int G_, int c_, int K_ = 0) { nM = M / BM; nN = N / BM; nwg = nM * nN; G = G_; c = c_; ntk = K_ / BK; }
    __host__ __device__ __forceinline__ bool next(int i, Unit& u) const {
        const long L = (long)i * G + c; if (L >= nwg) return false;
        int wgid = (int)L; { const int q = nwg / NXCD, r = nwg % NXCD, xcd = wgid % NXCD, off = wgid / NXCD; wgid = (xcd < r ? xcd * (q + 1) : r * (q + 1) + (xcd - r) * q) + off; }
        const int nig = WGM * nN, gid = wgid / nig, fm = gid * WGM, gsz = (nM - fm) < WGM ? (nM - fm) : WGM;
        u.pm = fm + ((wgid % nig) % gsz); u.pn = (wgid % nig) / gsz; u.k0 = 0; u.nt = ntk; u.aux = -1; return true;
    }
    __device__ __forceinline__ void a_ready(const Unit&) const {}
    __device__ __forceinline__ void done(const Unit&) const {}
};

__device__ __forceinline__ unsigned cvt_pk_bf16(float lo, float hi) { unsigned r; asm volatile("v_cvt_pk_bf16_f32 %0, %1, %2" : "=v"(r) : "v"(lo), "v"(hi)); return r; }
typedef float f32x2 __attribute__((ext_vector_type(2)));

template <class Epi, class Sched, bool ALIGN_EPI = false, bool SP2 = false>
__device__ __forceinline__ void gemm_phase(PG8_LAS unsigned char* lds, const Gemm g, const Sched& S, const Epi& E) {
    int tid_v = threadIdx.x; asm volatile("" : "+v"(tid_v));
    const int tid = tid_v, wid = __builtin_amdgcn_readfirstlane(tid >> 6), lane = tid & 63, wr = wid >> 2, wc = wid & 3, fr = lane & 15, fq = lane >> 4;
    const int K = g.K;
    unsigned voffA[2], voffB[2];
#pragma unroll
    for (int i = 0; i < 2; ++i) { int R, C; stage_rc(tid * 16 + i * 8192, R, C); const int Rb = Epi::PERM ? ((R & ~31) + perm32(R & 31)) : R;
        voffA[i] = (unsigned)(R * K + C) * 2u; voffB[i] = (unsigned)(Rb * K + C) * 2u; }
    const size_t kstep = (size_t)(BK * 2);
    const size_t hstep = (size_t)HALF * K * 2;
    const size_t tstep = 2 * hstep;
    const unsigned ldsw = (unsigned)wid * 1024u;
    const int aoff = lds_byte(wr * 64 + fr, fq * 8), boff = lds_byte(wc * 32 + fr, fq * 8);
#define PG8_SA(b, h) (((b) * 2 + (h)) * HTB)
#define PG8_SB(b, h) ((4 + (b) * 2 + (h)) * HTB)
#define PG8_STAGE(bufoff, gbase, voff) do { _Pragma("unroll") for (int _i = 0; _i < 2; ++_i) \
        __builtin_amdgcn_global_load_lds((const unsigned*)((const char*)(gbase) + (voff)[_i]), (PG8_LAS unsigned*)(lds + (bufoff) + ldsw + _i * 8192), 16, 0, 0); } while (0)
#define PG8_LDA(dst, b, h) do { _Pragma("unroll") for (int m = 0; m < 4; ++m) _Pragma("unroll") for (int k = 0; k < 2; ++k) dst[m][k] = *(const PG8_LAS bf16x8*)(lds + PG8_SA(b, h) + aoff + m * 2048 + k * 1024); } while (0)
#define PG8_LDB(dst, b, h) do { _Pragma("unroll") for (int n = 0; n < 2; ++n) _Pragma("unroll") for (int k = 0; k < 2; ++k) dst[n][k] = *(const PG8_LAS bf16x8*)(lds + PG8_SB(b, h) + boff + n * 2048 + k * 1024); } while (0)
#define PG8_MMA(ai, bj, At, Bt) do { __builtin_amdgcn_s_setprio(1); _Pragma("unroll") for (int m = 0; m < 4; ++m) _Pragma("unroll") for (int n = 0; n < 2; ++n) _Pragma("unroll") for (int k = 0; k < 2; ++k) \
        acc[ai][bj][m][n] = __builtin_amdgcn_mfma_f32_16x16x32_bf16(Bt[n][k], At[m][k], acc[ai][bj][m][n], 0, 0, 0); __builtin_amdgcn_s_setprio(0); } while (0)
#define PG8_WAIT_V(n) asm volatile("s_waitcnt vmcnt(" #n ")" ::: "memory")
#define PG8_WAIT_L(n) asm volatile("s_waitcnt lgkmcnt(" #n ")" ::: "memory")
#define PG8_BAR __builtin_amdgcn_s_barrier()
#define PG8_SCHED __builtin_amdgcn_sched_barrier(0)
    Unit cur, nxt; int ui = 0;
    if (!S.next(0, cur)) return;
    f32x4 acc[2][2][4][2];
#pragma unroll
    for (int a = 0; a < 2; ++a)
#pragma unroll
        for (int b = 0; b < 2; ++b)
#pragma unroll
            for (int m = 0; m < 4; ++m)
#pragma unroll
                for (int n = 0; n < 2; ++n) acc[a][b][m][n] = (f32x4){0.f, 0.f, 0.f, 0.f};
    bf16x8 At[4][2], B0[2][2], B1[2][2];
    const char* cA = (const char*)g.A + (size_t)cur.pm * tstep + (size_t)cur.k0 * 2; const char* cB = (const char*)g.Bt + (size_t)cur.pn * tstep + (size_t)cur.k0 * 2;
    S.a_ready(cur);
    if constexpr (SP2) {
        PG8_STAGE(PG8_SB(0, 0), cB, voffB); PG8_STAGE(PG8_SB(0, 1), cB + hstep, voffB); PG8_STAGE(PG8_SA(0, 0), cA, voffA); PG8_STAGE(PG8_SA(0, 1), cA + hstep, voffA);
        if (wr == 1) PG8_BAR;
        PG8_WAIT_V(2); PG8_BAR;
        PG8_STAGE(PG8_SB(1, 0), cB + kstep, voffB); PG8_STAGE(PG8_SA(1, 0), cA + kstep, voffA); PG8_STAGE(PG8_SB(1, 1), cB + hstep + kstep, voffB);
        PG8_WAIT_V(6); PG8_BAR;
    } else {
        PG8_STAGE(PG8_SB(0, 0), cB, voffB); PG8_STAGE(PG8_SA(0, 0), cA, voffA); PG8_STAGE(PG8_SB(0, 1), cB + hstep, voffB); PG8_STAGE(PG8_SA(0, 1), cA + hstep, voffA);
        if (wr == 1) PG8_BAR;
        PG8_WAIT_V(4); PG8_BAR;
        PG8_STAGE(PG8_SB(1, 0), cB + kstep, voffB); PG8_STAGE(PG8_SA(1, 0), cA + kstep, voffA); PG8_STAGE(PG8_SB(1, 1), cB + hstep + kstep, voffB);
        PG8_WAIT_V(6); PG8_BAR;
    }
    for (;;) {
        const bool has_next = S.next(ui + 1, nxt);
        const char* nA = has_next ? (const char*)g.A + (size_t)nxt.pm * tstep + (size_t)nxt.k0 * 2 : cA; const char* nB = has_next ? (const char*)g.Bt + (size_t)nxt.pn * tstep + (size_t)nxt.k0 * 2 : cB;
        const int nt = cur.nt;
        for (int t = 0; t < nt; t += 2) {
            const bool last = (t == nt - 2);
            const char* a1 = cA + (size_t)(t + 1) * kstep;
            const char* a2 = last ? nA : cA + (size_t)(t + 2) * kstep; const char* b2 = last ? nB : cB + (size_t)(t + 2) * kstep;
            const char* a3 = a2 + kstep; const char* b3 = b2 + kstep;
            if (last && has_next) S.a_ready(nxt);
            if constexpr (SP2) {
            PG8_LDB(B0, 0, 0); PG8_LDB(B1, 0, 1); PG8_SCHED; PG8_LDA(At, 0, 0); PG8_STAGE(PG8_SA(1, 1), a1 + hstep, voffA);
            PG8_WAIT_V(8); PG8_WAIT_L(0); PG8_BAR; PG8_MMA(0, 0, At, B0); PG8_MMA(0, 1, At, B1); PG8_BAR; PG8_SCHED;
            PG8_LDA(At, 0, 1); PG8_STAGE(PG8_SB(0, 0), b2, voffB); PG8_STAGE(PG8_SB(0, 1), b2 + hstep, voffB); PG8_STAGE(PG8_SA(0, 0), a2, voffA);
            PG8_WAIT_V(8); PG8_WAIT_L(0); PG8_BAR; PG8_MMA(1, 0, At, B0); PG8_MMA(1, 1, At, B1); PG8_BAR; PG8_SCHED;
            PG8_LDB(B0, 1, 0); PG8_LDB(B1, 1, 1); PG8_SCHED; PG8_LDA(At, 1, 0); PG8_STAGE(PG8_SA(0, 1), a2 + hstep, voffA);
            PG8_WAIT_V(8); PG8_WAIT_L(0); PG8_BAR; PG8_MMA(0, 0, At, B0); PG8_MMA(0, 1, At, B1); PG8_BAR; PG8_SCHED;
            PG8_LDA(At, 1, 1); PG8_STAGE(PG8_SB(1, 0), b3, voffB); PG8_STAGE(PG8_SB(1, 1), b3 + hstep, voffB); PG8_STAGE(PG8_SA(1, 0), a3, voffA);
            PG8_WAIT_V(8); PG8_WAIT_L(0); PG8_BAR; PG8_MMA(1, 0, At, B0); PG8_MMA(1, 1, At, B1); PG8_BAR; PG8_SCHED;
            } else {
            PG8_LDB(B0, 0, 0); PG8_SCHED; PG8_LDA(At, 0, 0); PG8_STAGE(PG8_SA(1, 1), a1 + hstep, voffA);
            PG8_WAIT_L(8); PG8_BAR; PG8_WAIT_L(0); PG8_MMA(0, 0, At, B0); PG8_BAR; PG8_SCHED;
            PG8_LDB(B1, 0, 1); PG8_STAGE(PG8_SB(0, 0), b2, voffB);
            PG8_BAR; PG8_WAIT_L(0); PG8_MMA(0, 1, At, B1); PG8_BAR;
            PG8_LDA(At, 0, 1); PG8_STAGE(PG8_SA(0, 0), a2, voffA);
            PG8_BAR; PG8_WAIT_L(0); PG8_MMA(1, 0, At, B0); PG8_BAR; PG8_SCHED;
            PG8_STAGE(PG8_SB(0, 1), b2 + hstep, voffB);
            PG8_WAIT_V(6); PG8_BAR; PG8_MMA(1, 1, At, B1); PG8_BAR;
            PG8_LDB(B0, 1, 0); PG8_SCHED; PG8_LDA(At, 1, 0); PG8_STAGE(PG8_SA(0, 1), a2 + hstep, voffA);
            PG8_WAIT_L(8); PG8_BAR; PG8_WAIT_L(0); PG8_MMA(0, 0, At, B0); PG8_BAR; PG8_SCHED;
            PG8_LDB(B1, 1, 1); PG8_STAGE(PG8_SB(1, 0), b3, voffB);
            PG8_BAR; PG8_WAIT_L(0); PG8_MMA(0, 1, At, B1); PG8_BAR;
            PG8_LDA(At, 1, 1); PG8_STAGE(PG8_SA(1, 0), a3, voffA);
            PG8_BAR; PG8_WAIT_L(0); PG8_MMA(1, 0, At, B0); PG8_BAR; PG8_SCHED;
            PG8_STAGE(PG8_SB(1, 1), b3 + hstep, voffB);
            PG8_WAIT_V(6); PG8_BAR; PG8_MMA(1, 1, At, B1); PG8_BAR;
            }
        }
        if constexpr (ALIGN_EPI) { if (wr == 0) PG8_BAR; }
        if constexpr (!Epi::AFTER_DRAIN) { E(acc, cur, wr, wc, fr, fq); S.done(cur); }
        if (!has_next) break;
#pragma unroll
        for (int a = 0; a < 2; ++a)
#pragma unroll
            for (int b = 0; b < 2; ++b)
#pragma unroll
                for (int m = 0; m < 4; ++m)
#pragma unroll
                    for (int n = 0; n < 2; ++n) acc[a][b][m][n] = (f32x4){0.f, 0.f, 0.f, 0.f};
        cur = nxt; cA = nA; cB = nB; ++ui;
        if constexpr (ALIGN_EPI) { if (wr == 1) PG8_BAR; }
    }
    PG8_WAIT_V(0);
    if constexpr (!ALIGN_EPI) { if (wr == 0) PG8_BAR; }
    PG8_BAR;
    if constexpr (Epi::AFTER_DRAIN) { E.fused(acc, cur, wr, wc, fr, fq, lds, wid, lane); S.done(cur); }
#undef PG8_SA
#undef PG8_SB
#undef PG8_STAGE
#undef PG8_LDA
#undef PG8_LDB
#undef PG8_MMA
#undef PG8_WAIT_V
#undef PG8_WAIT_L
#undef PG8_BAR
#undef PG8_SCHED
}

}

#define XB_TMO      128
#define XB_XCNT(j)  (256  + 64 * (j))
#define XB_XSUB(j)  (1280 + 64 * (j))
#define XB_XGEN(j)  (2304 + 64 * (j))
#define XB_TOP      3328
#define XB_TOPGEN   3392
#define XCD_BAR_WORDS 3456
#define XB_SPIN_CAP (1u << 18)
#define LAS __attribute__((address_space(3)))

__device__ __forceinline__ unsigned xb_ld(unsigned* p)              { return __hip_atomic_load(p, __ATOMIC_RELAXED, __HIP_MEMORY_SCOPE_AGENT); }
__device__ __forceinline__ unsigned xb_add(unsigned* p, unsigned v) { return __hip_atomic_fetch_add(p, v, __ATOMIC_RELAXED, __HIP_MEMORY_SCOPE_AGENT); }
__device__ __forceinline__ unsigned xb_xcc_id() { return (unsigned)__builtin_amdgcn_s_getreg((3 << 11) | 20) & 0xFu; }
#define XB_SPIN(cond, bar) do { unsigned _sp = 0; while (cond) { __builtin_amdgcn_s_sleep(1); \
    if ((++_sp & 255u) == 0u) { if (xb_ld(&(bar)[XB_TMO])) break; if (_sp > XB_SPIN_CAP) { atomicAdd(&(bar)[XB_TMO], 1u); break; } } } } while (0)

struct XcdBarrier {
    unsigned* bar; unsigned x;
    volatile LAS unsigned* st;
};

__device__ __forceinline__ XcdBarrier xcd_barrier_post(unsigned* bar, volatile LAS unsigned* st) {
    XcdBarrier b; b.bar = bar; b.x = xb_xcc_id(); b.st = st;
    if (threadIdx.x == 0) (void)xb_add(&bar[XB_XCNT(b.x)], 1u);
    return b;
}
__device__ __forceinline__ void xcd_barrier_complete(unsigned* bar, unsigned x, unsigned& nloc, unsigned& nx) {
    const unsigned G = gridDim.x * gridDim.y * gridDim.z;
    unsigned sum, cnt, mine, sp = 0u;
    for (;;) {
        sum = 0u; cnt = 0u; mine = 0u;
#pragma unroll
        for (unsigned j = 0; j < 16; ++j) { const unsigned c = xb_ld(&bar[XB_XCNT(j)]); sum += c; cnt += (c > 0u) ? 1u : 0u; mine = (j == x) ? c : mine; }
        if (sum == G) break;
        __builtin_amdgcn_s_sleep(1);
        if ((++sp & 255u) == 0u) { if (xb_ld(&bar[XB_TMO])) break; if (sp > XB_SPIN_CAP) { atomicAdd(&bar[XB_TMO], 1u); break; } }
    }
    nloc = mine > 0u ? mine : 1u; nx = cnt > 0u ? cnt : 1u;
}

__device__ __forceinline__ void xcd_barrier(const XcdBarrier& b) {
    asm volatile("s_waitcnt vmcnt(0)" ::: "memory");
    __syncthreads();
    if (threadIdx.x == 0) {
        unsigned* bar = b.bar;
        __builtin_amdgcn_s_waitcnt(0);
        unsigned nloc = b.st[0], nx = b.st[1];
        if (nloc == 0u) { xcd_barrier_complete(bar, b.x, nloc, nx); b.st[0] = nloc; b.st[1] = nx; }
        const unsigned old = xb_add(&bar[XB_XSUB(b.x)], 1u);
        const unsigned gen = old / nloc;
        if (old + 1u == (gen + 1u) * nloc) {
            __builtin_amdgcn_fence(__ATOMIC_RELEASE, "agent");
            asm volatile("s_waitcnt vmcnt(0)" ::: "memory");
            const unsigned og = xb_add(&bar[XB_TOP], 1u);
            const unsigned tg = og / nx;
            if (og + 1u == (tg + 1u) * nx) xb_add(&bar[XB_TOPGEN], 1u);
            else XB_SPIN(xb_ld(&bar[XB_TOPGEN]) == tg, bar);
            __builtin_amdgcn_fence(__ATOMIC_ACQUIRE, "agent");
            xb_add(&bar[XB_XGEN(b.x)], 1u);
            asm volatile("s_waitcnt vmcnt(0)" ::: "memory");
        } else {
            XB_SPIN(xb_ld(&bar[XB_XGEN(b.x)]) == gen, bar);
            __builtin_amdgcn_fence(__ATOMIC_ACQUIRE, "agent");
            asm volatile("s_waitcnt vmcnt(0)" ::: "memory");
        }
    }
    __syncthreads();
}


namespace {
typedef unsigned short bf16_t;
typedef float f32x4 __attribute__((ext_vector_type(4)));
typedef unsigned u32x4 __attribute__((ext_vector_type(4)));
typedef unsigned u32x2 __attribute__((ext_vector_type(2)));

constexpr int D = 2048, SEQ = 4096, NB = 2, MP = NB * SEQ, DB = 32, DS = 4, MS = DB * DS, MT = MP + MS, MPAD = 8448;
constexpr int DFF = 5504, DRNN = 1024, HD = 128, NKV = 4, IDH = 8, IDD = 64, DIN = 4680, DINP = 4864;
constexpr int NPAGES = 64, PAGE = 128, NPAST = NPAGES * PAGE, LS = NPAST + DS, TOPK = 256;
constexpr int C_XR = 0, C_GR = 1024, C_Q = 2048, C_K = 3072, C_V = 3584, C_QI = 4096, C_KI = 4608, C_WI = 4672;
constexpr float ALPHA = 1.189207115002721f, LN_EPS = 1e-5f, ATTN_SCALE = 0.08838834764831845f, IDX_SCALE = 0.125f, IDX_W_SCALE = 0.35355339059327373f;
constexpr size_t O_YP = 0, O_YS = 16777216, O_KP = 17039360, O_VP = 21233664, O_KIP = 25427968, O_CP = 25952256, O_HP = 25958400,
                 O_KS = 25960448, O_VS = 26025984, O_KIS = 26091520, O_CS = 26099712, O_HS = 26198016;
constexpr int SCS_LD = 8256;
constexpr int ZLD = DINP;

constexpr size_t al256(size_t x) { return (x + 255) & ~(size_t)255; }
constexpr size_t WS_CTL = 0;
constexpr size_t CTL_BYTES = 65536;
constexpr size_t WS_WGU1 = WS_CTL + CTL_BYTES;
constexpr size_t WS_WD1 = WS_WGU1 + al256((size_t)2 * DFF * D * 2);
constexpr size_t WS_WIN = WS_WD1 + al256((size_t)D * DFF * 2);
constexpr size_t WS_WOUT = WS_WIN + al256((size_t)DINP * D * 2);
constexpr size_t WS_WGU2 = WS_WOUT + al256((size_t)D * D * 2);
constexpr size_t WS_WD2 = WS_WGU2 + al256((size_t)2 * DFF * D * 2);
constexpr size_t WS_XB = WS_WD2 + al256((size_t)D * DFF * 2);
constexpr size_t WS_H = WS_XB + al256((size_t)MPAD * D * 2);
constexpr size_t WS_T = WS_H + al256((size_t)MPAD * DFF * 2);
constexpr size_t WS_X1 = WS_T + al256((size_t)MPAD * D * 4);
constexpr size_t WS_X2 = WS_X1 + al256((size_t)MPAD * D * 4);
constexpr size_t WS_XR = WS_X2 + al256((size_t)MPAD * D * 4);
constexpr size_t WS_GG = WS_XR + al256((size_t)MPAD * DRNN * 4);
constexpr size_t WS_QI = WS_GG + al256((size_t)MPAD * DRNN * 4);
constexpr size_t WS_WI = WS_QI + al256((size_t)MPAD * 512 * 4);
constexpr size_t WS_KIH = WS_WI + al256((size_t)MPAD * 8 * 4);
constexpr size_t WS_KIL = WS_KIH + al256((size_t)MPAD * 64 * 2);
constexpr size_t WS_ZEND = WS_KIL + al256((size_t)MPAD * 64 * 2);
constexpr size_t WS_CATB = WS_ZEND;
constexpr size_t WS_HL = WS_CATB + al256((size_t)MPAD * D * 2);
constexpr size_t WS_PP = WS_HL + al256((size_t)MT * DRNN * 4);
constexpr size_t WS_GI = WS_PP + al256((size_t)MT * DRNN * 4);
constexpr size_t WS_SCP = WS_GI + al256((size_t)MT * DRNN * 4);
constexpr size_t WS_SCS = WS_SCP + al256((size_t)MP * SEQ * 4);
constexpr size_t WS_SEL = WS_SCS + al256((size_t)MS * SCS_LD * 4);
constexpr size_t WS_NSEL = WS_SEL + al256((size_t)MT * TOPK * 4);
constexpr size_t WS_SUMA = WS_NSEL + al256((size_t)MT * 4);
constexpr size_t WS_SUMH = WS_SUMA + al256((size_t)130 * DRNN * 4);
constexpr size_t WS_WAT = WS_SUMH + al256((size_t)130 * DRNN * 4);
constexpr size_t WS_WIT = WS_WAT + al256((size_t)8 * 128 * 128 * 2);
constexpr size_t WS_BM = WS_WIT + al256((size_t)8 * 128 * 128 * 2);
constexpr size_t WS_QB = WS_BM + al256((size_t)MP * 64 * 8);
constexpr size_t WS_KB = WS_QB + al256((size_t)MPAD * 1024 * 2);
constexpr size_t WS_VB = WS_KB + al256((size_t)MPAD * 512 * 2);
constexpr size_t WS_END = WS_VB + al256((size_t)MPAD * 512 * 2);
constexpr size_t WS_PS = WS_END;
constexpr size_t WS_END2 = WS_PS + al256((size_t)21 * MS * D * 4);
constexpr size_t WS_ST = WS_END2;
constexpr size_t WS_END3 = WS_ST + al256((size_t)2 * MP * 2 * 4);
constexpr size_t WS_CTR = WS_CTL + 32768;

constexpr int NWAVES = 8, NTHREADS = 512;
#ifndef REP_6
#define REP_6 1
#endif
#ifndef MID_DUP
#define MID_DUP 0
#endif
#ifndef REP_G
#define REP_G 1
#endif
#ifndef REP_T
#define REP_T 1
#endif
#ifndef REP_5
#define REP_5 2
#endif
constexpr int LDS_STAGE = 131072, LDS_MISC = 134144, LDS_BYTES = 135168;

struct Params {
    const float* in[27];
    float* out;
    unsigned char* ws;
    int ph_lo, ph_hi, li, pad_;
};

__device__ __forceinline__ unsigned cvt_pk_bf16(float lo, float hi) { unsigned r; asm volatile("v_cvt_pk_bf16_f32 %0, %1, %2" : "=v"(r) : "v"(lo), "v"(hi)); return r; }
__device__ __forceinline__ int fresh_tid() { int t = threadIdx.x; asm volatile("" : "+v"(t)); return t; }
__device__ __forceinline__ float sigmoidf_(float x) { return 1.0f / (1.0f + expf(-x)); }
__device__ __forceinline__ float gelu_tanh(float x) { const float a = -2.3022081985f * (x + 0.044715f * x * x * x); return x * __builtin_amdgcn_rcpf(1.0f + __builtin_amdgcn_exp2f(a)); }
__device__ __forceinline__ bf16_t f2bf(float f) { return (bf16_t)(cvt_pk_bf16(f, 0.f) & 0xffffu); }

struct EpiSwiGLU {
    static constexpr bool PERM = true, AFTER_DRAIN = false;
    bf16_t* H;
    __device__ __forceinline__ void operator()(const f32x4 (&acc)[2][2][4][2], const pg8::Unit& u, int wr, int wc, int fr, int fq) const {
        const int row0 = u.pm * 256 + wr * 64 + fr, col0 = u.pn * 128 + wc * 32 + 8 * fq;
#pragma unroll
        for (int ai = 0; ai < 2; ++ai)
#pragma unroll
            for (int m = 0; m < 4; ++m) {
                bf16_t* rowp = H + (size_t)(row0 + ai * 128 + m * 16) * DFF + col0;
                float h[8];
#pragma unroll
                for (int n = 0; n < 2; ++n)
#pragma unroll
                    for (int j = 0; j < 4; ++j) {
                        const float g = acc[ai][0][m][n][j], up = acc[ai][1][m][n][j];
                        const float sg = __builtin_amdgcn_rcpf(1.0f + __builtin_amdgcn_exp2f(-1.4426950408889634f * g));
                        h[n * 4 + j] = g * sg * up;
                    }
                u32x4 w; w.x = cvt_pk_bf16(h[0], h[1]); w.y = cvt_pk_bf16(h[2], h[3]); w.z = cvt_pk_bf16(h[4], h[5]); w.w = cvt_pk_bf16(h[6], h[7]);
                *(u32x4*)rowp = w;
            }
    }
};
struct EpiResid {
    static constexpr bool PERM = false, AFTER_DRAIN = false;
    const float* Xp; const float* Xs; float* T; float s;
    __device__ __forceinline__ void operator()(const f32x4 (&acc)[2][2][4][2], const pg8::Unit& u, int wr, int wc, int fr, int fq) const {
        const int row0 = u.pm * 256 + wr * 64 + fr, col0 = u.pn * 256 + wc * 32 + 4 * fq;
#pragma unroll
        for (int ai = 0; ai < 2; ++ai)
#pragma unroll
            for (int m = 0; m < 4; ++m) {
                const int row = row0 + ai * 128 + m * 16;
                if (row < MT) {
                    const float* xr = (row < MP) ? Xp + (size_t)row * D + col0 : Xs + (size_t)(row - MP) * D + col0;
                    float* tr = T + (size_t)row * D + col0;
#pragma unroll
                    for (int bj = 0; bj < 2; ++bj)
#pragma unroll
                        for (int n = 0; n < 2; ++n) { const f32x4 xv = *(const f32x4*)(xr + bj * 128 + n * 16); *(f32x4*)(tr + bj * 128 + n * 16) = xv * ALPHA + acc[ai][bj][m][n] * s; }
                }
            }
    }
};
struct EpiF32 {
    static constexpr bool PERM = false, AFTER_DRAIN = false;
    float* C; int ldc;
    __device__ __forceinline__ void operator()(const f32x4 (&acc)[2][2][4][2], const pg8::Unit& u, int wr, int wc, int fr, int fq) const {
        const int row0 = u.pm * 256 + wr * 64 + fr, col0 = u.pn * 256 + wc * 32 + 4 * fq;
#pragma unroll
        for (int ai = 0; ai < 2; ++ai)
#pragma unroll
            for (int m = 0; m < 4; ++m) {
                float* rowp = C + (size_t)(row0 + ai * 128 + m * 16) * ldc + col0;
#pragma unroll
                for (int bj = 0; bj < 2; ++bj)
#pragma unroll
                    for (int n = 0; n < 2; ++n) *(f32x4*)(rowp + bj * 128 + n * 16) = acc[ai][bj][m][n];
            }
    }
};


struct EpiWin {
    static constexpr bool PERM = false, AFTER_DRAIN = false;
    float* XR; float* GG; bf16_t* QB; bf16_t* KB; bf16_t* VB; float* QI; bf16_t* KIH; bf16_t* KIL; float* WI; float* out;
    template <class F> __device__ __forceinline__ void each(const f32x4 (&acc)[2][2][4][2], const pg8::Unit& u, int wr, int wc, int fr, int fq, F f) const {
        const int row0 = u.pm * 256 + wr * 64 + fr, cl = wc * 32 + 4 * fq;
#pragma unroll
        for (int ai = 0; ai < 2; ++ai)
#pragma unroll
            for (int m = 0; m < 4; ++m)
#pragma unroll
                for (int bj = 0; bj < 2; ++bj)
#pragma unroll
                    for (int n = 0; n < 2; ++n) f(row0 + ai * 128 + m * 16, cl + 128 * bj + 16 * n, acc[ai][bj][m][n]);
    }
    static __device__ __forceinline__ u32x2 pk4(const f32x4 v) { u32x2 w; w.x = cvt_pk_bf16(v[0], v[1]); w.y = cvt_pk_bf16(v[2], v[3]); return w; }
    __device__ __forceinline__ void operator()(const f32x4 (&acc)[2][2][4][2], const pg8::Unit& u, int wr, int wc, int fr, int fq) const {
        const int pn = u.pn;
        if (pn < 4) each(acc, u, wr, wc, fr, fq, [&](int row, int c, const f32x4 v) { *(f32x4*)(XR + (size_t)row * DRNN + pn * 256 + c) = v; });
        else if (pn < 8) each(acc, u, wr, wc, fr, fq, [&](int row, int c, const f32x4 v) { *(f32x4*)(GG + (size_t)row * DRNN + (pn - 4) * 256 + c) = (f32x4){gelu_tanh(v[0]), gelu_tanh(v[1]), gelu_tanh(v[2]), gelu_tanh(v[3])}; });
        else if (pn < 12) each(acc, u, wr, wc, fr, fq, [&](int row, int c, const f32x4 v) { *(u32x2*)(QB + (size_t)row * 1024 + (pn - 8) * 256 + c) = pk4(v); });
        else if (pn < 16) {
            bf16_t* B = (pn < 14) ? KB : VB; const size_t op = (pn < 14) ? O_KP : O_VP, os = (pn < 14) ? O_KS : O_VS; const int c0 = (pn & 1) * 256;
            each(acc, u, wr, wc, fr, fq, [&](int row, int c, const f32x4 v) {
                *(u32x2*)(B + (size_t)row * 512 + c0 + c) = pk4(v);
                if (row < MT) *(f32x4*)(out + (row < MP ? op + (size_t)row * 512 : os + (size_t)(row - MP) * 512) + c0 + c) = v; });
        }
        else if (pn < 18) each(acc, u, wr, wc, fr, fq, [&](int row, int c, const f32x4 v) { *(f32x4*)(QI + (size_t)row * 512 + (pn - 16) * 256 + c) = v; });
        else each(acc, u, wr, wc, fr, fq, [&](int row, int c, const f32x4 v) {
            if (c < 64) {
                const u32x2 h = pk4(v);
                u32x2 l; l.x = cvt_pk_bf16(v[0] - __uint_as_float(h.x << 16), v[1] - __uint_as_float(h.x & 0xffff0000u)); l.y = cvt_pk_bf16(v[2] - __uint_as_float(h.y << 16), v[3] - __uint_as_float(h.y & 0xffff0000u));
                *(u32x2*)(KIH + (size_t)row * 64 + c) = h; *(u32x2*)(KIL + (size_t)row * 64 + c) = l;
                if (row < MT) *(f32x4*)(out + (row < MP ? O_KIP + (size_t)row * 64 : O_KIS + (size_t)(row - MP) * 64) + c) = v;
            } else if (c < 72) *(f32x4*)(WI + (size_t)row * 8 + (c - 64)) = v; });
    }
};


struct SplitOrder {
    pg8::StaticOrder base; int G, c, nmine, npiece, ntk, nN;
    __device__ __forceinline__ void init(int N, int K, int G_, int c_) { base.init(MP, N, G_, c_, K); G = G_; c = c_; nN = N / 256; ntk = K / 64; npiece = ntk / 4; nmine = (c_ < base.nwg) ? (base.nwg - c_ + G_ - 1) / G_ : 0; }
    __device__ __forceinline__ bool next(int i, pg8::Unit& u) const {
        if (i < nmine) return base.next(i, u);
        const int mi = (i - nmine) * G + c; if (mi >= npiece * nN) return false;
        const int kp = mi / nN; u.pm = MP / 256; u.pn = mi % nN; u.k0 = kp * 256; u.nt = (kp == npiece - 1) ? ntk - 4 * (npiece - 1) : 4; u.aux = kp; return true;
    }
    __device__ __forceinline__ void a_ready(const pg8::Unit&) const {}
    __device__ __forceinline__ void done(const pg8::Unit&) const {}
};
struct EpiResidSplit {
    static constexpr bool PERM = false, AFTER_DRAIN = false;
    const float* X; float* T; float* PS; float s; const float* ST; const float* gn; const float* bn;
    __device__ __forceinline__ void operator()(const f32x4 (&acc)[2][2][4][2], const pg8::Unit& u, int wr, int wc, int fr, int fq) const {
        const int col0 = u.pn * 256 + wc * 32 + 4 * fq;
        if (u.aux < 0) {
            const int row0 = u.pm * 256 + wr * 64 + fr;
            if (ST == nullptr) {
#pragma unroll
                for (int ai = 0; ai < 2; ++ai)
#pragma unroll
                    for (int m = 0; m < 4; ++m) {
                        const size_t off = (size_t)(row0 + ai * 128 + m * 16) * D + col0;
#pragma unroll
                        for (int bj = 0; bj < 2; ++bj)
#pragma unroll
                            for (int n = 0; n < 2; ++n) { const f32x4 xv = *(const f32x4*)(X + off + bj * 128 + n * 16); *(f32x4*)(T + off + bj * 128 + n * 16) = xv * ALPHA + acc[ai][bj][m][n] * s; }
                    }
            } else {
                f32x4 gv[2][2], bv[2][2];
#pragma unroll
                for (int bj = 0; bj < 2; ++bj)
#pragma unroll
                    for (int n = 0; n < 2; ++n) { gv[bj][n] = *(const f32x4*)(gn + col0 + bj * 128 + n * 16); bv[bj][n] = *(const f32x4*)(bn + col0 + bj * 128 + n * 16); }
#pragma unroll
                for (int ai = 0; ai < 2; ++ai)
#pragma unroll
                    for (int m = 0; m < 4; ++m) {
                        const int row = row0 + ai * 128 + m * 16;
                        const size_t off = (size_t)row * D + col0;
                        const float mean = ST[2 * row], rstd = ST[2 * row + 1];
#pragma unroll
                        for (int bj = 0; bj < 2; ++bj)
#pragma unroll
                            for (int n = 0; n < 2; ++n) { const f32x4 tv = *(const f32x4*)(T + off + bj * 128 + n * 16); const f32x4 xv = (tv - mean) * rstd * gv[bj][n] + bv[bj][n];
                                *(f32x4*)(T + off + bj * 128 + n * 16) = xv * ALPHA + acc[ai][bj][m][n] * s; }
                    }
            }
        } else {
            float* slab = PS + (size_t)u.aux * MS * D;
#pragma unroll
            for (int m = 0; m < 4; ++m) {
                float* rp = slab + (size_t)(wr * 64 + m * 16 + fr) * D + col0;
#pragma unroll
                for (int bj = 0; bj < 2; ++bj)
#pragma unroll
                    for (int n = 0; n < 2; ++n) *(f32x4*)(rp + bj * 128 + n * 16) = acc[0][bj][m][n];
            }
        }
    }
};

template <int MODE>
__device__ __forceinline__ void transpose_cvt(const float* __restrict__ W, int K, int N, int Npad, bf16_t* __restrict__ Wt, PG8_LAS float* tile, int wid, int nw) {
    const int tid = fresh_tid(), ntn = Npad / 64, ntk = K / 128, ntiles = ntn * ntk;
    const int lk = tid >> 4, ln4 = (tid & 15) * 4;
    f32x4 v[4];
    auto src0 = [&](int t) { const int n0 = (t % ntn) * 64; if (MODE == 1) { const int t256 = n0 >> 8, j = n0 & 255; return (j < 128) ? t256 * 128 + j : DFF + t256 * 128 + (j - 128); } return n0; };
    auto gload = [&](int t) {
        const int k0 = (t / ntn) * 128, s0 = src0(t);
#pragma unroll
        for (int i = 0; i < 4; ++i) {
            const float* q = W + (size_t)(k0 + lk + 32 * i) * N + s0 + ln4;
            if (MODE == 1 || s0 + ln4 + 3 < N) v[i] = *(const f32x4*)q;
            else { v[i] = (f32x4){0.f, 0.f, 0.f, 0.f}; for (int e = 0; e < 4; ++e) if (s0 + ln4 + e < N) v[i][e] = q[e]; }
        }
    };
    int t = wid;
    if (t < ntiles) gload(t);
    for (; t < ntiles; t += nw) {
#pragma unroll
        for (int i = 0; i < 4; ++i)
#pragma unroll
            for (int e = 0; e < 4; ++e) tile[(lk + 32 * i) * 65 + ln4 + e] = v[i][e];
        const int tn = t + nw;
        if (tn < ntiles) gload(tn);
        __syncthreads();
        {
            const int n0 = (t % ntn) * 64, k0 = (t / ntn) * 128;
            const int n = tid >> 3, kq = (tid & 7) * 16;
#pragma unroll
            for (int h = 0; h < 2; ++h) {
                float x[8];
#pragma unroll
                for (int j = 0; j < 8; ++j) x[j] = tile[(kq + 8 * h + j) * 65 + n];
                u32x4 w; w.x = cvt_pk_bf16(x[0], x[1]); w.y = cvt_pk_bf16(x[2], x[3]); w.z = cvt_pk_bf16(x[4], x[5]); w.w = cvt_pk_bf16(x[6], x[7]);
                *(u32x4*)(Wt + (size_t)(n0 + n) * K + k0 + kq + 8 * h) = w;
            }
        }
        __syncthreads();
    }
}
__device__ __forceinline__ void cvt_x(const float* __restrict__ xp, const float* __restrict__ xs, bf16_t* __restrict__ XB) {
    const size_t n4 = (size_t)MPAD * D / 4;
    for (size_t i = (size_t)blockIdx.x * NTHREADS + threadIdx.x; i < n4; i += (size_t)gridDim.x * NTHREADS) {
        const size_t e = i * 4, row = e / D;
        f32x4 v = (f32x4){0.f, 0.f, 0.f, 0.f};
        if (row < (size_t)MP) v = *(const f32x4*)(xp + e); else if (row < (size_t)MT) v = *(const f32x4*)(xs + (e - (size_t)MP * D));
        u32x2 w; w.x = cvt_pk_bf16(v[0], v[1]); w.y = cvt_pk_bf16(v[2], v[3]);
        *(u32x2*)(XB + e) = w;
    }
}
__device__ __forceinline__ void ln_phase(const float* __restrict__ T, const float* __restrict__ g, const float* __restrict__ b, float* __restrict__ Xo, bf16_t* __restrict__ Xb,
                                         const float* __restrict__ PS, int npiece, const float* __restrict__ Xs, float sres, float* __restrict__ ST) {
    const int tid_ = fresh_tid(), lane = tid_ & 63, wave = tid_ >> 6;
    for (int row = blockIdx.x * NWAVES + wave; row < MT; row += gridDim.x * NWAVES) {
        f32x4 v[8]; float s = 0.f;
        if (row < MP) {
            const float* tr = T + (size_t)row * D + lane * 4;
#pragma unroll
            for (int i = 0; i < 8; ++i) v[i] = *(const f32x4*)(tr + 256 * i);
        } else {
            const size_t ro = (size_t)(row - MP) * D + lane * 4;
#pragma unroll
            for (int i = 0; i < 8; ++i) v[i] = (f32x4){0.f, 0.f, 0.f, 0.f};
#pragma unroll 1
            for (int pz = 0; pz < npiece; ++pz) {
                const float* sp = PS + (size_t)pz * MS * D + ro;
#pragma unroll
                for (int i = 0; i < 8; ++i) v[i] += *(const f32x4*)(sp + 256 * i);
            }
#pragma unroll
            for (int i = 0; i < 8; ++i) v[i] = *(const f32x4*)(Xs + ro + 256 * i) * ALPHA + v[i] * sres;
        }
#pragma unroll
        for (int i = 0; i < 8; ++i) s += (v[i][0] + v[i][1]) + (v[i][2] + v[i][3]);
#pragma unroll
        for (int o = 32; o >= 1; o >>= 1) s += __shfl_xor(s, o);
        const float mean = s * (1.0f / D);
        float q = 0.f;
#pragma unroll
        for (int i = 0; i < 8; ++i) { const f32x4 d = v[i] - mean; q += (d[0] * d[0] + d[1] * d[1]) + (d[2] * d[2] + d[3] * d[3]); }
#pragma unroll
        for (int o = 32; o >= 1; o >>= 1) q += __shfl_xor(q, o);
        const float rstd = rsqrtf(q * (1.0f / D) + LN_EPS);
        if (ST && row < MP && lane == 0) { ST[2 * row] = mean; ST[2 * row + 1] = rstd; }
        const float* gq = g; const float* bq = b; asm volatile("" : "+s"(gq), "+s"(bq));
#pragma unroll
        for (int i = 0; i < 8; ++i) {
            const f32x4 o = (v[i] - mean) * rstd * *(const f32x4*)(gq + lane * 4 + 256 * i) + *(const f32x4*)(bq + lane * 4 + 256 * i);
            if (Xo && (ST == nullptr || row >= MP)) *(f32x4*)(Xo + (size_t)row * D + lane * 4 + 256 * i) = o;
            if (Xb) { u32x2 w; w.x = cvt_pk_bf16(o[0], o[1]); w.y = cvt_pk_bf16(o[2], o[3]); *(u32x2*)(Xb + (size_t)row * D + lane * 4 + 256 * i) = w; }
        }
    }
}

typedef short bf16x8 __attribute__((ext_vector_type(8)));
typedef float f32x16 __attribute__((ext_vector_type(16)));
__device__ __forceinline__ int crow(int reg, int h) { return (reg & 3) + 8 * (reg >> 2) + 4 * h; }
constexpr int LRU_CH = 64, LRU_NCHUNK = MT / LRU_CH  , LRU_PCHUNK = MP / LRU_CH  , LRU_CPB = SEQ / LRU_CH  ;
constexpr int L_XCF = 0, L_XCB = 32768, L_AA = 50176, L_UU = 82944, XCB_PITCH = 272;
__device__ __forceinline__ void lru_local_unit(const Params& p, PG8_LAS unsigned char* lds, int u) {
    const int tid = fresh_tid(), lane = tid & 63, wave = tid >> 6;
    unsigned char* ws = p.ws;
    const float* XR = (const float*)(ws + WS_XR);
    const float* state_conv = p.in[5]; const float* state_rnn = p.in[6];
    const float* cw = p.in[13]; const float* cb = p.in[14];
    const float* ba = p.in[16]; const float* bi = p.in[18]; const float* lam = p.in[19];
    const bf16_t* WAt = (const bf16_t*)(ws + WS_WAT); const bf16_t* WIt = (const bf16_t*)(ws + WS_WIT);
    float* HL = (float*)(ws + WS_HL); float* PP = (float*)(ws + WS_PP); float* SUMA = (float*)(ws + WS_SUMA); float* SUMH = (float*)(ws + WS_SUMH);
    float* out = p.out;
    PG8_LAS float* XCF = (PG8_LAS float*)(lds + L_XCF); PG8_LAS float* AA = (PG8_LAS float*)(lds + L_AA); PG8_LAS float* UU = (PG8_LAS float*)(lds + L_UU);
    {
        const int ck = u >> 3, nb = u & 7;
        const int mt = wave >> 2, nt = wave & 3, r = lane & 31, kh = lane >> 5;
        bf16x8 bfa[8], bfi[8];
        {
            const bf16_t* wa = WAt + (size_t)nb * 16384 + (size_t)(nt * 32 + r) * 128 + kh * 8;
            const bf16_t* wi = WIt + (size_t)nb * 16384 + (size_t)(nt * 32 + r) * 128 + kh * 8;
#pragma unroll
            for (int ks = 0; ks < 8; ++ks) { bfa[ks] = *(const bf16x8*)(wa + ks * 16); bfi[ks] = *(const bf16x8*)(wi + ks * 16); }
        }
        const int col_e = nt * 32 + r, ch_e = nb * 128 + col_e;
        const float lam_e = lam[ch_e], bac = ba[ch_e], bic = bi[ch_e];
        {
            const int c = tid & 127, rg = tid >> 7, ch = nb * 128 + c;
            const float w0 = cw[ch], w1 = cw[DRNN + ch], w2 = cw[2 * DRNN + ch], w3 = cw[3 * DRNN + ch], cbv = cb[ch];
            if (ck < LRU_PCHUNK) {
                const int b = ck / LRU_CPB, t0 = (ck % LRU_CPB) * LRU_CH + rg * 16;
                const float* zc = XR + (size_t)(b * SEQ) * DRNN + ch;
                float x0 = (t0 - 3 >= 0) ? zc[(size_t)(t0 - 3) * DRNN] : 0.f, x1 = (t0 - 2 >= 0) ? zc[(size_t)(t0 - 2) * DRNN] : 0.f, x2 = (t0 - 1 >= 0) ? zc[(size_t)(t0 - 1) * DRNN] : 0.f;
#pragma unroll
                for (int i = 0; i < 16; ++i) {
                    const int t = t0 + i, lr = rg * 16 + i;
                    const float x3 = zc[(size_t)t * DRNN];
                    const float xc = cbv + w0 * x0 + w1 * x1 + w2 * x2 + w3 * x3;
                    XCF[lr * 128 + c] = xc;
                    *(PG8_LAS bf16_t*)(lds + L_XCB + lr * XCB_PITCH + c * 2) = f2bf(xc);
                    if (t >= SEQ - 3) out[O_CP + (size_t)(b * 3 + (t - (SEQ - 3))) * DRNN + ch] = x3;
                    x0 = x1; x1 = x2; x2 = x3;
                }
            } else {
#pragma unroll
                for (int i = 0; i < 16; ++i) {
                    const int lr = rg * 16 + i, rs = (ck - LRU_PCHUNK) * LRU_CH + lr, bs = rs >> 2, tt = rs & 3;
                    float xv[4];
#pragma unroll
                    for (int j = 0; j < 4; ++j) { const int pp = tt + j; xv[j] = (pp < 3) ? state_conv[(size_t)(bs * 3 + pp) * DRNN + ch] : XR[(size_t)(MP + bs * DS + pp - 3) * DRNN + ch]; }
                    const float xc = cbv + w0 * xv[0] + w1 * xv[1] + w2 * xv[2] + w3 * xv[3];
                    XCF[lr * 128 + c] = xc;
                    *(PG8_LAS bf16_t*)(lds + L_XCB + lr * XCB_PITCH + c * 2) = f2bf(xc);
                    if (tt >= 1) out[O_CS + (size_t)(bs * 3 + (tt - 1)) * DRNN + ch] = xv[3];
                }
            }
        }
        __syncthreads();
        {
            f32x16 acc_a, acc_i;
#pragma unroll
            for (int i = 0; i < 16; ++i) { acc_a[i] = 0.f; acc_i[i] = 0.f; }
#pragma unroll
            for (int ks = 0; ks < 8; ++ks) {
                const bf16x8 af = *(const PG8_LAS bf16x8*)(lds + L_XCB + (mt * 32 + r) * XCB_PITCH + (ks * 16 + kh * 8) * 2);
                acc_a = __builtin_amdgcn_mfma_f32_32x32x16_bf16(af, bfa[ks], acc_a, 0, 0, 0);
                acc_i = __builtin_amdgcn_mfma_f32_32x32x16_bf16(af, bfi[ks], acc_i, 0, 0, 0);
            }
            const int col = col_e, hh = lane >> 5;
            const float l = lam_e, sp = (-l > 20.f) ? -l : log1pf(expf(-l));
#pragma unroll
            for (int i = 0; i < 16; ++i) {
                const int lr = mt * 32 + crow(i, hh);
                const float xc = XCF[lr * 128 + col];
                const float rg = __builtin_amdgcn_rcpf(1.0f + __builtin_amdgcn_exp2f(-1.4426950408889634f * (acc_a[i] + bac)));
                const float ig = __builtin_amdgcn_rcpf(1.0f + __builtin_amdgcn_exp2f(-1.4426950408889634f * (acc_i[i] + bic)));
                const float log_a = -8.0f * rg * sp, x = 2.0f * log_a;
                float q = 1.0f / 720.0f; q = q * x + 1.0f / 120.0f; q = q * x + 1.0f / 24.0f; q = q * x + 1.0f / 6.0f; q = q * x + 0.5f; q = q * x + 1.0f;
                const float om = (x > -0.25f) ? -x * q : 1.0f - __builtin_amdgcn_exp2f(1.4426950408889634f * x);
                AA[lr * 128 + col] = __builtin_amdgcn_exp2f(1.4426950408889634f * log_a);
                UU[lr * 128 + col] = __builtin_amdgcn_sqrtf(om) * ig * xc;
            }
        }
        __syncthreads();
        {
            const int c = tid & 127, sg = tid >> 7, ch = nb * 128 + c;
            PG8_LAS float* SEG = (PG8_LAS float*)(lds + L_XCF);
            float hv[16], pv[16];
            float h = 0.f, P = 1.f;
            const bool prompt = ck < LRU_PCHUNK;
#pragma unroll
            for (int i = 0; i < 16; ++i) {
                const int lr = sg * 16 + i;
                const float a = AA[lr * 128 + c], uu = UU[lr * 128 + c];
                if (!prompt && (i & 3) == 0) { h = state_rnn[(size_t)(((ck - LRU_PCHUNK) * LRU_CH + lr) >> 2) * DRNN + ch]; P = 0.f; }
                h = a * h + uu; P *= a;
                hv[i] = h; pv[i] = P;
            }
            SEG[(sg * 128 + c) * 2] = P; SEG[(sg * 128 + c) * 2 + 1] = h;
            __syncthreads();
            float cin = 0.f, pin = 1.f;
            if (prompt) {
#pragma unroll
                for (int s2 = 0; s2 < 3; ++s2) if (s2 < sg) { const float ps = SEG[(s2 * 128 + c) * 2], hs = SEG[(s2 * 128 + c) * 2 + 1]; cin = ps * cin + hs; pin *= ps; }
            }
#pragma unroll
            for (int i = 0; i < 16; ++i) {
                const int lr = sg * 16 + i;
                const size_t g = (size_t)(ck * LRU_CH + lr) * DRNN + ch;
                const float hf = prompt ? hv[i] + pv[i] * cin : hv[i];
                HL[g] = hf; PP[g] = prompt ? pv[i] * pin : 0.f;
                if (!prompt && (i & 3) == 3) out[O_HS + (size_t)(((ck - LRU_PCHUNK) * LRU_CH + lr) >> 2) * DRNN + ch] = hf;
            }
            if (sg == 3) { SUMA[(size_t)ck * DRNN + ch] = prompt ? pv[15] * pin : 0.f; SUMH[(size_t)ck * DRNN + ch] = prompt ? hv[15] + pv[15] * cin : 0.f; }
        }
        __syncthreads();
    }
}
__device__ __forceinline__ void lru_fixup_unit(const Params& p, int ck) {
    const int tid = fresh_tid(), ch = tid * 2;
    unsigned char* ws = p.ws;
    const float* GG = (const float*)(ws + WS_GG);
    const float* HL = (const float*)(ws + WS_HL); const float* PP = (const float*)(ws + WS_PP); const float* SUMA = (const float*)(ws + WS_SUMA); const float* SUMH = (const float*)(ws + WS_SUMH);
    bf16_t* CATB = (bf16_t*)(ws + WS_CATB); float* PS = (float*)(ws + WS_PS);
    typedef float f32x2 __attribute__((ext_vector_type(2)));
    f32x2 carry = (f32x2){0.f, 0.f};
    const bool prompt = ck < LRU_PCHUNK;
    if (prompt) {
        const int b = ck / LRU_CPB, kk = ck % LRU_CPB;
#pragma unroll 4
        for (int j = 0; j < kk; ++j) {
            const f32x2 A = *(const f32x2*)(SUMA + (size_t)(b * LRU_CPB + j) * DRNN + ch), Hh = *(const f32x2*)(SUMH + (size_t)(b * LRU_CPB + j) * DRNN + ch);
            carry = A * carry + Hh;
        }
    }
#pragma unroll 4
    for (int lr = 0; lr < LRU_CH; ++lr) {
        const size_t grow = (size_t)(ck * LRU_CH + lr);
        const f32x2 hl = *(const f32x2*)(HL + grow * DRNN + ch), pp = *(const f32x2*)(PP + grow * DRNN + ch), gg = *(const f32x2*)(GG + grow * DRNN + ch);
        const f32x2 h = hl + pp * carry;
        *(unsigned*)(CATB + grow * D + ch) = cvt_pk_bf16(h.x * gg.x, h.y * gg.y);
        if (prompt && (ck % LRU_CPB) == LRU_CPB - 1 && lr == LRU_CH - 1) *(f32x2*)(p.out + O_HP + (size_t)(ck / LRU_CPB) * DRNN + ch) = h;
    }
}


constexpr int IDX_SPLIT = 1;
constexpr int SCP_LD = 4096, SCS_LDL = 8200;
__device__ __forceinline__ unsigned fkey(float f) { const unsigned u = __float_as_uint(f); return (u & 0x80000000u) ? ~u : (u | 0x80000000u); }
__device__ __forceinline__ int mbcnt64(unsigned long long m) { return (int)__builtin_amdgcn_mbcnt_hi((unsigned)(m >> 32), __builtin_amdgcn_mbcnt_lo((unsigned)m, 0u)); }
template <int NB> __device__ __forceinline__ int wave_sum_small(unsigned c) {
    int t = 0;
#pragma unroll
    for (int b = 0; b < NB; ++b) t += __popcll(__ballot((c >> b) & 1u)) << b;
    return t;
}
__device__ __forceinline__ void split8(const f32x4 a, const f32x4 b, bf16x8& hi, bf16x8& lo) {
    u32x4 h; h.x = cvt_pk_bf16(a[0], a[1]); h.y = cvt_pk_bf16(a[2], a[3]); h.z = cvt_pk_bf16(b[0], b[1]); h.w = cvt_pk_bf16(b[2], b[3]);
    u32x4 l;
    l.x = cvt_pk_bf16(a[0] - __uint_as_float(h.x << 16), a[1] - __uint_as_float(h.x & 0xffff0000u));
    l.y = cvt_pk_bf16(a[2] - __uint_as_float(h.y << 16), a[3] - __uint_as_float(h.y & 0xffff0000u));
    l.z = cvt_pk_bf16(b[0] - __uint_as_float(h.z << 16), b[1] - __uint_as_float(h.z & 0xffff0000u));
    l.w = cvt_pk_bf16(b[2] - __uint_as_float(h.w << 16), b[3] - __uint_as_float(h.w & 0xffff0000u));
    hi = __builtin_bit_cast(bf16x8, h); lo = __builtin_bit_cast(bf16x8, l);
}
struct IdxQ { bf16x8 hi[4], lo[4]; float w[16]; };
struct IdxRaw { f32x4 v[8]; };
struct IdxKey { bf16x8 hi[4], lo[4]; };
__device__ __forceinline__ void idx_load_q(IdxQ& q, const float* QI, const float* WI, int grow0, int lane) {
    const int rho = lane & 31, kh = lane >> 5, ql = 2 * ((rho >> 2) & 1) + (rho >> 4), head = 4 * ((rho >> 3) & 1) + (rho & 3);
    const float* src = QI + (size_t)(grow0 + ql) * 512 + head * IDD + kh * 8;
#pragma unroll
    for (int ks = 0; ks < 4; ++ks) { const f32x4 a = *(const f32x4*)(src + ks * 16), b = *(const f32x4*)(src + ks * 16 + 4); split8(a, b, q.hi[ks], q.lo[ks]); }
#pragma unroll
    for (int e = 0; e < 2; ++e) {
        const float* wsrc = WI + (size_t)(grow0 + 2 * kh + e) * 8;
        const f32x4 a = *(const f32x4*)wsrc, b = *(const f32x4*)(wsrc + 4);
#pragma unroll
        for (int i = 0; i < 4; ++i) { q.w[e * 8 + i] = a[i] * IDX_W_SCALE; q.w[e * 8 + 4 + i] = b[i] * IDX_W_SCALE; }
    }
}
__device__ __forceinline__ void idx_load_raw(IdxRaw& raw, const float* kp) {
#pragma unroll
    for (int ks = 0; ks < 4; ++ks) { raw.v[2 * ks] = *(const f32x4*)(kp + ks * 16); raw.v[2 * ks + 1] = *(const f32x4*)(kp + ks * 16 + 4); }
}
__device__ __forceinline__ void idx_cvt_key(const IdxRaw& raw, IdxKey& k) {
#pragma unroll
    for (int ks = 0; ks < 4; ++ks) split8(raw.v[2 * ks], raw.v[2 * ks + 1], k.hi[ks], k.lo[ks]);
}
__device__ __forceinline__ void idx_load_keyb(IdxKey& k, const bf16_t* ph, const bf16_t* pl) {
#pragma unroll
    for (int ks = 0; ks < 4; ++ks) { k.hi[ks] = *(const bf16x8*)(ph + ks * 16); if (IDX_SPLIT == 3) k.lo[ks] = *(const bf16x8*)(pl + ks * 16); else k.lo[ks] = k.hi[ks]; }
}
__device__ __forceinline__ void idx_tile(const IdxQ& q, const IdxKey& k, float (&s)[2]) {
    f32x16 acc;
#pragma unroll
    for (int i = 0; i < 16; ++i) acc[i] = 0.f;
#pragma unroll
    for (int ks = 0; ks < 4; ++ks) {
        acc = __builtin_amdgcn_mfma_f32_32x32x16_bf16(q.hi[ks], k.hi[ks], acc, 0, 0, 0);
        if (IDX_SPLIT == 3) { acc = __builtin_amdgcn_mfma_f32_32x32x16_bf16(q.hi[ks], k.lo[ks], acc, 0, 0, 0); acc = __builtin_amdgcn_mfma_f32_32x32x16_bf16(q.lo[ks], k.hi[ks], acc, 0, 0, 0); }
    }
#pragma unroll
    for (int e = 0; e < 2; ++e) {
        float t = 0.f;
#pragma unroll
        for (int i = 0; i < 8; ++i) t += fmaxf(acc[e * 8 + i] * IDX_SCALE, 0.f) * q.w[e * 8 + i];
        s[e] = t;
    }
}

#define wlane2(vlo, vhi, m, j) asm volatile("s_nop 3\n\tv_writelane_b32 %0, %2, %4\n\tv_writelane_b32 %1, %3, %4" : "+v"(vlo), "+v"(vhi) : "s"((unsigned)(m)), "s"((unsigned)((m) >> 32)), "n"(j))
__device__ __forceinline__ int count8_ge(unsigned a0, unsigned a1, unsigned a2, unsigned a3, unsigned a4, unsigned a5, unsigned a6, unsigned a7, unsigned cand) {
    unsigned long long m0, m1, m2, m3, m4, m5, m6, m7;
    asm volatile("v_cmp_ge_u32_e64 %0, %8, %16\n\tv_cmp_ge_u32_e64 %1, %9, %16\n\tv_cmp_ge_u32_e64 %2, %10, %16\n\tv_cmp_ge_u32_e64 %3, %11, %16\n\t"
                 "v_cmp_ge_u32_e64 %4, %12, %16\n\tv_cmp_ge_u32_e64 %5, %13, %16\n\tv_cmp_ge_u32_e64 %6, %14, %16\n\tv_cmp_ge_u32_e64 %7, %15, %16\n\ts_nop 3"
                 : "=&s"(m0), "=&s"(m1), "=&s"(m2), "=&s"(m3), "=&s"(m4), "=&s"(m5), "=&s"(m6), "=&s"(m7)
                 : "v"(a0), "v"(a1), "v"(a2), "v"(a3), "v"(a4), "v"(a5), "v"(a6), "v"(a7), "v"(cand));
    return (__popcll(m0) + __popcll(m1)) + (__popcll(m2) + __popcll(m3)) + ((__popcll(m4) + __popcll(m5)) + (__popcll(m6) + __popcll(m7)));
}


__device__ __forceinline__ void count8_acc(unsigned& cnt, unsigned a0, unsigned a1, unsigned a2, unsigned a3, unsigned a4, unsigned a5, unsigned a6, unsigned a7, unsigned cand) {
    unsigned long long m0, m1, m2, m3, m4, m5, m6, m7;
    asm volatile("v_cmp_ge_u32_e64 %1, %9, %17\n\tv_cmp_ge_u32_e64 %2, %10, %17\n\tv_cmp_ge_u32_e64 %3, %11, %17\n\tv_cmp_ge_u32_e64 %4, %12, %17\n\t"
                 "v_cmp_ge_u32_e64 %5, %13, %17\n\tv_cmp_ge_u32_e64 %6, %14, %17\n\tv_cmp_ge_u32_e64 %7, %15, %17\n\tv_cmp_ge_u32_e64 %8, %16, %17\n\ts_nop 1\n\t"
                 "v_addc_co_u32_e64 %0, vcc, 0, %0, %1\n\tv_addc_co_u32_e64 %0, vcc, 0, %0, %2\n\tv_addc_co_u32_e64 %0, vcc, 0, %0, %3\n\tv_addc_co_u32_e64 %0, vcc, 0, %0, %4\n\t"
                 "v_addc_co_u32_e64 %0, vcc, 0, %0, %5\n\tv_addc_co_u32_e64 %0, vcc, 0, %0, %6\n\tv_addc_co_u32_e64 %0, vcc, 0, %0, %7\n\tv_addc_co_u32_e64 %0, vcc, 0, %0, %8"
                 : "+v"(cnt), "=&s"(m0), "=&s"(m1), "=&s"(m2), "=&s"(m3), "=&s"(m4), "=&s"(m5), "=&s"(m6), "=&s"(m7)
                 : "v"(a0), "v"(a1), "v"(a2), "v"(a3), "v"(a4), "v"(a5), "v"(a6), "v"(a7), "v"(cand) : "vcc");
}
__device__ __forceinline__ int wave_sum_dpp(int x) {
    x += __builtin_amdgcn_update_dpp(0, x, 0x111, 0xf, 0xf, true);
    x += __builtin_amdgcn_update_dpp(0, x, 0x112, 0xf, 0xf, true);
    x += __builtin_amdgcn_update_dpp(0, x, 0x114, 0xf, 0xf, true);
    x += __builtin_amdgcn_update_dpp(0, x, 0x118, 0xf, 0xf, true);
    x += __builtin_amdgcn_update_dpp(0, x, 0x142, 0xa, 0xf, true);
    x += __builtin_amdgcn_update_dpp(0, x, 0x143, 0xc, 0xf, true);
    return __builtin_amdgcn_readlane(x, 63);
}
template <int NGA, int NJ, int BITLO>
__device__ __forceinline__ bool bit_search(const unsigned (&v)[NJ], unsigned& prefix) {
    for (int bit = 31; bit >= BITLO; --bit) {
        const unsigned cand = prefix | (1u << bit);
        int cnt;
        if (NGA >= 2) {
            unsigned c = 0u;
#pragma unroll
            for (int g = 0; g < NGA; ++g) count8_acc(c, v[g * 8], v[g * 8 + 1], v[g * 8 + 2], v[g * 8 + 3], v[g * 8 + 4], v[g * 8 + 5], v[g * 8 + 6], v[g * 8 + 7], cand);
            cnt = wave_sum_dpp((int)c);
        } else cnt = count8_ge(v[0], v[1], v[2], v[3], v[4], v[5], v[6], v[7], cand);
        if (cnt >= TOPK) prefix = cand;
        if (cnt == TOPK) return true;
    }
    return false;
}
template <int NJ, int BITLO = 0>
__device__ __forceinline__ void select_row(const PG8_LAS float* sc, int n, int lane, unsigned long long* bm_row) {
    constexpr int NG = (NJ + 7) / 8;
    unsigned v[NJ];
    const int nj = __builtin_amdgcn_readfirstlane((n + 63) >> 6), ng = (nj + 7) >> 3;
    const PG8_LAS float* pl = sc + lane;
#pragma unroll
    for (int j = 0; j < NJ; ++j) { const unsigned k = fkey(pl[j * 64]); v[j] = (lane < n - j * 64) ? k : 0u; }
    unsigned T = 1u; int need = 1 << 30;
    if (n > TOPK) {
        unsigned prefix = 0u; bool exact;
        if (NG >= 8 && ng > 7) exact = bit_search<(NG >= 8 ? 8 : NG), NJ, BITLO>(v, prefix);
        else if (NG >= 7 && ng > 6) exact = bit_search<(NG >= 7 ? 7 : NG), NJ, BITLO>(v, prefix);
        else if (NG >= 6 && ng > 5) exact = bit_search<(NG >= 6 ? 6 : NG), NJ, BITLO>(v, prefix);
        else if (NG >= 5 && ng > 4) exact = bit_search<(NG >= 5 ? 5 : NG), NJ, BITLO>(v, prefix);
        else if (NG >= 4 && ng > 3) exact = bit_search<(NG >= 4 ? 4 : NG), NJ, BITLO>(v, prefix);
        else if (NG >= 3 && ng > 2) exact = bit_search<(NG >= 3 ? 3 : NG), NJ, BITLO>(v, prefix);
        else if (NG >= 2 && ng > 1) exact = bit_search<(NG >= 2 ? 2 : NG), NJ, BITLO>(v, prefix);
        else exact = bit_search<1, NJ, BITLO>(v, prefix);
        T = prefix;
        if (!exact) {
            int cgt = 0;
#pragma unroll
            for (int g = 0; g < NG; ++g) if (g < ng) {
#pragma unroll
                for (int jj = 0; jj < 8; ++jj) if (g * 8 + jj < NJ) cgt += __popcll(__ballot(v[g * 8 + jj] > T));
            }
            need = TOPK - cgt;
        }
    }
    unsigned mlo = 0u, mhi = 0u;
    if (need >= (1 << 29)) {
#pragma unroll
        for (int g = 0; g < NG; ++g) if (g < ng) {
#pragma unroll
            for (int jj = 0; jj < 8; ++jj) { const int j = g * 8 + jj; const unsigned long long sm = __ballot(v[j] >= T);
                wlane2(mlo, mhi, sm, j); }
        }
    } else {
        int base_eq = 0;
#pragma unroll
        for (int j = 0; j < NJ; ++j) if (j < nj) {
            const bool gt = v[j] > T, eq = v[j] == T;
            const unsigned long long eqm = __ballot(eq);
            const bool s = gt || (eq && (base_eq + mbcnt64(eqm)) < need);
            const unsigned long long sm = __ballot(s);
            base_eq += __popcll(eqm);
            wlane2(mlo, mhi, sm, j);
        }
    }
    const unsigned long long mymask = ((unsigned long long)mhi << 32) | mlo;
    bm_row[lane] = mymask;
}
__device__ __forceinline__ void select_row_wg(const PG8_LAS float* sc, int n, PG8_LAS int* sel, volatile PG8_LAS int* red) {
    constexpr int NC = 17;
    const int tid_ = fresh_tid(), lane = tid_ & 63, wave = __builtin_amdgcn_readfirstlane(tid_ >> 6);
    unsigned v[NC];
    const PG8_LAS float* pl = sc + wave * NC * 64 + lane;
    const int nrem = n - wave * NC * 64;
#pragma unroll
    for (int j = 0; j < NC; ++j) { const unsigned k = fkey(pl[j * 64]); v[j] = (lane < nrem - j * 64) ? k : 0u; }
    unsigned prefix = 0u; bool exact = false; int it = 0;
    for (int bit = 31; bit >= 0; --bit, ++it) {
        const unsigned cand = prefix | (1u << bit);
        int wc = 0;
#pragma unroll
        for (int j = 0; j < NC; ++j) wc += __popcll(__ballot(v[j] >= cand));
        if (lane == 0) red[(it & 1) * 8 + wave] = wc;
        __syncthreads();
        int cnt = 0;
#pragma unroll
        for (int w = 0; w < 8; ++w) cnt += red[(it & 1) * 8 + w];
        if (cnt >= TOPK) prefix = cand;
        if (cnt == TOPK) { exact = true; break; }
    }
    const unsigned T = prefix;
    unsigned cg = 0u, ce = 0u;
#pragma unroll
    for (int j = 0; j < NC; ++j) { cg += (v[j] > T) ? 1u : 0u; ce += (v[j] == T) ? 1u : 0u; }
    const int wg_ = wave_sum_small<5>(cg), we_ = wave_sum_small<5>(ce);
    __syncthreads();
    if (lane == 0) { red[16 + wave] = wg_; red[24 + wave] = we_; }
    __syncthreads();
    int tot_gt = 0, eq_before = 0, gt_before = 0;
#pragma unroll
    for (int w = 0; w < 8; ++w) { const int g = red[16 + w], e = red[24 + w]; tot_gt += g; if (w < wave) { gt_before += g; eq_before += e; } }
    const int need = exact ? (1 << 30) : TOPK - tot_gt;
    int base_sel = gt_before + (eq_before < need ? eq_before : need), base_eq = eq_before;
    int ln = lane; asm volatile("" : "+v"(ln));
#pragma unroll
    for (int j = 0; j < NC; ++j) {
        const bool gt = v[j] > T, eq = v[j] == T;
        const unsigned long long eqm = __ballot(eq);
        const bool s = gt || (eq && (base_eq + mbcnt64(eqm)) < need);
        const unsigned long long sm = __ballot(s);
        if (s) sel[base_sel + mbcnt64(sm)] = (wave * NC + j) * 64 + ln;
        base_eq += __popcll(eqm); base_sel += __popcll(sm);
    }
    __syncthreads();
}
__device__ __forceinline__ void idx_sample_score_unit(const Params& p, int bs, int pg8) {
    const int tid_ = fresh_tid(), lane = tid_ & 63, wave = __builtin_amdgcn_readfirstlane(tid_ >> 6), r = lane & 31, kh = lane >> 5;
    unsigned char* ws = p.ws;
    const float* QI = (const float*)(ws + WS_QI); const float* WI = (const float*)(ws + WS_WI); float* SCS = (float*)(ws + WS_SCS);
    const bf16_t* KIH = (const bf16_t*)(ws + WS_KIH); const bf16_t* KIL = (const bf16_t*)(ws + WS_KIL);
    const float* cache_ki = p.in[4]; const int* page_table = (const int*)p.in[7];
    IdxQ q; idx_load_q(q, QI, WI, MP + bs * DS, lane);
    const int pg = pg8 * 8 + wave, phys = page_table[bs * NPAGES + pg];
    const float* pbase = cache_ki + (size_t)phys * PAGE * IDD + (size_t)r * IDD + kh * 8;
    float* out0 = SCS + (size_t)(bs * DS + 2 * kh) * SCS_LD;
    IdxRaw raw; idx_load_raw(raw, pbase);
    IdxKey k;
#pragma unroll
    for (int tt = 0; tt < 4; ++tt) {
        idx_cvt_key(raw, k);
        if (tt < 3) idx_load_raw(raw, pbase + (size_t)(tt + 1) * 32 * IDD);
        float s[2]; idx_tile(q, k, s);
        const int col = pg * PAGE + tt * 32 + r;
        out0[col] = s[0]; out0[SCS_LD + col] = s[1];
    }
    if (pg8 == 0 && wave == 0) {
        const size_t kr = (size_t)(MP + bs * DS + (r & 3)) * IDD + kh * 8;
        idx_load_keyb(k, KIH + kr, KIL + kr);
        float s[2]; idx_tile(q, k, s);
        if (r < DS) { out0[NPAST + r] = s[0]; out0[SCS_LD + NPAST + r] = s[1]; }
    }
}

__device__ __forceinline__ void select_row_list(const PG8_LAS float* sc, int n, int lane, int* sel) {
    constexpr int NJ = 136, NG = 17;
    unsigned v[NJ];
    const int nj = __builtin_amdgcn_readfirstlane((n + 63) >> 6), ng = (nj + 7) >> 3;
    const PG8_LAS float* pl = sc + lane;
#pragma unroll
    for (int j = 0; j < NJ; ++j) { const unsigned k = fkey(pl[j * 64]); v[j] = (lane < n - j * 64) ? k : 0u; }
    unsigned prefix = 0u; bool exact = false;
    for (int bit = 31; bit >= 0; --bit) {
        const unsigned cand = prefix | (1u << bit);
        int cnt = 0;
#pragma unroll
        for (int g = 0; g < NG; ++g) if (g < ng) cnt += count8_ge(v[g * 8], v[g * 8 + 1], v[g * 8 + 2], v[g * 8 + 3], v[g * 8 + 4], v[g * 8 + 5], v[g * 8 + 6], v[g * 8 + 7], cand);
        if (cnt >= TOPK) prefix = cand;
        if (cnt == TOPK) { exact = true; break; }
    }
    const unsigned T = prefix; int need = 1 << 30;
    if (!exact) {
        int cgt = 0;
#pragma unroll
        for (int j = 0; j < NJ; ++j) if (j < nj) cgt += __popcll(__ballot(v[j] > T));
        need = TOPK - cgt;
    }
    int base_eq = 0, base_sel = 0;
    int ln = lane; asm volatile("" : "+v"(ln));
#pragma unroll
    for (int j = 0; j < NJ; ++j) if (j < nj) {
        const bool gt = v[j] > T, eq = v[j] == T;
        const unsigned long long eqm = __ballot(eq);
        const bool s = gt || (eq && (base_eq + mbcnt64(eqm)) < need);
        const unsigned long long sm = __ballot(s);
        if (s) sel[base_sel + mbcnt64(sm)] = j * 64 + ln;
        base_eq += __popcll(eqm); base_sel += __popcll(sm);
    }
}
__device__ __forceinline__ void idx_sample_batch_unit(const Params& p, PG8_LAS unsigned char* lds, int bs) {
    const int tid_ = fresh_tid(), lane = tid_ & 63, wave = __builtin_amdgcn_readfirstlane(tid_ >> 6), r = lane & 31, kh = lane >> 5;
    unsigned char* ws = p.ws;
    const float* QI = (const float*)(ws + WS_QI); const float* WI = (const float*)(ws + WS_WI); int* SEL = (int*)(ws + WS_SEL);
    const bf16_t* KIH = (const bf16_t*)(ws + WS_KIH); const bf16_t* KIL = (const bf16_t*)(ws + WS_KIL);
    const float* cache_ki = p.in[4]; const int* page_table = (const int*)p.in[7];
    PG8_LAS float* sc = (PG8_LAS float*)lds;
    IdxQ q; idx_load_q(q, QI, WI, MP + bs * DS, lane);
    IdxRaw raw; IdxKey k;
    for (int pg = wave; pg < NPAGES; pg += NWAVES) {
        const int phys = page_table[bs * NPAGES + pg];
        const float* pbase = cache_ki + (size_t)phys * PAGE * IDD + (size_t)r * IDD + kh * 8;
        idx_load_raw(raw, pbase);
#pragma unroll
        for (int tt = 0; tt < 4; ++tt) {
            idx_cvt_key(raw, k);
            if (tt < 3) idx_load_raw(raw, pbase + (size_t)(tt + 1) * 32 * IDD);
            float s2[2]; idx_tile(q, k, s2);
            const int col = pg * PAGE + tt * 32 + r;
            sc[(2 * kh) * SCS_LDL + col] = s2[0]; sc[(2 * kh + 1) * SCS_LDL + col] = s2[1];
        }
    }
    if (wave == 0) {
        const size_t kr = (size_t)(MP + bs * DS + (r & 3)) * IDD + kh * 8;
        idx_load_keyb(k, KIH + kr, KIL + kr);
        float s2[2]; idx_tile(q, k, s2);
        if (r < DS) { sc[(2 * kh) * SCS_LDL + NPAST + r] = s2[0]; sc[(2 * kh + 1) * SCS_LDL + NPAST + r] = s2[1]; }
    }
    __syncthreads();
    if (wave < DS) select_row_list(sc + wave * SCS_LDL, NPAST + wave + 1, lane, SEL + (size_t)(bs * DS + wave) * TOPK);
    __syncthreads();
}
__device__ __forceinline__ void idx_prompt_unit(const Params& p, PG8_LAS unsigned char* lds, int s, int mode = 1) {
    const int tid_ = fresh_tid(), lane = tid_ & 63, wave = __builtin_amdgcn_readfirstlane(tid_ >> 6), r = lane & 31, kh = lane >> 5;
    unsigned char* ws = p.ws;
    const float* QI = (const float*)(ws + WS_QI); const float* WI = (const float*)(ws + WS_WI); unsigned long long* BM = (unsigned long long*)(ws + WS_BM);
    const bf16_t* KIH = (const bf16_t*)(ws + WS_KIH); const bf16_t* KIL = (const bf16_t*)(ws + WS_KIL);
    PG8_LAS float* sc = (PG8_LAS float*)lds;
    const int b = s & 1, q0 = (s >> 1) * 8, grow0 = b * SEQ + q0, ntile = (q0 + 8 + 31) >> 5;
    IdxQ qa, qb; idx_load_q(qa, QI, WI, grow0, lane); idx_load_q(qb, QI, WI, grow0 + 4, lane);
    const size_t kbase = (size_t)(b * SEQ + r) * IDD + kh * 8;
    IdxKey kn;
    if (wave < ntile) idx_load_keyb(kn, KIH + kbase + (size_t)wave * 32 * IDD, KIL + kbase + (size_t)wave * 32 * IDD);
    for (int t = wave; t < ntile; t += NWAVES) {
        const IdxKey k = kn;
        if (t + NWAVES < ntile) idx_load_keyb(kn, KIH + kbase + (size_t)(t + NWAVES) * 32 * IDD, KIL + kbase + (size_t)(t + NWAVES) * 32 * IDD);
        float sa[2], sb[2]; idx_tile(qa, k, sa); idx_tile(qb, k, sb);
        const int col = t * 32 + r;
        sc[(2 * kh) * SCP_LD + col] = sa[0]; sc[(2 * kh + 1) * SCP_LD + col] = sa[1];
        sc[(4 + 2 * kh) * SCP_LD + col] = sb[0]; sc[(5 + 2 * kh) * SCP_LD + col] = sb[1];
    }
    __syncthreads();
    if (mode == 1) select_row<64>(sc + wave * SCP_LD, q0 + wave + 1, lane, BM + (size_t)(grow0 + wave) * 64);
    if (mode == 2) select_row<64>(sc + wave * SCP_LD, q0 + wave + 1, lane, (unsigned long long*)(ws + WS_SEL) + (size_t)(grow0 + wave) * 64);
    if (mode == 3) select_row<64, 24>(sc + wave * SCP_LD, q0 + wave + 1, lane, (unsigned long long*)(ws + WS_SEL) + (size_t)(grow0 + wave) * 64);
}
__device__ __forceinline__ unsigned wq_next(unsigned* ctr, PG8_LAS unsigned char* lds) {
    volatile PG8_LAS unsigned* slot = (volatile PG8_LAS unsigned*)(lds + LDS_MISC + 64);
    __syncthreads();
    if (threadIdx.x == 0) *slot = atomicAdd(ctr, 1u);
    __syncthreads();
    return *slot;
}

constexpr int G_SC = 0, G_SEL = 32800, G_RED = 33824, G_QS = 34304, G_PS = 38400, G_KP = 46592, G_VP = 48640, G_OP = 50688;
__device__ __forceinline__ void sample_row_unit(const Params& p, PG8_LAS unsigned char* lds, int rs) {
    const int tid = fresh_tid(), lane = tid & 63, wave = tid >> 6;
    unsigned char* ws = p.ws;
    const bf16_t* QB = (const bf16_t*)(ws + WS_QB); const float* SCS = (const float*)(ws + WS_SCS);
    const float* cache_k = p.in[2]; const float* cache_v = p.in[3]; const int* page_table = (const int*)p.in[7];
    bf16_t* CATB = (bf16_t*)(ws + WS_CATB); float* PS = (float*)(ws + WS_PS);
    const int row = MP + rs, b = rs / DS, n = NPAST + (rs % DS) + 1;
    PG8_LAS float* sc = (PG8_LAS float*)(lds + G_SC);
    PG8_LAS int* sel = (PG8_LAS int*)(lds + G_SEL);
    PG8_LAS float* qs = (PG8_LAS float*)(lds + G_QS);
    PG8_LAS float* ps = (PG8_LAS float*)(lds + G_PS);
    PG8_LAS unsigned long long* kps = (PG8_LAS unsigned long long*)(lds + G_KP);
    PG8_LAS unsigned long long* vps = (PG8_LAS unsigned long long*)(lds + G_VP);
    PG8_LAS float* op = (PG8_LAS float*)(lds + G_OP);
    { const bf16_t* z = QB + (size_t)row * 1024; qs[tid] = __uint_as_float((unsigned)z[tid] << 16); qs[tid + 512] = __uint_as_float((unsigned)z[tid + 512] << 16); }
    __syncthreads();
    (void)sc; (void)SCS; (void)n; (void)sel;
    if (tid < TOPK) {
        const int idx = ((const int*)(ws + WS_SEL))[(size_t)rs * TOPK + tid];
        const float* kp; const float* vp;
        if (idx < NPAST) { const size_t prow = (size_t)page_table[b * NPAGES + idx / PAGE] * PAGE + (idx % PAGE); kp = cache_k + prow * 512; vp = cache_v + prow * 512; }
        else { const size_t zr = (size_t)(b * DS + idx - NPAST); kp = p.out + O_KS + zr * 512; vp = p.out + O_VS + zr * 512; }
        kps[tid] = (unsigned long long)kp; vps[tid] = (unsigned long long)vp;
    }
    __syncthreads();
    {
        const int j = tid & 255, hg = tid >> 8;
        const float* kp = (const float*)kps[j] + hg * 256;
#pragma unroll
        for (int n2 = 0; n2 < 2; ++n2) {
            float d0 = 0.f, d1 = 0.f;
            const PG8_LAS float* q0 = qs + (4 * hg + 2 * n2) * HD; const PG8_LAS float* q1 = q0 + HD;
#pragma unroll 8
            for (int d = 0; d < HD; d += 4) {
                const f32x4 k4 = *(const f32x4*)(kp + n2 * HD + d);
                d0 += q0[d] * k4[0] + q0[d + 1] * k4[1] + q0[d + 2] * k4[2] + q0[d + 3] * k4[3];
                d1 += q1[d] * k4[0] + q1[d + 1] * k4[1] + q1[d + 2] * k4[2] + q1[d + 3] * k4[3];
            }
            ps[(4 * hg + 2 * n2) * TOPK + j] = d0 * ATTN_SCALE; ps[(4 * hg + 2 * n2 + 1) * TOPK + j] = d1 * ATTN_SCALE;
        }
    }
    __syncthreads();
    {
        float v[4]; float m = -INFINITY;
#pragma unroll
        for (int i = 0; i < 4; ++i) { v[i] = ps[wave * TOPK + lane + 64 * i]; m = fmaxf(m, v[i]); }
#pragma unroll
        for (int o = 32; o >= 1; o >>= 1) m = fmaxf(m, __shfl_xor(m, o));
        float sum = 0.f;
#pragma unroll
        for (int i = 0; i < 4; ++i) { v[i] = expf(v[i] - m); sum += v[i]; }
#pragma unroll
        for (int o = 32; o >= 1; o >>= 1) sum += __shfl_xor(sum, o);
        const float inv = 1.0f / sum;
#pragma unroll
        for (int i = 0; i < 4; ++i) ps[wave * TOPK + lane + 64 * i] = v[i] * inv;
    }
    __syncthreads();
    {
        const int o4 = tid & 255, kq = tid >> 8, hq = o4 >> 5, d = (o4 & 31) * 4, nkv = hq >> 1;
        f32x4 acc = (f32x4){0.f, 0.f, 0.f, 0.f};
#pragma unroll 8
        for (int j = kq * 128; j < kq * 128 + 128; ++j) acc += *(const f32x4*)((const float*)vps[j] + nkv * HD + d) * ps[hq * TOPK + j];
        if (kq == 1) *(PG8_LAS f32x4*)(op + o4 * 4) = acc;
        __syncthreads();
        if (kq == 0) {
            acc += *(const PG8_LAS f32x4*)(op + o4 * 4);
            u32x2 w; w.x = cvt_pk_bf16(acc[0], acc[1]); w.y = cvt_pk_bf16(acc[2], acc[3]);
            *(u32x2*)(CATB + (size_t)row * D + 1024 + o4 * 4) = w;
        }
    }
    __syncthreads();
}

typedef short s16x4 __attribute__((ext_vector_type(4)));
constexpr int A_KP = 272, A_VP = 320, A_KBYTES = 64 * A_KP, A_VBYTES = 64 * A_VP, A_STAGE = A_KBYTES + A_VBYTES;
constexpr float A_SC = 0.08838834764831845f * 1.4426950408889634f;
__device__ __forceinline__ float xhalf_max(float x) { const auto sw = __builtin_amdgcn_permlane32_swap(__float_as_uint(x), __float_as_uint(x), false, false); return fmaxf(__uint_as_float(sw[0]), __uint_as_float(sw[1])); }
__device__ __forceinline__ float xhalf_sum(float x) { const auto sw = __builtin_amdgcn_permlane32_swap(__float_as_uint(x), __float_as_uint(x), false, false); return __uint_as_float(sw[0]) + __uint_as_float(sw[1]); }
__device__ __forceinline__ void attn_dense_unit(const Params& p, PG8_LAS unsigned char* lds, int b, int n, int qb) {
    const int tid = fresh_tid(), lane = tid & 63, wave = __builtin_amdgcn_readfirstlane(tid >> 6), r = lane & 31, kh = lane >> 5;
    unsigned char* ws = p.ws;
    const bf16_t* QB = (const bf16_t*)(ws + WS_QB); const bf16_t* KB = (const bf16_t*)(ws + WS_KB); const bf16_t* VB = (const bf16_t*)(ws + WS_VB);
    const unsigned long long* BM = (const unsigned long long*)(ws + WS_BM);
    bf16_t* CATB = (bf16_t*)(ws + WS_CATB); float* PS = (float*)(ws + WS_PS);
    const int q = qb * 128 + wave * 16 + (r & 15), head = 2 * n + (r >> 4);
    const size_t qrow = (size_t)b * SEQ + q;
    bf16x8 qf[8];
#pragma unroll
    for (int ks = 0; ks < 8; ++ks) qf[ks] = *(const bf16x8*)(QB + qrow * 1024 + head * HD + ks * 16 + kh * 8);
    f32x16 O[4];
#pragma unroll
    for (int dt = 0; dt < 4; ++dt)
#pragma unroll
        for (int i = 0; i < 16; ++i) O[dt][i] = 0.f;
    float m = -INFINITY, l = 0.f;
    const int ntile = 2 * qb + 2, qmax_w = qb * 128 + wave * 16 + 15;
    const int srow = tid >> 4, sch = tid & 15;
    const bf16_t* kg = KB + ((size_t)b * SEQ + srow) * 512 + n * HD + sch * 8;
    const bf16_t* vg = VB + ((size_t)b * SEQ + srow) * 512 + n * HD + sch * 8;
    u32x4 kst[2], vst[2];
#define A_GLOAD(t) do { _Pragma("unroll") for (int _i = 0; _i < 2; ++_i) { kst[_i] = *(const u32x4*)(kg + (size_t)((t) * 64 + _i * 32) * 512); vst[_i] = *(const u32x4*)(vg + (size_t)((t) * 64 + _i * 32) * 512); } } while (0)
#define A_LSTORE(buf) do { _Pragma("unroll") for (int _i = 0; _i < 2; ++_i) { *(PG8_LAS u32x4*)(lds + (buf) * A_STAGE + (srow + _i * 32) * A_KP + sch * 16) = kst[_i]; \
        *(PG8_LAS u32x4*)(lds + (buf) * A_STAGE + A_KBYTES + (srow + _i * 32) * A_VP + sch * 16) = vst[_i]; } } while (0)
    A_GLOAD(0); A_LSTORE(0);
    unsigned long long mw = BM[qrow * 64];
    __syncthreads();
    const int i16 = lane & 15, g2 = (lane >> 4) & 1;
    const int vlane_off = (4 * kh + (i16 >> 2)) * A_VP + (16 * g2 + 4 * (i16 & 3)) * 2;
    for (int t = 0; t < ntile; ++t) {
        const bool more = (t + 1 < ntile);
        if (more) A_GLOAD(t + 1);
        const unsigned long long mw_next = more ? BM[qrow * 64 + t + 1] : 0ull;
        const int buf = t & 1;
        if (t * 64 <= qmax_w) {
            PG8_LAS unsigned char* kb = lds + buf * A_STAGE; PG8_LAS unsigned char* vb = kb + A_KBYTES;
            f32x16 s0, s1;
#pragma unroll
            for (int i = 0; i < 16; ++i) { s0[i] = 0.f; s1[i] = 0.f; }
#pragma unroll
            for (int ks = 0; ks < 8; ++ks) {
                const bf16x8 k0 = *(const PG8_LAS bf16x8*)(kb + r * A_KP + (ks * 16 + kh * 8) * 2);
                const bf16x8 k1 = *(const PG8_LAS bf16x8*)(kb + (32 + r) * A_KP + (ks * 16 + kh * 8) * 2);
                s0 = __builtin_amdgcn_mfma_f32_32x32x16_bf16(k0, qf[ks], s0, 0, 0, 0);
                s1 = __builtin_amdgcn_mfma_f32_32x32x16_bf16(k1, qf[ks], s1, 0, 0, 0);
            }
            const unsigned lo = (unsigned)mw >> (4 * kh), hi = (unsigned)(mw >> 32) >> (4 * kh);
            float mx = -INFINITY;
#pragma unroll
            for (int i = 0; i < 16; ++i) {
                const unsigned bit = 1u << ((i & 3) + 8 * (i >> 2));
                s0[i] = (lo & bit) ? s0[i] * A_SC : -INFINITY; s1[i] = (hi & bit) ? s1[i] * A_SC : -INFINITY;
                mx = fmaxf(mx, fmaxf(s0[i], s1[i]));
            }
            mx = xhalf_max(mx);
            const float m_new = fmaxf(m, mx), m_safe = (m_new == -INFINITY) ? 0.f : m_new;
            const float alpha = __builtin_amdgcn_exp2f(m - m_safe);
            float lsum = 0.f;
#pragma unroll
            for (int i = 0; i < 16; ++i) { s0[i] = __builtin_amdgcn_exp2f(s0[i] - m_safe); s1[i] = __builtin_amdgcn_exp2f(s1[i] - m_safe); lsum += s0[i] + s1[i]; }
            l = l * alpha + lsum; m = m_new;
            if (__ballot(alpha != 1.0f) != 0ull) {
#pragma unroll
                for (int dt = 0; dt < 4; ++dt)
#pragma unroll
                    for (int i = 0; i < 16; ++i) O[dt][i] *= alpha;
            }
            bf16x8 pf[2][2];
#pragma unroll
            for (int sx = 0; sx < 2; ++sx) {
                u32x4 w0, w1;
                w0.x = cvt_pk_bf16(s0[8 * sx], s0[8 * sx + 1]); w0.y = cvt_pk_bf16(s0[8 * sx + 2], s0[8 * sx + 3]); w0.z = cvt_pk_bf16(s0[8 * sx + 4], s0[8 * sx + 5]); w0.w = cvt_pk_bf16(s0[8 * sx + 6], s0[8 * sx + 7]);
                w1.x = cvt_pk_bf16(s1[8 * sx], s1[8 * sx + 1]); w1.y = cvt_pk_bf16(s1[8 * sx + 2], s1[8 * sx + 3]); w1.z = cvt_pk_bf16(s1[8 * sx + 4], s1[8 * sx + 5]); w1.w = cvt_pk_bf16(s1[8 * sx + 6], s1[8 * sx + 7]);
                pf[0][sx] = __builtin_bit_cast(bf16x8, w0); pf[1][sx] = __builtin_bit_cast(bf16x8, w1);
            }
#pragma unroll
            for (int st = 0; st < 2; ++st)
#pragma unroll
                for (int sx = 0; sx < 2; ++sx)
#pragma unroll
                    for (int dt = 0; dt < 4; ++dt) {
                        PG8_LAS unsigned char* a = vb + vlane_off + (st * 32 + 16 * sx) * A_VP + dt * 64;
                        const s16x4 vlo = __builtin_amdgcn_ds_read_tr16_b64_v4i16((PG8_LAS s16x4*)a);
                        const s16x4 vhi = __builtin_amdgcn_ds_read_tr16_b64_v4i16((PG8_LAS s16x4*)(a + 8 * A_VP));
                        const bf16x8 vf = __builtin_shufflevector(vlo, vhi, 0, 1, 2, 3, 4, 5, 6, 7);
                        O[dt] = __builtin_amdgcn_mfma_f32_32x32x16_bf16(vf, pf[st][sx], O[dt], 0, 0, 0);
                    }
        }
        if (more) A_LSTORE(buf ^ 1);
        __syncthreads();
        mw = mw_next;
    }
#undef A_GLOAD
#undef A_LSTORE
    const float inv = 1.0f / xhalf_sum(l);
    bf16_t* orow = CATB + qrow * D + 1024 + head * HD;
#pragma unroll
    for (int dt = 0; dt < 4; ++dt)
#pragma unroll
        for (int a = 0; a < 4; ++a) {
            u32x2 w; w.x = cvt_pk_bf16(O[dt][4 * a] * inv, O[dt][4 * a + 1] * inv); w.y = cvt_pk_bf16(O[dt][4 * a + 2] * inv, O[dt][4 * a + 3] * inv);
            *(u32x2*)(orow + 32 * dt + 8 * a + 4 * kh) = w;
        }
}
__device__ __forceinline__ void attn_phase(const Params& p, PG8_LAS unsigned char* lds, int ctr_off = 0) {
    const int G = gridDim.x;
    for (int u = blockIdx.x; u < 256; u += G) { const int qb = 31 - (u >> 3), bn = u & 7; attn_dense_unit(p, lds, bn >> 2, bn & 3, qb); }
    unsigned* ctr = (unsigned*)(p.ws + WS_CTR) + ctr_off;
    for (;;) {
        const unsigned idx = wq_next(ctr, lds);
        if (idx >= (unsigned)(MS + LRU_NCHUNK)) break;
        if (idx < (unsigned)MS) sample_row_unit(p, lds, (int)idx); else lru_fixup_unit(p, (int)idx - MS);
    }
}
__device__ __forceinline__ void mid1_phase(const Params& p, PG8_LAS unsigned char* lds) {
    unsigned* ctr = (unsigned*)(p.ws + WS_CTR) + 64;
    constexpr unsigned NA = DB, NB_ = MP / 8, NC_ = LRU_NCHUNK * 8;
    for (;;) {
        const unsigned idx = wq_next(ctr, lds);
        constexpr unsigned XA_ = (MID_DUP == 1) ? NA : 0u, XB_ = (MID_DUP >= 6) ? NB_ : 0u, XC_ = (MID_DUP == 3) ? NC_ : 0u;
        if (idx >= NA + XA_ + NB_ + XB_ + NC_ + XC_) break;
        if (idx < NA + XA_) { const unsigned u = idx % NA; idx_sample_batch_unit(p, lds, (int)u); }
        else if (idx < NA + XA_ + NB_) idx_prompt_unit(p, lds, (int)(NB_ - 1 - (idx - NA - XA_)));
        else if (idx < NA + XA_ + NB_ + XB_) idx_prompt_unit(p, lds, (int)(NB_ - 1 - (idx - NA - XA_ - NB_)), MID_DUP == 6 ? 2 : (MID_DUP == 7 ? 3 : 0));
        else lru_local_unit(p, lds, (int)((idx - NA - XA_ - NB_ - XB_) % NC_));
    }
}

__device__ __forceinline__ void prep_phase(const Params& p, PG8_LAS unsigned char* lds) {
    unsigned char* ws = p.ws;
    bf16_t* Wgu1 = (bf16_t*)(ws + WS_WGU1); bf16_t* Wd1 = (bf16_t*)(ws + WS_WD1); bf16_t* Win = (bf16_t*)(ws + WS_WIN); bf16_t* Wout = (bf16_t*)(ws + WS_WOUT);
    bf16_t* Wgu2 = (bf16_t*)(ws + WS_WGU2); bf16_t* Wd2 = (bf16_t*)(ws + WS_WD2); bf16_t* XB = (bf16_t*)(ws + WS_XB);
    PG8_LAS float* tile = (PG8_LAS float*)lds;
    const int wid = blockIdx.x, nw = gridDim.x;
    transpose_cvt<1>(p.in[10], D, 2 * DFF, 2 * DFF, Wgu1, tile, wid, nw);
    cvt_x(p.in[0], p.in[1], XB);
    for (int n = 0; n < 8; ++n) { transpose_cvt<0>(p.in[15] + n * 16384, 128, 128, 128, (bf16_t*)(ws + WS_WAT) + n * 16384, tile, wid, nw); transpose_cvt<0>(p.in[17] + n * 16384, 128, 128, 128, (bf16_t*)(ws + WS_WIT) + n * 16384, tile, wid, nw); }
    (void)Wd1; (void)Win; (void)Wout; (void)Wgu2; (void)Wd2;
}
__device__ __forceinline__ void tail_cvt(const Params& p, PG8_LAS unsigned char* lds, int which, int nunits) {
    const int G = gridDim.x, c = blockIdx.x, full = nunits / G, rem = nunits - full * G;
    if (rem != 0 && c < rem) return;
    const int wid = (rem == 0) ? c : c - rem, nw = (rem == 0) ? G : G - rem;
    unsigned char* ws = p.ws; PG8_LAS float* tile = (PG8_LAS float*)lds;
    __syncthreads();
    if (which == 0) {
        transpose_cvt<0>(p.in[11], DFF, D, D, (bf16_t*)(ws + WS_WD1), tile, wid, nw);
        transpose_cvt<0>(p.in[12], D, DIN, DINP, (bf16_t*)(ws + WS_WIN), tile, wid, nw);
        transpose_cvt<0>(p.in[20], D, D, D, (bf16_t*)(ws + WS_WOUT), tile, wid, nw);
    } else if (which == 1) transpose_cvt<1>(p.in[23], D, 2 * DFF, 2 * DFF, (bf16_t*)(ws + WS_WGU2), tile, wid, nw);
    else transpose_cvt<0>(p.in[24], DFF, D, D, (bf16_t*)(ws + WS_WD2), tile, wid, nw);
}

__global__ void __launch_bounds__(NTHREADS, 2) mk_fwd(Params p) {
    extern __shared__ __attribute__((aligned(16))) unsigned char lds_raw[];
    PG8_LAS unsigned char* lds = (PG8_LAS unsigned char*)lds_raw;
    unsigned char* ws = p.ws;
    const int lo = p.ph_lo, hi = p.ph_hi;
    const int G = gridDim.x;
    if (threadIdx.x < 4) ((volatile PG8_LAS unsigned*)(lds + LDS_MISC))[threadIdx.x] = 0u;
    __syncthreads();
    XcdBarrier bar = xcd_barrier_post((unsigned*)(ws + WS_CTL) + (size_t)p.li * XCD_BAR_WORDS, (volatile LAS unsigned*)(lds + LDS_MISC));
#define SEAM(k) do { if (lo <= (k) && (k) + 1 < hi) xcd_barrier(bar); } while (0)
    bf16_t* Wgu1 = (bf16_t*)(ws + WS_WGU1); bf16_t* Wd1 = (bf16_t*)(ws + WS_WD1); bf16_t* Win = (bf16_t*)(ws + WS_WIN); bf16_t* Wout = (bf16_t*)(ws + WS_WOUT);
    bf16_t* Wgu2 = (bf16_t*)(ws + WS_WGU2); bf16_t* Wd2 = (bf16_t*)(ws + WS_WD2);
    bf16_t* XB = (bf16_t*)(ws + WS_XB); bf16_t* H = (bf16_t*)(ws + WS_H); float* T = (float*)(ws + WS_T); float* X1 = (float*)(ws + WS_X1); float* X2 = (float*)(ws + WS_X2);
    bf16_t* CATB = (bf16_t*)(ws + WS_CATB); float* PS = (float*)(ws + WS_PS); float* ST1 = (float*)(ws + WS_ST); float* ST2 = ST1 + 2 * MP;
#define IN(k) (lo <= (k) && (k) < hi)
    if (IN(0)) prep_phase(p, lds);
    SEAM(0);
    if (IN(1)) {
        pg8::Gemm g{XB, Wgu1, MPAD, 2 * DFF, D}; pg8::StaticOrder S; S.init(MPAD, 2 * DFF, G, (int)blockIdx.x, D);
        EpiSwiGLU E{H};
        pg8::gemm_phase<EpiSwiGLU, pg8::StaticOrder, true, true>(lds, g, S, E);
        tail_cvt(p, lds, 0, (MPAD / 256) * (2 * DFF / 256));
    }
    SEAM(1);
    if (IN(2)) {
        pg8::Gemm g{H, Wd1, MPAD, D, DFF}; SplitOrder S; S.init(D, DFF, G, (int)blockIdx.x);
        EpiResidSplit E{p.in[0], T, PS, 0.5f, nullptr, nullptr, nullptr};
        pg8::gemm_phase<EpiResidSplit, SplitOrder, true, true>(lds, g, S, E);
    }
    SEAM(2);
    if (IN(3)) ln_phase(T, p.in[8], p.in[9], X1, XB, PS, DFF / 256, p.in[1], 0.5f, ST1);
    SEAM(3);
    if (IN(4)) {
        pg8::Gemm g{XB, Win, MPAD, DINP, D}; pg8::StaticOrder S; S.init(MPAD, DINP, G, (int)blockIdx.x, D);
        EpiWin E{(float*)(ws + WS_XR), (float*)(ws + WS_GG), (bf16_t*)(ws + WS_QB), (bf16_t*)(ws + WS_KB), (bf16_t*)(ws + WS_VB), (float*)(ws + WS_QI), (bf16_t*)(ws + WS_KIH), (bf16_t*)(ws + WS_KIL), (float*)(ws + WS_WI), p.out};
        pg8::gemm_phase<EpiWin, pg8::StaticOrder, true, true>(lds, g, S, E);
        tail_cvt(p, lds, 1, (MPAD / 256) * (DINP / 256));
    }
    SEAM(4);
    if (IN(5)) mid1_phase(p, lds);
    SEAM(5);
    if (IN(6)) { attn_phase(p, lds); if (REP_6 > 1) { __syncthreads(); attn_phase(p, lds, 128); } }
    SEAM(6);
    if (IN(7)) {
        pg8::Gemm g{CATB, Wout, MPAD, D, D}; SplitOrder S; S.init(D, D, G, (int)blockIdx.x);
        EpiResidSplit E{nullptr, T, PS, 1.0f, ST1, p.in[8], p.in[9]};
        pg8::gemm_phase<EpiResidSplit, SplitOrder, true, true>(lds, g, S, E);
    }
    SEAM(7);
    if (IN(8)) ln_phase(T, p.in[21], p.in[22], X2, XB, PS, D / 256, X1 + (size_t)MP * D, 1.0f, ST2);
    SEAM(8);
    if (IN(9)) {
        pg8::Gemm g{XB, Wgu2, MPAD, 2 * DFF, D}; pg8::StaticOrder S; S.init(MPAD, 2 * DFF, G, (int)blockIdx.x, D);
        EpiSwiGLU E{H};
        pg8::gemm_phase<EpiSwiGLU, pg8::StaticOrder, true, true>(lds, g, S, E);
        tail_cvt(p, lds, 2, (MPAD / 256) * (2 * DFF / 256));
    }
    SEAM(9);
    if (IN(10)) {
        pg8::Gemm g{H, Wd2, MPAD, D, DFF}; SplitOrder S; S.init(D, DFF, G, (int)blockIdx.x);
        EpiResidSplit E{nullptr, T, PS, 0.5f, ST2, p.in[21], p.in[22]};
        pg8::gemm_phase<EpiResidSplit, SplitOrder, true, true>(lds, g, S, E);
    }
    SEAM(10);
    if (IN(11)) ln_phase(T, p.in[25], p.in[26], p.out + O_YP, nullptr, PS, DFF / 256, X2 + (size_t)MP * D, 0.5f, nullptr);
#undef IN
#undef SEAM
}

}

extern "C" void kernel_launch(void* const* d_in, const int* in_sizes, int n_in, void* d_out, int out_size, void* d_ws, size_t ws_size, hipStream_t stream) {
    static int grid = 0;
    if (grid == 0) {
        if (n_in != 27 || ws_size < WS_END3) { grid = -1; return; }
        int dev = 0, cus = 0;
        if (hipGetDevice(&dev) != hipSuccess || hipDeviceGetAttribute(&cus, hipDeviceAttributeMultiprocessorCount, dev) != hipSuccess) { grid = -1; return; }
        if (hipFuncSetAttribute((const void*)mk_fwd, hipFuncAttributeMaxDynamicSharedMemorySize, LDS_BYTES) != hipSuccess) { grid = -1; return; }
        (void)hipGetLastError();
        grid = cus;
    }
    if (grid < 0) return;
    float* out = (float*)d_out;
    unsigned char* ws = (unsigned char*)d_ws;

    (void)hipMemsetAsync(ws + WS_CTL, 0, CTL_BYTES, stream);
    Params p{};
    for (int i = 0; i < 27; ++i) p.in[i] = (const float*)d_in[i];
    p.out = out; p.ws = ws;
    int nli = 0;
    auto run = [&](int lo, int hi) { p.ph_lo = lo; p.ph_hi = hi; p.li = nli++; hipLaunchKernelGGL(mk_fwd, dim3(grid), dim3(NTHREADS), LDS_BYTES, stream, p); };
    run(0, 12);
}
```
